# Optimizing an MI355X kernel written in HIP

```python
import jax, jax.numpy as jnp
from jax import lax
import numpy as np

D_MODEL = 1024
BATCH = 16
SEQ = 2048
DEPTH = 1

CHUNK = 64
LEFT_CHUNKS = 8
BAND = (LEFT_CHUNKS + 1) * CHUNK
Q_BLOCK = 128
MLA_HEADS = 8
MLA_Q_RANK = 256
MLA_KV_RANK = 128
MLA_NOPE = 64
MLA_ROPE = 32
MLA_QK = MLA_NOPE + MLA_ROPE
MLA_V = 64
ROPE_THETA = 10000.0
CA_HEADS = 8
CA_HEAD_DIM = 64
REL_CLIP = 128
D_MIX = MLA_HEADS * MLA_V + CA_HEADS * CA_HEAD_DIM
D_IN = MLA_Q_RANK + MLA_KV_RANK + MLA_ROPE + 3 * CA_HEADS * CA_HEAD_DIM
D_FF = 2816
CONV_WIDTH = 3
N_MOD = 6
EPS = 1e-6
NEG_INF = -1e30

kernel_name = "hybrid_mla_chunkband_convffn_adaln"


def rmsnorm(x, g):
    xf = x.astype(jnp.float32)
    y = xf * lax.rsqrt(jnp.mean(xf * xf, axis=-1, keepdims=True) + EPS)
    return (y * g.astype(jnp.float32)).astype(x.dtype)


def modulate(h, shift, scale):
    return h * (1 + scale[:, None, :]) + shift[:, None, :]


def rope(x, positions):
    half = x.shape[-1] // 2
    inv = jnp.power(ROPE_THETA, -jnp.arange(half, dtype=jnp.float32) / half)
    ang = positions.astype(jnp.float32)[..., None] * inv
    cos = jnp.cos(ang)[:, :, None, :]
    sin = jnp.sin(ang)[:, :, None, :]
    xf = x.astype(jnp.float32)
    x1, x2 = xf[..., :half], xf[..., half:]
    out = jnp.concatenate([x1 * cos - x2 * sin, x2 * cos + x1 * sin], axis=-1)
    return out.astype(x.dtype)


def mla_attention(q, k, v):
    B, S, H, Dq = q.shape
    nqb = S // Q_BLOCK
    scale = Dq ** -0.5
    key_chunk = jnp.arange(S) // CHUNK
    qb = q.reshape(B, nqb, Q_BLOCK, H, Dq).swapaxes(0, 1)

    def block(args):
        qi, i = args
        s = jnp.einsum('bqhd,bkhd->bhqk', qi, k,
                       preferred_element_type=jnp.float32) * scale
        q_chunk = (i * Q_BLOCK + jnp.arange(Q_BLOCK)) // CHUNK
        mask = key_chunk[None, :] <= q_chunk[:, None]
        s = jnp.where(mask[None, None], s, NEG_INF)
        p = jax.nn.softmax(s, axis=-1).astype(v.dtype)
        return jnp.einsum('bhqk,bkhd->bqhd', p, v)

    o = lax.map(block, (qb, jnp.arange(nqb)))
    return o.swapaxes(0, 1).reshape(B, S, H * v.shape[-1])


def chunk_attention(q, k, v, rel_bias):
    B, S, H, D = q.shape
    nc = S // CHUNK
    pad = LEFT_CHUNKS * CHUNK
    scale = D ** -0.5
    k_pad = jnp.pad(k, ((0, 0), (pad, 0), (0, 0), (0, 0)))
    v_pad = jnp.pad(v, ((0, 0), (pad, 0), (0, 0), (0, 0)))
    qi = jnp.arange(CHUNK)
    kj = jnp.arange(BAND)
    rel = (pad + qi[:, None]) - kj[None, :]
    bias = rel_bias[:, jnp.clip(rel, -REL_CLIP, REL_CLIP) + REL_CLIP].astype(jnp.float32)
    qc = q.reshape(B, nc, CHUNK, H, D).swapaxes(0, 1)

    def one_chunk(args):
        qch, ci = args
        kb = lax.dynamic_slice_in_dim(k_pad, ci * CHUNK, BAND, axis=1)
        vb = lax.dynamic_slice_in_dim(v_pad, ci * CHUNK, BAND, axis=1)
        s = jnp.einsum('bqhd,bkhd->bhqk', qch, kb,
                       preferred_element_type=jnp.float32) * scale + bias[None]
        valid = kj >= (LEFT_CHUNKS - ci) * CHUNK
        s = jnp.where(valid[None, None, None, :], s, NEG_INF)
        p = jax.nn.softmax(s, axis=-1).astype(vb.dtype)
        return jnp.einsum('bhqk,bkhd->bqhd', p, vb)

    o = lax.map(one_chunk, (qc, jnp.arange(nc)))
    return o.swapaxes(0, 1).reshape(B, S, H * D)


def causal_dwconv(u, w, b):
    S = u.shape[1]
    up = jnp.pad(u, ((0, 0), (CONV_WIDTH - 1, 0), (0, 0)))
    out = up[:, 0:S] * w[0]
    for j in range(1, CONV_WIDTH):
        out = out + up[:, j:j + S] * w[j]
    return out + b


def setup_inputs(seed: int = 0) -> dict:
    key = jax.random.key(seed)
    ks = jax.random.split(key, 24)
    f32 = jnp.float32

    def nrm(k, shape, fan_in):
        return jax.random.normal(k, shape, f32) * (fan_in ** -0.5)

    def gain(k, shape):
        return 1.0 + 0.05 * jax.random.normal(k, shape, f32)

    L = DEPTH
    x = jax.random.normal(ks[0], (BATCH, SEQ, D_MODEL), f32)
    c = jax.random.normal(ks[1], (BATCH, D_MODEL), f32)
    offsets = jax.random.randint(ks[2], (BATCH, 1), 0, 4096, dtype=jnp.int32)
    positions = (offsets + jnp.arange(SEQ, dtype=jnp.int32)[None, :]).astype(jnp.int32)
    return {
        "x": x,
        "c": c,
        "positions": positions,
        "w_ada": nrm(ks[3], (L, D_MODEL, N_MOD * D_MODEL), D_MODEL),
        "b_ada": 0.02 * jax.random.normal(ks[4], (L, N_MOD * D_MODEL), f32),
        "g_attn_norm": gain(ks[5], (L, D_MODEL)),
        "w_in": nrm(ks[6], (L, D_MODEL, D_IN), D_MODEL),
        "g_q_latent": gain(ks[7], (L, MLA_Q_RANK)),
        "g_kv_latent": gain(ks[8], (L, MLA_KV_RANK)),
        "w_q_up": nrm(ks[9], (L, MLA_Q_RANK, MLA_HEADS * MLA_QK), MLA_Q_RANK),
        "w_kv_up": nrm(ks[10], (L, MLA_KV_RANK, MLA_HEADS * (MLA_NOPE + MLA_V)), MLA_KV_RANK),
        "g_mla_q": gain(ks[11], (L, MLA_QK)),
        "g_mla_k": gain(ks[12], (L, MLA_QK)),
        "g_ca_q": gain(ks[13], (L, CA_HEAD_DIM)),
        "g_ca_k": gain(ks[14], (L, CA_HEAD_DIM)),
        "rel_bias": 0.5 * jax.random.normal(ks[15], (L, CA_HEADS, 2 * REL_CLIP + 1), f32),
        "w_out": nrm(ks[16], (L, D_MIX, D_MODEL), D_MIX),
        "g_mlp_norm": gain(ks[17], (L, D_MODEL)),
        "w_up": nrm(ks[18], (L, D_MODEL, 2 * D_FF), D_MODEL),
        "conv_w": nrm(ks[19], (L, CONV_WIDTH, 2 * D_FF), CONV_WIDTH),
        "conv_b": 0.02 * jax.random.normal(ks[20], (L, 2 * D_FF), f32),
        "w_down": nrm(ks[21], (L, D_FF, D_MODEL), D_FF),
    }


def reference(x, c, positions, w_ada, b_ada, g_attn_norm, w_in, g_q_latent, g_kv_latent,
              w_q_up, w_kv_up, g_mla_q, g_mla_k, g_ca_q, g_ca_k, rel_bias, w_out,
              g_mlp_norm, w_up, conv_w, conv_b, w_down):
    B, S, _ = x.shape
    split_pts = [MLA_Q_RANK, MLA_Q_RANK + MLA_KV_RANK, MLA_Q_RANK + MLA_KV_RANK + MLA_ROPE]
    for l in range(DEPTH):
        mod = jnp.dot(jax.nn.silu(c), w_ada[l]) + b_ada[l]
        sh_a, sc_a, g_a, sh_m, sc_m, g_m = jnp.split(mod, N_MOD, axis=-1)

        h = modulate(rmsnorm(x, g_attn_norm[l]), sh_a, sc_a)
        proj = jnp.dot(h, w_in[l])
        q_lat, kv_lat, k_rope, ca_qkv = jnp.split(proj, split_pts, axis=-1)

        q = jnp.dot(rmsnorm(q_lat, g_q_latent[l]), w_q_up[l]).reshape(B, S, MLA_HEADS, MLA_QK)
        kv = jnp.dot(rmsnorm(kv_lat, g_kv_latent[l]), w_kv_up[l]).reshape(B, S, MLA_HEADS, MLA_NOPE + MLA_V)
        k_nope, v = kv[..., :MLA_NOPE], kv[..., MLA_NOPE:]
        k = jnp.concatenate(
            [k_nope, jnp.broadcast_to(k_rope[:, :, None, :], (B, S, MLA_HEADS, MLA_ROPE))], axis=-1)
        q = rmsnorm(q, g_mla_q[l])
        k = rmsnorm(k, g_mla_k[l])
        q = jnp.concatenate([q[..., :MLA_NOPE], rope(q[..., MLA_NOPE:], positions)], axis=-1)
        k = jnp.concatenate([k[..., :MLA_NOPE], rope(k[..., MLA_NOPE:], positions)], axis=-1)
        o_mla = mla_attention(q, k, v)

        ca = ca_qkv.reshape(B, S, 3, CA_HEADS, CA_HEAD_DIM)
        cq = rmsnorm(ca[:, :, 0], g_ca_q[l])
        ck = rmsnorm(ca[:, :, 1], g_ca_k[l])
        cv = ca[:, :, 2]
        o_ca = chunk_attention(cq, ck, cv, rel_bias[l])

        mixed = jnp.dot(jnp.concatenate([o_mla, o_ca], axis=-1), w_out[l])
        x = x + g_a[:, None, :] * mixed

        h = modulate(rmsnorm(x, g_mlp_norm[l]), sh_m, sc_m)
        u = causal_dwconv(jnp.dot(h, w_up[l]), conv_w[l], conv_b[l])
        gate, val = jnp.split(u, 2, axis=-1)
        x = x + g_m[:, None, :] * jnp.dot(jax.nn.silu(gate) * val, w_down[l])
    return x
```

```cpp
#include <hip/hip_runtime.h>
#include <cstdio>
#include <cstdint>

#define LAS __attribute__((address_space(3)))
#define GAS __attribute__((address_space(1)))
typedef unsigned short bf16_t;
typedef short bf16x8 __attribute__((ext_vector_type(8)));
typedef short s16x4 __attribute__((ext_vector_type(4)));
typedef float f32x2 __attribute__((ext_vector_type(2)));
typedef float f32x4 __attribute__((ext_vector_type(4)));
typedef float f32x16 __attribute__((ext_vector_type(16)));
typedef unsigned u32x2 __attribute__((ext_vector_type(2)));
typedef unsigned u32x4 __attribute__((ext_vector_type(4)));
typedef __bf16 bf16x2_t __attribute__((ext_vector_type(2)));

#ifndef MK_N_LAUNCHES
#define MK_N_LAUNCHES 10
#endif

constexpr int BATCH = 16, SEQ = 2048, DM = 1024, MTOK = BATCH * SEQ;
constexpr int NMOD = 6 * DM;
constexpr int DFF = 2816, DFF2 = 5632;
constexpr float EPS = 1e-6f;
constexpr float LOG2E = 1.4426950408889634f;
constexpr float C2_MLA = 0.10206207261596577f * LOG2E;
constexpr float C2_CA = 0.125f * LOG2E;

__device__ __forceinline__ unsigned cvtpk(float lo, float hi) { f32x2 v = {lo, hi}; bf16x2_t b = __builtin_convertvector(v, bf16x2_t); return __builtin_bit_cast(unsigned, b); }
__device__ __forceinline__ u32x4 pack8(f32x4 a, f32x4 b) { u32x4 w; w.x = cvtpk(a[0], a[1]); w.y = cvtpk(a[2], a[3]); w.z = cvtpk(b[0], b[1]); w.w = cvtpk(b[2], b[3]); return w; }
__device__ __forceinline__ u32x2 pack4(f32x4 a) { u32x2 w; w.x = cvtpk(a[0], a[1]); w.y = cvtpk(a[2], a[3]); return w; }
__device__ __forceinline__ float dot4(f32x4 a) { return (a[0] * a[0] + a[1] * a[1]) + (a[2] * a[2] + a[3] * a[3]); }
#define LDS_BARRIER() do { asm volatile("s_waitcnt lgkmcnt(0)" ::: "memory"); __builtin_amdgcn_s_barrier(); asm volatile("" ::: "memory"); } while (0)

namespace pg8 {
constexpr int BM = 256, BK = 64, HALF = 128, HTB = HALF * BK * 2, STAGE_BYTES = 8 * HTB, NXCD = 8, WGM = 8;
__host__ __device__ __forceinline__ int lds_byte(int r, int c) { const int st = (r >> 4) * 2 + (c >> 5), rr = r & 15, cc = c & 31, ob = rr * 64 + cc * 2; return st * 1024 + (ob ^ (((ob >> 9) & 1) << 5)); }
__host__ __device__ __forceinline__ void stage_rc(int b, int& R, int& C) { const int st = b / 1024, sb = b % 1024, swz = sb ^ (((sb >> 9) & 1) << 5); R = (st >> 1) * 16 + swz / 64; C = (st & 1) * 32 + (swz % 64) / 2; }
__host__ __device__ __forceinline__ int perm32(int rho) { const int n = rho >> 4, i = rho & 15; return 8 * (i >> 2) + 4 * n + (i & 3); }

struct Unit { int pm, pn; };
struct Gemm { const bf16_t* A; const bf16_t* Bt; int M, N, K; };

struct StaticOrder {
    int nM, nN, nwg, G, c;
    __host__ __device__ void init(int M, int N, int G_, int c_) { nM = M / BM; nN = N / BM; nwg = nM * nN; G = G_; c = c_; }
    __host__ __device__ bool next(int i, Unit& u) const {
        const long L = (long)i * G + c; if (L >= nwg) return false;
        int wgid = (int)L; { const int q = nwg / NXCD, r = nwg % NXCD, xcd = wgid % NXCD, off = wgid / NXCD; wgid = (xcd < r ? xcd * (q + 1) : r * (q + 1) + (xcd - r) * q) + off; }
        const int nig = WGM * nN, gid = wgid / nig, fm = gid * WGM, gsz = (nM - fm) < WGM ? (nM - fm) : WGM;
        u.pm = fm + ((wgid % nig) % gsz); u.pn = (wgid % nig) / gsz; return true;
    }
};

template <class Epi, class Sched>
__device__ __forceinline__ void gemm_phase(LAS unsigned char* lds, LAS float* xl, const Gemm g, const Sched& S, const Epi& E) {
    const int tid = threadIdx.x, wid = __builtin_amdgcn_readfirstlane(tid >> 6), lane = tid & 63, wr = wid >> 2, wc = wid & 3, fr = lane & 15, fq = lane >> 4;
    const int K = g.K, nt = K / BK;
    unsigned voffA[2], voffB[2];
#pragma unroll
    for (int i = 0; i < 2; ++i) { int R, C; stage_rc(tid * 16 + i * 8192, R, C); const int Rb = (R & ~31) + perm32(R & 31);
        voffA[i] = (unsigned)(R * K + C) * 2u; voffB[i] = (unsigned)(Rb * K + C) * 2u; }
    const size_t kstep = (size_t)(BK * 2);
    const size_t hstep = (size_t)HALF * K * 2;
    const size_t tstep = 2 * hstep;
    const unsigned ldsw = (unsigned)wid * 1024u;
    const int aoff = lds_byte(wr * 64 + fr, fq * 8), boff = lds_byte(wc * 32 + fr, fq * 8);
#define PG8_SA(b, h) (((b) * 2 + (h)) * HTB)
#define PG8_SB(b, h) ((4 + (b) * 2 + (h)) * HTB)
#define PG8_STAGE(bufoff, gbase, voff) do { _Pragma("unroll") for (int _i = 0; _i < 2; ++_i) \
        __builtin_amdgcn_global_load_lds((const unsigned*)((const char*)(gbase) + (voff)[_i]), (LAS unsigned*)(lds + (bufoff) + ldsw + _i * 8192), 16, 0, 0); } while (0)
#define PG8_LDA(dst, b, h) do { _Pragma("unroll") for (int m = 0; m < 4; ++m) _Pragma("unroll") for (int k = 0; k < 2; ++k) dst[m][k] = *(const LAS bf16x8*)(lds + PG8_SA(b, h) + aoff + m * 2048 + k * 1024); } while (0)
#define PG8_LDB(dst, b, h) do { _Pragma("unroll") for (int n = 0; n < 2; ++n) _Pragma("unroll") for (int k = 0; k < 2; ++k) dst[n][k] = *(const LAS bf16x8*)(lds + PG8_SB(b, h) + boff + n * 2048 + k * 1024); } while (0)
#define PG8_MMA(ai, bj, At, Bt) do { __builtin_amdgcn_s_setprio(1); _Pragma("unroll") for (int m = 0; m < 4; ++m) _Pragma("unroll") for (int n = 0; n < 2; ++n) _Pragma("unroll") for (int k = 0; k < 2; ++k) \
        acc[ai][bj][m][n] = __builtin_amdgcn_mfma_f32_16x16x32_bf16(Bt[n][k], At[m][k], acc[ai][bj][m][n], 0, 0, 0); __builtin_amdgcn_s_setprio(0); } while (0)
#define PG8_WAIT_V(n) asm volatile("s_waitcnt vmcnt(" #n ")" ::: "memory")
#define PG8_WAIT_L(n) asm volatile("s_waitcnt lgkmcnt(" #n ")" ::: "memory")
#define PG8_BAR __builtin_amdgcn_s_barrier()
#define PG8_SCHED __builtin_amdgcn_sched_barrier(0)
    Unit cur, nxt; int ui = 0;
    if (!S.next(0, cur)) return;
    f32x4 acc[2][2][4][2];
#pragma unroll
    for (int a = 0; a < 2; ++a)
#pragma unroll
        for (int b = 0; b < 2; ++b)
#pragma unroll
            for (int m = 0; m < 4; ++m)
#pragma unroll
                for (int n = 0; n < 2; ++n) acc[a][b][m][n] = (f32x4){0.f, 0.f, 0.f, 0.f};
    bf16x8 At[4][2], B0[2][2], B1[2][2];
    const char* cA = (const char*)g.A + (size_t)cur.pm * tstep; const char* cB = (const char*)g.Bt + (size_t)cur.pn * tstep;
    PG8_STAGE(PG8_SB(0, 0), cB, voffB); PG8_STAGE(PG8_SB(0, 1), cB + hstep, voffB); PG8_STAGE(PG8_SA(0, 0), cA, voffA); PG8_STAGE(PG8_SA(0, 1), cA + hstep, voffA);
    if (wr == 1) PG8_BAR;
    PG8_WAIT_V(2); PG8_BAR;
    PG8_STAGE(PG8_SB(1, 0), cB + kstep, voffB); PG8_STAGE(PG8_SA(1, 0), cA + kstep, voffA); PG8_STAGE(PG8_SB(1, 1), cB + hstep + kstep, voffB);
    PG8_WAIT_V(6); PG8_BAR;
    for (;;) {
        const bool has_next = S.next(ui + 1, nxt);
        const char* nA = has_next ? (const char*)g.A + (size_t)nxt.pm * tstep : cA; const char* nB = has_next ? (const char*)g.Bt + (size_t)nxt.pn * tstep : cB;
        for (int t = 0; t < nt; t += 2) {
            const bool last = (t == nt - 2);
            const char* a1 = cA + (size_t)(t + 1) * kstep;
            const char* a2 = last ? nA : cA + (size_t)(t + 2) * kstep; const char* b2 = last ? nB : cB + (size_t)(t + 2) * kstep;
            const char* a3 = a2 + kstep; const char* b3 = b2 + kstep;
            PG8_LDB(B0, 0, 0); PG8_LDB(B1, 0, 1); PG8_SCHED; PG8_LDA(At, 0, 0); PG8_STAGE(PG8_SA(1, 1), a1 + hstep, voffA);
            PG8_WAIT_V(8); PG8_WAIT_L(0); PG8_BAR; PG8_MMA(0, 0, At, B0); PG8_MMA(0, 1, At, B1); PG8_BAR; PG8_SCHED;
            PG8_LDA(At, 0, 1); PG8_STAGE(PG8_SB(0, 0), b2, voffB); PG8_STAGE(PG8_SB(0, 1), b2 + hstep, voffB); PG8_STAGE(PG8_SA(0, 0), a2, voffA);
            PG8_WAIT_V(8); PG8_WAIT_L(0); PG8_BAR; PG8_MMA(1, 0, At, B0); PG8_MMA(1, 1, At, B1); PG8_BAR; PG8_SCHED;
            PG8_LDB(B0, 1, 0); PG8_LDB(B1, 1, 1); PG8_SCHED; PG8_LDA(At, 1, 0); PG8_STAGE(PG8_SA(0, 1), a2 + hstep, voffA);
            PG8_WAIT_V(8); PG8_WAIT_L(0); PG8_BAR; PG8_MMA(0, 0, At, B0); PG8_MMA(0, 1, At, B1); PG8_BAR; PG8_SCHED;
            PG8_LDA(At, 1, 1); PG8_STAGE(PG8_SB(1, 0), b3, voffB); PG8_STAGE(PG8_SB(1, 1), b3 + hstep, voffB); PG8_STAGE(PG8_SA(1, 0), a3, voffA);
            PG8_WAIT_V(8); PG8_WAIT_L(0); PG8_BAR; PG8_MMA(1, 0, At, B0); PG8_MMA(1, 1, At, B1); PG8_BAR; PG8_SCHED;
        }
        if (wr == 0) PG8_BAR;
        E(acc, cur, wr, wc, fr, fq, xl);
        if (!has_next) break;
#pragma unroll
        for (int a = 0; a < 2; ++a)
#pragma unroll
            for (int b = 0; b < 2; ++b)
#pragma unroll
                for (int m = 0; m < 4; ++m)
#pragma unroll
                    for (int n = 0; n < 2; ++n) acc[a][b][m][n] = (f32x4){0.f, 0.f, 0.f, 0.f};
        cur = nxt; cA = nA; cB = nB; ++ui;
        if (wr == 1) PG8_BAR;
    }
    PG8_WAIT_V(0);
    PG8_BAR;
#undef PG8_SA
#undef PG8_SB
#undef PG8_STAGE
#undef PG8_LDA
#undef PG8_LDB
#undef PG8_MMA
#undef PG8_WAIT_V
#undef PG8_WAIT_L
#undef PG8_BAR
#undef PG8_SCHED
}
}
using pg8::Unit;


struct EpiIn {
    bf16_t *QLN, *KVLN, *CQ, *CK, *CV; float *KR, *SSR; const float *g_ql, *g_kvl, *g_caq, *g_cak;
    __device__ __forceinline__ void operator()(const f32x4 (&acc)[2][2][4][2], const Unit& u, int wr, int wc, int fr, int fq, LAS float* red) const {
        asm volatile("" : "+v"(fr), "+v"(fq));
        const int rl0 = wr * 64 + fr; const size_t row0 = (size_t)u.pm * 256 + rl0; const int pn = u.pn;
        if (pn >= 6) {
            bf16_t* base = CV + (pn - 6) * 256 + wc * 32 + 8 * fq;
#pragma unroll
            for (int ai = 0; ai < 2; ++ai)
#pragma unroll
                for (int m = 0; m < 4; ++m) { bf16_t* rp = base + (row0 + ai * 128 + m * 16) * 512;
#pragma unroll
                    for (int bj = 0; bj < 2; ++bj) *(u32x4*)(rp + bj * 128) = pack8(acc[ai][bj][m][0], acc[ai][bj][m][1]); }
        } else if (pn >= 2) {
            const bool isq = pn < 4; const int head = 4 * ((pn - 2) & 1) + wc; const float* g = isq ? g_caq : g_cak; const float sc = isq ? C2_CA : 1.0f;
            f32x4 gv[2][2];
#pragma unroll
            for (int bj = 0; bj < 2; ++bj)
#pragma unroll
                for (int n = 0; n < 2; ++n) gv[bj][n] = *(const f32x4*)(g + 32 * bj + 8 * fq + 4 * n) * sc;
            bf16_t* base = (isq ? CQ : CK) + head * 64 + 8 * fq;
#pragma unroll
            for (int ai = 0; ai < 2; ++ai)
#pragma unroll
                for (int m = 0; m < 4; ++m) {
                    float ss = (dot4(acc[ai][0][m][0]) + dot4(acc[ai][0][m][1])) + (dot4(acc[ai][1][m][0]) + dot4(acc[ai][1][m][1]));
                    ss += __shfl_xor(ss, 16); ss += __shfl_xor(ss, 32);
                    const float r = rsqrtf(ss * (1.0f / 64.0f) + EPS);
                    bf16_t* rp = base + (row0 + ai * 128 + m * 16) * 512;
#pragma unroll
                    for (int bj = 0; bj < 2; ++bj) *(u32x4*)(rp + bj * 32) = pack8(acc[ai][bj][m][0] * r * gv[bj][0], acc[ai][bj][m][1] * r * gv[bj][1]);
                }
        } else if (pn == 0) {
#pragma unroll
            for (int ai = 0; ai < 2; ++ai)
#pragma unroll
                for (int m = 0; m < 4; ++m) {
                    float ss = (dot4(acc[ai][0][m][0]) + dot4(acc[ai][0][m][1])) + (dot4(acc[ai][1][m][0]) + dot4(acc[ai][1][m][1]));
                    ss += __shfl_xor(ss, 16); ss += __shfl_xor(ss, 32);
                    if (fq == 0) red[(ai * 128 + m * 16 + rl0) * 8 + wc] = ss;
                }
            LDS_BARRIER();
            f32x4 gv[2][2];
#pragma unroll
            for (int bj = 0; bj < 2; ++bj)
#pragma unroll
                for (int n = 0; n < 2; ++n) gv[bj][n] = *(const f32x4*)(g_ql + 128 * bj + 32 * wc + 8 * fq + 4 * n);
            bf16_t* base = QLN + wc * 32 + 8 * fq;
#pragma unroll
            for (int ai = 0; ai < 2; ++ai)
#pragma unroll
                for (int m = 0; m < 4; ++m) {
                    const f32x4 t = *(const LAS f32x4*)(red + (ai * 128 + m * 16 + rl0) * 8);
                    const float r = rsqrtf(((t[0] + t[1]) + (t[2] + t[3])) * (1.0f / 256.0f) + EPS);
                    bf16_t* rp = base + (row0 + ai * 128 + m * 16) * 256;
#pragma unroll
                    for (int bj = 0; bj < 2; ++bj) *(u32x4*)(rp + bj * 128) = pack8(acc[ai][bj][m][0] * r * gv[bj][0], acc[ai][bj][m][1] * r * gv[bj][1]);
                }
        } else {
#pragma unroll
            for (int ai = 0; ai < 2; ++ai)
#pragma unroll
                for (int m = 0; m < 4; ++m) {
                    float ss = dot4(acc[ai][0][m][0]) + dot4(acc[ai][0][m][1]);
                    ss += __shfl_xor(ss, 16); ss += __shfl_xor(ss, 32);
                    if (fq == 0) red[(ai * 128 + m * 16 + rl0) * 8 + wc] = ss;
                }
            LDS_BARRIER();
            f32x4 gv[2];
#pragma unroll
            for (int n = 0; n < 2; ++n) gv[n] = *(const f32x4*)(g_kvl + 32 * wc + 8 * fq + 4 * n);
            bf16_t* base = KVLN + wc * 32 + 8 * fq;
#pragma unroll
            for (int ai = 0; ai < 2; ++ai)
#pragma unroll
                for (int m = 0; m < 4; ++m) {
                    const f32x4 t = *(const LAS f32x4*)(red + (ai * 128 + m * 16 + rl0) * 8);
                    const float r = rsqrtf(((t[0] + t[1]) + (t[2] + t[3])) * (1.0f / 128.0f) + EPS);
                    const size_t row = row0 + ai * 128 + m * 16;
                    bf16_t* rp = base + row * 256;
                    *(u32x4*)(rp) = pack8(acc[ai][0][m][0] * r * gv[0], acc[ai][0][m][1] * r * gv[1]);
                    *(u32x4*)(rp + 128) = (u32x4){0u, 0u, 0u, 0u};
                    if (wc == 0) {
                        *(f32x4*)(KR + row * 32 + 8 * fq) = acc[ai][1][m][0]; *(f32x4*)(KR + row * 32 + 8 * fq + 4) = acc[ai][1][m][1];
                        float sr = dot4(acc[ai][1][m][0]) + dot4(acc[ai][1][m][1]);
                        sr += __shfl_xor(sr, 16); sr += __shfl_xor(sr, 32);
                        if (fq == 0) SSR[row] = sr;
                    }
                }
        }
    }
};

struct EpiQ {
    bf16_t* QM; const float *g, *cosT, *sinT;
    __device__ __forceinline__ void operator()(const f32x4 (&acc)[2][2][4][2], const Unit& u, int wr, int wc, int fr, int fq, LAS float* red) const {
        asm volatile("" : "+v"(fr), "+v"(fq));
        const int rl0 = wr * 64 + fr; const size_t row0 = (size_t)u.pm * 256 + rl0;
#pragma unroll
        for (int ai = 0; ai < 2; ++ai)
#pragma unroll
            for (int m = 0; m < 4; ++m)
#pragma unroll
                for (int bj = 0; bj < 2; ++bj) {
                    float ss = dot4(acc[ai][bj][m][0]) + dot4(acc[ai][bj][m][1]);
                    ss += __shfl_xor(ss, 16); ss += __shfl_xor(ss, 32);
                    if (fq == 0) red[(ai * 128 + m * 16 + rl0) * 8 + bj * 4 + wc] = ss;
                }
        LDS_BARRIER();
        if (wc < 2) {
            const f32x4 g0 = *(const f32x4*)(g + 32 * wc + 8 * fq) * C2_MLA, g1 = *(const f32x4*)(g + 32 * wc + 8 * fq + 4) * C2_MLA;
#pragma unroll
            for (int ai = 0; ai < 2; ++ai)
#pragma unroll
                for (int m = 0; m < 4; ++m) {
                    const size_t row = row0 + ai * 128 + m * 16;
#pragma unroll
                    for (int bj = 0; bj < 2; ++bj) {
                        const f32x4 t = *(const LAS f32x4*)(red + (ai * 128 + m * 16 + rl0) * 8 + bj * 4);
                        const float r = rsqrtf(((t[0] + t[1]) + (t[2] + t[3])) * (1.0f / 96.0f) + EPS);
                        *(u32x4*)(QM + row * 768 + (2 * u.pn + bj) * 96 + 32 * wc + 8 * fq) = pack8(acc[ai][bj][m][0] * r * g0, acc[ai][bj][m][1] * r * g1);
                    }
                }
        } else if (wc == 2) {
            const f32x4 g0 = *(const f32x4*)(g + 64 + 4 * fq) * C2_MLA, g1 = *(const f32x4*)(g + 80 + 4 * fq) * C2_MLA;
#pragma unroll
            for (int ai = 0; ai < 2; ++ai)
#pragma unroll
                for (int m = 0; m < 4; ++m) {
                    const size_t row = row0 + ai * 128 + m * 16;
                    const f32x4 cs = *(const f32x4*)(cosT + row * 16 + 4 * fq), sn = *(const f32x4*)(sinT + row * 16 + 4 * fq);
#pragma unroll
                    for (int bj = 0; bj < 2; ++bj) {
                        const f32x4 t = *(const LAS f32x4*)(red + (ai * 128 + m * 16 + rl0) * 8 + bj * 4);
                        const float r = rsqrtf(((t[0] + t[1]) + (t[2] + t[3])) * (1.0f / 96.0f) + EPS);
                        bf16_t* hp = QM + row * 768 + (2 * u.pn + bj) * 96;
                        const f32x4 x1 = acc[ai][bj][m][0] * r * g0, x2 = acc[ai][bj][m][1] * r * g1;
                        *(u32x2*)(hp + 64 + 4 * fq) = pack4(x1 * cs - x2 * sn); *(u32x2*)(hp + 80 + 4 * fq) = pack4(x2 * cs + x1 * sn);
                    }
                    asm volatile("" ::: "memory");
                }
        }
    }
};

struct EpiKV {
    bf16_t *KM, *VM; const float *g, *cosT, *sinT, *KR, *SSR;
    __device__ __forceinline__ void operator()(const f32x4 (&acc)[2][2][4][2], const Unit& u, int wr, int wc, int fr, int fq, LAS float* red) const {
        asm volatile("" : "+v"(fr), "+v"(fq));
        const int rl0 = wr * 64 + fr; const size_t row0 = (size_t)u.pm * 256 + rl0;
        if (wc < 2) {
#pragma unroll
            for (int ai = 0; ai < 2; ++ai)
#pragma unroll
                for (int m = 0; m < 4; ++m)
#pragma unroll
                    for (int bj = 0; bj < 2; ++bj) {
                        float ss = dot4(acc[ai][bj][m][0]) + dot4(acc[ai][bj][m][1]);
                        ss += __shfl_xor(ss, 16); ss += __shfl_xor(ss, 32);
                        if (fq == 0) red[(ai * 128 + m * 16 + rl0) * 8 + bj * 2 + wc] = ss;
                    }
        }
        LDS_BARRIER();
        if (wc < 2) {
            const f32x4 g0 = *(const f32x4*)(g + 32 * wc + 8 * fq), g1 = *(const f32x4*)(g + 32 * wc + 8 * fq + 4);
#pragma unroll
            for (int ai = 0; ai < 2; ++ai)
#pragma unroll
                for (int m = 0; m < 4; ++m) {
                    const size_t row = row0 + ai * 128 + m * 16;
                    const float ssr = SSR[row];
                    const f32x4 t = *(const LAS f32x4*)(red + (ai * 128 + m * 16 + rl0) * 8);
#pragma unroll
                    for (int bj = 0; bj < 2; ++bj) {
                        const float rk = rsqrtf((t[2 * bj] + t[2 * bj + 1] + ssr) * (1.0f / 96.0f) + EPS);
                        *(u32x4*)(KM + row * 768 + (2 * u.pn + bj) * 96 + 32 * wc + 8 * fq) = pack8(acc[ai][bj][m][0] * rk * g0, acc[ai][bj][m][1] * rk * g1);
                    }
                    asm volatile("" ::: "memory");
                }
        } else {
            const int bj0 = wc - 2, h0 = 2 * u.pn + bj0;
            const f32x4 g0 = *(const f32x4*)(g + 64 + 4 * fq), g1 = *(const f32x4*)(g + 80 + 4 * fq);
#pragma unroll
            for (int ai = 0; ai < 2; ++ai)
#pragma unroll
                for (int m = 0; m < 4; ++m) {
                    const size_t row = row0 + ai * 128 + m * 16;
#pragma unroll
                    for (int bj = 0; bj < 2; ++bj) *(u32x4*)(VM + row * 512 + (2 * u.pn + bj) * 64 + 32 * (wc - 2) + 8 * fq) = pack8(acc[ai][bj][m][0], acc[ai][bj][m][1]);
                    const f32x2 t = *(const LAS f32x2*)(red + (ai * 128 + m * 16 + rl0) * 8 + 2 * bj0);
                    const float rk = rsqrtf((t[0] + t[1] + SSR[row]) * (1.0f / 96.0f) + EPS);
                    const f32x4 cs = *(const f32x4*)(cosT + row * 16 + 4 * fq), sn = *(const f32x4*)(sinT + row * 16 + 4 * fq);
                    const f32x4 x1 = *(const f32x4*)(KR + row * 32 + 4 * fq) * rk * g0, x2 = *(const f32x4*)(KR + row * 32 + 16 + 4 * fq) * rk * g1;
                    bf16_t* hp = KM + row * 768 + h0 * 96;
                    *(u32x2*)(hp + 64 + 4 * fq) = pack4(x1 * cs - x2 * sn); *(u32x2*)(hp + 80 + 4 * fq) = pack4(x2 * cs + x1 * sn);
                    asm volatile("" ::: "memory");
                }
        }
    }
};

struct EpiRes {
    const float* base; float* out; const float* gate;
    __device__ __forceinline__ void operator()(const f32x4 (&acc)[2][2][4][2], const Unit& u, int wr, int wc, int fr, int fq, LAS float* red) const {
        asm volatile("" : "+v"(fr), "+v"(fq));
        const int b = u.pm >> 3; const int col0 = u.pn * 256 + wc * 32 + 8 * fq;
        f32x4 gv[2][2];
#pragma unroll
        for (int bj = 0; bj < 2; ++bj)
#pragma unroll
            for (int n = 0; n < 2; ++n) gv[bj][n] = *(const f32x4*)(gate + (size_t)b * NMOD + col0 + 128 * bj + 4 * n);
#pragma unroll
        for (int ai = 0; ai < 2; ++ai)
#pragma unroll
            for (int m = 0; m < 4; ++m) {
                const size_t off = ((size_t)u.pm * 256 + ai * 128 + wr * 64 + m * 16 + fr) * DM + col0;
#pragma unroll
                for (int bj = 0; bj < 2; ++bj)
#pragma unroll
                    for (int n = 0; n < 2; ++n) { const f32x4 xs = *(const f32x4*)(base + off + 128 * bj + 4 * n); *(f32x4*)(out + off + 128 * bj + 4 * n) = xs + gv[bj][n] * acc[ai][bj][m][n]; }
                if (m & 1) asm volatile("" ::: "memory");
            }
    }
};

struct EpiUp {
    bf16_t* ACT; float* RAW4; const float *cw, *cb;
    __device__ __forceinline__ void operator()(const f32x4 (&acc)[2][2][4][2], const Unit& u, int wr, int wc, int fr, int fq, LAS float* red) const {
        asm volatile("" : "+v"(fr), "+v"(fq));
        const int lane = threadIdx.x & 63; const int j = u.pn; const int cc0 = 32 * wc + 8 * fq;
        const int src1 = (lane & 48) | ((fr - 1) & 15), src2 = (lane & 48) | ((fr - 2) & 15);
#pragma unroll
        for (int n = 0; n < 2; ++n) {
            const int gcol = 128 * j + cc0 + 4 * n, vcol = DFF + gcol;
            const f32x4 wg0 = *(const f32x4*)(cw + gcol), wg1 = *(const f32x4*)(cw + DFF2 + gcol), wg2 = *(const f32x4*)(cw + 2 * DFF2 + gcol), bg = *(const f32x4*)(cb + gcol);
            const f32x4 wv0 = *(const f32x4*)(cw + vcol), wv1 = *(const f32x4*)(cw + DFF2 + vcol), wv2 = *(const f32x4*)(cw + 2 * DFF2 + vcol), bv = *(const f32x4*)(cb + vcol);
#pragma unroll
            for (int ai = 0; ai < 2; ++ai) {
                const size_t blk = (size_t)u.pm * 4 + 2 * ai + wr;
                f32x4 pg1 = {0.f, 0.f, 0.f, 0.f}, pg2 = pg1, pv1 = pg1, pv2 = pg1;
#pragma unroll
                for (int m = 0; m < 4; ++m) {
                    const f32x4 gr = acc[ai][0][m][n], vr = acc[ai][1][m][n];
                    f32x4 g1, g2, v1, v2;
#pragma unroll
                    for (int e = 0; e < 4; ++e) { g1[e] = __shfl(gr[e], src1); g2[e] = __shfl(gr[e], src2); v1[e] = __shfl(vr[e], src1); v2[e] = __shfl(vr[e], src2); }
                    const f32x4 gp1 = fr >= 1 ? g1 : pg1, gp2 = fr >= 2 ? g2 : pg2, vp1 = fr >= 1 ? v1 : pv1, vp2 = fr >= 2 ? v2 : pv2;
                    pg1 = g1; pg2 = g2; pv1 = v1; pv2 = v2;
                    const f32x4 G = wg0 * gp2 + wg1 * gp1 + wg2 * gr + bg, V = wv0 * vp2 + wv1 * vp1 + wv2 * vr + bv;
                    f32x4 a;
#pragma unroll
                    for (int e = 0; e < 4; ++e) a[e] = G[e] * __builtin_amdgcn_rcpf(1.0f + __builtin_amdgcn_exp2f(-LOG2E * G[e])) * V[e];
                    const int rin = 16 * m + fr; const size_t row = blk * 64 + rin;
                    if (m > 0 || fr >= 2) *(u32x2*)(ACT + row * DFF + 128 * j + cc0 + 4 * n) = pack4(a);
                    if (m == 0 && fr < 2) { float* rp = RAW4 + (blk * 4 + fr) * DFF2 + 256 * j + cc0 + 4 * n; *(f32x4*)rp = gr; *(f32x4*)(rp + 128) = vr; }
                    if (m == 3 && fr >= 14) { float* rp = RAW4 + (blk * 4 + (fr - 12)) * DFF2 + 256 * j + cc0 + 4 * n; *(f32x4*)rp = gr; *(f32x4*)(rp + 128) = vr; }
                }
            }
        }
    }
};

namespace att {
__device__ __forceinline__ int crow(int r, int hi) { return (r & 3) + 8 * (r >> 2) + 4 * hi; }
__device__ __forceinline__ void glds16(const void* gsrc, unsigned lds_dst) { unsigned keep;
    asm volatile("s_mov_b32 %0, m0\n\ts_mov_b32 m0, %2\n\ts_nop 0\n\tglobal_load_lds_dwordx4 %1, off\n\ts_mov_b32 m0, %0" : "=&s"(keep) : "v"(gsrc), "s"(lds_dst) : "memory"); }
__device__ __forceinline__ float max3f(float a, float b, float c) { float r; asm("v_max3_f32 %0, %1, %2, %3" : "=v"(r) : "v"(a), "v"(b), "v"(c)); return r; }
__device__ __forceinline__ float rowmax(const f32x16& p0, const f32x16& p1) {
    float a = max3f(p0[0], p0[1], p1[0]), b = max3f(p0[2], p0[3], p1[1]); a = max3f(a, p1[2], p1[3]);
#pragma unroll
    for (int r = 4; r < 16; r += 4) { a = max3f(a, p0[r], p0[r + 1]); b = max3f(b, p0[r + 2], p0[r + 3]); a = max3f(a, p1[r], p1[r + 1]); b = max3f(b, p1[r + 2], p1[r + 3]); }
    const float m = fmaxf(a, b);
    auto rr = __builtin_amdgcn_permlane32_swap(__float_as_uint(m), __float_as_uint(m), false, false);
    return fmaxf(__uint_as_float(rr[0]), __uint_as_float(rr[1]));
}
__device__ __forceinline__ void pv(f32x16* o, int vb, bf16x8 pa0, bf16x8 pa1, bf16x8 pa2, bf16x8 pa3) {
#pragma unroll
    for (int d0 = 0; d0 < 2; ++d0) { s16x4 lo[4], hi[4];
#pragma unroll
        for (int ks = 0; ks < 4; ++ks) {
            asm volatile("ds_read_b64_tr_b16 %0,%1 offset:%c2" : "=&v"(lo[ks]) : "v"(vb), "i"(d0 * 4096 + ks * 1024) : "memory");
            asm volatile("ds_read_b64_tr_b16 %0,%1 offset:%c2" : "=&v"(hi[ks]) : "v"(vb), "i"(d0 * 4096 + ks * 1024 + 512) : "memory"); }
        asm volatile("s_waitcnt lgkmcnt(0)" ::: "memory"); __builtin_amdgcn_sched_barrier(0);
#define PK(k) (bf16x8){lo[k][0], lo[k][1], lo[k][2], lo[k][3], hi[k][0], hi[k][1], hi[k][2], hi[k][3]}
        o[d0] = __builtin_amdgcn_mfma_f32_32x32x16_bf16(pa0, PK(0), o[d0], 0, 0, 0);
        o[d0] = __builtin_amdgcn_mfma_f32_32x32x16_bf16(pa1, PK(1), o[d0], 0, 0, 0);
        o[d0] = __builtin_amdgcn_mfma_f32_32x32x16_bf16(pa2, PK(2), o[d0], 0, 0, 0);
        o[d0] = __builtin_amdgcn_mfma_f32_32x32x16_bf16(pa3, PK(3), o[d0], 0, 0, 0);
#undef PK
    }
}
constexpr int ATT_LDS_BYTES = 2 * 12288 + 2 * 8192 + 8 * 256 + 8 * 4096 + 2048;

template <int DQK, bool CA, int THR>
__device__ __forceinline__ void attn_unit(int b, int h, int u, const bf16_t* Q, const bf16_t* K, const bf16_t* V, bf16_t* O, const float* relb, LAS unsigned char* shm) {
    constexpr int ND = DQK / 16, NCH = DQK / 8, KSLOT = NCH * 1024, VSLOT = 8192;
    constexpr int LDS_K = 0, LDS_V = 2 * KSLOT, LDS_WS = LDS_V + 2 * VSLOT, LDS_OST = LDS_WS + 8 * 256, LDS_TAB = LDS_OST + 8 * 4096;
    constexpr int LDQ = CA ? 512 : 768, LDV = 512, LDO = 1024, OCOL = CA ? 512 : 0;
    const int tid = threadIdx.x, lane = tid & 63, r32 = lane & 31, hi = lane >> 5; const int wid = __builtin_amdgcn_readfirstlane(tid >> 6);
    const long rowbase = (long)b * SEQ; const int q0 = u * 256;
    const bf16_t* Qw = Q + (rowbase + q0 + wid * 32) * LDQ + h * DQK;
    const bf16_t* Kh = K + rowbase * LDQ + h * DQK; const bf16_t* Vh = V + rowbase * LDV + h * 64;
    const unsigned lds0 = (unsigned)(uintptr_t)shm;
    LAS float* wsf = (LAS float*)(shm + LDS_WS) + wid * 64;
    LAS float* tab = (LAS float*)(shm + LDS_TAB);
    const int t0 = CA ? (4 * u - 8 > 0 ? 4 * u - 8 : 0) : 0, t1 = 4 * u + 3, cw = 4 * u + (wid >> 1);
    const bf16_t* ksrc = Kh + (long)lane * LDQ + wid * 8;
    const bf16_t* ksrc2 = Kh + (long)lane * LDQ + (8 + (wid & 3)) * 8;
    const bf16_t* vsrc = Vh + (long)(16 * (wid & 3) + (lane >> 2)) * LDV + (wid >> 2) * 32 + (lane & 3) * 8;
#define DMA_TILE(t, s) do { glds16(ksrc + (long)(t) * 64 * LDQ, (unsigned)__builtin_amdgcn_readfirstlane(lds0 + LDS_K + (s) * KSLOT + wid * 1024)); \
        if (DQK == 96) glds16(ksrc2 + (long)(t) * 64 * LDQ, (unsigned)__builtin_amdgcn_readfirstlane(lds0 + LDS_K + (s) * KSLOT + (8 + (wid & 3)) * 1024)); \
        glds16(vsrc + (long)(t) * 64 * LDV, (unsigned)__builtin_amdgcn_readfirstlane(lds0 + LDS_V + (s) * VSLOT + wid * 1024)); } while (0)
    if (CA) { for (int i = tid; i < 320; i += 512) tab[i] = relb[h * 257 + (i < 256 ? i : 256)] * LOG2E; }
    bf16x8 qr[ND];
#pragma unroll
    for (int d0 = 0; d0 < ND; ++d0) qr[d0] = *(const bf16x8*)(Qw + (long)r32 * LDQ + d0 * 16 + hi * 8);
    DMA_TILE(t0, 0);
    float mrun = -1e30f, l_reg = 0.f; f32x16 o[2]; o[0] = f32x16{}; o[1] = f32x16{};
    const int vb0 = (int)(lds0 + LDS_V) + ((lane >> 4) & 1) * 32 + (lane & 3) * 8 + (4 * hi + ((lane & 15) >> 2)) * 64;
    for (int t = t0; t <= t1; ++t) {
        const int s = (t - t0) & 1;
        asm volatile("s_waitcnt vmcnt(0) lgkmcnt(0)\n\ts_barrier" ::: "memory");
        if (t < t1) DMA_TILE(t + 1, s ^ 1);
        const bool valid = CA ? (t <= cw && t >= cw - 8) : (t <= cw);
        if (valid) {
            f32x16 p0 = f32x16{}, p1 = f32x16{};
            const LAS unsigned char* kb = shm + LDS_K + s * KSLOT + hi * 1024 + r32 * 16;
#pragma unroll
            for (int d0 = 0; d0 < ND; ++d0) {
                const bf16x8 b0 = *(const LAS bf16x8*)(kb + d0 * 2048), b1 = *(const LAS bf16x8*)(kb + d0 * 2048 + 512);
                p0 = __builtin_amdgcn_mfma_f32_32x32x16_bf16(b0, qr[d0], p0, 0, 0, 0); p1 = __builtin_amdgcn_mfma_f32_32x32x16_bf16(b1, qr[d0], p1, 0, 0, 0); }
            if (CA) {
                const int dist = cw - t;
                if (dist >= 3) { const float c = tab[256];
#pragma unroll
                    for (int r = 0; r < 16; ++r) { p0[r] += c; p1[r] += c; } }
                else { const int bi = 64 * dist + 32 * (wid & 1) + r32 + 128 - 4 * hi;
#pragma unroll
                    for (int r = 0; r < 16; ++r) { p0[r] += tab[bi - ((r & 3) + 8 * (r >> 2))]; p1[r] += tab[bi - 32 - ((r & 3) + 8 * (r >> 2))]; } }
            }
            const float rm = rowmax(p0, p1);
            if (__any(rm > mrun + (float)THR)) {
                const float mn = fmaxf(mrun, rm), f = __builtin_amdgcn_exp2f(mrun - mn); mrun = mn; l_reg *= f;
                if (hi == 0) wsf[r32] = f;
                asm volatile("s_waitcnt lgkmcnt(0)" ::: "memory");
#pragma unroll
                for (int r = 0; r < 16; ++r) { const float fr_ = wsf[crow(r, hi)]; o[0][r] *= fr_; o[1][r] *= fr_; }
            }
            float sacc = 0.f;
#pragma unroll
            for (int r = 0; r < 16; ++r) { p0[r] = __builtin_amdgcn_exp2f(p0[r] - mrun); p1[r] = __builtin_amdgcn_exp2f(p1[r] - mrun); sacc += p0[r] + p1[r]; }
            l_reg += sacc;
            u32x4 pw0, pw1, pw2, pw3;
            pw0 = (u32x4){cvtpk(p0[0], p0[1]), cvtpk(p0[2], p0[3]), cvtpk(p0[4], p0[5]), cvtpk(p0[6], p0[7])};
            pw1 = (u32x4){cvtpk(p0[8], p0[9]), cvtpk(p0[10], p0[11]), cvtpk(p0[12], p0[13]), cvtpk(p0[14], p0[15])};
            pw2 = (u32x4){cvtpk(p1[0], p1[1]), cvtpk(p1[2], p1[3]), cvtpk(p1[4], p1[5]), cvtpk(p1[6], p1[7])};
            pw3 = (u32x4){cvtpk(p1[8], p1[9]), cvtpk(p1[10], p1[11]), cvtpk(p1[12], p1[13]), cvtpk(p1[14], p1[15])};
            pv(o, vb0 + s * VSLOT, __builtin_bit_cast(bf16x8, pw0), __builtin_bit_cast(bf16x8, pw1), __builtin_bit_cast(bf16x8, pw2), __builtin_bit_cast(bf16x8, pw3));
        }
    }
    { auto rr = __builtin_amdgcn_permlane32_swap(__float_as_uint(l_reg), __float_as_uint(l_reg), false, false); l_reg = __uint_as_float(rr[0]) + __uint_as_float(rr[1]); }
    if (hi == 0) wsf[32 + r32] = l_reg;
    asm volatile("s_waitcnt lgkmcnt(0)" ::: "memory");
    float rli[16];
#pragma unroll
    for (int r = 0; r < 16; ++r) rli[r] = __builtin_amdgcn_rcpf(wsf[32 + crow(r, hi)]);
    bf16_t* Ow = O + (rowbase + q0 + wid * 32) * LDO + OCOL + h * 64;
    { LAS bf16_t* stg = (LAS bf16_t*)(shm + LDS_OST) + wid * 2048;
#pragma unroll
        for (int r = 0; r < 16; ++r) { const int orow = crow(r, hi);
#pragma unroll
            for (int d0 = 0; d0 < 2; ++d0) { const unsigned w = cvtpk(o[d0][r] * rli[r], 0.f); stg[orow * 64 + d0 * 32 + r32] = (bf16_t)(w & 0xffffu); } }
        asm volatile("s_waitcnt lgkmcnt(0)" ::: "memory");
#pragma unroll
        for (int i = 0; i < 4; ++i) { const int row = i * 8 + (lane >> 3), ch = lane & 7; const u32x4 v = *(const LAS u32x4*)(stg + row * 64 + ch * 8); *(u32x4*)(Ow + (long)row * LDO + ch * 8) = v; } }
    asm volatile("s_waitcnt lgkmcnt(0)\n\ts_barrier" ::: "memory");
#undef DMA_TILE
}
}

constexpr int NWAVES = 8;
constexpr int NPHASE = 10;
constexpr int N_LAUNCHES = MK_N_LAUNCHES;
static_assert(N_LAUNCHES == 1 || N_LAUNCHES == NPHASE, "MK_N_LAUNCHES is 1 or 10");

constexpr size_t MiB = 1u << 20;
constexpr size_t WS_CTL = 0, CTL_ZERO_BYTES = 64 * 1024;
constexpr size_t WS_MOD = 1 * MiB;
constexpr size_t WS_COS = 2 * MiB, WS_SIN = 4 * MiB;
constexpr size_t WS_KR = 6 * MiB;
constexpr size_t WS_SSR = 10 * MiB;
constexpr size_t WS_WIN = 11 * MiB;
constexpr size_t WS_WQUP = 15 * MiB;
constexpr size_t WS_WKVUP = WS_WQUP + 512 * 1024;
constexpr size_t WS_WOUT = 16 * MiB;
constexpr size_t WS_WUP = 18 * MiB;
constexpr size_t WS_WDOWN = 29 * MiB;
constexpr size_t WS_XN = 36 * MiB;
constexpr size_t WS_QLN = 100 * MiB, WS_KVLN = 116 * MiB;
constexpr size_t WS_CQ = 132 * MiB, WS_CK = 164 * MiB, WS_CV = 196 * MiB;
constexpr size_t WS_QM = 228 * MiB, WS_KM = 276 * MiB;
constexpr size_t WS_VM = 324 * MiB;
constexpr size_t WS_OM = 356 * MiB;
constexpr size_t WS_ACT = 100 * MiB;
constexpr size_t WS_RAW4 = 276 * MiB;
constexpr size_t WS_END = 420 * MiB;
static_assert(WS_ACT + (size_t)MTOK * DFF * 2 <= WS_RAW4 && WS_RAW4 + (size_t)512 * 4 * DFF2 * 4 <= WS_OM, "overlay map");
constexpr int CW_BAR = 1024;

constexpr int RING_BYTES = 131072, LDSCTL_OFF = RING_BYTES, MISC_OFF = LDSCTL_OFF + 320, XL_OFF = LDSCTL_OFF + 1024, LDS_BYTES = 147456;
static_assert(XL_OFF + 8192 <= LDS_BYTES && att::ATT_LDS_BYTES <= RING_BYTES, "LDS map");

typedef GAS unsigned gu32;
#define RLX_AGENT __ATOMIC_RELAXED, __HIP_MEMORY_SCOPE_AGENT

#define XB_TMO      128
#define XB_XCNT(j)  (256  + 64 * (j))
#define XB_XSUB(j)  (1280 + 64 * (j))
#define XB_XGEN(j)  (2304 + 64 * (j))
#define XB_TOP      3328
#define XB_TOPGEN   3392
#define XCD_BAR_WORDS 3456
#define XB_SPIN_CAP (1u << 18)
__device__ __forceinline__ unsigned xb_ld(unsigned* p)              { return __hip_atomic_load(p, __ATOMIC_RELAXED, __HIP_MEMORY_SCOPE_AGENT); }
__device__ __forceinline__ unsigned xb_add(unsigned* p, unsigned v) { return __hip_atomic_fetch_add(p, v, __ATOMIC_RELAXED, __HIP_MEMORY_SCOPE_AGENT); }
__device__ __forceinline__ unsigned xb_xcc_id() { return (unsigned)__builtin_amdgcn_s_getreg((3 << 11) | 20) & 0xFu; }
#define XB_SPIN(cond, bar) do { unsigned _sp = 0; while (cond) { __builtin_amdgcn_s_sleep(1); \
    if ((++_sp & 255u) == 0u) { if (xb_ld(&(bar)[XB_TMO])) break; if (_sp > XB_SPIN_CAP) { atomicAdd(&(bar)[XB_TMO], 1u); break; } } } } while (0)
struct XcdBarrier { unsigned* bar; unsigned x; volatile LAS unsigned* st; };
__device__ __forceinline__ XcdBarrier xcd_barrier_post(unsigned* bar, volatile LAS unsigned* st) {
    XcdBarrier b; b.bar = bar; b.x = xb_xcc_id(); b.st = st;
    if (threadIdx.x == 0) (void)xb_add(&bar[XB_XCNT(b.x)], 1u);
    return b;
}
__device__ __forceinline__ void xcd_barrier_complete(unsigned* bar, unsigned x, unsigned& nloc, unsigned& nx) {
    const unsigned G = gridDim.x * gridDim.y * gridDim.z;
    unsigned sum, cnt, mine, sp = 0u;
    for (;;) {
        sum = 0u; cnt = 0u; mine = 0u;
#pragma unroll
        for (unsigned j = 0; j < 16; ++j) { const unsigned c = xb_ld(&bar[XB_XCNT(j)]); sum += c; cnt += (c > 0u) ? 1u : 0u; mine = (j == x) ? c : mine; }
        if (sum == G) break;
        __builtin_amdgcn_s_sleep(1);
        if ((++sp & 255u) == 0u) { if (xb_ld(&bar[XB_TMO])) break; if (sp > XB_SPIN_CAP) { atomicAdd(&bar[XB_TMO], 1u); break; } }
    }
    nloc = mine > 0u ? mine : 1u; nx = cnt > 0u ? cnt : 1u;
}
__device__ __forceinline__ void xcd_barrier(const XcdBarrier& b) {
    asm volatile("s_waitcnt vmcnt(0)" ::: "memory");
    __syncthreads();
    if (threadIdx.x == 0) {
        unsigned* bar = b.bar;
        __builtin_amdgcn_s_waitcnt(0);
        unsigned nloc = b.st[0], nx = b.st[1];
        if (nloc == 0u) { xcd_barrier_complete(bar, b.x, nloc, nx); b.st[0] = nloc; b.st[1] = nx; }
        const unsigned old = xb_add(&bar[XB_XSUB(b.x)], 1u);
        const unsigned gen = old / nloc;
        if (old + 1u == (gen + 1u) * nloc) {
            __builtin_amdgcn_fence(__ATOMIC_RELEASE, "agent");
            asm volatile("s_waitcnt vmcnt(0)" ::: "memory");
            const unsigned og = xb_add(&bar[XB_TOP], 1u);
            const unsigned tg = og / nx;
            if (og + 1u == (tg + 1u) * nx) xb_add(&bar[XB_TOPGEN], 1u);
            else XB_SPIN(xb_ld(&bar[XB_TOPGEN]) == tg, bar);
            __builtin_amdgcn_fence(__ATOMIC_ACQUIRE, "agent");
            xb_add(&bar[XB_XGEN(b.x)], 1u);
            asm volatile("s_waitcnt vmcnt(0)" ::: "memory");
        } else {
            XB_SPIN(xb_ld(&bar[XB_XGEN(b.x)]) == gen, bar);
            __builtin_amdgcn_fence(__ATOMIC_ACQUIRE, "agent");
            asm volatile("s_waitcnt vmcnt(0)" ::: "memory");
        }
    }
    __syncthreads();
}

struct Frame {
    LAS unsigned char* lds; LAS float* xl;
    int tid, lane, wave, vcu, G;
    unsigned char* ws;
    const float *x, *c; const int* pos; const float *w_ada, *b_ada, *g_an, *w_in, *g_ql, *g_kvl, *w_qup, *w_kvup, *g_mq, *g_mk, *g_cq, *g_ck, *relb, *w_out, *g_mn, *w_up, *conv_w, *conv_b, *w_down;
    float* out;
};

template <int WHICH> __device__ __forceinline__ int wmap(int n) {
    if (WHICH == 0) {
        if (n < 256) return n;
        if (n < 512) { const int c = n - 256; return c < 160 ? 256 + c : -1; }
        if (n < 1536) { const int t4 = (n - 512) >> 8, which = t4 >> 1, jj = t4 & 1, c = (n - 512) & 255, bj = c >> 7, wc = (c >> 5) & 3, i = c & 31; return 416 + which * 512 + (4 * jj + wc) * 64 + 32 * bj + i; }
        return 416 + 1024 + (n - 1536);
    } else if (WHICH == 1) {
        const int pn = n >> 8, c = n & 255, bj = c >> 7, wc = (c >> 5) & 3, i = c & 31, head = 2 * pn + bj;
        if (wc < 2) return head * 96 + 32 * wc + i;
        if (wc == 2) { const int fq = i >> 3, nn = (i >> 2) & 1, e = i & 3; return head * 96 + 64 + 4 * fq + e + 16 * nn; }
        return -1;
    } else if (WHICH == 2) {
        const int pn = n >> 8, c = n & 255, bj = c >> 7, wc = (c >> 5) & 3, i = c & 31, head = 2 * pn + bj;
        return wc < 2 ? head * 128 + 32 * wc + i : head * 128 + 64 + 32 * (wc - 2) + i;
    } else if (WHICH == 4) {
        const int j = n >> 8, c = n & 255; return c < 128 ? 128 * j + c : DFF + 128 * j + (c - 128);
    }
    return n;
}
template <int WHICH> __device__ __forceinline__ void cvt_item(const float* W, int K, int N, bf16_t* WT, int KP, int NP, LAS float* scr, int item, int lane) {
    const int nblk = NP / 32, kb = item / nblk, nb = item % nblk, k0 = 64 * kb, n0 = 32 * nb;
    const int src = wmap<WHICH>(n0 + (lane & 31)); const bool live = (src >= 0) && (k0 < K);
#pragma unroll 8
    for (int i = 0; i < 32; ++i) { const int kk = 2 * i + (lane >> 5); scr[kk * 33 + (lane & 31)] = live ? W[(size_t)(k0 + kk) * N + src] : 0.f; }
    asm volatile("s_waitcnt lgkmcnt(0)" ::: "memory");
    const int c = lane & 7;
#pragma unroll
    for (int j = 0; j < 4; ++j) { const int n = (lane >> 3) + 8 * j; const LAS float* s = scr + (8 * c) * 33 + n;
        u32x4 o; o.x = cvtpk(s[0 * 33], s[1 * 33]); o.y = cvtpk(s[2 * 33], s[3 * 33]); o.z = cvtpk(s[4 * 33], s[5 * 33]); o.w = cvtpk(s[6 * 33], s[7 * 33]);
        *(u32x4*)(WT + (size_t)(n0 + n) * KP + k0 + 8 * c) = o; }
    asm volatile("s_waitcnt lgkmcnt(0)" ::: "memory");
}
__device__ __forceinline__ void p0_prologue(Frame& F) {
    LAS float* scr = (LAS float*)(F.lds) + F.wave * 4096;
    const int gw = F.vcu * NWAVES + F.wave, NGW = F.G * NWAVES;
    constexpr int I0 = 16 * 64, I1 = 4 * 32, I2 = 4 * 32, I3 = 16 * 32, I4 = 16 * 176, I5 = 44 * 32;
    constexpr int NITEMS = I0 + I1 + I2 + I3 + I4 + I5;
    for (int it = gw; it < NITEMS; it += NGW) {
        int r = it;
        if (r < I0) { cvt_item<0>(F.w_in, 1024, 1952, (bf16_t*)(F.ws + WS_WIN), 1024, 2048, scr, r, F.lane); continue; } r -= I0;
        if (r < I1) { cvt_item<1>(F.w_qup, 256, 768, (bf16_t*)(F.ws + WS_WQUP), 256, 1024, scr, r, F.lane); continue; } r -= I1;
        if (r < I2) { cvt_item<2>(F.w_kvup, 128, 1024, (bf16_t*)(F.ws + WS_WKVUP), 256, 1024, scr, r, F.lane); continue; } r -= I2;
        if (r < I3) { cvt_item<3>(F.w_out, 1024, 1024, (bf16_t*)(F.ws + WS_WOUT), 1024, 1024, scr, r, F.lane); continue; } r -= I3;
        if (r < I4) { cvt_item<4>(F.w_up, 1024, DFF2, (bf16_t*)(F.ws + WS_WUP), 1024, DFF2, scr, r, F.lane); continue; } r -= I4;
        cvt_item<5>(F.w_down, DFF, 1024, (bf16_t*)(F.ws + WS_WDOWN), DFF, 1024, scr, r, F.lane);
    }
    {
        float* cosT = (float*)(F.ws + WS_COS); float* sinT = (float*)(F.ws + WS_SIN);
        const int gt = F.vcu * (NWAVES * 64) + F.tid, NT = F.G * NWAVES * 64;
        for (int idx = gt; idx < MTOK * 16; idx += NT) {
            const int m = idx >> 4, i = idx & 15;
            const float inv = __builtin_amdgcn_exp2f(-(float)i * (13.287712379549449f / 16.0f));
            const float ang = (float)F.pos[m] * inv;
            const float n = rintf(ang * 0.15915494309189535f);
            float r = fmaf(-n, 6.2831854820251465f, ang); r = fmaf(-n, -1.7484555e-7f, r);
            cosT[idx] = __cosf(r); sinT[idx] = __sinf(r);
        }
    }
    if (F.vcu < 96) {
        __syncthreads();
        const int n0 = F.vcu * 64, kbase = F.wave * 128;
        for (int idx = F.lane; idx < 2048; idx += 64) { const int b = idx >> 7, k = idx & 127; const float xv = F.c[b * 1024 + kbase + k]; scr[k * 16 + b] = xv / (1.0f + __expf(-xv)); }
        asm volatile("s_waitcnt lgkmcnt(0)" ::: "memory");
        f32x4 a0 = {0.f, 0.f, 0.f, 0.f}, a1 = a0, a2 = a0, a3 = a0;
#pragma unroll 8
        for (int k = 0; k < 128; ++k) {
            const float w = F.w_ada[(size_t)(kbase + k) * NMOD + n0 + F.lane];
            const LAS f32x4* sp = (const LAS f32x4*)(scr + k * 16);
            a0 += sp[0] * w; a1 += sp[1] * w; a2 += sp[2] * w; a3 += sp[3] * w;
        }
#pragma unroll
        for (int e = 0; e < 4; ++e) { scr[2048 + (0 + e) * 64 + F.lane] = a0[e]; scr[2048 + (4 + e) * 64 + F.lane] = a1[e]; scr[2048 + (8 + e) * 64 + F.lane] = a2[e]; scr[2048 + (12 + e) * 64 + F.lane] = a3[e]; }
        __syncthreads();
        float* MOD = (float*)(F.ws + WS_MOD);
#pragma unroll
        for (int bb = 0; bb < 2; ++bb) { const int b = 2 * F.wave + bb; float s = F.b_ada[n0 + F.lane];
#pragma unroll
            for (int w2 = 0; w2 < 8; ++w2) s += ((LAS float*)F.lds)[w2 * 4096 + 2048 + b * 64 + F.lane];
            MOD[(size_t)b * NMOD + n0 + F.lane] = s; }
        __syncthreads();
    }
}
__device__ __forceinline__ float wave_sum(float v) {
#pragma unroll
    for (int o = 1; o < 64; o <<= 1) v += __shfl_xor(v, o);
    return v;
}
__device__ __forceinline__ void norm_rows(Frame& F, const float* X, const float* g, int shift_off, int scale_off, bf16_t* out) {
    const float* MOD = (const float*)(F.ws + WS_MOD);
    const int gw = F.vcu * NWAVES + F.wave, NGW = F.G * NWAVES;
    for (int m = gw; m < MTOK; m += NGW) {
        const int b = m >> 11;
        const f32x4* xr = (const f32x4*)(X + (size_t)m * DM) + F.lane;
        f32x4 v[4]; float s = 0.f;
#pragma unroll
        for (int j = 0; j < 4; ++j) { v[j] = xr[64 * j]; s += dot4(v[j]); }
        const float r = rsqrtf(wave_sum(s) * (1.0f / DM) + EPS);
        const f32x4* gp = (const f32x4*)g + F.lane; const f32x4* shp = (const f32x4*)(MOD + (size_t)b * NMOD + shift_off) + F.lane; const f32x4* scp = (const f32x4*)(MOD + (size_t)b * NMOD + scale_off) + F.lane;
        u32x2* o8 = (u32x2*)(out + (size_t)m * DM) + F.lane;
#pragma unroll
        for (int j = 0; j < 4; ++j) { const f32x4 y = v[j] * r * gp[64 * j] * (scp[64 * j] + 1.0f) + shp[64 * j]; o8[64 * j] = pack4(y); }
    }
}
__device__ __forceinline__ void conv_fixup(Frame& F) {
    const float* RAW4 = (const float*)(F.ws + WS_RAW4); bf16_t* ACT = (bf16_t*)(F.ws + WS_ACT);
    const int gt = F.vcu * (NWAVES * 64) + F.tid, NT = F.G * NWAVES * 64;
    for (int idx = gt; idx < 512 * DFF; idx += NT) {
        const int blk = idx / DFF, c = idx - blk * DFF, j = c >> 7, cc = c & 127;
        const bool first = (blk & 31) == 0;
        float o[2][2];
#pragma unroll
        for (int half = 0; half < 2; ++half) {
            const int tcol = 256 * j + 128 * half + cc, ocol = half * DFF + c;
            const float w0 = F.conv_w[ocol], w1 = F.conv_w[DFF2 + ocol], w2 = F.conv_w[2 * DFF2 + ocol], bb = F.conv_b[ocol];
            const float pm2 = first ? 0.f : RAW4[((size_t)(blk - 1) * 4 + 2) * DFF2 + tcol], pm1 = first ? 0.f : RAW4[((size_t)(blk - 1) * 4 + 3) * DFF2 + tcol];
            const float r0 = RAW4[((size_t)blk * 4 + 0) * DFF2 + tcol], r1 = RAW4[((size_t)blk * 4 + 1) * DFF2 + tcol];
            o[half][0] = w0 * pm2 + w1 * pm1 + w2 * r0 + bb; o[half][1] = w0 * pm1 + w1 * r0 + w2 * r1 + bb;
        }
#pragma unroll
        for (int rr = 0; rr < 2; ++rr) { const float G = o[0][rr], a = G / (1.0f + __expf(-G)) * o[1][rr];
            ACT[((size_t)blk * 64 + rr) * DFF + c] = (bf16_t)(cvtpk(a, 0.f) & 0xffffu); }
    }
}

struct Args { const void* in[22]; float* out; unsigned char* ws; int ph_lo, ph_hi, li, pad; };
__global__ void __launch_bounds__(NWAVES * 64, 2) fwd_kernel(Args args) {
    extern __shared__ __attribute__((aligned(16))) unsigned char lds_raw[];
    Frame F;
    F.lds = (LAS unsigned char*)lds_raw; F.xl = (LAS float*)(F.lds + XL_OFF);
    F.tid = threadIdx.x; F.lane = F.tid & 63; F.wave = __builtin_amdgcn_readfirstlane(F.tid >> 6);
    F.G = gridDim.x; { const int bx = blockIdx.x; F.vcu = (F.G % 8 == 0) ? (bx % 8) * (F.G / 8) + bx / 8 : bx; }
    F.ws = args.ws; F.out = args.out;
    F.x = (const float*)args.in[0]; F.c = (const float*)args.in[1]; F.pos = (const int*)args.in[2]; F.w_ada = (const float*)args.in[3]; F.b_ada = (const float*)args.in[4];
    F.g_an = (const float*)args.in[5]; F.w_in = (const float*)args.in[6]; F.g_ql = (const float*)args.in[7]; F.g_kvl = (const float*)args.in[8]; F.w_qup = (const float*)args.in[9];
    F.w_kvup = (const float*)args.in[10]; F.g_mq = (const float*)args.in[11]; F.g_mk = (const float*)args.in[12]; F.g_cq = (const float*)args.in[13]; F.g_ck = (const float*)args.in[14];
    F.relb = (const float*)args.in[15]; F.w_out = (const float*)args.in[16]; F.g_mn = (const float*)args.in[17]; F.w_up = (const float*)args.in[18]; F.conv_w = (const float*)args.in[19];
    F.conv_b = (const float*)args.in[20]; F.w_down = (const float*)args.in[21];
    unsigned char* ws = args.ws;
    for (int u = F.tid; u < (LDS_BYTES - LDSCTL_OFF) / 4; u += NWAVES * 64) ((LAS unsigned*)(F.lds + LDSCTL_OFF))[u] = 0u;
    __syncthreads();
    XcdBarrier bar; bar.bar = (unsigned*)(ws + WS_CTL) + CW_BAR; bar.x = 0; bar.st = nullptr;
    if (N_LAUNCHES == 1) bar = xcd_barrier_post((unsigned*)(ws + WS_CTL) + CW_BAR, (volatile LAS unsigned*)(F.lds + MISC_OFF) + 8);
#define GRID_BAR() do { if (N_LAUNCHES == 1) xcd_barrier(bar); } while (0)
    const int lo = args.ph_lo, hi = args.ph_hi;
#ifndef PH_MASK
#define PH_MASK 0x3ff
#endif
#define IN(k) (((PH_MASK >> (k)) & 1) && lo <= (k) && (k) < hi)
#define BOTH(k) (IN(k) && IN((k) + 1))
    float* MOD = (float*)(ws + WS_MOD);
    bf16_t* XN = (bf16_t*)(ws + WS_XN);

    if (IN(0)) { p0_prologue(F); if (BOTH(0)) GRID_BAR(); }
    if (IN(1)) { norm_rows(F, F.x, F.g_an, 0, DM, XN); if (BOTH(1)) GRID_BAR(); }
    if (IN(2)) {
        pg8::Gemm g{XN, (const bf16_t*)(ws + WS_WIN), MTOK, 2048, 1024}; pg8::StaticOrder S; S.init(MTOK, 2048, F.G, (int)blockIdx.x);
        EpiIn E{(bf16_t*)(ws + WS_QLN), (bf16_t*)(ws + WS_KVLN), (bf16_t*)(ws + WS_CQ), (bf16_t*)(ws + WS_CK), (bf16_t*)(ws + WS_CV), (float*)(ws + WS_KR), (float*)(ws + WS_SSR), F.g_ql, F.g_kvl, F.g_cq, F.g_ck};
        pg8::gemm_phase(F.lds, F.xl, g, S, E);
        if (BOTH(2)) GRID_BAR();
    }
    if (IN(3)) {
#ifndef P3_NO_Q
        { pg8::Gemm g{(const bf16_t*)(ws + WS_QLN), (const bf16_t*)(ws + WS_WQUP), MTOK, 1024, 256}; pg8::StaticOrder S; S.init(MTOK, 1024, F.G, (int)blockIdx.x);
          EpiQ E{(bf16_t*)(ws + WS_QM), F.g_mq, (const float*)(ws + WS_COS), (const float*)(ws + WS_SIN)};
          pg8::gemm_phase(F.lds, F.xl, g, S, E); }
#endif
#ifndef P3_NO_KV
        { pg8::Gemm g{(const bf16_t*)(ws + WS_KVLN), (const bf16_t*)(ws + WS_WKVUP), MTOK, 1024, 256}; pg8::StaticOrder S; S.init(MTOK, 1024, F.G, (int)blockIdx.x);
          EpiKV E{(bf16_t*)(ws + WS_KM), (bf16_t*)(ws + WS_VM), F.g_mk, (const float*)(ws + WS_COS), (const float*)(ws + WS_SIN), (const float*)(ws + WS_KR), (const float*)(ws + WS_SSR)};
          pg8::gemm_phase(F.lds, F.xl, g, S, E); }
#endif
        if (BOTH(3)) GRID_BAR();
    }
    if (IN(4)) {
        bf16_t* OM = (bf16_t*)(ws + WS_OM);
        if (F.G == 256) {
            const int bh = F.vcu >> 1, par = F.vcu & 1, b = bh >> 3, h = bh & 7;
            for (int i = 0; i < 4; ++i) { const int s = 2 * par + (i >> 1); const int qb = (i & 1) ? 7 - s : s;
                att::attn_unit<96, false, 8>(b, h, qb, (const bf16_t*)(ws + WS_QM), (const bf16_t*)(ws + WS_KM), (const bf16_t*)(ws + WS_VM), OM, nullptr, F.lds); }
            for (int i = 0; i < 4; ++i) { const int qb = 2 * i + par;
                att::attn_unit<64, true, 8>(b, h, qb, (const bf16_t*)(ws + WS_CQ), (const bf16_t*)(ws + WS_CK), (const bf16_t*)(ws + WS_CV), OM, F.relb, F.lds); }
        } else {
            for (int i = F.vcu; i < 2048; i += F.G) { const int kind = i >> 10, j = i & 1023, bh = j >> 3, qb = j & 7;
                if (kind == 0) att::attn_unit<96, false, 8>(bh >> 3, bh & 7, qb, (const bf16_t*)(ws + WS_QM), (const bf16_t*)(ws + WS_KM), (const bf16_t*)(ws + WS_VM), OM, nullptr, F.lds);
                else att::attn_unit<64, true, 8>(bh >> 3, bh & 7, qb, (const bf16_t*)(ws + WS_CQ), (const bf16_t*)(ws + WS_CK), (const bf16_t*)(ws + WS_CV), OM, F.relb, F.lds); }
        }
        if (BOTH(4)) GRID_BAR();
    }
    if (IN(5)) {
        pg8::Gemm g{(const bf16_t*)(ws + WS_OM), (const bf16_t*)(ws + WS_WOUT), MTOK, 1024, 1024}; pg8::StaticOrder S; S.init(MTOK, 1024, F.G, (int)blockIdx.x);
        EpiRes E{F.x, F.out, MOD + 2 * DM};
        pg8::gemm_phase(F.lds, F.xl, g, S, E);
        if (BOTH(5)) GRID_BAR();
    }
    if (IN(6)) { norm_rows(F, F.out, F.g_mn, 3 * DM, 4 * DM, XN); if (BOTH(6)) GRID_BAR(); }
    if (IN(7)) {
        pg8::Gemm g{XN, (const bf16_t*)(ws + WS_WUP), MTOK, DFF2, 1024}; pg8::StaticOrder S; S.init(MTOK, DFF2, F.G, (int)blockIdx.x);
        EpiUp E{(bf16_t*)(ws + WS_ACT), (float*)(ws + WS_RAW4), F.conv_w, F.conv_b};
        pg8::gemm_phase(F.lds, F.xl, g, S, E);
        if (BOTH(7)) GRID_BAR();
    }
    if (IN(8)) { conv_fixup(F); if (BOTH(8)) GRID_BAR(); }
    if (IN(9)) {
        pg8::Gemm g{(const bf16_t*)(ws + WS_ACT), (const bf16_t*)(ws + WS_WDOWN), MTOK, 1024, DFF}; pg8::StaticOrder S; S.init(MTOK, 1024, F.G, (int)blockIdx.x);
        EpiRes E{F.out, F.out, MOD + 5 * DM};
        pg8::gemm_phase(F.lds, F.xl, g, S, E);
    }
#undef IN
#undef BOTH
}

extern "C" void kernel_launch(void* const* d_in, const int* in_sizes, int n_in, void* d_out, int out_size, void* d_ws, size_t ws_size, hipStream_t stream) {
    static int grid = 0;
    if (grid == 0) {
        if (n_in != 22 || in_sizes[0] != MTOK * DM || out_size != MTOK * DM || ws_size < WS_END) {
            fprintf(stderr, "kernel_launch: unexpected shapes (n_in %d, in0 %d, out %d, ws %zu); nothing launched\n", n_in, n_in > 0 ? in_sizes[0] : -1, out_size, ws_size); grid = -1; return; }
        int dev = 0, cus = 0, per_cu = 0;
        if (hipGetDevice(&dev) != hipSuccess || hipDeviceGetAttribute(&cus, hipDeviceAttributeMultiprocessorCount, dev) != hipSuccess) { grid = -1; return; }
        if (hipFuncSetAttribute((const void*)fwd_kernel, hipFuncAttributeMaxDynamicSharedMemorySize, LDS_BYTES) != hipSuccess) { fprintf(stderr, "kernel_launch: hipFuncSetAttribute failed\n"); grid = -1; return; }
        if (hipOccupancyMaxActiveBlocksPerMultiprocessor(&per_cu, (const void*)fwd_kernel, NWAVES * 64, LDS_BYTES) != hipSuccess || per_cu < 1)
            fprintf(stderr, "kernel_launch: note: occupancy query reports %d workgroups per CU\n", per_cu);
        (void)hipGetLastError();
        grid = cus;
    }
    if (grid < 0) return;
    if (hipMemsetAsync((char*)d_ws + WS_CTL, 0, CTL_ZERO_BYTES, stream) != hipSuccess) { fprintf(stderr, "kernel_launch: memset failed\n"); return; }
    Args a{};
    for (int i = 0; i < 22; ++i) a.in[i] = d_in[i];
    a.out = (float*)d_out; a.ws = (unsigned char*)d_ws;
    for (int li = 0; li < N_LAUNCHES; ++li) {
        a.ph_lo = (N_LAUNCHES == 1) ? 0 : li; a.ph_hi = (N_LAUNCHES == 1) ? NPHASE : li + 1; a.li = li;
        hipLaunchKernelGGL(fwd_kernel, dim3(grid), dim3(NWAVES * 64), LDS_BYTES, stream, a);
        const hipError_t le = hipPeekAtLastError();
        if (le != hipSuccess) { fprintf(stderr, "kernel_launch: launch %d failed: %s\n", li, hipGetErrorName(le)); break; }
    }
}
```

```cpp
#include <hip/hip_runtime.h>
#include <cstdio>
#include <cstdint>

#define LAS __attribute__((address_space(3)))
#define GAS __attribute__((address_space(1)))
typedef unsigned short bf16_t;
typedef short bf16x8 __attribute__((ext_vector_type(8)));
typedef short s16x4 __attribute__((ext_vector_type(4)));
typedef float f32x2 __attribute__((ext_vector_type(2)));
typedef float f32x4 __attribute__((ext_vector_type(4)));
typedef float f32x16 __attribute__((ext_vector_type(16)));
typedef unsigned u32x2 __attribute__((ext_vector_type(2)));
typedef unsigned u32x4 __attribute__((ext_vector_type(4)));
typedef __bf16 bf16x2_t __attribute__((ext_vector_type(2)));

#ifndef MK_N_LAUNCHES
#define MK_N_LAUNCHES 1
#endif

constexpr int BATCH = 16, SEQ = 2048, DM = 1024, MTOK = BATCH * SEQ;
constexpr int NMOD = 6 * DM;
constexpr int DFF = 2816, DFF2 = 5632;
constexpr float EPS = 1e-6f;
constexpr float LOG2E = 1.4426950408889634f;
constexpr float C2_MLA = 0.10206207261596577f * LOG2E;
constexpr float C2_CA = 0.125f * LOG2E;

__device__ __forceinline__ unsigned cvtpk(float lo, float hi) { f32x2 v = {lo, hi}; bf16x2_t b = __builtin_convertvector(v, bf16x2_t); return __builtin_bit_cast(unsigned, b); }
__device__ __forceinline__ u32x4 pack8(f32x4 a, f32x4 b) { u32x4 w; w.x = cvtpk(a[0], a[1]); w.y = cvtpk(a[2], a[3]); w.z = cvtpk(b[0], b[1]); w.w = cvtpk(b[2], b[3]); return w; }
__device__ __forceinline__ u32x2 pack4(f32x4 a) { u32x2 w; w.x = cvtpk(a[0], a[1]); w.y = cvtpk(a[2], a[3]); return w; }
__device__ __forceinline__ float dot4(f32x4 a) { return (a[0] * a[0] + a[1] * a[1]) + (a[2] * a[2] + a[3] * a[3]); }
#define LDS_BARRIER() do { asm volatile("s_waitcnt lgkmcnt(0)" ::: "memory"); __builtin_amdgcn_s_barrier(); asm volatile("" ::: "memory"); } while (0)

namespace pg8 {
constexpr int BM = 256, BK = 64, HALF = 128, HTB = HALF * BK * 2, STAGE_BYTES = 8 * HTB, NXCD = 8, WGM = 8;
__host__ __device__ __forceinline__ int lds_byte(int r, int c) { const int st = (r >> 4) * 2 + (c >> 5), rr = r & 15, cc = c & 31, ob = rr * 64 + cc * 2; return st * 1024 + (ob ^ (((ob >> 9) & 1) << 5)); }
__host__ __device__ __forceinline__ void stage_rc(int b, int& R, int& C) { const int st = b / 1024, sb = b % 1024, swz = sb ^ (((sb >> 9) & 1) << 5); R = (st >> 1) * 16 + swz / 64; C = (st & 1) * 32 + (swz % 64) / 2; }
__host__ __device__ __forceinline__ int perm32(int rho) { const int n = rho >> 4, i = rho & 15; return 8 * (i >> 2) + 4 * n + (i & 3); }

struct Unit { int pm, pn; };
struct Gemm { const bf16_t* A; const bf16_t* Bt; int M, N, K; };

struct StaticOrder {
    int nM, nN, nwg, G, c;
    __host__ __device__ void init(int M, int N, int G_, int c_) { nM = M / BM; nN = N / BM; nwg = nM * nN; G = G_; c = c_; }
    __host__ __device__ bool next(int i, Unit& u) const {
        const long L = (long)i * G + c; if (L >= nwg) return false;
        int wgid = (int)L; { const int q = nwg / NXCD, r = nwg % NXCD, xcd = wgid % NXCD, off = wgid / NXCD; wgid = (xcd < r ? xcd * (q + 1) : r * (q + 1) + (xcd - r) * q) + off; }
        const int nig = WGM * nN, gid = wgid / nig, fm = gid * WGM, gsz = (nM - fm) < WGM ? (nM - fm) : WGM;
        u.pm = fm + ((wgid % nig) % gsz); u.pn = (wgid % nig) / gsz; return true;
    }
};

template <class Epi, class Sched>
__device__ __forceinline__ void gemm_phase(LAS unsigned char* lds, LAS float* xl, const Gemm g, const Sched& S, const Epi& E) {
    const int tid = threadIdx.x, wid = __builtin_amdgcn_readfirstlane(tid >> 6), lane = tid & 63, wr = wid >> 2, wc = wid & 3, fr = lane & 15, fq = lane >> 4;
    const int K = g.K, nt = K / BK;
    unsigned voffA[2], voffB[2];
#pragma unroll
    for (int i = 0; i < 2; ++i) { int R, C; stage_rc(tid * 16 + i * 8192, R, C); const int Rb = (R & ~31) + perm32(R & 31);
        voffA[i] = (unsigned)(R * K + C) * 2u; voffB[i] = (unsigned)(Rb * K + C) * 2u; }
    const size_t kstep = (size_t)(BK * 2);
    const size_t hstep = (size_t)HALF * K * 2;
    const size_t tstep = 2 * hstep;
    const unsigned ldsw = (unsigned)wid * 1024u;
    const int aoff = lds_byte(wr * 64 + fr, fq * 8), boff = lds_byte(wc * 32 + fr, fq * 8);
#define PG8_SA(b, h) (((b) * 2 + (h)) * HTB)
#define PG8_SB(b, h) ((4 + (b) * 2 + (h)) * HTB)
#define PG8_STAGE(bufoff, gbase, voff) do { _Pragma("unroll") for (int _i = 0; _i < 2; ++_i) \
        __builtin_amdgcn_global_load_lds((const unsigned*)((const char*)(gbase) + (voff)[_i]), (LAS unsigned*)(lds + (bufoff) + ldsw + _i * 8192), 16, 0, 0); } while (0)
#define PG8_LDA(dst, b, h) do { _Pragma("unroll") for (int m = 0; m < 4; ++m) _Pragma("unroll") for (int k = 0; k < 2; ++k) dst[m][k] = *(const LAS bf16x8*)(lds + PG8_SA(b, h) + aoff + m * 2048 + k * 1024); } while (0)
#define PG8_LDB(dst, b, h) do { _Pragma("unroll") for (int n = 0; n < 2; ++n) _Pragma("unroll") for (int k = 0; k < 2; ++k) dst[n][k] = *(const LAS bf16x8*)(lds + PG8_SB(b, h) + boff + n * 2048 + k * 1024); } while (0)
#define PG8_MMA(ai, bj, At, Bt) do { __builtin_amdgcn_s_setprio(1); _Pragma("unroll") for (int m = 0; m < 4; ++m) _Pragma("unroll") for (int n = 0; n < 2; ++n) _Pragma("unroll") for (int k = 0; k < 2; ++k) \
        acc[ai][bj][m][n] = __builtin_amdgcn_mfma_f32_16x16x32_bf16(Bt[n][k], At[m][k], acc[ai][bj][m][n], 0, 0, 0); __builtin_amdgcn_s_setprio(0); } while (0)
#define PG8_WAIT_V(n) asm volatile("s_waitcnt vmcnt(" #n ")" ::: "memory")
#define PG8_WAIT_L(n) asm volatile("s_waitcnt lgkmcnt(" #n ")" ::: "memory")
#define PG8_BAR __builtin_amdgcn_s_barrier()
#define PG8_SCHED __builtin_amdgcn_sched_barrier(0)
    Unit cur, nxt; int ui = 0;
    if (!S.next(0, cur)) return;
    f32x4 acc[2][2][4][2];
#pragma unroll
    for (int a = 0; a < 2; ++a)
#pragma unroll
        for (int b = 0; b < 2; ++b)
#pragma unroll
            for (int m = 0; m < 4; ++m)
#pragma unroll
                for (int n = 0; n < 2; ++n) acc[a][b][m][n] = (f32x4){0.f, 0.f, 0.f, 0.f};
    bf16x8 At[4][2], B0[2][2], B1[2][2];
    const char* cA = (const char*)g.A + (size_t)cur.pm * tstep; const char* cB = (const char*)g.Bt + (size_t)cur.pn * tstep;
    PG8_STAGE(PG8_SB(0, 0), cB, voffB); PG8_STAGE(PG8_SB(0, 1), cB + hstep, voffB); PG8_STAGE(PG8_SA(0, 0), cA, voffA); PG8_STAGE(PG8_SA(0, 1), cA + hstep, voffA);
    if (wr == 1) PG8_BAR;
    PG8_WAIT_V(2); PG8_BAR;
    PG8_STAGE(PG8_SB(1, 0), cB + kstep, voffB); PG8_STAGE(PG8_SA(1, 0), cA + kstep, voffA); PG8_STAGE(PG8_SB(1, 1), cB + hstep + kstep, voffB);
    PG8_WAIT_V(6); PG8_BAR;
    for (;;) {
        const bool has_next = S.next(ui + 1, nxt);
        const char* nA = has_next ? (const char*)g.A + (size_t)nxt.pm * tstep : cA; const char* nB = has_next ? (const char*)g.Bt + (size_t)nxt.pn * tstep : cB;
        for (int t = 0; t < nt; t += 2) {
            const bool last = (t == nt - 2);
            const char* a1 = cA + (size_t)(t + 1) * kstep;
            const char* a2 = last ? nA : cA + (size_t)(t + 2) * kstep; const char* b2 = last ? nB : cB + (size_t)(t + 2) * kstep;
            const char* a3 = a2 + kstep; const char* b3 = b2 + kstep;
            PG8_LDB(B0, 0, 0); PG8_LDB(B1, 0, 1); PG8_SCHED; PG8_LDA(At, 0, 0); PG8_STAGE(PG8_SA(1, 1), a1 + hstep, voffA);
            PG8_WAIT_V(8); PG8_WAIT_L(0); PG8_BAR; PG8_MMA(0, 0, At, B0); PG8_MMA(0, 1, At, B1); PG8_BAR; PG8_SCHED;
            PG8_LDA(At, 0, 1); PG8_STAGE(PG8_SB(0, 0), b2, voffB); PG8_STAGE(PG8_SB(0, 1), b2 + hstep, voffB); PG8_STAGE(PG8_SA(0, 0), a2, voffA);
            PG8_WAIT_V(8); PG8_WAIT_L(0); PG8_BAR; PG8_MMA(1, 0, At, B0); PG8_MMA(1, 1, At, B1); PG8_BAR; PG8_SCHED;
            PG8_LDB(B0, 1, 0); PG8_LDB(B1, 1, 1); PG8_SCHED; PG8_LDA(At, 1, 0); PG8_STAGE(PG8_SA(0, 1), a2 + hstep, voffA);
            PG8_WAIT_V(8); PG8_WAIT_L(0); PG8_BAR; PG8_MMA(0, 0, At, B0); PG8_MMA(0, 1, At, B1); PG8_BAR; PG8_SCHED;
            PG8_LDA(At, 1, 1); PG8_STAGE(PG8_SB(1, 0), b3, voffB); PG8_STAGE(PG8_SB(1, 1), b3 + hstep, voffB); PG8_STAGE(PG8_SA(1, 0), a3, voffA);
            PG8_WAIT_V(8); PG8_WAIT_L(0); PG8_BAR; PG8_MMA(1, 0, At, B0); PG8_MMA(1, 1, At, B1); PG8_BAR; PG8_SCHED;
        }
        if (wr == 0) PG8_BAR;
        E(acc, cur, wr, wc, fr, fq, xl);
        if (!has_next) break;
#pragma unroll
        for (int a = 0; a < 2; ++a)
#pragma unroll
            for (int b = 0; b < 2; ++b)
#pragma unroll
                for (int m = 0; m < 4; ++m)
#pragma unroll
                    for (int n = 0; n < 2; ++n) acc[a][b][m][n] = (f32x4){0.f, 0.f, 0.f, 0.f};
        cur = nxt; cA = nA; cB = nB; ++ui;
        if (wr == 1) PG8_BAR;
    }
    PG8_WAIT_V(0);
    PG8_BAR;
#undef PG8_SA
#undef PG8_SB
#undef PG8_STAGE
#undef PG8_LDA
#undef PG8_LDB
#undef PG8_MMA
#undef PG8_WAIT_V
#undef PG8_WAIT_L
#undef PG8_BAR
#undef PG8_SCHED
}
}
using pg8::Unit;


struct EpiIn {
    bf16_t *QLN, *KVLN, *CQ, *CK, *CV; float *KR, *SSR; const float *g_ql, *g_kvl, *g_caq, *g_cak;
    __device__ __forceinline__ void operator()(const f32x4 (&acc)[2][2][4][2], const Unit& u, int wr, int wc, int fr, int fq, LAS float* red) const {
        asm volatile("" : "+v"(fr), "+v"(fq));
        const int rl0 = wr * 64 + fr; const size_t row0 = (size_t)u.pm * 256 + rl0; const int pn = u.pn;
        if (pn >= 6) {
            bf16_t* base = CV + (pn - 6) * 256 + wc * 32 + 8 * fq;
#pragma unroll
            for (int ai = 0; ai < 2; ++ai)
#pragma unroll
                for (int m = 0; m < 4; ++m) { bf16_t* rp = base + (row0 + ai * 128 + m * 16) * 512;
#pragma unroll
                    for (int bj = 0; bj < 2; ++bj) *(u32x4*)(rp + bj * 128) = pack8(acc[ai][bj][m][0], acc[ai][bj][m][1]); }
        } else if (pn >= 2) {
            const bool isq = pn < 4; const int head = 4 * ((pn - 2) & 1) + wc; const float* g = isq ? g_caq : g_cak; const float sc = isq ? C2_CA : 1.0f;
            f32x4 gv[2][2];
#pragma unroll
            for (int bj = 0; bj < 2; ++bj)
#pragma unroll
                for (int n = 0; n < 2; ++n) gv[bj][n] = *(const f32x4*)(g + 32 * bj + 8 * fq + 4 * n) * sc;
            bf16_t* base = (isq ? CQ : CK) + head * 64 + 8 * fq;
#pragma unroll
            for (int ai = 0; ai < 2; ++ai)
#pragma unroll
                for (int m = 0; m < 4; ++m) {
                    float ss = (dot4(acc[ai][0][m][0]) + dot4(acc[ai][0][m][1])) + (dot4(acc[ai][1][m][0]) + dot4(acc[ai][1][m][1]));
                    ss += __shfl_xor(ss, 16); ss += __shfl_xor(ss, 32);
                    const float r = rsqrtf(ss * (1.0f / 64.0f) + EPS);
                    bf16_t* rp = base + (row0 + ai * 128 + m * 16) * 512;
#pragma unroll
                    for (int bj = 0; bj < 2; ++bj) *(u32x4*)(rp + bj * 32) = pack8(acc[ai][bj][m][0] * r * gv[bj][0], acc[ai][bj][m][1] * r * gv[bj][1]);
                }
        } else if (pn == 0) {
#pragma unroll
            for (int ai = 0; ai < 2; ++ai)
#pragma unroll
                for (int m = 0; m < 4; ++m) {
                    float ss = (dot4(acc[ai][0][m][0]) + dot4(acc[ai][0][m][1])) + (dot4(acc[ai][1][m][0]) + dot4(acc[ai][1][m][1]));
                    ss += __shfl_xor(ss, 16); ss += __shfl_xor(ss, 32);
                    if (fq == 0) red[(ai * 128 + m * 16 + rl0) * 8 + wc] = ss;
                }
            LDS_BARRIER();
            f32x4 gv[2][2];
#pragma unroll
            for (int bj = 0; bj < 2; ++bj)
#pragma unroll
                for (int n = 0; n < 2; ++n) gv[bj][n] = *(const f32x4*)(g_ql + 128 * bj + 32 * wc + 8 * fq + 4 * n);
            bf16_t* base = QLN + wc * 32 + 8 * fq;
#pragma unroll
            for (int ai = 0; ai < 2; ++ai)
#pragma unroll
                for (int m = 0; m < 4; ++m) {
                    const f32x4 t = *(const LAS f32x4*)(red + (ai * 128 + m * 16 + rl0) * 8);
                    const float r = rsqrtf(((t[0] + t[1]) + (t[2] + t[3])) * (1.0f / 256.0f) + EPS);
                    bf16_t* rp = base + (row0 + ai * 128 + m * 16) * 256;
#pragma unroll
                    for (int bj = 0; bj < 2; ++bj) *(u32x4*)(rp + bj * 128) = pack8(acc[ai][bj][m][0] * r * gv[bj][0], acc[ai][bj][m][1] * r * gv[bj][1]);
                }
        } else {
#pragma unroll
            for (int ai = 0; ai < 2; ++ai)
#pragma unroll
                for (int m = 0; m < 4; ++m) {
                    float ss = dot4(acc[ai][0][m][0]) + dot4(acc[ai][0][m][1]);
                    ss += __shfl_xor(ss, 16); ss += __shfl_xor(ss, 32);
                    if (fq == 0) red[(ai * 128 + m * 16 + rl0) * 8 + wc] = ss;
                }
            LDS_BARRIER();
            f32x4 gv[2];
#pragma unroll
            for (int n = 0; n < 2; ++n) gv[n] = *(const f32x4*)(g_kvl + 32 * wc + 8 * fq + 4 * n);
            bf16_t* base = KVLN + wc * 32 + 8 * fq;
#pragma unroll
            for (int ai = 0; ai < 2; ++ai)
#pragma unroll
                for (int m = 0; m < 4; ++m) {
                    const f32x4 t = *(const LAS f32x4*)(red + (ai * 128 + m * 16 + rl0) * 8);
                    const float r = rsqrtf(((t[0] + t[1]) + (t[2] + t[3])) * (1.0f / 128.0f) + EPS);
                    const size_t row = row0 + ai * 128 + m * 16;
                    bf16_t* rp = base + row * 256;
                    *(u32x4*)(rp) = pack8(acc[ai][0][m][0] * r * gv[0], acc[ai][0][m][1] * r * gv[1]);
                    *(u32x4*)(rp + 128) = (u32x4){0u, 0u, 0u, 0u};
                    if (wc == 0) {
                        *(f32x4*)(KR + row * 32 + 8 * fq) = acc[ai][1][m][0]; *(f32x4*)(KR + row * 32 + 8 * fq + 4) = acc[ai][1][m][1];
                        float sr = dot4(acc[ai][1][m][0]) + dot4(acc[ai][1][m][1]);
                        sr += __shfl_xor(sr, 16); sr += __shfl_xor(sr, 32);
                        if (fq == 0) SSR[row] = sr;
                    }
                }
        }
    }
};

struct EpiQ {
    bf16_t* QM; const float *g, *cosT, *sinT;
    __device__ __forceinline__ void operator()(const f32x4 (&acc)[2][2][4][2], const Unit& u, int wr, int wc, int fr, int fq, LAS float* red) const {
        asm volatile("" : "+v"(fr), "+v"(fq));
        const int rl0 = wr * 64 + fr; const size_t row0 = (size_t)u.pm * 256 + rl0;
#pragma unroll
        for (int ai = 0; ai < 2; ++ai)
#pragma unroll
            for (int m = 0; m < 4; ++m)
#pragma unroll
                for (int bj = 0; bj < 2; ++bj) {
                    float ss = dot4(acc[ai][bj][m][0]) + dot4(acc[ai][bj][m][1]);
                    ss += __shfl_xor(ss, 16); ss += __shfl_xor(ss, 32);
                    if (fq == 0) red[(ai * 128 + m * 16 + rl0) * 8 + bj * 4 + wc] = ss;
                }
        LDS_BARRIER();
        if (wc < 2) {
            const f32x4 g0 = *(const f32x4*)(g + 32 * wc + 8 * fq) * C2_MLA, g1 = *(const f32x4*)(g + 32 * wc + 8 * fq + 4) * C2_MLA;
#pragma unroll
            for (int ai = 0; ai < 2; ++ai)
#pragma unroll
                for (int m = 0; m < 4; ++m) {
                    const size_t row = row0 + ai * 128 + m * 16;
#pragma unroll
                    for (int bj = 0; bj < 2; ++bj) {
                        const f32x4 t = *(const LAS f32x4*)(red + (ai * 128 + m * 16 + rl0) * 8 + bj * 4);
                        const float r = rsqrtf(((t[0] + t[1]) + (t[2] + t[3])) * (1.0f / 96.0f) + EPS);
                        *(u32x4*)(QM + row * 768 + (2 * u.pn + bj) * 96 + 32 * wc + 8 * fq) = pack8(acc[ai][bj][m][0] * r * g0, acc[ai][bj][m][1] * r * g1);
                    }
                }
        } else if (wc == 2) {
            const f32x4 g0 = *(const f32x4*)(g + 64 + 4 * fq) * C2_MLA, g1 = *(const f32x4*)(g + 80 + 4 * fq) * C2_MLA;
#pragma unroll
            for (int ai = 0; ai < 2; ++ai)
#pragma unroll
                for (int m = 0; m < 4; ++m) {
                    const size_t row = row0 + ai * 128 + m * 16;
                    const f32x4 cs = *(const f32x4*)(cosT + row * 16 + 4 * fq), sn = *(const f32x4*)(sinT + row * 16 + 4 * fq);
#pragma unroll
                    for (int bj = 0; bj < 2; ++bj) {
                        const f32x4 t = *(const LAS f32x4*)(red + (ai * 128 + m * 16 + rl0) * 8 + bj * 4);
                        const float r = rsqrtf(((t[0] + t[1]) + (t[2] + t[3])) * (1.0f / 96.0f) + EPS);
                        bf16_t* hp = QM + row * 768 + (2 * u.pn + bj) * 96;
                        const f32x4 x1 = acc[ai][bj][m][0] * r * g0, x2 = acc[ai][bj][m][1] * r * g1;
                        *(u32x2*)(hp + 64 + 4 * fq) = pack4(x1 * cs - x2 * sn); *(u32x2*)(hp + 80 + 4 * fq) = pack4(x2 * cs + x1 * sn);
                    }
                    asm volatile("" ::: "memory");
                }
        }
    }
};

struct EpiKV {
    bf16_t *KM, *VM; const float *g, *cosT, *sinT, *KR, *SSR;
    __device__ __forceinline__ void operator()(const f32x4 (&acc)[2][2][4][2], const Unit& u, int wr, int wc, int fr, int fq, LAS float* red) const {
        asm volatile("" : "+v"(fr), "+v"(fq));
        const int rl0 = wr * 64 + fr; const size_t row0 = (size_t)u.pm * 256 + rl0;
        if (wc < 2) {
#pragma unroll
            for (int ai = 0; ai < 2; ++ai)
#pragma unroll
                for (int m = 0; m < 4; ++m)
#pragma unroll
                    for (int bj = 0; bj < 2; ++bj) {
                        float ss = dot4(acc[ai][bj][m][0]) + dot4(acc[ai][bj][m][1]);
                        ss += __shfl_xor(ss, 16); ss += __shfl_xor(ss, 32);
                        if (fq == 0) red[(ai * 128 + m * 16 + rl0) * 8 + bj * 2 + wc] = ss;
                    }
        }
        LDS_BARRIER();
        if (wc < 2) {
            const f32x4 g0 = *(const f32x4*)(g + 32 * wc + 8 * fq), g1 = *(const f32x4*)(g + 32 * wc + 8 * fq + 4);
#pragma unroll
            for (int ai = 0; ai < 2; ++ai)
#pragma unroll
                for (int m = 0; m < 4; ++m) {
                    const size_t row = row0 + ai * 128 + m * 16;
                    const float ssr = SSR[row];
                    const f32x4 t = *(const LAS f32x4*)(red + (ai * 128 + m * 16 + rl0) * 8);
#pragma unroll
                    for (int bj = 0; bj < 2; ++bj) {
                        const float rk = rsqrtf((t[2 * bj] + t[2 * bj + 1] + ssr) * (1.0f / 96.0f) + EPS);
                        *(u32x4*)(KM + row * 768 + (2 * u.pn + bj) * 96 + 32 * wc + 8 * fq) = pack8(acc[ai][bj][m][0] * rk * g0, acc[ai][bj][m][1] * rk * g1);
                    }
                    asm volatile("" ::: "memory");
                }
        } else {
            const int bj0 = wc - 2, h0 = 2 * u.pn + bj0;
            const f32x4 g0 = *(const f32x4*)(g + 64 + 4 * fq), g1 = *(const f32x4*)(g + 80 + 4 * fq);
#pragma unroll
            for (int ai = 0; ai < 2; ++ai)
#pragma unroll
                for (int m = 0; m < 4; ++m) {
                    const size_t row = row0 + ai * 128 + m * 16;
#pragma unroll
                    for (int bj = 0; bj < 2; ++bj) *(u32x4*)(VM + row * 512 + (2 * u.pn + bj) * 64 + 32 * (wc - 2) + 8 * fq) = pack8(acc[ai][bj][m][0], acc[ai][bj][m][1]);
                    const f32x2 t = *(const LAS f32x2*)(red + (ai * 128 + m * 16 + rl0) * 8 + 2 * bj0);
                    const float rk = rsqrtf((t[0] + t[1] + SSR[row]) * (1.0f / 96.0f) + EPS);
                    const f32x4 cs = *(const f32x4*)(cosT + row * 16 + 4 * fq), sn = *(const f32x4*)(sinT + row * 16 + 4 * fq);
                    const f32x4 x1 = *(const f32x4*)(KR + row * 32 + 4 * fq) * rk * g0, x2 = *(const f32x4*)(KR + row * 32 + 16 + 4 * fq) * rk * g1;
                    bf16_t* hp = KM + row * 768 + h0 * 96;
                    *(u32x2*)(hp + 64 + 4 * fq) = pack4(x1 * cs - x2 * sn); *(u32x2*)(hp + 80 + 4 * fq) = pack4(x2 * cs + x1 * sn);
                    asm volatile("" ::: "memory");
                }
        }
    }
};

struct EpiRes {
    const float* base; float* out; const float* gate;
    __device__ __forceinline__ void operator()(const f32x4 (&acc)[2][2][4][2], const Unit& u, int wr, int wc, int fr, int fq, LAS float* red) const {
        asm volatile("" : "+v"(fr), "+v"(fq));
        const int b = u.pm >> 3; const int col0 = u.pn * 256 + wc * 32 + 8 * fq;
        f32x4 gv[2][2];
#pragma unroll
        for (int bj = 0; bj < 2; ++bj)
#pragma unroll
            for (int n = 0; n < 2; ++n) gv[bj][n] = *(const f32x4*)(gate + (size_t)b * NMOD + col0 + 128 * bj + 4 * n);
#pragma unroll
        for (int ai = 0; ai < 2; ++ai)
#pragma unroll
            for (int m = 0; m < 4; ++m) {
                const size_t off = ((size_t)u.pm * 256 + ai * 128 + wr * 64 + m * 16 + fr) * DM + col0;
#pragma unroll
                for (int bj = 0; bj < 2; ++bj)
#pragma unroll
                    for (int n = 0; n < 2; ++n) { const f32x4 xs = *(const f32x4*)(base + off + 128 * bj + 4 * n); *(f32x4*)(out + off + 128 * bj + 4 * n) = xs + gv[bj][n] * acc[ai][bj][m][n]; }
                if (m & 1) asm volatile("" ::: "memory");
            }
    }
};

struct EpiUp {
    bf16_t* ACT; float* RAW4; const float *cw, *cb;
    __device__ __forceinline__ void operator()(const f32x4 (&acc)[2][2][4][2], const Unit& u, int wr, int wc, int fr, int fq, LAS float* red) const {
        asm volatile("" : "+v"(fr), "+v"(fq));
        const int lane = threadIdx.x & 63; const int j = u.pn; const int cc0 = 32 * wc + 8 * fq;
        const int src1 = (lane & 48) | ((fr - 1) & 15), src2 = (lane & 48) | ((fr - 2) & 15);
#pragma unroll
        for (int n = 0; n < 2; ++n) {
            const int gcol = 128 * j + cc0 + 4 * n, vcol = DFF + gcol;
            const f32x4 wg0 = *(const f32x4*)(cw + gcol), wg1 = *(const f32x4*)(cw + DFF2 + gcol), wg2 = *(const f32x4*)(cw + 2 * DFF2 + gcol), bg = *(const f32x4*)(cb + gcol);
            const f32x4 wv0 = *(const f32x4*)(cw + vcol), wv1 = *(const f32x4*)(cw + DFF2 + vcol), wv2 = *(const f32x4*)(cw + 2 * DFF2 + vcol), bv = *(const f32x4*)(cb + vcol);
#pragma unroll
            for (int ai = 0; ai < 2; ++ai) {
                const size_t blk = (size_t)u.pm * 4 + 2 * ai + wr;
                f32x4 pg1 = {0.f, 0.f, 0.f, 0.f}, pg2 = pg1, pv1 = pg1, pv2 = pg1;
#pragma unroll
                for (int m = 0; m < 4; ++m) {
                    const f32x4 gr = acc[ai][0][m][n], vr = acc[ai][1][m][n];
                    f32x4 g1, g2, v1, v2;
#pragma unroll
                    for (int e = 0; e < 4; ++e) { g1[e] = __shfl(gr[e], src1); g2[e] = __shfl(gr[e], src2); v1[e] = __shfl(vr[e], src1); v2[e] = __shfl(vr[e], src2); }
                    const f32x4 gp1 = fr >= 1 ? g1 : pg1, gp2 = fr >= 2 ? g2 : pg2, vp1 = fr >= 1 ? v1 : pv1, vp2 = fr >= 2 ? v2 : pv2;
                    pg1 = g1; pg2 = g2; pv1 = v1; pv2 = v2;
                    const f32x4 G = wg0 * gp2 + wg1 * gp1 + wg2 * gr + bg, V = wv0 * vp2 + wv1 * vp1 + wv2 * vr + bv;
                    f32x4 a;
#pragma unroll
                    for (int e = 0; e < 4; ++e) a[e] = G[e] * __builtin_amdgcn_rcpf(1.0f + __builtin_amdgcn_exp2f(-LOG2E * G[e])) * V[e];
                    const int rin = 16 * m + fr; const size_t row = blk * 64 + rin;
                    if (m > 0 || fr >= 2) *(u32x2*)(ACT + row * DFF + 128 * j + cc0 + 4 * n) = pack4(a);
                    if (m == 0 && fr < 2) { float* rp = RAW4 + (blk * 4 + fr) * DFF2 + 256 * j + cc0 + 4 * n; *(f32x4*)rp = gr; *(f32x4*)(rp + 128) = vr; }
                    if (m == 3 && fr >= 14) { float* rp = RAW4 + (blk * 4 + (fr - 12)) * DFF2 + 256 * j + cc0 + 4 * n; *(f32x4*)rp = gr; *(f32x4*)(rp + 128) = vr; }
                }
            }
        }
    }
};

namespace att {
__device__ __forceinline__ int crow(int r, int hi) { return (r & 3) + 8 * (r >> 2) + 4 * hi; }
__device__ __forceinline__ void glds16(const void* gsrc, unsigned lds_dst) { unsigned keep;
    asm volatile("s_mov_b32 %0, m0\n\ts_mov_b32 m0, %2\n\ts_nop 0\n\tglobal_load_lds_dwordx4 %1, off\n\ts_mov_b32 m0, %0" : "=&s"(keep) : "v"(gsrc), "s"(lds_dst) : "memory"); }
__device__ __forceinline__ float max3f(float a, float b, float c) { float r; asm("v_max3_f32 %0, %1, %2, %3" : "=v"(r) : "v"(a), "v"(b), "v"(c)); return r; }
__device__ __forceinline__ float rowmax(const f32x16& p0, const f32x16& p1) {
    float a = max3f(p0[0], p0[1], p1[0]), b = max3f(p0[2], p0[3], p1[1]); a = max3f(a, p1[2], p1[3]);
#pragma unroll
    for (int r = 4; r < 16; r += 4) { a = max3f(a, p0[r], p0[r + 1]); b = max3f(b, p0[r + 2], p0[r + 3]); a = max3f(a, p1[r], p1[r + 1]); b = max3f(b, p1[r + 2], p1[r + 3]); }
    const float m = fmaxf(a, b);
    auto rr = __builtin_amdgcn_permlane32_swap(__float_as_uint(m), __float_as_uint(m), false, false);
    return fmaxf(__uint_as_float(rr[0]), __uint_as_float(rr[1]));
}
__device__ __forceinline__ void pv(f32x16* o, int vb, bf16x8 pa0, bf16x8 pa1, bf16x8 pa2, bf16x8 pa3) {
#pragma unroll
    for (int d0 = 0; d0 < 2; ++d0) { s16x4 lo[4], hi[4];
#pragma unroll
        for (int ks = 0; ks < 4; ++ks) {
            asm volatile("ds_read_b64_tr_b16 %0,%1 offset:%c2" : "=&v"(lo[ks]) : "v"(vb), "i"(d0 * 4096 + ks * 1024) : "memory");
            asm volatile("ds_read_b64_tr_b16 %0,%1 offset:%c2" : "=&v"(hi[ks]) : "v"(vb), "i"(d0 * 4096 + ks * 1024 + 512) : "memory"); }
        asm volatile("s_waitcnt lgkmcnt(0)" ::: "memory"); __builtin_amdgcn_sched_barrier(0);
#define PK(k) (bf16x8){lo[k][0], lo[k][1], lo[k][2], lo[k][3], hi[k][0], hi[k][1], hi[k][2], hi[k][3]}
        o[d0] = __builtin_amdgcn_mfma_f32_32x32x16_bf16(pa0, PK(0), o[d0], 0, 0, 0);
        o[d0] = __builtin_amdgcn_mfma_f32_32x32x16_bf16(pa1, PK(1), o[d0], 0, 0, 0);
        o[d0] = __builtin_amdgcn_mfma_f32_32x32x16_bf16(pa2, PK(2), o[d0], 0, 0, 0);
        o[d0] = __builtin_amdgcn_mfma_f32_32x32x16_bf16(pa3, PK(3), o[d0], 0, 0, 0);
#undef PK
    }
}
constexpr int ATT_LDS_BYTES = 2 * 12288 + 2 * 8192 + 8 * 256 + 8 * 4096 + 2048;

template <int DQK, bool CA, int THR>
__device__ __forceinline__ void attn_unit(int b, int h, int u, const bf16_t* Q, const bf16_t* K, const bf16_t* V, bf16_t* O, const float* relb, LAS unsigned char* shm) {
    constexpr int ND = DQK / 16, NCH = DQK / 8, KSLOT = NCH * 1024, VSLOT = 8192;
    constexpr int LDS_K = 0, LDS_V = 2 * KSLOT, LDS_WS = LDS_V + 2 * VSLOT, LDS_OST = LDS_WS + 8 * 256, LDS_TAB = LDS_OST + 8 * 4096;
    constexpr int LDQ = CA ? 512 : 768, LDV = 512, LDO = 1024, OCOL = CA ? 512 : 0;
    const int tid = threadIdx.x, lane = tid & 63, r32 = lane & 31, hi = lane >> 5; const int wid = __builtin_amdgcn_readfirstlane(tid >> 6);
    const long rowbase = (long)b * SEQ; const int q0 = u * 256;
    const bf16_t* Qw = Q + (rowbase + q0 + wid * 32) * LDQ + h * DQK;
    const bf16_t* Kh = K + rowbase * LDQ + h * DQK; const bf16_t* Vh = V + rowbase * LDV + h * 64;
    const unsigned lds0 = (unsigned)(uintptr_t)shm;
    LAS float* wsf = (LAS float*)(shm + LDS_WS) + wid * 64;
    LAS float* tab = (LAS float*)(shm + LDS_TAB);
    const int t0 = CA ? (4 * u - 8 > 0 ? 4 * u - 8 : 0) : 0, t1 = 4 * u + 3, cw = 4 * u + (wid >> 1);
    const bf16_t* ksrc = Kh + (long)lane * LDQ + wid * 8;
    const bf16_t* ksrc2 = Kh + (long)lane * LDQ + (8 + (wid & 3)) * 8;
    const bf16_t* vsrc = Vh + (long)(16 * (wid & 3) + (lane >> 2)) * LDV + (wid >> 2) * 32 + (lane & 3) * 8;
#define DMA_TILE(t, s) do { glds16(ksrc + (long)(t) * 64 * LDQ, (unsigned)__builtin_amdgcn_readfirstlane(lds0 + LDS_K + (s) * KSLOT + wid * 1024)); \
        if (DQK == 96) glds16(ksrc2 + (long)(t) * 64 * LDQ, (unsigned)__builtin_amdgcn_readfirstlane(lds0 + LDS_K + (s) * KSLOT + (8 + (wid & 3)) * 1024)); \
        glds16(vsrc + (long)(t) * 64 * LDV, (unsigned)__builtin_amdgcn_readfirstlane(lds0 + LDS_V + (s) * VSLOT + wid * 1024)); } while (0)
    if (CA) { for (int i = tid; i < 320; i += 512) tab[i] = relb[h * 257 + (i < 256 ? i : 256)] * LOG2E; }
    bf16x8 qr[ND];
#pragma unroll
    for (int d0 = 0; d0 < ND; ++d0) qr[d0] = *(const bf16x8*)(Qw + (long)r32 * LDQ + d0 * 16 + hi * 8);
    DMA_TILE(t0, 0);
    float mrun = -1e30f, l_reg = 0.f; f32x16 o[2]; o[0] = f32x16{}; o[1] = f32x16{};
    const int vb0 = (int)(lds0 + LDS_V) + ((lane >> 4) & 1) * 32 + (lane & 3) * 8 + (4 * hi + ((lane & 15) >> 2)) * 64;
    for (int t = t0; t <= t1; ++t) {
        const int s = (t - t0) & 1;
        asm volatile("s_waitcnt vmcnt(0) lgkmcnt(0)\n\ts_barrier" ::: "memory");
        if (t < t1) DMA_TILE(t + 1, s ^ 1);
        const bool valid = CA ? (t <= cw && t >= cw - 8) : (t <= cw);
        if (valid) {
            f32x16 p0 = f32x16{}, p1 = f32x16{};
            const LAS unsigned char* kb = shm + LDS_K + s * KSLOT + hi * 1024 + r32 * 16;
#pragma unroll
            for (int d0 = 0; d0 < ND; ++d0) {
                const bf16x8 b0 = *(const LAS bf16x8*)(kb + d0 * 2048), b1 = *(const LAS bf16x8*)(kb + d0 * 2048 + 512);
                p0 = __builtin_amdgcn_mfma_f32_32x32x16_bf16(b0, qr[d0], p0, 0, 0, 0); p1 = __builtin_amdgcn_mfma_f32_32x32x16_bf16(b1, qr[d0], p1, 0, 0, 0); }
            if (CA) {
                const int dist = cw - t;
                if (dist >= 3) { const float c = tab[256];
#pragma unroll
                    for (int r = 0; r < 16; ++r) { p0[r] += c; p1[r] += c; } }
                else { const int bi = 64 * dist + 32 * (wid & 1) + r32 + 128 - 4 * hi;
#pragma unroll
                    for (int r = 0; r < 16; ++r) { p0[r] += tab[bi - ((r & 3) + 8 * (r >> 2))]; p1[r] += tab[bi - 32 - ((r & 3) + 8 * (r >> 2))]; } }
            }
            const float rm = rowmax(p0, p1);
            if (__any(rm > mrun + (float)THR)) {
                const float mn = fmaxf(mrun, rm), f = __builtin_amdgcn_exp2f(mrun - mn); mrun = mn; l_reg *= f;
                if (hi == 0) wsf[r32] = f;
                asm volatile("s_waitcnt lgkmcnt(0)" ::: "memory");
#pragma unroll
                for (int r = 0; r < 16; ++r) { const float fr_ = wsf[crow(r, hi)]; o[0][r] *= fr_; o[1][r] *= fr_; }
            }
            float sacc = 0.f;
#pragma unroll
            for (int r = 0; r < 16; ++r) { p0[r] = __builtin_amdgcn_exp2f(p0[r] - mrun); p1[r] = __builtin_amdgcn_exp2f(p1[r] - mrun); sacc += p0[r] + p1[r]; }
            l_reg += sacc;
            u32x4 pw0, pw1, pw2, pw3;
            pw0 = (u32x4){cvtpk(p0[0], p0[1]), cvtpk(p0[2], p0[3]), cvtpk(p0[4], p0[5]), cvtpk(p0[6], p0[7])};
            pw1 = (u32x4){cvtpk(p0[8], p0[9]), cvtpk(p0[10], p0[11]), cvtpk(p0[12], p0[13]), cvtpk(p0[14], p0[15])};
            pw2 = (u32x4){cvtpk(p1[0], p1[1]), cvtpk(p1[2], p1[3]), cvtpk(p1[4], p1[5]), cvtpk(p1[6], p1[7])};
            pw3 = (u32x4){cvtpk(p1[8], p1[9]), cvtpk(p1[10], p1[11]), cvtpk(p1[12], p1[13]), cvtpk(p1[14], p1[15])};
            pv(o, vb0 + s * VSLOT, __builtin_bit_cast(bf16x8, pw0), __builtin_bit_cast(bf16x8, pw1), __builtin_bit_cast(bf16x8, pw2), __builtin_bit_cast(bf16x8, pw3));
        }
    }
    { auto rr = __builtin_amdgcn_permlane32_swap(__float_as_uint(l_reg), __float_as_uint(l_reg), false, false); l_reg = __uint_as_float(rr[0]) + __uint_as_float(rr[1]); }
    if (hi == 0) wsf[32 + r32] = l_reg;
    asm volatile("s_waitcnt lgkmcnt(0)" ::: "memory");
    float rli[16];
#pragma unroll
    for (int r = 0; r < 16; ++r) rli[r] = __builtin_amdgcn_rcpf(wsf[32 + crow(r, hi)]);
    bf16_t* Ow = O + (rowbase + q0 + wid * 32) * LDO + OCOL + h * 64;
    { LAS bf16_t* stg = (LAS bf16_t*)(shm + LDS_OST) + wid * 2048;
#pragma unroll
        for (int r = 0; r < 16; ++r) { const int orow = crow(r, hi);
#pragma unroll
            for (int d0 = 0; d0 < 2; ++d0) { const unsigned w = cvtpk(o[d0][r] * rli[r], 0.f); stg[orow * 64 + d0 * 32 + r32] = (bf16_t)(w & 0xffffu); } }
        asm volatile("s_waitcnt lgkmcnt(0)" ::: "memory");
#pragma unroll
        for (int i = 0; i < 4; ++i) { const int row = i * 8 + (lane >> 3), ch = lane & 7; const u32x4 v = *(const LAS u32x4*)(stg + row * 64 + ch * 8); *(u32x4*)(Ow + (long)row * LDO + ch * 8) = v; } }
    asm volatile("s_waitcnt lgkmcnt(0)\n\ts_barrier" ::: "memory");
#undef DMA_TILE
}
}

constexpr int NWAVES = 8;
constexpr int NPHASE = 10;
constexpr int N_LAUNCHES = MK_N_LAUNCHES;
static_assert(N_LAUNCHES == 1 || N_LAUNCHES == NPHASE, "MK_N_LAUNCHES is 1 or 10");

constexpr size_t MiB = 1u << 20;
constexpr size_t WS_CTL = 0, CTL_ZERO_BYTES = 64 * 1024;
constexpr size_t WS_MOD = 1 * MiB;
constexpr size_t WS_COS = 2 * MiB, WS_SIN = 4 * MiB;
constexpr size_t WS_KR = 6 * MiB;
constexpr size_t WS_SSR = 10 * MiB;
constexpr size_t WS_WIN = 11 * MiB;
constexpr size_t WS_WQUP = 15 * MiB;
constexpr size_t WS_WKVUP = WS_WQUP + 512 * 1024;
constexpr size_t WS_WOUT = 16 * MiB;
constexpr size_t WS_WUP = 18 * MiB;
constexpr size_t WS_WDOWN = 29 * MiB;
constexpr size_t WS_XN = 36 * MiB;
constexpr size_t WS_QLN = 100 * MiB, WS_KVLN = 116 * MiB;
constexpr size_t WS_CQ = 132 * MiB, WS_CK = 164 * MiB, WS_CV = 196 * MiB;
constexpr size_t WS_QM = 228 * MiB, WS_KM = 276 * MiB;
constexpr size_t WS_VM = 324 * MiB;
constexpr size_t WS_OM = 356 * MiB;
constexpr size_t WS_ACT = 100 * MiB;
constexpr size_t WS_RAW4 = 276 * MiB;
constexpr size_t WS_END = 420 * MiB;
static_assert(WS_ACT + (size_t)MTOK * DFF * 2 <= WS_RAW4 && WS_RAW4 + (size_t)512 * 4 * DFF2 * 4 <= WS_OM, "overlay map");
constexpr int CW_BAR = 1024;

constexpr int RING_BYTES = 131072, LDSCTL_OFF = RING_BYTES, MISC_OFF = LDSCTL_OFF + 320, XL_OFF = LDSCTL_OFF + 1024, LDS_BYTES = 147456;
static_assert(XL_OFF + 8192 <= LDS_BYTES && att::ATT_LDS_BYTES <= RING_BYTES, "LDS map");

typedef GAS unsigned gu32;
#define RLX_AGENT __ATOMIC_RELAXED, __HIP_MEMORY_SCOPE_AGENT

#define XB_TMO      128
#define XB_XCNT(j)  (256  + 64 * (j))
#define XB_XSUB(j)  (1280 + 64 * (j))
#define XB_XGEN(j)  (2304 + 64 * (j))
#define XB_TOP      3328
#define XB_TOPGEN   3392
#define XCD_BAR_WORDS 3456
#define XB_SPIN_CAP (1u << 18)
__device__ __forceinline__ unsigned xb_ld(unsigned* p)              { return __hip_atomic_load(p, __ATOMIC_RELAXED, __HIP_MEMORY_SCOPE_AGENT); }
__device__ __forceinline__ unsigned xb_add(unsigned* p, unsigned v) { return __hip_atomic_fetch_add(p, v, __ATOMIC_RELAXED, __HIP_MEMORY_SCOPE_AGENT); }
__device__ __forceinline__ unsigned xb_xcc_id() { return (unsigned)__builtin_amdgcn_s_getreg((3 << 11) | 20) & 0xFu; }
#define XB_SPIN(cond, bar) do { unsigned _sp = 0; while (cond) { __builtin_amdgcn_s_sleep(1); \
    if ((++_sp & 255u) == 0u) { if (xb_ld(&(bar)[XB_TMO])) break; if (_sp > XB_SPIN_CAP) { atomicAdd(&(bar)[XB_TMO], 1u); break; } } } } while (0)
struct XcdBarrier { unsigned* bar; unsigned x; volatile LAS unsigned* st; };
__device__ __forceinline__ XcdBarrier xcd_barrier_post(unsigned* bar, volatile LAS unsigned* st) {
    XcdBarrier b; b.bar = bar; b.x = xb_xcc_id(); b.st = st;
    if (threadIdx.x == 0) (void)xb_add(&bar[XB_XCNT(b.x)], 1u);
    return b;
}
__device__ __forceinline__ void xcd_barrier_complete(unsigned* bar, unsigned x, unsigned& nloc, unsigned& nx) {
    const unsigned G = gridDim.x * gridDim.y * gridDim.z;
    unsigned sum, cnt, mine, sp = 0u;
    for (;;) {
        sum = 0u; cnt = 0u; mine = 0u;
#pragma unroll
        for (unsigned j = 0; j < 16; ++j) { const unsigned c = xb_ld(&bar[XB_XCNT(j)]); sum += c; cnt += (c > 0u) ? 1u : 0u; mine = (j == x) ? c : mine; }
        if (sum == G) break;
        __builtin_amdgcn_s_sleep(1);
        if ((++sp & 255u) == 0u) { if (xb_ld(&bar[XB_TMO])) break; if (sp > XB_SPIN_CAP) { atomicAdd(&bar[XB_TMO], 1u); break; } }
    }
    nloc = mine > 0u ? mine : 1u; nx = cnt > 0u ? cnt : 1u;
}
__device__ __forceinline__ void xcd_barrier(const XcdBarrier& b) {
    asm volatile("s_waitcnt vmcnt(0)" ::: "memory");
    __syncthreads();
    if (threadIdx.x == 0) {
        unsigned* bar = b.bar;
        __builtin_amdgcn_s_waitcnt(0);
        unsigned nloc = b.st[0], nx = b.st[1];
        if (nloc == 0u) { xcd_barrier_complete(bar, b.x, nloc, nx); b.st[0] = nloc; b.st[1] = nx; }
        const unsigned old = xb_add(&bar[XB_XSUB(b.x)], 1u);
        const unsigned gen = old / nloc;
        if (old + 1u == (gen + 1u) * nloc) {
            __builtin_amdgcn_fence(__ATOMIC_RELEASE, "agent");
            asm volatile("s_waitcnt vmcnt(0)" ::: "memory");
            const unsigned og = xb_add(&bar[XB_TOP], 1u);
            const unsigned tg = og / nx;
            if (og + 1u == (tg + 1u) * nx) xb_add(&bar[XB_TOPGEN], 1u);
            else XB_SPIN(xb_ld(&bar[XB_TOPGEN]) == tg, bar);
            __builtin_amdgcn_fence(__ATOMIC_ACQUIRE, "agent");
            xb_add(&bar[XB_XGEN(b.x)], 1u);
            asm volatile("s_waitcnt vmcnt(0)" ::: "memory");
        } else {
            XB_SPIN(xb_ld(&bar[XB_XGEN(b.x)]) == gen, bar);
            __builtin_amdgcn_fence(__ATOMIC_ACQUIRE, "agent");
            asm volatile("s_waitcnt vmcnt(0)" ::: "memory");
        }
    }
    __syncthreads();
}

struct Frame {
    LAS unsigned char* lds; LAS float* xl;
    int tid, lane, wave, vcu, G;
    unsigned char* ws;
    const float *x, *c; const int* pos; const float *w_ada, *b_ada, *g_an, *w_in, *g_ql, *g_kvl, *w_qup, *w_kvup, *g_mq, *g_mk, *g_cq, *g_ck, *relb, *w_out, *g_mn, *w_up, *conv_w, *conv_b, *w_down;
    float* out;
};

template <int WHICH> __device__ __forceinline__ int wmap(int n) {
    if (WHICH == 0) {
        if (n < 256) return n;
        if (n < 512) { const int c = n - 256; return c < 160 ? 256 + c : -1; }
        if (n < 1536) { const int t4 = (n - 512) >> 8, which = t4 >> 1, jj = t4 & 1, c = (n - 512) & 255, bj = c >> 7, wc = (c >> 5) & 3, i = c & 31; return 416 + which * 512 + (4 * jj + wc) * 64 + 32 * bj + i; }
        return 416 + 1024 + (n - 1536);
    } else if (WHICH == 1) {
        const int pn = n >> 8, c = n & 255, bj = c >> 7, wc = (c >> 5) & 3, i = c & 31, head = 2 * pn + bj;
        if (wc < 2) return head * 96 + 32 * wc + i;
        if (wc == 2) { const int fq = i >> 3, nn = (i >> 2) & 1, e = i & 3; return head * 96 + 64 + 4 * fq + e + 16 * nn; }
        return -1;
    } else if (WHICH == 2) {
        const int pn = n >> 8, c = n & 255, bj = c >> 7, wc = (c >> 5) & 3, i = c & 31, head = 2 * pn + bj;
        return wc < 2 ? head * 128 + 32 * wc + i : head * 128 + 64 + 32 * (wc - 2) + i;
    } else if (WHICH == 4) {
        const int j = n >> 8, c = n & 255; return c < 128 ? 128 * j + c : DFF + 128 * j + (c - 128);
    }
    return n;
}
template <int WHICH> __device__ __forceinline__ void cvt_item(const float* W, int K, int N, bf16_t* WT, int KP, int NP, LAS float* scr, int item, int lane) {
    const int nblk = NP / 32, kb = item / nblk, nb = item % nblk, k0 = 64 * kb, n0 = 32 * nb;
    const int src = wmap<WHICH>(n0 + (lane & 31)); const bool live = (src >= 0) && (k0 < K);
#pragma unroll 8
    for (int i = 0; i < 32; ++i) { const int kk = 2 * i + (lane >> 5); scr[kk * 33 + (lane & 31)] = live ? W[(size_t)(k0 + kk) * N + src] : 0.f; }
    asm volatile("s_waitcnt lgkmcnt(0)" ::: "memory");
    const int c = lane & 7;
#pragma unroll
    for (int j = 0; j < 4; ++j) { const int n = (lane >> 3) + 8 * j; const LAS float* s = scr + (8 * c) * 33 + n;
        u32x4 o; o.x = cvtpk(s[0 * 33], s[1 * 33]); o.y = cvtpk(s[2 * 33], s[3 * 33]); o.z = cvtpk(s[4 * 33], s[5 * 33]); o.w = cvtpk(s[6 * 33], s[7 * 33]);
        *(u32x4*)(WT + (size_t)(n0 + n) * KP + k0 + 8 * c) = o; }
    asm volatile("s_waitcnt lgkmcnt(0)" ::: "memory");
}
__device__ __forceinline__ void p0_prologue(Frame& F) {
    LAS float* scr = (LAS float*)(F.lds) + F.wave * 4096;
    const int gw = F.vcu * NWAVES + F.wave, NGW = F.G * NWAVES;
    constexpr int I0 = 16 * 64, I1 = 4 * 32, I2 = 4 * 32, I3 = 16 * 32, I4 = 16 * 176, I5 = 44 * 32;
    constexpr int NITEMS = I0 + I1 + I2 + I3 + I4 + I5;
    for (int it = gw; it < NITEMS; it += NGW) {
        int r = it;
        if (r < I0) { cvt_item<0>(F.w_in, 1024, 1952, (bf16_t*)(F.ws + WS_WIN), 1024, 2048, scr, r, F.lane); continue; } r -= I0;
        if (r < I1) { cvt_item<1>(F.w_qup, 256, 768, (bf16_t*)(F.ws + WS_WQUP), 256, 1024, scr, r, F.lane); continue; } r -= I1;
        if (r < I2) { cvt_item<2>(F.w_kvup, 128, 1024, (bf16_t*)(F.ws + WS_WKVUP), 256, 1024, scr, r, F.lane); continue; } r -= I2;
        if (r < I3) { cvt_item<3>(F.w_out, 1024, 1024, (bf16_t*)(F.ws + WS_WOUT), 1024, 1024, scr, r, F.lane); continue; } r -= I3;
        if (r < I4) { cvt_item<4>(F.w_up, 1024, DFF2, (bf16_t*)(F.ws + WS_WUP), 1024, DFF2, scr, r, F.lane); continue; } r -= I4;
        cvt_item<5>(F.w_down, DFF, 1024, (bf16_t*)(F.ws + WS_WDOWN), DFF, 1024, scr, r, F.lane);
    }
    {
        float* cosT = (float*)(F.ws + WS_COS); float* sinT = (float*)(F.ws + WS_SIN);
        const int gt = F.vcu * (NWAVES * 64) + F.tid, NT = F.G * NWAVES * 64;
        for (int idx = gt; idx < MTOK * 16; idx += NT) {
            const int m = idx >> 4, i = idx & 15;
            const float inv = __builtin_amdgcn_exp2f(-(float)i * (13.287712379549449f / 16.0f));
            const float ang = (float)F.pos[m] * inv;
            const float n = rintf(ang * 0.15915494309189535f);
            float r = fmaf(-n, 6.2831854820251465f, ang); r = fmaf(-n, -1.7484555e-7f, r);
            cosT[idx] = __cosf(r); sinT[idx] = __sinf(r);
        }
    }
    if (F.vcu < 96) {
        __syncthreads();
        const int n0 = F.vcu * 64, kbase = F.wave * 128;
        for (int idx = F.lane; idx < 2048; idx += 64) { const int b = idx >> 7, k = idx & 127; const float xv = F.c[b * 1024 + kbase + k]; scr[k * 16 + b] = xv / (1.0f + __expf(-xv)); }
        asm volatile("s_waitcnt lgkmcnt(0)" ::: "memory");
        f32x4 a0 = {0.f, 0.f, 0.f, 0.f}, a1 = a0, a2 = a0, a3 = a0;
#pragma unroll 8
        for (int k = 0; k < 128; ++k) {
            const float w = F.w_ada[(size_t)(kbase + k) * NMOD + n0 + F.lane];
            const LAS f32x4* sp = (const LAS f32x4*)(scr + k * 16);
            a0 += sp[0] * w; a1 += sp[1] * w; a2 += sp[2] * w; a3 += sp[3] * w;
        }
#pragma unroll
        for (int e = 0; e < 4; ++e) { scr[2048 + (0 + e) * 64 + F.lane] = a0[e]; scr[2048 + (4 + e) * 64 + F.lane] = a1[e]; scr[2048 + (8 + e) * 64 + F.lane] = a2[e]; scr[2048 + (12 + e) * 64 + F.lane] = a3[e]; }
        __syncthreads();
        float* MOD = (float*)(F.ws + WS_MOD);
#pragma unroll
        for (int bb = 0; bb < 2; ++bb) { const int b = 2 * F.wave + bb; float s = F.b_ada[n0 + F.lane];
#pragma unroll
            for (int w2 = 0; w2 < 8; ++w2) s += ((LAS float*)F.lds)[w2 * 4096 + 2048 + b * 64 + F.lane];
            MOD[(size_t)b * NMOD + n0 + F.lane] = s; }
        __syncthreads();
    }
}
__device__ __forceinline__ float wave_sum(float v) {
#pragma unroll
    for (int o = 1; o < 64; o <<= 1) v += __shfl_xor(v, o);
    return v;
}
__device__ __forceinline__ void norm_rows(Frame& F, const float* X, const float* g, int shift_off, int scale_off, bf16_t* out) {
    const float* MOD = (const float*)(F.ws + WS_MOD);
    const int gw = F.vcu * NWAVES + F.wave, NGW = F.G * NWAVES;
    for (int m = gw; m < MTOK; m += NGW) {
        const int b = m >> 11;
        const f32x4* xr = (const f32x4*)(X + (size_t)m * DM) + F.lane;
        f32x4 v[4]; float s = 0.f;
#pragma unroll
        for (int j = 0; j < 4; ++j) { v[j] = xr[64 * j]; s += dot4(v[j]); }
        const float r = rsqrtf(wave_sum(s) * (1.0f / DM) + EPS);
        const f32x4* gp = (const f32x4*)g + F.lane; const f32x4* shp = (const f32x4*)(MOD + (size_t)b * NMOD + shift_off) + F.lane; const f32x4* scp = (const f32x4*)(MOD + (size_t)b * NMOD + scale_off) + F.lane;
        u32x2* o8 = (u32x2*)(out + (size_t)m * DM) + F.lane;
#pragma unroll
        for (int j = 0; j < 4; ++j) { const f32x4 y = v[j] * r * gp[64 * j] * (scp[64 * j] + 1.0f) + shp[64 * j]; o8[64 * j] = pack4(y); }
    }
}
__device__ __forceinline__ void conv_fixup(Frame& F) {
    const float* RAW4 = (const float*)(F.ws + WS_RAW4); bf16_t* ACT = (bf16_t*)(F.ws + WS_ACT);
    const int gt = F.vcu * (NWAVES * 64) + F.tid, NT = F.G * NWAVES * 64;
    for (int idx = gt; idx < 512 * DFF; idx += NT) {
        const int blk = idx / DFF, c = idx - blk * DFF, j = c >> 7, cc = c & 127;
        const bool first = (blk & 31) == 0;
        float o[2][2];
#pragma unroll
        for (int half = 0; half < 2; ++half) {
            const int tcol = 256 * j + 128 * half + cc, ocol = half * DFF + c;
            const float w0 = F.conv_w[ocol], w1 = F.conv_w[DFF2 + ocol], w2 = F.conv_w[2 * DFF2 + ocol], bb = F.conv_b[ocol];
            const float pm2 = first ? 0.f : RAW4[((size_t)(blk - 1) * 4 + 2) * DFF2 + tcol], pm1 = first ? 0.f : RAW4[((size_t)(blk - 1) * 4 + 3) * DFF2 + tcol];
            const float r0 = RAW4[((size_t)blk * 4 + 0) * DFF2 + tcol], r1 = RAW4[((size_t)blk * 4 + 1) * DFF2 + tcol];
            o[half][0] = w0 * pm2 + w1 * pm1 + w2 * r0 + bb; o[half][1] = w0 * pm1 + w1 * r0 + w2 * r1 + bb;
        }
#pragma unroll
        for (int rr = 0; rr < 2; ++rr) { const float G = o[0][rr], a = G / (1.0f + __expf(-G)) * o[1][rr];
            ACT[((size_t)blk * 64 + rr) * DFF + c] = (bf16_t)(cvtpk(a, 0.f) & 0xffffu); }
    }
}

struct Args { const void* in[22]; float* out; unsigned char* ws; int ph_lo, ph_hi, li, pad; };
__global__ void __launch_bounds__(NWAVES * 64, 2) fwd_kernel(Args args) {
    extern __shared__ __attribute__((aligned(16))) unsigned char lds_raw[];
    Frame F;
    F.lds = (LAS unsigned char*)lds_raw; F.xl = (LAS float*)(F.lds + XL_OFF);
    F.tid = threadIdx.x; F.lane = F.tid & 63; F.wave = __builtin_amdgcn_readfirstlane(F.tid >> 6);
    F.G = gridDim.x; { const int bx = blockIdx.x; F.vcu = (F.G % 8 == 0) ? (bx % 8) * (F.G / 8) + bx / 8 : bx; }
    F.ws = args.ws; F.out = args.out;
    F.x = (const float*)args.in[0]; F.c = (const float*)args.in[1]; F.pos = (const int*)args.in[2]; F.w_ada = (const float*)args.in[3]; F.b_ada = (const float*)args.in[4];
    F.g_an = (const float*)args.in[5]; F.w_in = (const float*)args.in[6]; F.g_ql = (const float*)args.in[7]; F.g_kvl = (const float*)args.in[8]; F.w_qup = (const float*)args.in[9];
    F.w_kvup = (const float*)args.in[10]; F.g_mq = (const float*)args.in[11]; F.g_mk = (const float*)args.in[12]; F.g_cq = (const float*)args.in[13]; F.g_ck = (const float*)args.in[14];
    F.relb = (const float*)args.in[15]; F.w_out = (const float*)args.in[16]; F.g_mn = (const float*)args.in[17]; F.w_up = (const float*)args.in[18]; F.conv_w = (const float*)args.in[19];
    F.conv_b = (const float*)args.in[20]; F.w_down = (const float*)args.in[21];
    unsigned char* ws = args.ws;
    for (int u = F.tid; u < (LDS_BYTES - LDSCTL_OFF) / 4; u += NWAVES * 64) ((LAS unsigned*)(F.lds + LDSCTL_OFF))[u] = 0u;
    __syncthreads();
    XcdBarrier bar; bar.bar = (unsigned*)(ws + WS_CTL) + CW_BAR; bar.x = 0; bar.st = nullptr;
    if (N_LAUNCHES == 1) bar = xcd_barrier_post((unsigned*)(ws + WS_CTL) + CW_BAR, (volatile LAS unsigned*)(F.lds + MISC_OFF) + 8);
#define GRID_BAR() do { if (N_LAUNCHES == 1) xcd_barrier(bar); } while (0)
    const int lo = args.ph_lo, hi = args.ph_hi;
#ifndef PH_MASK
#define PH_MASK 0x3ff
#endif
#define IN(k) (((PH_MASK >> (k)) & 1) && lo <= (k) && (k) < hi)
#define BOTH(k) (IN(k) && IN((k) + 1))
    float* MOD = (float*)(ws + WS_MOD);
    bf16_t* XN = (bf16_t*)(ws + WS_XN);

    if (IN(0)) { p0_prologue(F); if (BOTH(0)) GRID_BAR(); }
    if (IN(1)) { norm_rows(F, F.x, F.g_an, 0, DM, XN); if (BOTH(1)) GRID_BAR(); }
    if (IN(2)) {
        pg8::Gemm g{XN, (const bf16_t*)(ws + WS_WIN), MTOK, 2048, 1024}; pg8::StaticOrder S; S.init(MTOK, 2048, F.G, (int)blockIdx.x);
        EpiIn E{(bf16_t*)(ws + WS_QLN), (bf16_t*)(ws + WS_KVLN), (bf16_t*)(ws + WS_CQ), (bf16_t*)(ws + WS_CK), (bf16_t*)(ws + WS_CV), (float*)(ws + WS_KR), (float*)(ws + WS_SSR), F.g_ql, F.g_kvl, F.g_cq, F.g_ck};
        pg8::gemm_phase(F.lds, F.xl, g, S, E);
        if (BOTH(2)) GRID_BAR();
    }
    if (IN(3)) {
#ifndef P3_NO_Q
        { pg8::Gemm g{(const bf16_t*)(ws + WS_QLN), (const bf16_t*)(ws + WS_WQUP), MTOK, 1024, 256}; pg8::StaticOrder S; S.init(MTOK, 1024, F.G, (int)blockIdx.x);
          EpiQ E{(bf16_t*)(ws + WS_QM), F.g_mq, (const float*)(ws + WS_COS), (const float*)(ws + WS_SIN)};
          pg8::gemm_phase(F.lds, F.xl, g, S, E); }
#endif
#ifndef P3_NO_KV
        { pg8::Gemm g{(const bf16_t*)(ws + WS_KVLN), (const bf16_t*)(ws + WS_WKVUP), MTOK, 1024, 256}; pg8::StaticOrder S; S.init(MTOK, 1024, F.G, (int)blockIdx.x);
          EpiKV E{(bf16_t*)(ws + WS_KM), (bf16_t*)(ws + WS_VM), F.g_mk, (const float*)(ws + WS_COS), (const float*)(ws + WS_SIN), (const float*)(ws + WS_KR), (const float*)(ws + WS_SSR)};
          pg8::gemm_phase(F.lds, F.xl, g, S, E); }
#endif
        if (BOTH(3)) GRID_BAR();
    }
    if (IN(4)) {
        bf16_t* OM = (bf16_t*)(ws + WS_OM);
        if (F.G == 256) {
            const int bh = F.vcu >> 1, par = F.vcu & 1, b = bh >> 3, h = bh & 7;
            for (int i = 0; i < 4; ++i) { const int s = 2 * par + (i >> 1); const int qb = (i & 1) ? 7 - s : s;
                att::attn_unit<96, false, 8>(b, h, qb, (const bf16_t*)(ws + WS_QM), (const bf16_t*)(ws + WS_KM), (const bf16_t*)(ws + WS_VM), OM, nullptr, F.lds); }
            for (int i = 0; i < 4; ++i) { const int qb = 2 * i + par;
                att::attn_unit<64, true, 8>(b, h, qb, (const bf16_t*)(ws + WS_CQ), (const bf16_t*)(ws + WS_CK), (const bf16_t*)(ws + WS_CV), OM, F.relb, F.lds); }
        } else {
            for (int i = F.vcu; i < 2048; i += F.G) { const int kind = i >> 10, j = i & 1023, bh = j >> 3, qb = j & 7;
                if (kind == 0) att::attn_unit<96, false, 8>(bh >> 3, bh & 7, qb, (const bf16_t*)(ws + WS_QM), (const bf16_t*)(ws + WS_KM), (const bf16_t*)(ws + WS_VM), OM, nullptr, F.lds);
                else att::attn_unit<64, true, 8>(bh >> 3, bh & 7, qb, (const bf16_t*)(ws + WS_CQ), (const bf16_t*)(ws + WS_CK), (const bf16_t*)(ws + WS_CV), OM, F.relb, F.lds); }
        }
        if (BOTH(4)) GRID_BAR();
    }
    if (IN(5)) {
        pg8::Gemm g{(const bf16_t*)(ws + WS_OM), (const bf16_t*)(ws + WS_WOUT), MTOK, 1024, 1024}; pg8::StaticOrder S; S.init(MTOK, 1024, F.G, (int)blockIdx.x);
        EpiRes E{F.x, F.out, MOD + 2 * DM};
        pg8::gemm_phase(F.lds, F.xl, g, S, E);
        if (BOTH(5)) GRID_BAR();
    }
    if (IN(6)) { norm_rows(F, F.out, F.g_mn, 3 * DM, 4 * DM, XN); if (BOTH(6)) GRID_BAR(); }
    if (IN(7)) {
        pg8::Gemm g{XN, (const bf16_t*)(ws + WS_WUP), MTOK, DFF2, 1024}; pg8::StaticOrder S; S.init(MTOK, DFF2, F.G, (int)blockIdx.x);
        EpiUp E{(bf16_t*)(ws + WS_ACT), (float*)(ws + WS_RAW4), F.conv_w, F.conv_b};
        pg8::gemm_phase(F.lds, F.xl, g, S, E);
        if (BOTH(7)) GRID_BAR();
    }
    if (IN(8)) { conv_fixup(F); if (BOTH(8)) GRID_BAR(); }
    if (IN(9)) {
        pg8::Gemm g{(const bf16_t*)(ws + WS_ACT), (const bf16_t*)(ws + WS_WDOWN), MTOK, 1024, DFF}; pg8::StaticOrder S; S.init(MTOK, 1024, F.G, (int)blockIdx.x);
        EpiRes E{F.out, F.out, MOD + 5 * DM};
        pg8::gemm_phase(F.lds, F.xl, g, S, E);
    }
#undef IN
#undef BOTH
}

extern "C" void kernel_launch(void* const* d_in, const int* in_sizes, int n_in, void* d_out, int out_size, void* d_ws, size_t ws_size, hipStream_t stream) {
    static int grid = 0;
    if (grid == 0) {
        if (n_in != 22 || in_sizes[0] != MTOK * DM || out_size != MTOK * DM || ws_size < WS_END) {
            fprintf(stderr, "kernel_launch: unexpected shapes (n_in %d, in0 %d, out %d, ws %zu); nothing launched\n", n_in, n_in > 0 ? in_sizes[0] : -1, out_size, ws_size); grid = -1; return; }
        int dev = 0, cus = 0, per_cu = 0;
        if (hipGetDevice(&dev) != hipSuccess || hipDeviceGetAttribute(&cus, hipDeviceAttributeMultiprocessorCount, dev) != hipSuccess) { grid = -1; return; }
        if (hipFuncSetAttribute((const void*)fwd_kernel, hipFuncAttributeMaxDynamicSharedMemorySize, LDS_BYTES) != hipSuccess) { fprintf(stderr, "kernel_launch: hipFuncSetAttribute failed\n"); grid = -1; return; }
        if (hipOccupancyMaxActiveBlocksPerMultiprocessor(&per_cu, (const void*)fwd_kernel, NWAVES * 64, LDS_BYTES) != hipSuccess || per_cu < 1)
            fprintf(stderr, "kernel_launch: note: occupancy query reports %d workgroups per CU\n", per_cu);
        (void)hipGetLastError();
        grid = cus;
    }
    if (grid < 0) return;
    if (hipMemsetAsync((char*)d_ws + WS_CTL, 0, CTL_ZERO_BYTES, stream) != hipSuccess) { fprintf(stderr, "kernel_launch: memset failed\n"); return; }
    Args a{};
    for (int i = 0; i < 22; ++i) a.in[i] = d_in[i];
    a.out = (float*)d_out; a.ws = (unsigned char*)d_ws;
    for (int li = 0; li < N_LAUNCHES; ++li) {
        a.ph_lo = (N_LAUNCHES == 1) ? 0 : li; a.ph_hi = (N_LAUNCHES == 1) ? NPHASE : li + 1; a.li = li;
        hipLaunchKernelGGL(fwd_kernel, dim3(grid), dim3(NWAVES * 64), LDS_BYTES, stream, a);
        const hipError_t le = hipPeekAtLastError();
        if (le != hipSuccess) { fprintf(stderr, "kernel_launch: launch %d failed: %s\n", li, hipGetErrorName(le)); break; }
    }
}
```

```cpp
#include <hip/hip_runtime.h>
#include <cstdio>
#include <cstdint>

#define LAS __attribute__((address_space(3)))
#define GAS __attribute__((address_space(1)))
typedef unsigned short bf16_t;
typedef short bf16x8 __attribute__((ext_vector_type(8)));
typedef short s16x4 __attribute__((ext_vector_type(4)));
typedef float f32x2 __attribute__((ext_vector_type(2)));
typedef float f32x4 __attribute__((ext_vector_type(4)));
typedef float f32x16 __attribute__((ext_vector_type(16)));
typedef unsigned u32x2 __attribute__((ext_vector_type(2)));
typedef unsigned u32x4 __attribute__((ext_vector_type(4)));
typedef __bf16 bf16x2_t __attribute__((ext_vector_type(2)));

#ifndef MK_N_LAUNCHES
#define MK_N_LAUNCHES 1
#endif

constexpr int BATCH = 16, SEQ = 2048, DM = 1024, MTOK = BATCH * SEQ;
constexpr int NMOD = 6 * DM;
constexpr int DFF = 2816, DFF2 = 5632;
constexpr float EPS = 1e-6f;
constexpr float LOG2E = 1.4426950408889634f;
constexpr float C2_MLA = 0.10206207261596577f * LOG2E;
constexpr float C2_CA = 0.125f * LOG2E;

__device__ __forceinline__ unsigned cvtpk(float lo, float hi) { f32x2 v = {lo, hi}; bf16x2_t b = __builtin_convertvector(v, bf16x2_t); return __builtin_bit_cast(unsigned, b); }
__device__ __forceinline__ u32x4 pack8(f32x4 a, f32x4 b) { u32x4 w; w.x = cvtpk(a[0], a[1]); w.y = cvtpk(a[2], a[3]); w.z = cvtpk(b[0], b[1]); w.w = cvtpk(b[2], b[3]); return w; }
__device__ __forceinline__ u32x2 pack4(f32x4 a) { u32x2 w; w.x = cvtpk(a[0], a[1]); w.y = cvtpk(a[2], a[3]); return w; }
__device__ __forceinline__ float dot4(f32x4 a) { return (a[0] * a[0] + a[1] * a[1]) + (a[2] * a[2] + a[3] * a[3]); }
#define LDS_BARRIER() do { asm volatile("s_waitcnt lgkmcnt(0)" ::: "memory"); __builtin_amdgcn_s_barrier(); asm volatile("" ::: "memory"); } while (0)

namespace pg8 {
constexpr int BM = 256, BK = 64, HALF = 128, HTB = HALF * BK * 2, STAGE_BYTES = 8 * HTB, NXCD = 8, WGM = 8;
__host__ __device__ __forceinline__ int lds_byte(int r, int c) { const int st = (r >> 4) * 2 + (c >> 5), rr = r & 15, cc = c & 31, ob = rr * 64 + cc * 2; return st * 1024 + (ob ^ (((ob >> 9) & 1) << 5)); }
__host__ __device__ __forceinline__ void stage_rc(int b, int& R, int& C) { const int st = b / 1024, sb = b % 1024, swz = sb ^ (((sb >> 9) & 1) << 5); R = (st >> 1) * 16 + swz / 64; C = (st & 1) * 32 + (swz % 64) / 2; }
__host__ __device__ __forceinline__ int perm32(int rho) { const int n = rho >> 4, i = rho & 15; return 8 * (i >> 2) + 4 * n + (i & 3); }

struct Unit { int pm, pn; };
struct Gemm { const bf16_t* A; const bf16_t* Bt; int M, N, K; const bf16_t* A2; int nsplit; };

struct StaticOrder {
    int nM, nN, nwg, G, c;
    __host__ __device__ void init(int M, int N, int G_, int c_) { nM = M / BM; nN = N / BM; nwg = nM * nN; G = G_; c = c_; }
    __host__ __device__ bool next(int i, Unit& u) const {
        const long L = (long)i * G + c; if (L >= nwg) return false;
        int wgid = (int)L; { const int q = nwg / NXCD, r = nwg % NXCD, xcd = wgid % NXCD, off = wgid / NXCD; wgid = (xcd < r ? xcd * (q + 1) : r * (q + 1) + (xcd - r) * q) + off; }
        const int nig = WGM * nN, gid = wgid / nig, fm = gid * WGM, gsz = (nM - fm) < WGM ? (nM - fm) : WGM;
        u.pm = fm + ((wgid % nig) % gsz); u.pn = (wgid % nig) / gsz; return true;
    }
};

template <class Epi, class Sched>
__device__ __forceinline__ void gemm_phase(LAS unsigned char* lds, LAS float* xl, const Gemm g, const Sched& S, const Epi& E) {
    int tid = threadIdx.x; asm volatile("" : "+v"(tid)); tid &= 511;
    const int wid = __builtin_amdgcn_readfirstlane(tid >> 6), lane = tid & 63, wr = wid >> 2, wc = wid & 3, fr = lane & 15, fq = lane >> 4;
    const int K = g.K, nt = K / BK;
    unsigned voffA[2], voffB[2];
#pragma unroll
    for (int i = 0; i < 2; ++i) { int R, C; stage_rc(tid * 16 + i * 8192, R, C); const int Rb = (R & ~31) + perm32(R & 31);
        const int Ra = Epi::APERM ? ((R & 64) | ((R & 15) << 2) | ((R >> 4) & 3)) : R;
        voffA[i] = (unsigned)(Ra * K + C) * 2u; voffB[i] = (unsigned)(Rb * K + C) * 2u; }
    const size_t kstep = (size_t)(BK * 2);
    const size_t hstep = (size_t)HALF * K * 2;
    const size_t tstep = 2 * hstep;
    const unsigned ldsw = (unsigned)wid * 1024u;
    const int aoff = lds_byte(wr * 64 + fr, fq * 8), boff = lds_byte(wc * 32 + fr, fq * 8);
#define PG8_SA(b, h) (((b) * 2 + (h)) * HTB)
#define PG8_SB(b, h) ((4 + (b) * 2 + (h)) * HTB)
#define PG8_STAGE(bufoff, gbase, voff) do { _Pragma("unroll") for (int _i = 0; _i < 2; ++_i) \
        __builtin_amdgcn_global_load_lds((const unsigned*)((const char*)(gbase) + (voff)[_i]), (LAS unsigned*)(lds + (bufoff) + ldsw + _i * 8192), 16, 0, 0); } while (0)
#define PG8_LDA(dst, b, h) do { _Pragma("unroll") for (int m = 0; m < 4; ++m) _Pragma("unroll") for (int k = 0; k < 2; ++k) dst[m][k] = *(const LAS bf16x8*)(lds + PG8_SA(b, h) + aoff + m * 2048 + k * 1024); } while (0)
#define PG8_LDB(dst, b, h) do { _Pragma("unroll") for (int n = 0; n < 2; ++n) _Pragma("unroll") for (int k = 0; k < 2; ++k) dst[n][k] = *(const LAS bf16x8*)(lds + PG8_SB(b, h) + boff + n * 2048 + k * 1024); } while (0)
#define PG8_MMA(ai, bj, At, Bt) do { __builtin_amdgcn_s_setprio(1); _Pragma("unroll") for (int m = 0; m < 4; ++m) _Pragma("unroll") for (int n = 0; n < 2; ++n) _Pragma("unroll") for (int k = 0; k < 2; ++k) \
        acc[ai][bj][m][n] = __builtin_amdgcn_mfma_f32_16x16x32_bf16(Bt[n][k], At[m][k], acc[ai][bj][m][n], 0, 0, 0); __builtin_amdgcn_s_setprio(0); } while (0)
#define PG8_WAIT_V(n) asm volatile("s_waitcnt vmcnt(" #n ")" ::: "memory")
#define PG8_WAIT_L(n) asm volatile("s_waitcnt lgkmcnt(" #n ")" ::: "memory")
#define PG8_BAR __builtin_amdgcn_s_barrier()
#define PG8_SCHED __builtin_amdgcn_sched_barrier(0)
    Unit cur, nxt; int ui = 0;
    if (!S.next(0, cur)) return;
    f32x4 acc[2][2][4][2];
#pragma unroll
    for (int a = 0; a < 2; ++a)
#pragma unroll
        for (int b = 0; b < 2; ++b)
#pragma unroll
            for (int m = 0; m < 4; ++m)
#pragma unroll
                for (int n = 0; n < 2; ++n) acc[a][b][m][n] = (f32x4){0.f, 0.f, 0.f, 0.f};
    bf16x8 At[4][2], B0[2][2], B1[2][2];
    const char* cA = (const char*)(cur.pn < g.nsplit ? g.A : g.A2) + (size_t)cur.pm * tstep; const char* cB = (const char*)g.Bt + (size_t)cur.pn * tstep;
    PG8_STAGE(PG8_SB(0, 0), cB, voffB); PG8_STAGE(PG8_SB(0, 1), cB + hstep, voffB); PG8_STAGE(PG8_SA(0, 0), cA, voffA); PG8_STAGE(PG8_SA(0, 1), cA + hstep, voffA);
    if (wr == 1) PG8_BAR;
    PG8_WAIT_V(2); PG8_BAR;
    PG8_STAGE(PG8_SB(1, 0), cB + kstep, voffB); PG8_STAGE(PG8_SA(1, 0), cA + kstep, voffA); PG8_STAGE(PG8_SB(1, 1), cB + hstep + kstep, voffB);
    PG8_WAIT_V(6); PG8_BAR;
    for (;;) {
        const bool has_next = S.next(ui + 1, nxt);
        const char* nA = has_next ? (const char*)(nxt.pn < g.nsplit ? g.A : g.A2) + (size_t)nxt.pm * tstep : cA; const char* nB = has_next ? (const char*)g.Bt + (size_t)nxt.pn * tstep : cB;
        for (int t = 0; t < nt; t += 2) {
            const bool last = (t == nt - 2);
            const char* a1 = cA + (size_t)(t + 1) * kstep;
            const char* a2 = last ? nA : cA + (size_t)(t + 2) * kstep; const char* b2 = last ? nB : cB + (size_t)(t + 2) * kstep;
            const char* a3 = a2 + kstep; const char* b3 = b2 + kstep;
            PG8_LDB(B0, 0, 0); PG8_LDB(B1, 0, 1); PG8_SCHED; PG8_LDA(At, 0, 0); PG8_STAGE(PG8_SA(1, 1), a1 + hstep, voffA);
            PG8_WAIT_V(8); PG8_WAIT_L(0); PG8_BAR; PG8_MMA(0, 0, At, B0); PG8_MMA(0, 1, At, B1); PG8_BAR; PG8_SCHED;
            PG8_LDA(At, 0, 1); PG8_STAGE(PG8_SB(0, 0), b2, voffB); PG8_STAGE(PG8_SB(0, 1), b2 + hstep, voffB); PG8_STAGE(PG8_SA(0, 0), a2, voffA);
            PG8_WAIT_V(8); PG8_WAIT_L(0); PG8_BAR; PG8_MMA(1, 0, At, B0); PG8_MMA(1, 1, At, B1); PG8_BAR; PG8_SCHED;
            PG8_LDB(B0, 1, 0); PG8_LDB(B1, 1, 1); PG8_SCHED; PG8_LDA(At, 1, 0); PG8_STAGE(PG8_SA(0, 1), a2 + hstep, voffA);
            PG8_WAIT_V(8); PG8_WAIT_L(0); PG8_BAR; PG8_MMA(0, 0, At, B0); PG8_MMA(0, 1, At, B1); PG8_BAR; PG8_SCHED;
            PG8_LDA(At, 1, 1); PG8_STAGE(PG8_SB(1, 0), b3, voffB); PG8_STAGE(PG8_SB(1, 1), b3 + hstep, voffB); PG8_STAGE(PG8_SA(1, 0), a3, voffA);
            PG8_WAIT_V(8); PG8_WAIT_L(0); PG8_BAR; PG8_MMA(1, 0, At, B0); PG8_MMA(1, 1, At, B1); PG8_BAR; PG8_SCHED;
        }
        if (wr == 0) PG8_BAR;
        E(acc, cur, wr, wc, fr, fq, xl);
        if (!has_next) break;
#pragma unroll
        for (int a = 0; a < 2; ++a)
#pragma unroll
            for (int b = 0; b < 2; ++b)
#pragma unroll
                for (int m = 0; m < 4; ++m)
#pragma unroll
                    for (int n = 0; n < 2; ++n) acc[a][b][m][n] = (f32x4){0.f, 0.f, 0.f, 0.f};
        cur = nxt; cA = nA; cB = nB; ++ui;
        if (wr == 1) PG8_BAR;
    }
    PG8_WAIT_V(0);
    PG8_BAR;
#undef PG8_SA
#undef PG8_SB
#undef PG8_STAGE
#undef PG8_LDA
#undef PG8_LDB
#undef PG8_MMA
#undef PG8_WAIT_V
#undef PG8_WAIT_L
#undef PG8_BAR
#undef PG8_SCHED
}
}
using pg8::Unit;

constexpr size_t MiB = 1u << 20;
constexpr size_t WS_CTL = 0, CTL_ZERO_BYTES = 64 * 1024;
constexpr size_t WS_MOD = 1 * MiB;
constexpr size_t WS_COS = 2 * MiB, WS_SIN = 4 * MiB;
constexpr size_t WS_KR = 6 * MiB;
constexpr size_t WS_SSR = 10 * MiB;
constexpr size_t WS_WIN = 11 * MiB;
constexpr size_t WS_WQUP = 15 * MiB;
constexpr size_t WS_WKVUP = WS_WQUP + 512 * 1024;
constexpr size_t WS_WOUT = 16 * MiB;
constexpr size_t WS_WUP = 18 * MiB;
constexpr size_t WS_WDOWN = 29 * MiB;
constexpr size_t WS_XN = 36 * MiB;
constexpr size_t WS_QLN = 100 * MiB, WS_KVLN = 116 * MiB;
constexpr size_t WS_CQ = 132 * MiB, WS_CK = 164 * MiB, WS_CV = 196 * MiB;
constexpr size_t WS_QM = 228 * MiB, WS_KM = 276 * MiB;
constexpr size_t WS_VM = 324 * MiB;
constexpr size_t WS_OM = WS_XN;
constexpr size_t WS_ACT = 100 * MiB;
constexpr size_t WS_X1 = 276 * MiB;
constexpr size_t WS_RAW4 = 404 * MiB;
constexpr size_t WS_END = 448 * MiB;
static_assert(WS_ACT + (size_t)MTOK * DFF * 2 <= WS_X1 && WS_X1 + (size_t)MTOK * DM * 4 <= WS_RAW4 && WS_RAW4 + (size_t)512 * 4 * DFF2 * 4 <= WS_END, "overlay map");
constexpr int CW_BAR = 1024;


struct EpiIn {
    static constexpr bool APERM = false;
    unsigned char* ws; const float *g_ql, *g_kvl, *g_caq, *g_cak;
    __device__ __forceinline__ void operator()(const f32x4 (&acc)[2][2][4][2], const Unit& u, int wr, int wc, int fr, int fq, LAS float* red) const {
        asm volatile("" : "+v"(fr), "+v"(fq), "+s"(wr), "+s"(wc));
        const int rl0 = wr * 64 + fr; const size_t row0 = (size_t)u.pm * 256 + rl0; const int pn = u.pn;
        bf16_t* const QLN = (bf16_t*)(ws + WS_QLN); bf16_t* const KVLN = (bf16_t*)(ws + WS_KVLN); bf16_t* const CQ = (bf16_t*)(ws + WS_CQ); bf16_t* const CK = (bf16_t*)(ws + WS_CK); bf16_t* const CV = (bf16_t*)(ws + WS_CV);
        float* const KR = (float*)(ws + WS_KR); float* const SSR = (float*)(ws + WS_SSR);
        if (pn >= 6) {
            bf16_t* base = CV + (pn - 6) * 256 + wc * 32 + 8 * fq;
#pragma unroll
            for (int ai = 0; ai < 2; ++ai)
#pragma unroll
                for (int m = 0; m < 4; ++m) { bf16_t* rp = base + (row0 + ai * 128 + m * 16) * 512;
#pragma unroll
                    for (int bj = 0; bj < 2; ++bj) *(u32x4*)(rp + bj * 128) = pack8(acc[ai][bj][m][0], acc[ai][bj][m][1]); }
        } else if (pn >= 2) {
            const bool isq = pn < 4; const int head = 4 * ((pn - 2) & 1) + wc; const float* g = isq ? g_caq : g_cak; const float sc = isq ? C2_CA : 1.0f;
            f32x4 gv[2][2];
#pragma unroll
            for (int bj = 0; bj < 2; ++bj)
#pragma unroll
                for (int n = 0; n < 2; ++n) gv[bj][n] = *(const f32x4*)(g + 32 * bj + 8 * fq + 4 * n) * sc;
            bf16_t* base = (isq ? CQ : CK) + head * 64 + 8 * fq;
#pragma unroll
            for (int ai = 0; ai < 2; ++ai)
#pragma unroll
                for (int m = 0; m < 4; ++m) {
                    float ss = (dot4(acc[ai][0][m][0]) + dot4(acc[ai][0][m][1])) + (dot4(acc[ai][1][m][0]) + dot4(acc[ai][1][m][1]));
                    ss += __shfl_xor(ss, 16); ss += __shfl_xor(ss, 32);
                    const float r = rsqrtf(ss * (1.0f / 64.0f) + EPS);
                    bf16_t* rp = base + (row0 + ai * 128 + m * 16) * 512;
#pragma unroll
                    for (int bj = 0; bj < 2; ++bj) *(u32x4*)(rp + bj * 32) = pack8(acc[ai][bj][m][0] * r * gv[bj][0], acc[ai][bj][m][1] * r * gv[bj][1]);
                }
        } else if (pn == 0) {
#pragma unroll
            for (int ai = 0; ai < 2; ++ai)
#pragma unroll
                for (int m = 0; m < 4; ++m) {
                    float ss = (dot4(acc[ai][0][m][0]) + dot4(acc[ai][0][m][1])) + (dot4(acc[ai][1][m][0]) + dot4(acc[ai][1][m][1]));
                    ss += __shfl_xor(ss, 16); ss += __shfl_xor(ss, 32);
                    if (fq == 0) red[(ai * 128 + m * 16 + rl0) * 8 + wc] = ss;
                }
            LDS_BARRIER();
            f32x4 gv[2][2];
#pragma unroll
            for (int bj = 0; bj < 2; ++bj)
#pragma unroll
                for (int n = 0; n < 2; ++n) gv[bj][n] = *(const f32x4*)(g_ql + 128 * bj + 32 * wc + 8 * fq + 4 * n);
            bf16_t* base = QLN + wc * 32 + 8 * fq;
#pragma unroll
            for (int ai = 0; ai < 2; ++ai)
#pragma unroll
                for (int m = 0; m < 4; ++m) {
                    const f32x4 t = *(const LAS f32x4*)(red + (ai * 128 + m * 16 + rl0) * 8);
                    const float r = rsqrtf(((t[0] + t[1]) + (t[2] + t[3])) * (1.0f / 256.0f) + EPS);
                    bf16_t* rp = base + (row0 + ai * 128 + m * 16) * 256;
#pragma unroll
                    for (int bj = 0; bj < 2; ++bj) *(u32x4*)(rp + bj * 128) = pack8(acc[ai][bj][m][0] * r * gv[bj][0], acc[ai][bj][m][1] * r * gv[bj][1]);
                }
        } else {
#pragma unroll
            for (int ai = 0; ai < 2; ++ai)
#pragma unroll
                for (int m = 0; m < 4; ++m) {
                    float ss = dot4(acc[ai][0][m][0]) + dot4(acc[ai][0][m][1]);
                    ss += __shfl_xor(ss, 16); ss += __shfl_xor(ss, 32);
                    if (fq == 0) red[(ai * 128 + m * 16 + rl0) * 8 + wc] = ss;
                }
            LDS_BARRIER();
            f32x4 gv[2];
#pragma unroll
            for (int n = 0; n < 2; ++n) gv[n] = *(const f32x4*)(g_kvl + 32 * wc + 8 * fq + 4 * n);
            bf16_t* base = KVLN + wc * 32 + 8 * fq;
#pragma unroll
            for (int ai = 0; ai < 2; ++ai)
#pragma unroll
                for (int m = 0; m < 4; ++m) {
                    const f32x4 t = *(const LAS f32x4*)(red + (ai * 128 + m * 16 + rl0) * 8);
                    const float r = rsqrtf(((t[0] + t[1]) + (t[2] + t[3])) * (1.0f / 128.0f) + EPS);
                    const size_t row = row0 + ai * 128 + m * 16;
                    bf16_t* rp = base + row * 256;
                    *(u32x4*)(rp) = pack8(acc[ai][0][m][0] * r * gv[0], acc[ai][0][m][1] * r * gv[1]);
                    *(u32x4*)(rp + 128) = (u32x4){0u, 0u, 0u, 0u};
                    if (wc == 0) {
                        *(f32x4*)(KR + row * 32 + 8 * fq) = acc[ai][1][m][0]; *(f32x4*)(KR + row * 32 + 8 * fq + 4) = acc[ai][1][m][1];
                        float sr = dot4(acc[ai][1][m][0]) + dot4(acc[ai][1][m][1]);
                        sr += __shfl_xor(sr, 16); sr += __shfl_xor(sr, 32);
                        if (fq == 0) SSR[row] = sr;
                    }
                }
        }
    }
};

struct EpiQ {
    static constexpr bool APERM = false;
    unsigned char* ws; const float* g;
    __device__ __forceinline__ void operator()(const f32x4 (&acc)[2][2][4][2], const Unit& u, int wr, int wc, int fr, int fq, LAS float* red) const {
        asm volatile("" : "+v"(fr), "+v"(fq), "+s"(wr), "+s"(wc));
        const int rl0 = wr * 64 + fr; const size_t row0 = (size_t)u.pm * 256 + rl0;
        bf16_t* const QM = (bf16_t*)(ws + WS_QM); const float* const cosT = (const float*)(ws + WS_COS); const float* const sinT = (const float*)(ws + WS_SIN);
#pragma unroll
        for (int ai = 0; ai < 2; ++ai)
#pragma unroll
            for (int m = 0; m < 4; ++m)
#pragma unroll
                for (int bj = 0; bj < 2; ++bj) {
                    float ss = dot4(acc[ai][bj][m][0]) + dot4(acc[ai][bj][m][1]);
                    ss += __shfl_xor(ss, 16); ss += __shfl_xor(ss, 32);
                    if (fq == 0) red[(ai * 128 + m * 16 + rl0) * 8 + bj * 4 + wc] = ss;
                }
        LDS_BARRIER();
        if (wc < 2) {
            const f32x4 g0 = *(const f32x4*)(g + 32 * wc + 8 * fq) * C2_MLA, g1 = *(const f32x4*)(g + 32 * wc + 8 * fq + 4) * C2_MLA;
#pragma unroll
            for (int ai = 0; ai < 2; ++ai)
#pragma unroll
                for (int m = 0; m < 4; ++m) {
                    const size_t row = row0 + ai * 128 + m * 16;
#pragma unroll
                    for (int bj = 0; bj < 2; ++bj) {
                        const f32x4 t = *(const LAS f32x4*)(red + (ai * 128 + m * 16 + rl0) * 8 + bj * 4);
                        const float r = rsqrtf(((t[0] + t[1]) + (t[2] + t[3])) * (1.0f / 96.0f) + EPS);
                        *(u32x4*)(QM + row * 768 + (2 * u.pn + bj) * 96 + 32 * wc + 8 * fq) = pack8(acc[ai][bj][m][0] * r * g0, acc[ai][bj][m][1] * r * g1);
                    }
                }
        } else if (wc == 2) {
            const f32x4 g0 = *(const f32x4*)(g + 64 + 4 * fq) * C2_MLA, g1 = *(const f32x4*)(g + 80 + 4 * fq) * C2_MLA;
#pragma unroll
            for (int ai = 0; ai < 2; ++ai)
#pragma unroll
                for (int m = 0; m < 4; ++m) {
                    const size_t row = row0 + ai * 128 + m * 16;
                    const f32x4 cs = *(const f32x4*)(cosT + row * 16 + 4 * fq), sn = *(const f32x4*)(sinT + row * 16 + 4 * fq);
#pragma unroll
                    for (int bj = 0; bj < 2; ++bj) {
                        const f32x4 t = *(const LAS f32x4*)(red + (ai * 128 + m * 16 + rl0) * 8 + bj * 4);
                        const float r = rsqrtf(((t[0] + t[1]) + (t[2] + t[3])) * (1.0f / 96.0f) + EPS);
                        bf16_t* hp = QM + row * 768 + (2 * u.pn + bj) * 96;
                        const f32x4 x1 = acc[ai][bj][m][0] * r * g0, x2 = acc[ai][bj][m][1] * r * g1;
                        *(u32x2*)(hp + 64 + 4 * fq) = pack4(x1 * cs - x2 * sn); *(u32x2*)(hp + 80 + 4 * fq) = pack4(x2 * cs + x1 * sn);
                    }
                    asm volatile("" ::: "memory");
                }
        }
    }
};

struct EpiKV {
    static constexpr bool APERM = false;
    unsigned char* ws; const float* g;
    __device__ __forceinline__ void operator()(const f32x4 (&acc)[2][2][4][2], const Unit& u, int wr, int wc, int fr, int fq, LAS float* red) const {
        asm volatile("" : "+v"(fr), "+v"(fq), "+s"(wr), "+s"(wc));
        const int rl0 = wr * 64 + fr; const size_t row0 = (size_t)u.pm * 256 + rl0;
        bf16_t* const KM = (bf16_t*)(ws + WS_KM); bf16_t* const VM = (bf16_t*)(ws + WS_VM); const float* const cosT = (const float*)(ws + WS_COS); const float* const sinT = (const float*)(ws + WS_SIN);
        const float* const KR = (const float*)(ws + WS_KR); const float* const SSR = (const float*)(ws + WS_SSR);
        if (wc < 2) {
#pragma unroll
            for (int ai = 0; ai < 2; ++ai)
#pragma unroll
                for (int m = 0; m < 4; ++m)
#pragma unroll
                    for (int bj = 0; bj < 2; ++bj) {
                        float ss = dot4(acc[ai][bj][m][0]) + dot4(acc[ai][bj][m][1]);
                        ss += __shfl_xor(ss, 16); ss += __shfl_xor(ss, 32);
                        if (fq == 0) red[(ai * 128 + m * 16 + rl0) * 8 + bj * 2 + wc] = ss;
                    }
        }
        LDS_BARRIER();
        if (wc < 2) {
            const f32x4 g0 = *(const f32x4*)(g + 32 * wc + 8 * fq), g1 = *(const f32x4*)(g + 32 * wc + 8 * fq + 4);
#pragma unroll
            for (int ai = 0; ai < 2; ++ai)
#pragma unroll
                for (int m = 0; m < 4; ++m) {
                    const size_t row = row0 + ai * 128 + m * 16;
                    const float ssr = SSR[row];
                    const f32x4 t = *(const LAS f32x4*)(red + (ai * 128 + m * 16 + rl0) * 8);
#pragma unroll
                    for (int bj = 0; bj < 2; ++bj) {
                        const float rk = rsqrtf((t[2 * bj] + t[2 * bj + 1] + ssr) * (1.0f / 96.0f) + EPS);
                        *(u32x4*)(KM + row * 768 + (2 * u.pn + bj) * 96 + 32 * wc + 8 * fq) = pack8(acc[ai][bj][m][0] * rk * g0, acc[ai][bj][m][1] * rk * g1);
                    }
                    asm volatile("" ::: "memory");
                }
        } else {
            const int bj0 = wc - 2, h0 = 2 * u.pn + bj0;
            const f32x4 g0 = *(const f32x4*)(g + 64 + 4 * fq), g1 = *(const f32x4*)(g + 80 + 4 * fq);
#pragma unroll
            for (int ai = 0; ai < 2; ++ai)
#pragma unroll
                for (int m = 0; m < 4; ++m) {
                    const size_t row = row0 + ai * 128 + m * 16;
#pragma unroll
                    for (int bj = 0; bj < 2; ++bj) *(u32x4*)(VM + row * 512 + (2 * u.pn + bj) * 64 + 32 * (wc - 2) + 8 * fq) = pack8(acc[ai][bj][m][0], acc[ai][bj][m][1]);
                    const f32x2 t = *(const LAS f32x2*)(red + (ai * 128 + m * 16 + rl0) * 8 + 2 * bj0);
                    const float rk = rsqrtf((t[0] + t[1] + SSR[row]) * (1.0f / 96.0f) + EPS);
                    const f32x4 cs = *(const f32x4*)(cosT + row * 16 + 4 * fq), sn = *(const f32x4*)(sinT + row * 16 + 4 * fq);
                    const f32x4 x1 = *(const f32x4*)(KR + row * 32 + 4 * fq) * rk * g0, x2 = *(const f32x4*)(KR + row * 32 + 16 + 4 * fq) * rk * g1;
                    bf16_t* hp = KM + row * 768 + h0 * 96;
                    *(u32x2*)(hp + 64 + 4 * fq) = pack4(x1 * cs - x2 * sn); *(u32x2*)(hp + 80 + 4 * fq) = pack4(x2 * cs + x1 * sn);
                    asm volatile("" ::: "memory");
                }
        }
    }
};

struct EpiQKV {
    static constexpr bool APERM = false;
    EpiQ q; EpiKV kv;
    __device__ __forceinline__ void operator()(const f32x4 (&acc)[2][2][4][2], const Unit& u, int wr, int wc, int fr, int fq, LAS float* red) const {
        if (u.pn < 4) q(acc, u, wr, wc, fr, fq, red);
        else { Unit v; v.pm = u.pm; v.pn = u.pn - 4; kv(acc, v, wr, wc, fr, fq, red); }
    }
};

struct EpiRes {
    static constexpr bool APERM = false;
    const float* base; float* out; const float* gate;
    __device__ __forceinline__ void operator()(const f32x4 (&acc)[2][2][4][2], const Unit& u, int wr, int wc, int fr, int fq, LAS float* red) const {
        asm volatile("" : "+v"(fr), "+v"(fq), "+s"(wr), "+s"(wc));
        const int b = u.pm >> 3; const int col0 = u.pn * 256 + wc * 32 + 8 * fq;
        f32x4 gv[2][2];
#pragma unroll
        for (int bj = 0; bj < 2; ++bj)
#pragma unroll
            for (int n = 0; n < 2; ++n) gv[bj][n] = *(const f32x4*)(gate + (size_t)b * NMOD + col0 + 128 * bj + 4 * n);
#pragma unroll
        for (int ai = 0; ai < 2; ++ai)
#pragma unroll
            for (int m = 0; m < 4; ++m) {
                const size_t off = ((size_t)u.pm * 256 + ai * 128 + wr * 64 + m * 16 + fr) * DM + col0;
#pragma unroll
                for (int bj = 0; bj < 2; ++bj)
#pragma unroll
                    for (int n = 0; n < 2; ++n) { const f32x4 xs = *(const f32x4*)(base + off + 128 * bj + 4 * n); *(f32x4*)(out + off + 128 * bj + 4 * n) = xs + gv[bj][n] * acc[ai][bj][m][n]; }
                if (m & 1) asm volatile("" ::: "memory");
            }
    }
};

__device__ __forceinline__ float dpp_shr1(float v) { return __builtin_bit_cast(float, __builtin_amdgcn_update_dpp(0, __builtin_bit_cast(int, v), 0x111, 0xF, 0xF, false)); }
__device__ __forceinline__ f32x4 dpp_shr1(f32x4 v) { f32x4 r; r[0] = dpp_shr1(v[0]); r[1] = dpp_shr1(v[1]); r[2] = dpp_shr1(v[2]); r[3] = dpp_shr1(v[3]); return r; }
struct EpiUp {
    static constexpr bool APERM = true;
    unsigned char* ws; const float *cw, *cb;
    __device__ __forceinline__ void operator()(const f32x4 (&acc)[2][2][4][2], const Unit& u, int wr, int wc, int fr, int fq, LAS float* red) const {
        asm volatile("" : "+v"(fr), "+v"(fq), "+s"(wr), "+s"(wc));
        const int j = u.pn; const int cc0 = 32 * wc + 8 * fq;
        bf16_t* const ACT = (bf16_t*)(ws + WS_ACT); float* const RAW4 = (float*)(ws + WS_RAW4);
#pragma unroll
        for (int n = 0; n < 2; ++n) {
            const int gcol = 128 * j + cc0 + 4 * n, vcol = DFF + gcol;
            const f32x4 wg0 = *(const f32x4*)(cw + gcol), wg1 = *(const f32x4*)(cw + DFF2 + gcol), wg2 = *(const f32x4*)(cw + 2 * DFF2 + gcol), bg = *(const f32x4*)(cb + gcol);
            const f32x4 wv0 = *(const f32x4*)(cw + vcol), wv1 = *(const f32x4*)(cw + DFF2 + vcol), wv2 = *(const f32x4*)(cw + 2 * DFF2 + vcol), bv = *(const f32x4*)(cb + vcol);
#pragma unroll
            for (int ai = 0; ai < 2; ++ai) {
                const size_t blk = (size_t)u.pm * 4 + 2 * ai + wr;
                const f32x4 g2s = dpp_shr1(acc[ai][0][2][n]), g3s = dpp_shr1(acc[ai][0][3][n]), v2s = dpp_shr1(acc[ai][1][2][n]), v3s = dpp_shr1(acc[ai][1][3][n]);
#pragma unroll
                for (int m = 0; m < 4; ++m) {
                    const f32x4 gr = acc[ai][0][m][n], vr = acc[ai][1][m][n];
                    const f32x4 gp1 = m == 0 ? g3s : acc[ai][0][m - 1 < 0 ? 0 : m - 1][n], gp2 = m == 0 ? g2s : (m == 1 ? g3s : acc[ai][0][m - 2 < 0 ? 0 : m - 2][n]);
                    const f32x4 vp1 = m == 0 ? v3s : acc[ai][1][m - 1 < 0 ? 0 : m - 1][n], vp2 = m == 0 ? v2s : (m == 1 ? v3s : acc[ai][1][m - 2 < 0 ? 0 : m - 2][n]);
                    const f32x4 G = wg0 * gp2 + wg1 * gp1 + wg2 * gr + bg, V = wv0 * vp2 + wv1 * vp1 + wv2 * vr + bv;
                    f32x4 a;
#pragma unroll
                    for (int e = 0; e < 4; ++e) a[e] = G[e] * __builtin_amdgcn_rcpf(1.0f + __builtin_amdgcn_exp2f(-LOG2E * G[e])) * V[e];
                    const size_t row = blk * 64 + 4 * fr + m;
                    if (m >= 2 || fr > 0) *(u32x2*)(ACT + row * DFF + 128 * j + cc0 + 4 * n) = pack4(a);
                    if (m < 2 && fr == 0) { float* rp = RAW4 + (blk * 4 + m) * DFF2 + 256 * j + cc0 + 4 * n; *(f32x4*)rp = gr; *(f32x4*)(rp + 128) = vr; }
                    if (m >= 2 && fr == 15) { float* rp = RAW4 + (blk * 4 + m) * DFF2 + 256 * j + cc0 + 4 * n; *(f32x4*)rp = gr; *(f32x4*)(rp + 128) = vr; }
                }
            }
        }
    }
};

namespace att {
__device__ __forceinline__ int crow(int r, int hi) { return (r & 3) + 8 * (r >> 2) + 4 * hi; }
__device__ __forceinline__ void glds16(const void* gsrc, unsigned lds_dst) { unsigned keep;
    asm volatile("s_mov_b32 %0, m0\n\ts_mov_b32 m0, %2\n\ts_nop 0\n\tglobal_load_lds_dwordx4 %1, off\n\ts_mov_b32 m0, %0" : "=&s"(keep) : "v"(gsrc), "s"(lds_dst) : "memory"); }
__device__ __forceinline__ float max3f(float a, float b, float c) { float r; asm("v_max3_f32 %0, %1, %2, %3" : "=v"(r) : "v"(a), "v"(b), "v"(c)); return r; }
__device__ __forceinline__ float rowmax(const f32x16& p0, const f32x16& p1) {
    float a = max3f(p0[0], p0[1], p1[0]), b = max3f(p0[2], p0[3], p1[1]); a = max3f(a, p1[2], p1[3]);
#pragma unroll
    for (int r = 4; r < 16; r += 4) { a = max3f(a, p0[r], p0[r + 1]); b = max3f(b, p0[r + 2], p0[r + 3]); a = max3f(a, p1[r], p1[r + 1]); b = max3f(b, p1[r + 2], p1[r + 3]); }
    const float m = fmaxf(a, b);
    auto rr = __builtin_amdgcn_permlane32_swap(__float_as_uint(m), __float_as_uint(m), false, false);
    return fmaxf(__uint_as_float(rr[0]), __uint_as_float(rr[1]));
}
typedef short v4i16_t __attribute__((ext_vector_type(4)));
__device__ __forceinline__ s16x4 vtr(const LAS unsigned char* p) { return __builtin_bit_cast(s16x4, __builtin_amdgcn_ds_read_tr16_b64_v4i16((LAS v4i16_t*)p)); }
__device__ __forceinline__ void pv(f32x16* o, const LAS unsigned char* vp, bf16x8 pa0, bf16x8 pa1, bf16x8 pa2, bf16x8 pa3) {
#pragma unroll
    for (int d0 = 0; d0 < 2; ++d0) { s16x4 lo[4], hi[4];
        __builtin_amdgcn_sched_barrier(0);
#pragma unroll
        for (int ks = 0; ks < 4; ++ks) { lo[ks] = vtr(vp + d0 * 4096 + ks * 1024); hi[ks] = vtr(vp + d0 * 4096 + ks * 1024 + 512); }
#define PK(k) (bf16x8){lo[k][0], lo[k][1], lo[k][2], lo[k][3], hi[k][0], hi[k][1], hi[k][2], hi[k][3]}
        o[d0] = __builtin_amdgcn_mfma_f32_32x32x16_bf16(pa0, PK(0), o[d0], 0, 0, 0);
        o[d0] = __builtin_amdgcn_mfma_f32_32x32x16_bf16(pa1, PK(1), o[d0], 0, 0, 0);
        o[d0] = __builtin_amdgcn_mfma_f32_32x32x16_bf16(pa2, PK(2), o[d0], 0, 0, 0);
        o[d0] = __builtin_amdgcn_mfma_f32_32x32x16_bf16(pa3, PK(3), o[d0], 0, 0, 0);
#undef PK
    }
}
constexpr int NSLOT = 4;
constexpr int ATT_LDS_BYTES = NSLOT * 12288 + NSLOT * 8192 + 8 * 256 + 8 * 4096 + 2048;

template <int DQK, bool CA, int THR>
__device__ __forceinline__ void attn_unit(int tid, int b, int h, int u, const bf16_t* Q, const bf16_t* K, const bf16_t* V, bf16_t* O, const float* relb, LAS unsigned char* shm) {
    constexpr int ND = DQK / 16, NCH = DQK / 8, KSLOT = NCH * 1024, VSLOT = 8192;
    constexpr int NP = (DQK == 96) ? 3 : 2;
    constexpr int LDS_K = 0, LDS_V = NSLOT * KSLOT, LDS_WS = LDS_V + NSLOT * VSLOT, LDS_OST = LDS_WS + 8 * 256, LDS_TAB = LDS_OST + 8 * 4096;
    constexpr int LDQ = CA ? 512 : 768, LDV = 512, LDO = 1024, OCOL = CA ? 512 : 0;
    const int lane = tid & 63, r32 = lane & 31, hi = lane >> 5; const int wid = __builtin_amdgcn_readfirstlane(tid >> 6);
    const bool grpB = wid >= 4;
    const long rowbase = (long)b * SEQ; const int q0 = u * 256;
    const bf16_t* Qw = Q + (rowbase + q0 + wid * 32) * LDQ + h * DQK;
    const bf16_t* Kh = K + rowbase * LDQ + h * DQK; const bf16_t* Vh = V + rowbase * LDV + h * 64;
    const unsigned lds0 = (unsigned)(uintptr_t)shm;
    LAS float* wsf = (LAS float*)(shm + LDS_WS) + wid * 64;
    LAS float* tab = (LAS float*)(shm + LDS_TAB);
    const int t0 = CA ? (4 * u - 8 > 0 ? 4 * u - 8 : 0) : 0, t1 = 4 * u + 3, cw = 4 * u + (wid >> 1);
    const bf16_t* ksrc = Kh + (long)lane * LDQ + wid * 8;
    const bf16_t* ksrc2 = Kh + (long)lane * LDQ + (8 + (wid & 3)) * 8;
    const bf16_t* vsrc = Vh + (long)(16 * (wid & 3) + (lane >> 2)) * LDV + (wid >> 2) * 32 + (lane & 3) * 8;
#define DMA_TILE(t, s) do { glds16(ksrc + (long)(t) * 64 * LDQ, (unsigned)__builtin_amdgcn_readfirstlane(lds0 + LDS_K + (s) * KSLOT + wid * 1024)); \
        if (DQK == 96) glds16(ksrc2 + (long)(t) * 64 * LDQ, (unsigned)__builtin_amdgcn_readfirstlane(lds0 + LDS_K + (s) * KSLOT + (8 + (wid & 3)) * 1024)); \
        glds16(vsrc + (long)(t) * 64 * LDV, (unsigned)__builtin_amdgcn_readfirstlane(lds0 + LDS_V + (s) * VSLOT + wid * 1024)); } while (0)
#define TVALID(t) (CA ? ((t) <= cw && (t) >= cw - 8) : ((t) <= cw))
    if (CA) { for (int i = tid; i < 320; i += 512) tab[i] = relb[h * 257 + (i < 256 ? i : 256)] * LOG2E; }
    bf16x8 qr[ND];
#pragma unroll
    for (int d0 = 0; d0 < ND; ++d0) qr[d0] = *(const bf16x8*)(Qw + (long)r32 * LDQ + d0 * 16 + hi * 8);
    DMA_TILE(t0, 0); DMA_TILE(t0 + 1, 1);
#pragma unroll
    for (int d0 = 0; d0 < ND; ++d0) asm volatile("" :: "v"(qr[d0]));
    float mrun = -1e30f, l_reg = 0.f; f32x16 o[2]; o[0] = f32x16{}; o[1] = f32x16{};
    f32x16 pb0 = f32x16{}, pb1 = f32x16{};
    const LAS unsigned char* vp0 = shm + LDS_V + ((lane >> 4) & 1) * 32 + (lane & 3) * 8 + (4 * hi + ((lane & 15) >> 2)) * 64;
    const LAS unsigned char* kp0 = shm + LDS_K + hi * 1024 + r32 * 16;
#define QK_TILE(p0, p1, t, s) do { __builtin_amdgcn_sched_barrier(0); p0 = f32x16{}; p1 = f32x16{}; const LAS unsigned char* kb = kp0 + (s) * KSLOT; \
        _Pragma("unroll") for (int d0 = 0; d0 < ND; ++d0) { const bf16x8 b0 = *(const LAS bf16x8*)(kb + d0 * 2048), b1 = *(const LAS bf16x8*)(kb + d0 * 2048 + 512); \
            p0 = __builtin_amdgcn_mfma_f32_32x32x16_bf16(b0, qr[d0], p0, 0, 0, 0); p1 = __builtin_amdgcn_mfma_f32_32x32x16_bf16(b1, qr[d0], p1, 0, 0, 0); } \
        if (CA) { const int dist = cw - (t); \
            if (dist >= 3) { const float c = tab[256]; _Pragma("unroll") for (int r = 0; r < 16; ++r) { p0[r] += c; p1[r] += c; } } \
            else { const int bi = 64 * dist + 32 * (wid & 1) + r32 + 128 - 4 * hi; \
                _Pragma("unroll") for (int r = 0; r < 16; ++r) { p0[r] += tab[bi - ((r & 3) + 8 * (r >> 2))]; p1[r] += tab[bi - 32 - ((r & 3) + 8 * (r >> 2))]; } } } } while (0)
#define SM_PV(p0, p1, s) do { __builtin_amdgcn_sched_barrier(0); const float rm = rowmax(p0, p1); \
        if (__any(rm > mrun + (float)THR)) { const float mn = fmaxf(mrun, rm), f = __builtin_amdgcn_exp2f(mrun - mn); mrun = mn; l_reg *= f; \
            if (hi == 0) wsf[r32] = f; \
            _Pragma("unroll") for (int r = 0; r < 16; ++r) { const float fr_ = wsf[crow(r, hi)]; o[0][r] *= fr_; o[1][r] *= fr_; } } \
        float sacc = 0.f; \
        _Pragma("unroll") for (int r = 0; r < 16; ++r) { p0[r] = __builtin_amdgcn_exp2f(p0[r] - mrun); p1[r] = __builtin_amdgcn_exp2f(p1[r] - mrun); sacc += p0[r] + p1[r]; } \
        l_reg += sacc; __builtin_amdgcn_sched_barrier(0); \
        const u32x4 pw0 = {cvtpk(p0[0], p0[1]), cvtpk(p0[2], p0[3]), cvtpk(p0[4], p0[5]), cvtpk(p0[6], p0[7])}; \
        const u32x4 pw1 = {cvtpk(p0[8], p0[9]), cvtpk(p0[10], p0[11]), cvtpk(p0[12], p0[13]), cvtpk(p0[14], p0[15])}; \
        const u32x4 pw2 = {cvtpk(p1[0], p1[1]), cvtpk(p1[2], p1[3]), cvtpk(p1[4], p1[5]), cvtpk(p1[6], p1[7])}; \
        const u32x4 pw3 = {cvtpk(p1[8], p1[9]), cvtpk(p1[10], p1[11]), cvtpk(p1[12], p1[13]), cvtpk(p1[14], p1[15])}; \
        pv(o, vp0 + (s) * VSLOT, __builtin_bit_cast(bf16x8, pw0), __builtin_bit_cast(bf16x8, pw1), __builtin_bit_cast(bf16x8, pw2), __builtin_bit_cast(bf16x8, pw3)); } while (0)
    for (int t = t0; t <= t1; ++t) {
        const int s = (t - t0) & (NSLOT - 1);
        if (t + 1 <= t1) asm volatile("s_waitcnt vmcnt(%0) lgkmcnt(0)\n\ts_barrier" :: "n"(NP) : "memory");
        else asm volatile("s_waitcnt vmcnt(0) lgkmcnt(0)\n\ts_barrier" ::: "memory");
        if (t + 2 <= t1) DMA_TILE(t + 2, (s + 2) & (NSLOT - 1));
        if (!grpB) { if (TVALID(t)) { f32x16 a0, a1; QK_TILE(a0, a1, t, s); SM_PV(a0, a1, s); } }
        else { if (t > t0 && TVALID(t - 1)) SM_PV(pb0, pb1, (s + NSLOT - 1) & (NSLOT - 1)); if (TVALID(t)) QK_TILE(pb0, pb1, t, s); }
    }
    if (grpB && TVALID(t1)) SM_PV(pb0, pb1, (t1 - t0) & (NSLOT - 1));
    { auto rr = __builtin_amdgcn_permlane32_swap(__float_as_uint(l_reg), __float_as_uint(l_reg), false, false); l_reg = __uint_as_float(rr[0]) + __uint_as_float(rr[1]); }
    if (hi == 0) wsf[32 + r32] = l_reg;
    float rli[16];
#pragma unroll
    for (int r = 0; r < 16; ++r) rli[r] = __builtin_amdgcn_rcpf(wsf[32 + crow(r, hi)]);
    bf16_t* Ow = O + (rowbase + q0 + wid * 32) * LDO + OCOL + h * 64;
    { LAS bf16_t* stg = (LAS bf16_t*)(shm + LDS_OST) + wid * 2048;
#pragma unroll
        for (int r = 0; r < 16; ++r) { const int orow = crow(r, hi);
#pragma unroll
            for (int d0 = 0; d0 < 2; ++d0) { const unsigned w = cvtpk(o[d0][r] * rli[r], 0.f); stg[orow * 64 + d0 * 32 + r32] = (bf16_t)(w & 0xffffu); } }
#pragma unroll
        for (int i = 0; i < 4; ++i) { const int row = i * 8 + (lane >> 3), ch = lane & 7; const u32x4 v = *(const LAS u32x4*)(stg + row * 64 + ch * 8); *(u32x4*)(Ow + (long)row * LDO + ch * 8) = v; } }
    asm volatile("s_waitcnt lgkmcnt(0)\n\ts_barrier" ::: "memory");
#undef DMA_TILE
#undef TVALID
#undef QK_TILE
#undef SM_PV
}
}

constexpr int NWAVES = 8;
constexpr int NPHASE = 10;
constexpr int N_LAUNCHES = MK_N_LAUNCHES;
static_assert(N_LAUNCHES == 1 || N_LAUNCHES == NPHASE, "MK_N_LAUNCHES is 1 or 10");

constexpr int RING_BYTES = 131072, LDSCTL_OFF = RING_BYTES, MISC_OFF = LDSCTL_OFF + 320, XL_OFF = LDSCTL_OFF + 1024, LDS_BYTES = 147456;
static_assert(XL_OFF + 8192 <= LDS_BYTES && att::ATT_LDS_BYTES <= RING_BYTES, "LDS map");

typedef GAS unsigned gu32;
#define RLX_AGENT __ATOMIC_RELAXED, __HIP_MEMORY_SCOPE_AGENT

#define XB_TMO      128
#define XB_XCNT(j)  (256  + 64 * (j))
#define XB_XSUB(j)  (1280 + 64 * (j))
#define XB_XGEN(j)  (2304 + 64 * (j))
#define XB_TOP      3328
#define XB_TOPGEN   3392
#define XCD_BAR_WORDS 3456
#define XB_SPIN_CAP (1u << 18)
__device__ __forceinline__ unsigned xb_ld(unsigned* p)              { return __hip_atomic_load(p, __ATOMIC_RELAXED, __HIP_MEMORY_SCOPE_AGENT); }
__device__ __forceinline__ unsigned xb_add(unsigned* p, unsigned v) { return __hip_atomic_fetch_add(p, v, __ATOMIC_RELAXED, __HIP_MEMORY_SCOPE_AGENT); }
__device__ __forceinline__ unsigned xb_xcc_id() { return (unsigned)__builtin_amdgcn_s_getreg((3 << 11) | 20) & 0xFu; }
#define XB_SPIN(cond, bar) do { unsigned _sp = 0; while (cond) { __builtin_amdgcn_s_sleep(1); \
    if ((++_sp & 255u) == 0u) { if (xb_ld(&(bar)[XB_TMO])) break; if (_sp > XB_SPIN_CAP) { atomicAdd(&(bar)[XB_TMO], 1u); break; } } } } while (0)
struct XcdBarrier { unsigned* bar; unsigned x; volatile LAS unsigned* st; };
__device__ __forceinline__ XcdBarrier xcd_barrier_post(unsigned* bar, volatile LAS unsigned* st) {
    XcdBarrier b; b.bar = bar; b.x = xb_xcc_id(); b.st = st;
    if (threadIdx.x == 0) (void)xb_add(&bar[XB_XCNT(b.x)], 1u);
    return b;
}
__device__ __forceinline__ void xcd_barrier_complete(unsigned* bar, unsigned x, unsigned& nloc, unsigned& nx) {
    const unsigned G = gridDim.x * gridDim.y * gridDim.z;
    unsigned sum, cnt, mine, sp = 0u;
    for (;;) {
        sum = 0u; cnt = 0u; mine = 0u;
#pragma unroll
        for (unsigned j = 0; j < 16; ++j) { const unsigned c = xb_ld(&bar[XB_XCNT(j)]); sum += c; cnt += (c > 0u) ? 1u : 0u; mine = (j == x) ? c : mine; }
        if (sum == G) break;
        __builtin_amdgcn_s_sleep(1);
        if ((++sp & 255u) == 0u) { if (xb_ld(&bar[XB_TMO])) break; if (sp > XB_SPIN_CAP) { atomicAdd(&bar[XB_TMO], 1u); break; } }
    }
    nloc = mine > 0u ? mine : 1u; nx = cnt > 0u ? cnt : 1u;
}
__device__ __forceinline__ void xcd_barrier(const XcdBarrier& b) {
    asm volatile("s_waitcnt vmcnt(0)" ::: "memory");
    __syncthreads();
    if (threadIdx.x == 0) {
        unsigned* bar = b.bar;
        __builtin_amdgcn_s_waitcnt(0);
        unsigned nloc = b.st[0], nx = b.st[1];
        if (nloc == 0u) { xcd_barrier_complete(bar, b.x, nloc, nx); b.st[0] = nloc; b.st[1] = nx; }
        const unsigned old = xb_add(&bar[XB_XSUB(b.x)], 1u);
        const unsigned gen = old / nloc;
        if (old + 1u == (gen + 1u) * nloc) {
            __builtin_amdgcn_fence(__ATOMIC_RELEASE, "agent");
            asm volatile("s_waitcnt vmcnt(0)" ::: "memory");
            const unsigned og = xb_add(&bar[XB_TOP], 1u);
            const unsigned tg = og / nx;
            if (og + 1u == (tg + 1u) * nx) xb_add(&bar[XB_TOPGEN], 1u);
            else XB_SPIN(xb_ld(&bar[XB_TOPGEN]) == tg, bar);
            __builtin_amdgcn_fence(__ATOMIC_ACQUIRE, "agent");
            xb_add(&bar[XB_XGEN(b.x)], 1u);
            asm volatile("s_waitcnt vmcnt(0)" ::: "memory");
        } else {
            XB_SPIN(xb_ld(&bar[XB_XGEN(b.x)]) == gen, bar);
            __builtin_amdgcn_fence(__ATOMIC_ACQUIRE, "agent");
            asm volatile("s_waitcnt vmcnt(0)" ::: "memory");
        }
    }
    __syncthreads();
}

struct Args { const void* in[22]; float* out; unsigned char* ws; int ph_lo, ph_hi, li, pad; };
#define ARGF(k) ((const float*)args.in[k])
struct Frame {
    LAS unsigned char* lds; LAS float* xl;
    int tid, lane, wave, vcu, G;
    unsigned char* ws;
};

template <int WHICH> __device__ __forceinline__ int wmap(int n) {
    if (WHICH == 0) {
        if (n < 256) return n;
        if (n < 512) { const int c = n - 256; return c < 160 ? 256 + c : -1; }
        if (n < 1536) { const int t4 = (n - 512) >> 8, which = t4 >> 1, jj = t4 & 1, c = (n - 512) & 255, bj = c >> 7, wc = (c >> 5) & 3, i = c & 31; return 416 + which * 512 + (4 * jj + wc) * 64 + 32 * bj + i; }
        return 416 + 1024 + (n - 1536);
    } else if (WHICH == 1) {
        const int pn = n >> 8, c = n & 255, bj = c >> 7, wc = (c >> 5) & 3, i = c & 31, head = 2 * pn + bj;
        if (wc < 2) return head * 96 + 32 * wc + i;
        if (wc == 2) { const int fq = i >> 3, nn = (i >> 2) & 1, e = i & 3; return head * 96 + 64 + 4 * fq + e + 16 * nn; }
        return -1;
    } else if (WHICH == 2) {
        const int pn = n >> 8, c = n & 255, bj = c >> 7, wc = (c >> 5) & 3, i = c & 31, head = 2 * pn + bj;
        return wc < 2 ? head * 128 + 32 * wc + i : head * 128 + 64 + 32 * (wc - 2) + i;
    } else if (WHICH == 4) {
        const int j = n >> 8, c = n & 255; return c < 128 ? 128 * j + c : DFF + 128 * j + (c - 128);
    }
    return n;
}
template <int WHICH> __device__ __forceinline__ void cvt_item(const float* W, int K, int N, bf16_t* WT, int KP, int NP, LAS float* scr, int item, int lane) {
    const int nblk = NP / 32, kb = item / nblk, nb = item % nblk, k0 = 64 * kb, n0 = 32 * nb;
    const int src = wmap<WHICH>(n0 + (lane & 31)); const bool live = (src >= 0) && (k0 < K);
#pragma unroll 8
    for (int i = 0; i < 32; ++i) { const int kk = 2 * i + (lane >> 5); scr[kk * 33 + (lane & 31)] = live ? W[(size_t)(k0 + kk) * N + src] : 0.f; }
    asm volatile("s_waitcnt lgkmcnt(0)" ::: "memory");
    const int c = lane & 7;
#pragma unroll
    for (int j = 0; j < 4; ++j) { const int n = (lane >> 3) + 8 * j; const LAS float* s = scr + (8 * c) * 33 + n;
        u32x4 o; o.x = cvtpk(s[0 * 33], s[1 * 33]); o.y = cvtpk(s[2 * 33], s[3 * 33]); o.z = cvtpk(s[4 * 33], s[5 * 33]); o.w = cvtpk(s[6 * 33], s[7 * 33]);
        *(u32x4*)(WT + (size_t)(n0 + n) * KP + k0 + 8 * c) = o; }
    asm volatile("s_waitcnt lgkmcnt(0)" ::: "memory");
}
__device__ __forceinline__ void p0_prologue(Frame& F, const Args& args) {
    LAS float* scr = (LAS float*)(F.lds) + F.wave * 4096;
    const int gw = F.vcu * NWAVES + F.wave, NGW = F.G * NWAVES;
    constexpr int I0 = 16 * 64, I1 = 4 * 32, I2 = 4 * 32, I3 = 16 * 32, I4 = 16 * 176, I5 = 44 * 32;
    constexpr int NITEMS = I0 + I1 + I2 + I3 + I4 + I5;
    for (int it = gw; it < NITEMS; it += NGW) {
        int r = it;
        if (r < I0) { cvt_item<0>(ARGF(6), 1024, 1952, (bf16_t*)(F.ws + WS_WIN), 1024, 2048, scr, r, F.lane); continue; } r -= I0;
        if (r < I1) { cvt_item<1>(ARGF(9), 256, 768, (bf16_t*)(F.ws + WS_WQUP), 256, 1024, scr, r, F.lane); continue; } r -= I1;
        if (r < I2) { cvt_item<2>(ARGF(10), 128, 1024, (bf16_t*)(F.ws + WS_WKVUP), 256, 1024, scr, r, F.lane); continue; } r -= I2;
        if (r < I3) { cvt_item<3>(ARGF(16), 1024, 1024, (bf16_t*)(F.ws + WS_WOUT), 1024, 1024, scr, r, F.lane); continue; } r -= I3;
        if (r < I4) { cvt_item<4>(ARGF(18), 1024, DFF2, (bf16_t*)(F.ws + WS_WUP), 1024, DFF2, scr, r, F.lane); continue; } r -= I4;
        cvt_item<5>(ARGF(21), DFF, 1024, (bf16_t*)(F.ws + WS_WDOWN), DFF, 1024, scr, r, F.lane);
    }
    {
        float* cosT = (float*)(F.ws + WS_COS); float* sinT = (float*)(F.ws + WS_SIN);
        const int gt = F.vcu * (NWAVES * 64) + F.tid, NT = F.G * NWAVES * 64;
        for (int idx = gt; idx < MTOK * 16; idx += NT) {
            const int m = idx >> 4, i = idx & 15;
            const float inv = __builtin_amdgcn_exp2f(-(float)i * (13.287712379549449f / 16.0f));
            const float ang = (float)((const int*)args.in[2])[m] * inv;
            const float n = rintf(ang * 0.15915494309189535f);
            float r = fmaf(-n, 6.2831854820251465f, ang); r = fmaf(-n, -1.7484555e-7f, r);
            cosT[idx] = __cosf(r); sinT[idx] = __sinf(r);
        }
    }
}
__device__ __forceinline__ void p0_mod(Frame& F, const Args& args) {
    LAS float* scr = (LAS float*)(F.lds) + F.wave * 4096;
    if (F.vcu < 192) {
        const int n0 = F.vcu * 32, kbase = F.wave * 128, col = F.lane & 31, kh = F.lane >> 5;
        for (int idx = F.lane; idx < 2048; idx += 64) { const int b = idx >> 7, k = idx & 127; const float xv = ARGF(1)[b * 1024 + kbase + k]; scr[k * 16 + b] = xv / (1.0f + __expf(-xv)); }
        asm volatile("s_waitcnt lgkmcnt(0)" ::: "memory");
        f32x4 a0 = {0.f, 0.f, 0.f, 0.f}, a1 = a0, a2 = a0, a3 = a0;
#pragma unroll 8
        for (int i = 0; i < 64; ++i) { const int k = 2 * i + kh;
            const float w = ARGF(3)[(size_t)(kbase + k) * NMOD + n0 + col];
            const LAS f32x4* sp = (const LAS f32x4*)(scr + k * 16);
            a0 += sp[0] * w; a1 += sp[1] * w; a2 += sp[2] * w; a3 += sp[3] * w;
        }
#pragma unroll
        for (int e = 0; e < 4; ++e) { a0[e] += __shfl_xor(a0[e], 32); a1[e] += __shfl_xor(a1[e], 32); a2[e] += __shfl_xor(a2[e], 32); a3[e] += __shfl_xor(a3[e], 32); }
        if (kh == 0) {
#pragma unroll
            for (int e = 0; e < 4; ++e) { scr[2048 + (0 + e) * 32 + col] = a0[e]; scr[2048 + (4 + e) * 32 + col] = a1[e]; scr[2048 + (8 + e) * 32 + col] = a2[e]; scr[2048 + (12 + e) * 32 + col] = a3[e]; } }
        __syncthreads();
        float* MOD = (float*)(F.ws + WS_MOD);
        { const int b = 2 * F.wave + kh; float s = ARGF(4)[n0 + col];
#pragma unroll
            for (int w2 = 0; w2 < 8; ++w2) s += ((LAS float*)F.lds)[w2 * 4096 + 2048 + b * 32 + col];
            MOD[(size_t)b * NMOD + n0 + col] = s; }
    }
}
__device__ __forceinline__ float wave_sum(float v) {
#pragma unroll
    for (int o = 1; o < 64; o <<= 1) v += __shfl_xor(v, o);
    return v;
}
__device__ __forceinline__ void norm_rows(Frame& F, const float* X, const float* g, int shift_off, int scale_off, bf16_t* out) {
    const float* MOD = (const float*)(F.ws + WS_MOD);
    const int gw = F.vcu * NWAVES + F.wave, NGW = F.G * NWAVES;
    for (int m = gw; m < MTOK; m += NGW) {
        const int b = m >> 11;
        const f32x4* xr = (const f32x4*)(X + (size_t)m * DM) + F.lane;
        f32x4 v[4]; float s = 0.f;
#pragma unroll
        for (int j = 0; j < 4; ++j) { v[j] = xr[64 * j]; s += dot4(v[j]); }
        const float r = rsqrtf(wave_sum(s) * (1.0f / DM) + EPS);
        const f32x4* gp = (const f32x4*)g + F.lane; const f32x4* shp = (const f32x4*)(MOD + (size_t)b * NMOD + shift_off) + F.lane; const f32x4* scp = (const f32x4*)(MOD + (size_t)b * NMOD + scale_off) + F.lane;
        u32x2* o8 = (u32x2*)(out + (size_t)m * DM) + F.lane;
#pragma unroll
        for (int j = 0; j < 4; ++j) { const f32x4 y = v[j] * r * gp[64 * j] * (scp[64 * j] + 1.0f) + shp[64 * j]; o8[64 * j] = pack4(y); }
    }
}
__device__ __forceinline__ void conv_fixup(Frame& F, const Args& args) {
    const float* RAW4 = (const float*)(F.ws + WS_RAW4); bf16_t* ACT = (bf16_t*)(F.ws + WS_ACT);
    const int gt = F.vcu * (NWAVES * 64) + F.tid, NT = F.G * NWAVES * 64;
    for (int idx = gt; idx < 512 * DFF; idx += NT) {
        const int blk = idx / DFF, c = idx - blk * DFF, j = c >> 7, cc = c & 127;
        const bool first = (blk & 31) == 0;
        float o[2][2];
#pragma unroll
        for (int half = 0; half < 2; ++half) {
            const int tcol = 256 * j + 128 * half + cc, ocol = half * DFF + c;
            const float w0 = ARGF(19)[ocol], w1 = ARGF(19)[DFF2 + ocol], w2 = ARGF(19)[2 * DFF2 + ocol], bb = ARGF(20)[ocol];
            const float pm2 = first ? 0.f : RAW4[((size_t)(blk - 1) * 4 + 2) * DFF2 + tcol], pm1 = first ? 0.f : RAW4[((size_t)(blk - 1) * 4 + 3) * DFF2 + tcol];
            const float r0 = RAW4[((size_t)blk * 4 + 0) * DFF2 + tcol], r1 = RAW4[((size_t)blk * 4 + 1) * DFF2 + tcol];
            o[half][0] = w0 * pm2 + w1 * pm1 + w2 * r0 + bb; o[half][1] = w0 * pm1 + w1 * r0 + w2 * r1 + bb;
        }
#pragma unroll
        for (int rr = 0; rr < 2; ++rr) { const float G = o[0][rr], a = G / (1.0f + __expf(-G)) * o[1][rr];
            ACT[((size_t)blk * 64 + rr) * DFF + c] = (bf16_t)(cvtpk(a, 0.f) & 0xffffu); }
    }
}

__global__ void __launch_bounds__(NWAVES * 64, 2) fwd_kernel(Args args) {
    extern __shared__ __attribute__((aligned(16))) unsigned char lds_raw[];
    Frame F;
    F.lds = (LAS unsigned char*)lds_raw; F.xl = (LAS float*)(F.lds + XL_OFF);
    F.tid = threadIdx.x; F.lane = F.tid & 63; F.wave = __builtin_amdgcn_readfirstlane(F.tid >> 6);
    F.G = gridDim.x; { const int bx = blockIdx.x; F.vcu = (F.G % 8 == 0) ? (bx % 8) * (F.G / 8) + bx / 8 : bx; }
    F.ws = args.ws;
    unsigned char* ws = args.ws;
    for (int u = F.tid; u < (LDS_BYTES - LDSCTL_OFF) / 4; u += NWAVES * 64) ((LAS unsigned*)(F.lds + LDSCTL_OFF))[u] = 0u;
    __syncthreads();
    XcdBarrier bar; bar.bar = (unsigned*)(ws + WS_CTL) + CW_BAR; bar.x = 0; bar.st = nullptr;
    if (N_LAUNCHES == 1) bar = xcd_barrier_post((unsigned*)(ws + WS_CTL) + CW_BAR, (volatile LAS unsigned*)(F.lds + MISC_OFF) + 8);
#define GRID_BAR() do { if (N_LAUNCHES == 1) xcd_barrier(bar); } while (0)
    const int lo = args.ph_lo, hi = args.ph_hi;
#ifndef PH_MASK
#define PH_MASK 0x3ff
#endif
#define IN(k) (((PH_MASK >> (k)) & 1) && lo <= (k) && (k) < hi)
#define BOTH(k) (IN(k) && IN((k) + 1))
    float* MOD = (float*)(ws + WS_MOD);
    bf16_t* XN = (bf16_t*)(ws + WS_XN);

#define REFRESH_TID() do { int t_ = threadIdx.x; asm volatile("" : "+v"(t_)); t_ &= 511; F.tid = t_; F.lane = t_ & 63; } while (0)
    if (IN(0)) { REFRESH_TID(); p0_mod(F, args); if (BOTH(0)) GRID_BAR(); }
    if (IN(1)) { REFRESH_TID(); p0_prologue(F, args); norm_rows(F, ARGF(0), ARGF(5), 0, DM, XN); if (BOTH(1)) GRID_BAR(); }
    if (IN(2)) {
        pg8::Gemm g{XN, (const bf16_t*)(ws + WS_WIN), MTOK, 2048, 1024, nullptr, 1 << 30}; pg8::StaticOrder S; S.init(MTOK, 2048, F.G, (int)blockIdx.x);
        EpiIn E{ws, ARGF(7), ARGF(8), ARGF(13), ARGF(14)};
        pg8::gemm_phase(F.lds, F.xl, g, S, E);
        if (BOTH(2)) GRID_BAR();
    }
    if (IN(3)) {
        pg8::Gemm g{(const bf16_t*)(ws + WS_QLN), (const bf16_t*)(ws + WS_WQUP), MTOK, 2048, 256, (const bf16_t*)(ws + WS_KVLN), 4}; pg8::StaticOrder S; S.init(MTOK, 2048, F.G, (int)blockIdx.x);
        EpiQKV E{EpiQ{ws, ARGF(11)}, EpiKV{ws, ARGF(12)}};
        pg8::gemm_phase(F.lds, F.xl, g, S, E);
        if (BOTH(3)) GRID_BAR();
    }
    if (IN(4)) {
        bf16_t* OM = (bf16_t*)(ws + WS_OM);
        int atid = threadIdx.x; asm volatile("" : "+v"(atid)); atid &= 511;
        for (int i = 0; ; ++i) {
            int kind, bh, qb;
            if (F.G == 256) { if (i >= 8) break; bh = F.vcu >> 1; const int par = F.vcu & 1;
                if (i < 4) { kind = 0; const int s = 2 * par + (i >> 1); qb = (i & 1) ? 7 - s : s; } else { kind = 1; qb = 2 * (i - 4) + par; } }
            else { const int j = F.vcu + i * F.G; if (j >= 2048) break; kind = j >> 10; bh = (j & 1023) >> 3; qb = j & 7; }
            if (kind == 0) att::attn_unit<96, false, 8>(atid, bh >> 3, bh & 7, qb, (const bf16_t*)(ws + WS_QM), (const bf16_t*)(ws + WS_KM), (const bf16_t*)(ws + WS_VM), OM, nullptr, F.lds);
            else att::attn_unit<64, true, 8>(atid, bh >> 3, bh & 7, qb, (const bf16_t*)(ws + WS_CQ), (const bf16_t*)(ws + WS_CK), (const bf16_t*)(ws + WS_CV), OM, ARGF(15), F.lds);
        }
        if (BOTH(4)) GRID_BAR();
    }
    if (IN(5)) {
        pg8::Gemm g{(const bf16_t*)(ws + WS_OM), (const bf16_t*)(ws + WS_WOUT), MTOK, 1024, 1024, nullptr, 1 << 30}; pg8::StaticOrder S; S.init(MTOK, 1024, F.G, (int)blockIdx.x);
        EpiRes E{ARGF(0), (float*)(ws + WS_X1), MOD + 2 * DM};
        pg8::gemm_phase(F.lds, F.xl, g, S, E);
        if (BOTH(5)) GRID_BAR();
    }
    if (IN(6)) { REFRESH_TID(); norm_rows(F, (const float*)(ws + WS_X1), ARGF(17), 3 * DM, 4 * DM, XN); if (BOTH(6)) GRID_BAR(); }
    if (IN(7)) {
        pg8::Gemm g{XN, (const bf16_t*)(ws + WS_WUP), MTOK, DFF2, 1024, nullptr, 1 << 30}; pg8::StaticOrder S; S.init(MTOK, DFF2, F.G, (int)blockIdx.x);
        EpiUp E{ws, ARGF(19), ARGF(20)};
        pg8::gemm_phase(F.lds, F.xl, g, S, E);
        if (BOTH(7)) GRID_BAR();
    }
    if (IN(8)) { REFRESH_TID(); conv_fixup(F, args); if (BOTH(8)) GRID_BAR(); }
    if (IN(9)) {
        pg8::Gemm g{(const bf16_t*)(ws + WS_ACT), (const bf16_t*)(ws + WS_WDOWN), MTOK, 1024, DFF, nullptr, 1 << 30}; pg8::StaticOrder S; S.init(MTOK, 1024, F.G, (int)blockIdx.x);
        EpiRes E{(const float*)(ws + WS_X1), args.out, MOD + 5 * DM};
        pg8::gemm_phase(F.lds, F.xl, g, S, E);
    }
#undef IN
#undef BOTH
}

extern "C" void kernel_launch(void* const* d_in, const int* in_sizes, int n_in, void* d_out, int out_size, void* d_ws, size_t ws_size, hipStream_t stream) {
    static int grid = 0;
    if (grid == 0) {
        if (n_in != 22 || in_sizes[0] != MTOK * DM || out_size != MTOK * DM || ws_size < WS_END) {
            fprintf(stderr, "kernel_launch: unexpected shapes (n_in %d, in0 %d, out %d, ws %zu); nothing launched\n", n_in, n_in > 0 ? in_sizes[0] : -1, out_size, ws_size); grid = -1; return; }
        int dev = 0, cus = 0, per_cu = 0;
        if (hipGetDevice(&dev) != hipSuccess || hipDeviceGetAttribute(&cus, hipDeviceAttributeMultiprocessorCount, dev) != hipSuccess) { grid = -1; return; }
        if (hipFuncSetAttribute((const void*)fwd_kernel, hipFuncAttributeMaxDynamicSharedMemorySize, LDS_BYTES) != hipSuccess) { fprintf(stderr, "kernel_launch: hipFuncSetAttribute failed\n"); grid = -1; return; }
        if (hipOccupancyMaxActiveBlocksPerMultiprocessor(&per_cu, (const void*)fwd_kernel, NWAVES * 64, LDS_BYTES) != hipSuccess || per_cu < 1)
            fprintf(stderr, "kernel_launch: note: occupancy query reports %d workgroups per CU\n", per_cu);
        (void)hipGetLastError();
        grid = cus;
    }
    if (grid < 0) return;
    Args a{};
    for (int i = 0; i < 22; ++i) a.in[i] = d_in[i];
    a.out = (float*)d_out; a.ws = (unsigned char*)d_ws;
#ifndef PROBE_DUP
#define PROBE_DUP -1
#endif
    const int nl = (PROBE_DUP >= 0) ? 2 : N_LAUNCHES;
    for (int li = 0; li < nl; ++li) {
        if (hipMemsetAsync((char*)d_ws + WS_CTL, 0, CTL_ZERO_BYTES, stream) != hipSuccess) { fprintf(stderr, "kernel_launch: memset failed\n"); return; }
        a.ph_lo = (N_LAUNCHES == 1) ? 0 : li; a.ph_hi = (N_LAUNCHES == 1) ? NPHASE : li + 1; a.li = li;
        if (PROBE_DUP >= 0) { a.ph_lo = li == 0 ? 0 : PROBE_DUP; a.ph_hi = li == 0 ? PROBE_DUP + 1 : NPHASE; }
        hipLaunchKernelGGL(fwd_kernel, dim3(grid), dim3(NWAVES * 64), LDS_BYTES, stream, a);
        const hipError_t le = hipPeekAtLastError();
        if (le != hipSuccess) { fprintf(stderr, "kernel_launch: launch %d failed: %s\n", li, hipGetErrorName(le)); break; }
    }
}
```

```cpp
#include <hip/hip_runtime.h>
#include <cstdio>
#include <cstdint>

#define LAS __attribute__((address_space(3)))
#define GAS __attribute__((address_space(1)))
typedef unsigned short bf16_t;
typedef short bf16x8 __attribute__((ext_vector_type(8)));
typedef short s16x4 __attribute__((ext_vector_type(4)));
typedef float f32x2 __attribute__((ext_vector_type(2)));
typedef float f32x4 __attribute__((ext_vector_type(4)));
typedef float f32x16 __attribute__((ext_vector_type(16)));
typedef unsigned u32x2 __attribute__((ext_vector_type(2)));
typedef unsigned u32x4 __attribute__((ext_vector_type(4)));
typedef __bf16 bf16x2_t __attribute__((ext_vector_type(2)));

#ifndef MK_N_LAUNCHES
#define MK_N_LAUNCHES 1
#endif

constexpr int BATCH = 16, SEQ = 2048, DM = 1024, MTOK = BATCH * SEQ;
constexpr int NMOD = 6 * DM;
constexpr int DFF = 2816, DFF2 = 5632;
constexpr float EPS = 1e-6f;
constexpr float LOG2E = 1.4426950408889634f;
constexpr float C2_MLA = 0.10206207261596577f * LOG2E;
constexpr float C2_CA = 0.125f * LOG2E;

__device__ __forceinline__ unsigned cvtpk(float lo, float hi) { f32x2 v = {lo, hi}; bf16x2_t b = __builtin_convertvector(v, bf16x2_t); return __builtin_bit_cast(unsigned, b); }
__device__ __forceinline__ u32x4 pack8(f32x4 a, f32x4 b) { u32x4 w; w.x = cvtpk(a[0], a[1]); w.y = cvtpk(a[2], a[3]); w.z = cvtpk(b[0], b[1]); w.w = cvtpk(b[2], b[3]); return w; }
__device__ __forceinline__ u32x2 pack4(f32x4 a) { u32x2 w; w.x = cvtpk(a[0], a[1]); w.y = cvtpk(a[2], a[3]); return w; }
__device__ __forceinline__ float dot4(f32x4 a) { return (a[0] * a[0] + a[1] * a[1]) + (a[2] * a[2] + a[3] * a[3]); }
#define LDS_BARRIER() do { asm volatile("s_waitcnt lgkmcnt(0)" ::: "memory"); __builtin_amdgcn_s_barrier(); asm volatile("" ::: "memory"); } while (0)

namespace pg8 {
constexpr int BM = 256, BK = 64, HALF = 128, HTB = HALF * BK * 2, STAGE_BYTES = 8 * HTB, NXCD = 8, WGM = 8;
__host__ __device__ __forceinline__ int lds_byte(int r, int c) { const int st = (r >> 4) * 2 + (c >> 5), rr = r & 15, cc = c & 31, ob = rr * 64 + cc * 2; return st * 1024 + (ob ^ (((ob >> 9) & 1) << 5)); }
__host__ __device__ __forceinline__ void stage_rc(int b, int& R, int& C) { const int st = b / 1024, sb = b % 1024, swz = sb ^ (((sb >> 9) & 1) << 5); R = (st >> 1) * 16 + swz / 64; C = (st & 1) * 32 + (swz % 64) / 2; }
__host__ __device__ __forceinline__ int perm32(int rho) { const int n = rho >> 4, i = rho & 15; return 8 * (i >> 2) + 4 * n + (i & 3); }

struct Unit { int pm, pn; };
struct Gemm { const bf16_t* A; const bf16_t* Bt; int M, N, K; const bf16_t* A2; int nsplit; };

struct StaticOrder {
    int nM, nN, nwg, G, c;
    __host__ __device__ void init(int M, int N, int G_, int c_) { nM = M / BM; nN = N / BM; nwg = nM * nN; G = G_; c = c_; }
    __host__ __device__ bool next(int i, Unit& u) const {
        const long L = (long)i * G + c; if (L >= nwg) return false;
        int wgid = (int)L; { const int q = nwg / NXCD, r = nwg % NXCD, xcd = wgid % NXCD, off = wgid / NXCD; wgid = (xcd < r ? xcd * (q + 1) : r * (q + 1) + (xcd - r) * q) + off; }
        const int nig = WGM * nN, gid = wgid / nig, fm = gid * WGM, gsz = (nM - fm) < WGM ? (nM - fm) : WGM;
        u.pm = fm + ((wgid % nig) % gsz); u.pn = (wgid % nig) / gsz; return true;
    }
};

template <class Epi, class Sched>
__device__ __forceinline__ void gemm_phase(LAS unsigned char* lds, LAS float* xl, const Gemm g, const Sched& S, const Epi& E) {
    int tid = threadIdx.x; asm volatile("" : "+v"(tid)); tid &= 511;
    const int wid = __builtin_amdgcn_readfirstlane(tid >> 6), lane = tid & 63, wr = wid >> 2, wc = wid & 3, fr = lane & 15, fq = lane >> 4;
    const int K = g.K, nt = K / BK;
    unsigned voffA[2], voffB[2];
#pragma unroll
    for (int i = 0; i < 2; ++i) { int R, C; stage_rc(tid * 16 + i * 8192, R, C); const int Rb = (R & ~31) + perm32(R & 31);
        const int Ra = Epi::APERM ? ((R & 64) | ((R & 15) << 2) | ((R >> 4) & 3)) : R;
        voffA[i] = (unsigned)(Ra * K + C) * 2u; voffB[i] = (unsigned)(Rb * K + C) * 2u; }
    const size_t kstep = (size_t)(BK * 2);
    const size_t hstep = (size_t)HALF * K * 2;
    const size_t tstep = 2 * hstep;
    const unsigned ldsw = (unsigned)wid * 1024u;
    const int aoff = lds_byte(wr * 64 + fr, fq * 8), boff = lds_byte(wc * 32 + fr, fq * 8);
#define PG8_SA(b, h) (((b) * 2 + (h)) * HTB)
#define PG8_SB(b, h) ((4 + (b) * 2 + (h)) * HTB)
#define PG8_STAGE(bufoff, gbase, voff) do { _Pragma("unroll") for (int _i = 0; _i < 2; ++_i) \
        __builtin_amdgcn_global_load_lds((const unsigned*)((const char*)(gbase) + (voff)[_i]), (LAS unsigned*)(lds + (bufoff) + ldsw + _i * 8192), 16, 0, 0); } while (0)
#define PG8_LDA(dst, b, h) do { _Pragma("unroll") for (int m = 0; m < 4; ++m) _Pragma("unroll") for (int k = 0; k < 2; ++k) dst[m][k] = *(const LAS bf16x8*)(lds + PG8_SA(b, h) + aoff + m * 2048 + k * 1024); } while (0)
#define PG8_LDB(dst, b, h) do { _Pragma("unroll") for (int n = 0; n < 2; ++n) _Pragma("unroll") for (int k = 0; k < 2; ++k) dst[n][k] = *(const LAS bf16x8*)(lds + PG8_SB(b, h) + boff + n * 2048 + k * 1024); } while (0)
#define PG8_MMA(ai, bj, At, Bt) do { __builtin_amdgcn_s_setprio(1); _Pragma("unroll") for (int m = 0; m < 4; ++m) _Pragma("unroll") for (int n = 0; n < 2; ++n) _Pragma("unroll") for (int k = 0; k < 2; ++k) \
        acc[ai][bj][m][n] = __builtin_amdgcn_mfma_f32_16x16x32_bf16(Bt[n][k], At[m][k], acc[ai][bj][m][n], 0, 0, 0); __builtin_amdgcn_s_setprio(0); } while (0)
#define PG8_WAIT_V(n) asm volatile("s_waitcnt vmcnt(" #n ")" ::: "memory")
#define PG8_WAIT_L(n) asm volatile("s_waitcnt lgkmcnt(" #n ")" ::: "memory")
#define PG8_BAR __builtin_amdgcn_s_barrier()
#define PG8_SCHED __builtin_amdgcn_sched_barrier(0)
    Unit cur, nxt; int ui = 0;
    if (!S.next(0, cur)) return;
    f32x4 acc[2][2][4][2];
#pragma unroll
    for (int a = 0; a < 2; ++a)
#pragma unroll
        for (int b = 0; b < 2; ++b)
#pragma unroll
            for (int m = 0; m < 4; ++m)
#pragma unroll
                for (int n = 0; n < 2; ++n) acc[a][b][m][n] = (f32x4){0.f, 0.f, 0.f, 0.f};
    bf16x8 At[4][2], B0[2][2], B1[2][2];
    const char* cA = (const char*)(cur.pn < g.nsplit ? g.A : g.A2) + (size_t)cur.pm * tstep; const char* cB = (const char*)g.Bt + (size_t)cur.pn * tstep;
    PG8_STAGE(PG8_SB(0, 0), cB, voffB); PG8_STAGE(PG8_SB(0, 1), cB + hstep, voffB); PG8_STAGE(PG8_SA(0, 0), cA, voffA); PG8_STAGE(PG8_SA(0, 1), cA + hstep, voffA);
    if (wr == 1) PG8_BAR;
    PG8_WAIT_V(2); PG8_BAR;
    PG8_STAGE(PG8_SB(1, 0), cB + kstep, voffB); PG8_STAGE(PG8_SA(1, 0), cA + kstep, voffA); PG8_STAGE(PG8_SB(1, 1), cB + hstep + kstep, voffB);
    PG8_WAIT_V(6); PG8_BAR;
    for (;;) {
        const bool has_next = S.next(ui + 1, nxt);
        const char* nA = has_next ? (const char*)(nxt.pn < g.nsplit ? g.A : g.A2) + (size_t)nxt.pm * tstep : cA; const char* nB = has_next ? (const char*)g.Bt + (size_t)nxt.pn * tstep : cB;
        for (int t = 0; t < nt; t += 2) {
            const bool last = (t == nt - 2);
            const char* a1 = cA + (size_t)(t + 1) * kstep;
            const char* a2 = last ? nA : cA + (size_t)(t + 2) * kstep; const char* b2 = last ? nB : cB + (size_t)(t + 2) * kstep;
            const char* a3 = a2 + kstep; const char* b3 = b2 + kstep;
            PG8_LDB(B0, 0, 0); PG8_LDB(B1, 0, 1); PG8_SCHED; PG8_LDA(At, 0, 0); PG8_STAGE(PG8_SA(1, 1), a1 + hstep, voffA);
            PG8_WAIT_V(8); PG8_WAIT_L(0); PG8_BAR; PG8_MMA(0, 0, At, B0); PG8_MMA(0, 1, At, B1); PG8_BAR; PG8_SCHED;
            PG8_LDA(At, 0, 1); PG8_STAGE(PG8_SB(0, 0), b2, voffB); PG8_STAGE(PG8_SB(0, 1), b2 + hstep, voffB); PG8_STAGE(PG8_SA(0, 0), a2, voffA);
            PG8_WAIT_V(8); PG8_WAIT_L(0); PG8_BAR; PG8_MMA(1, 0, At, B0); PG8_MMA(1, 1, At, B1); PG8_BAR; PG8_SCHED;
            PG8_LDB(B0, 1, 0); PG8_LDB(B1, 1, 1); PG8_SCHED; PG8_LDA(At, 1, 0); PG8_STAGE(PG8_SA(0, 1), a2 + hstep, voffA);
            PG8_WAIT_V(8); PG8_WAIT_L(0); PG8_BAR; PG8_MMA(0, 0, At, B0); PG8_MMA(0, 1, At, B1); PG8_BAR; PG8_SCHED;
            PG8_LDA(At, 1, 1); PG8_STAGE(PG8_SB(1, 0), b3, voffB); PG8_STAGE(PG8_SB(1, 1), b3 + hstep, voffB); PG8_STAGE(PG8_SA(1, 0), a3, voffA);
            PG8_WAIT_V(8); PG8_WAIT_L(0); PG8_BAR; PG8_MMA(1, 0, At, B0); PG8_MMA(1, 1, At, B1); PG8_BAR; PG8_SCHED;
        }
        if (wr == 0) PG8_BAR;
        E(acc, cur, wr, wc, fr, fq, xl);
        if (!has_next) break;
#pragma unroll
        for (int a = 0; a < 2; ++a)
#pragma unroll
            for (int b = 0; b < 2; ++b)
#pragma unroll
                for (int m = 0; m < 4; ++m)
#pragma unroll
                    for (int n = 0; n < 2; ++n) acc[a][b][m][n] = (f32x4){0.f, 0.f, 0.f, 0.f};
        cur = nxt; cA = nA; cB = nB; ++ui;
        if (wr == 1) PG8_BAR;
    }
    PG8_WAIT_V(0);
    PG8_BAR;
#undef PG8_SA
#undef PG8_SB
#undef PG8_STAGE
#undef PG8_LDA
#undef PG8_LDB
#undef PG8_MMA
#undef PG8_WAIT_V
#undef PG8_WAIT_L
#undef PG8_BAR
#undef PG8_SCHED
}
}
using pg8::Unit;

constexpr size_t MiB = 1u << 20;
constexpr size_t WS_CTL = 0, CTL_ZERO_BYTES = 64 * 1024;
constexpr size_t WS_MOD = 1 * MiB;
constexpr size_t WS_COS = 2 * MiB, WS_SIN = 4 * MiB;
constexpr size_t WS_KR = 6 * MiB;
constexpr size_t WS_SSR = 10 * MiB;
constexpr size_t WS_WIN = 11 * MiB;
constexpr size_t WS_WQUP = 15 * MiB;
constexpr size_t WS_WKVUP = WS_WQUP + 512 * 1024;
constexpr size_t WS_WOUT = 16 * MiB;
constexpr size_t WS_WUP = 18 * MiB;
constexpr size_t WS_WDOWN = 29 * MiB;
constexpr size_t WS_XN = 36 * MiB;
constexpr size_t WS_QLN = 100 * MiB, WS_KVLN = 116 * MiB;
constexpr size_t WS_CQ = 132 * MiB, WS_CK = 164 * MiB, WS_CV = 196 * MiB;
constexpr size_t WS_QM = 228 * MiB, WS_KM = 276 * MiB;
constexpr size_t WS_VM = 324 * MiB;
constexpr size_t WS_OM = WS_XN;
constexpr size_t WS_ACT = 100 * MiB;
constexpr size_t WS_X1 = 276 * MiB;
constexpr size_t WS_RAW4 = 404 * MiB;
constexpr size_t WS_END = 448 * MiB;
static_assert(WS_ACT + (size_t)MTOK * DFF * 2 <= WS_X1 && WS_X1 + (size_t)MTOK * DM * 4 <= WS_RAW4 && WS_RAW4 + (size_t)512 * 4 * DFF2 * 4 <= WS_END, "overlay map");
constexpr int CW_BAR = 1024;


struct EpiIn {
    static constexpr bool APERM = false;
    unsigned char* ws; const float *g_ql, *g_kvl, *g_caq, *g_cak;
    __device__ __forceinline__ void operator()(const f32x4 (&acc)[2][2][4][2], const Unit& u, int wr, int wc, int fr, int fq, LAS float* red) const {
        asm volatile("" : "+v"(fr), "+v"(fq), "+s"(wr), "+s"(wc));
        const int rl0 = wr * 64 + fr; const size_t row0 = (size_t)u.pm * 256 + rl0; const int pn = u.pn;
        bf16_t* const QLN = (bf16_t*)(ws + WS_QLN); bf16_t* const KVLN = (bf16_t*)(ws + WS_KVLN); bf16_t* const CQ = (bf16_t*)(ws + WS_CQ); bf16_t* const CK = (bf16_t*)(ws + WS_CK); bf16_t* const CV = (bf16_t*)(ws + WS_CV);
        float* const KR = (float*)(ws + WS_KR); float* const SSR = (float*)(ws + WS_SSR);
        if (pn >= 6) {
            bf16_t* base = CV + (pn - 6) * 256 + wc * 32 + 8 * fq;
#pragma unroll
            for (int ai = 0; ai < 2; ++ai)
#pragma unroll
                for (int m = 0; m < 4; ++m) { bf16_t* rp = base + (row0 + ai * 128 + m * 16) * 512;
#pragma unroll
                    for (int bj = 0; bj < 2; ++bj) *(u32x4*)(rp + bj * 128) = pack8(acc[ai][bj][m][0], acc[ai][bj][m][1]); }
        } else if (pn >= 2) {
            const bool isq = pn < 4; const int head = 4 * ((pn - 2) & 1) + wc; const float* g = isq ? g_caq : g_cak; const float sc = isq ? C2_CA : 1.0f;
            f32x4 gv[2][2];
#pragma unroll
            for (int bj = 0; bj < 2; ++bj)
#pragma unroll
                for (int n = 0; n < 2; ++n) gv[bj][n] = *(const f32x4*)(g + 32 * bj + 8 * fq + 4 * n) * sc;
            bf16_t* base = (isq ? CQ : CK) + head * 64 + 8 * fq;
#pragma unroll
            for (int ai = 0; ai < 2; ++ai)
#pragma unroll
                for (int m = 0; m < 4; ++m) {
                    float ss = (dot4(acc[ai][0][m][0]) + dot4(acc[ai][0][m][1])) + (dot4(acc[ai][1][m][0]) + dot4(acc[ai][1][m][1]));
                    ss += __shfl_xor(ss, 16); ss += __shfl_xor(ss, 32);
                    const float r = rsqrtf(ss * (1.0f / 64.0f) + EPS);
                    bf16_t* rp = base + (row0 + ai * 128 + m * 16) * 512;
#pragma unroll
                    for (int bj = 0; bj < 2; ++bj) *(u32x4*)(rp + bj * 32) = pack8(acc[ai][bj][m][0] * r * gv[bj][0], acc[ai][bj][m][1] * r * gv[bj][1]);
                }
        } else if (pn == 0) {
#pragma unroll
            for (int ai = 0; ai < 2; ++ai)
#pragma unroll
                for (int m = 0; m < 4; ++m) {
                    float ss = (dot4(acc[ai][0][m][0]) + dot4(acc[ai][0][m][1])) + (dot4(acc[ai][1][m][0]) + dot4(acc[ai][1][m][1]));
                    ss += __shfl_xor(ss, 16); ss += __shfl_xor(ss, 32);
                    if (fq == 0) red[(ai * 128 + m * 16 + rl0) * 8 + wc] = ss;
                }
            LDS_BARRIER();
            f32x4 gv[2][2];
#pragma unroll
            for (int bj = 0; bj < 2; ++bj)
#pragma unroll
                for (int n = 0; n < 2; ++n) gv[bj][n] = *(const f32x4*)(g_ql + 128 * bj + 32 * wc + 8 * fq + 4 * n);
            bf16_t* base = QLN + wc * 32 + 8 * fq;
#pragma unroll
            for (int ai = 0; ai < 2; ++ai)
#pragma unroll
                for (int m = 0; m < 4; ++m) {
                    const f32x4 t = *(const LAS f32x4*)(red + (ai * 128 + m * 16 + rl0) * 8);
                    const float r = rsqrtf(((t[0] + t[1]) + (t[2] + t[3])) * (1.0f / 256.0f) + EPS);
                    bf16_t* rp = base + (row0 + ai * 128 + m * 16) * 256;
#pragma unroll
                    for (int bj = 0; bj < 2; ++bj) *(u32x4*)(rp + bj * 128) = pack8(acc[ai][bj][m][0] * r * gv[bj][0], acc[ai][bj][m][1] * r * gv[bj][1]);
                }
        } else {
#pragma unroll
            for (int ai = 0; ai < 2; ++ai)
#pragma unroll
                for (int m = 0; m < 4; ++m) {
                    float ss = dot4(acc[ai][0][m][0]) + dot4(acc[ai][0][m][1]);
                    ss += __shfl_xor(ss, 16); ss += __shfl_xor(ss, 32);
                    if (fq == 0) red[(ai * 128 + m * 16 + rl0) * 8 + wc] = ss;
                }
            LDS_BARRIER();
            f32x4 gv[2];
#pragma unroll
            for (int n = 0; n < 2; ++n) gv[n] = *(const f32x4*)(g_kvl + 32 * wc + 8 * fq + 4 * n);
            bf16_t* base = KVLN + wc * 32 + 8 * fq;
#pragma unroll
            for (int ai = 0; ai < 2; ++ai)
#pragma unroll
                for (int m = 0; m < 4; ++m) {
                    const f32x4 t = *(const LAS f32x4*)(red + (ai * 128 + m * 16 + rl0) * 8);
                    const float r = rsqrtf(((t[0] + t[1]) + (t[2] + t[3])) * (1.0f / 128.0f) + EPS);
                    const size_t row = row0 + ai * 128 + m * 16;
                    bf16_t* rp = base + row * 256;
                    *(u32x4*)(rp) = pack8(acc[ai][0][m][0] * r * gv[0], acc[ai][0][m][1] * r * gv[1]);
                    *(u32x4*)(rp + 128) = (u32x4){0u, 0u, 0u, 0u};
                    if (wc == 0) {
                        *(f32x4*)(KR + row * 32 + 8 * fq) = acc[ai][1][m][0]; *(f32x4*)(KR + row * 32 + 8 * fq + 4) = acc[ai][1][m][1];
                        float sr = dot4(acc[ai][1][m][0]) + dot4(acc[ai][1][m][1]);
                        sr += __shfl_xor(sr, 16); sr += __shfl_xor(sr, 32);
                        if (fq == 0) SSR[row] = sr;
                    }
                }
        }
    }
};

struct EpiQ {
    static constexpr bool APERM = false;
    unsigned char* ws; const float* g;
    __device__ __forceinline__ void operator()(const f32x4 (&acc)[2][2][4][2], const Unit& u, int wr, int wc, int fr, int fq, LAS float* red) const {
        asm volatile("" : "+v"(fr), "+v"(fq), "+s"(wr), "+s"(wc));
        const int rl0 = wr * 64 + fr; const size_t row0 = (size_t)u.pm * 256 + rl0;
        bf16_t* const QM = (bf16_t*)(ws + WS_QM); const float* const cosT = (const float*)(ws + WS_COS); const float* const sinT = (const float*)(ws + WS_SIN);
#pragma unroll
        for (int ai = 0; ai < 2; ++ai)
#pragma unroll
            for (int m = 0; m < 4; ++m)
#pragma unroll
                for (int bj = 0; bj < 2; ++bj) {
                    float ss = dot4(acc[ai][bj][m][0]) + dot4(acc[ai][bj][m][1]);
                    ss += __shfl_xor(ss, 16); ss += __shfl_xor(ss, 32);
                    if (fq == 0) red[(ai * 128 + m * 16 + rl0) * 8 + bj * 4 + wc] = ss;
                }
        LDS_BARRIER();
        if (wc < 2) {
            const f32x4 g0 = *(const f32x4*)(g + 32 * wc + 8 * fq) * C2_MLA, g1 = *(const f32x4*)(g + 32 * wc + 8 * fq + 4) * C2_MLA;
#pragma unroll
            for (int ai = 0; ai < 2; ++ai)
#pragma unroll
                for (int m = 0; m < 4; ++m) {
                    const size_t row = row0 + ai * 128 + m * 16;
#pragma unroll
                    for (int bj = 0; bj < 2; ++bj) {
                        const f32x4 t = *(const LAS f32x4*)(red + (ai * 128 + m * 16 + rl0) * 8 + bj * 4);
                        const float r = rsqrtf(((t[0] + t[1]) + (t[2] + t[3])) * (1.0f / 96.0f) + EPS);
                        *(u32x4*)(QM + row * 768 + (2 * u.pn + bj) * 96 + 32 * wc + 8 * fq) = pack8(acc[ai][bj][m][0] * r * g0, acc[ai][bj][m][1] * r * g1);
                    }
                }
        } else if (wc == 2) {
            const f32x4 g0 = *(const f32x4*)(g + 64 + 4 * fq) * C2_MLA, g1 = *(const f32x4*)(g + 80 + 4 * fq) * C2_MLA;
#pragma unroll
            for (int ai = 0; ai < 2; ++ai)
#pragma unroll
                for (int m = 0; m < 4; ++m) {
                    const size_t row = row0 + ai * 128 + m * 16;
                    const f32x4 cs = *(const f32x4*)(cosT + row * 16 + 4 * fq), sn = *(const f32x4*)(sinT + row * 16 + 4 * fq);
#pragma unroll
                    for (int bj = 0; bj < 2; ++bj) {
                        const f32x4 t = *(const LAS f32x4*)(red + (ai * 128 + m * 16 + rl0) * 8 + bj * 4);
                        const float r = rsqrtf(((t[0] + t[1]) + (t[2] + t[3])) * (1.0f / 96.0f) + EPS);
                        bf16_t* hp = QM + row * 768 + (2 * u.pn + bj) * 96;
                        const f32x4 x1 = acc[ai][bj][m][0] * r * g0, x2 = acc[ai][bj][m][1] * r * g1;
                        *(u32x2*)(hp + 64 + 4 * fq) = pack4(x1 * cs - x2 * sn); *(u32x2*)(hp + 80 + 4 * fq) = pack4(x2 * cs + x1 * sn);
                    }
                    asm volatile("" ::: "memory");
                }
        }
    }
};

struct EpiKV {
    static constexpr bool APERM = false;
    unsigned char* ws; const float* g;
    __device__ __forceinline__ void operator()(const f32x4 (&acc)[2][2][4][2], const Unit& u, int wr, int wc, int fr, int fq, LAS float* red) const {
        asm volatile("" : "+v"(fr), "+v"(fq), "+s"(wr), "+s"(wc));
        const int rl0 = wr * 64 + fr; const size_t row0 = (size_t)u.pm * 256 + rl0;
        bf16_t* const KM = (bf16_t*)(ws + WS_KM); bf16_t* const VM = (bf16_t*)(ws + WS_VM); const float* const cosT = (const float*)(ws + WS_COS); const float* const sinT = (const float*)(ws + WS_SIN);
        const float* const KR = (const float*)(ws + WS_KR); const float* const SSR = (const float*)(ws + WS_SSR);
        if (wc < 2) {
#pragma unroll
            for (int ai = 0; ai < 2; ++ai)
#pragma unroll
                for (int m = 0; m < 4; ++m)
#pragma unroll
                    for (int bj = 0; bj < 2; ++bj) {
                        float ss = dot4(acc[ai][bj][m][0]) + dot4(acc[ai][bj][m][1]);
                        ss += __shfl_xor(ss, 16); ss += __shfl_xor(ss, 32);
                        if (fq == 0) red[(ai * 128 + m * 16 + rl0) * 8 + bj * 2 + wc] = ss;
                    }
        }
        LDS_BARRIER();
        if (wc < 2) {
            const f32x4 g0 = *(const f32x4*)(g + 32 * wc + 8 * fq), g1 = *(const f32x4*)(g + 32 * wc + 8 * fq + 4);
#pragma unroll
            for (int ai = 0; ai < 2; ++ai)
#pragma unroll
                for (int m = 0; m < 4; ++m) {
                    const size_t row = row0 + ai * 128 + m * 16;
                    const float ssr = SSR[row];
                    const f32x4 t = *(const LAS f32x4*)(red + (ai * 128 + m * 16 + rl0) * 8);
#pragma unroll
                    for (int bj = 0; bj < 2; ++bj) {
                        const float rk = rsqrtf((t[2 * bj] + t[2 * bj + 1] + ssr) * (1.0f / 96.0f) + EPS);
                        *(u32x4*)(KM + row * 768 + (2 * u.pn + bj) * 96 + 32 * wc + 8 * fq) = pack8(acc[ai][bj][m][0] * rk * g0, acc[ai][bj][m][1] * rk * g1);
                    }
                    asm volatile("" ::: "memory");
                }
        } else {
            const int bj0 = wc - 2, h0 = 2 * u.pn + bj0;
            const f32x4 g0 = *(const f32x4*)(g + 64 + 4 * fq), g1 = *(const f32x4*)(g + 80 + 4 * fq);
#pragma unroll
            for (int ai = 0; ai < 2; ++ai)
#pragma unroll
                for (int m = 0; m < 4; ++m) {
                    const size_t row = row0 + ai * 128 + m * 16;
#pragma unroll
                    for (int bj = 0; bj < 2; ++bj) *(u32x4*)(VM + row * 512 + (2 * u.pn + bj) * 64 + 32 * (wc - 2) + 8 * fq) = pack8(acc[ai][bj][m][0], acc[ai][bj][m][1]);
                    const f32x2 t = *(const LAS f32x2*)(red + (ai * 128 + m * 16 + rl0) * 8 + 2 * bj0);
                    const float rk = rsqrtf((t[0] + t[1] + SSR[row]) * (1.0f / 96.0f) + EPS);
                    const f32x4 cs = *(const f32x4*)(cosT + row * 16 + 4 * fq), sn = *(const f32x4*)(sinT + row * 16 + 4 * fq);
                    const f32x4 x1 = *(const f32x4*)(KR + row * 32 + 4 * fq) * rk * g0, x2 = *(const f32x4*)(KR + row * 32 + 16 + 4 * fq) * rk * g1;
                    bf16_t* hp = KM + row * 768 + h0 * 96;
                    *(u32x2*)(hp + 64 + 4 * fq) = pack4(x1 * cs - x2 * sn); *(u32x2*)(hp + 80 + 4 * fq) = pack4(x2 * cs + x1 * sn);
                    asm volatile("" ::: "memory");
                }
        }
    }
};

struct EpiQKV {
    static constexpr bool APERM = false;
    EpiQ q; EpiKV kv;
    __device__ __forceinline__ void operator()(const f32x4 (&acc)[2][2][4][2], const Unit& u, int wr, int wc, int fr, int fq, LAS float* red) const {
        if (u.pn < 4) q(acc, u, wr, wc, fr, fq, red);
        else { Unit v; v.pm = u.pm; v.pn = u.pn - 4; kv(acc, v, wr, wc, fr, fq, red); }
    }
};

template <bool NT> struct EpiRes {
    static constexpr bool APERM = false;
    const float* base; float* out; const float* gate;
    __device__ __forceinline__ void operator()(const f32x4 (&acc)[2][2][4][2], const Unit& u, int wr, int wc, int fr, int fq, LAS float* red) const {
        asm volatile("" : "+v"(fr), "+v"(fq), "+s"(wr), "+s"(wc));
        const int b = u.pm >> 3; const int col0 = u.pn * 256 + wc * 32 + 8 * fq;
        f32x4 gv[2][2];
#pragma unroll
        for (int bj = 0; bj < 2; ++bj)
#pragma unroll
            for (int n = 0; n < 2; ++n) gv[bj][n] = *(const f32x4*)(gate + (size_t)b * NMOD + col0 + 128 * bj + 4 * n);
#pragma unroll
        for (int ai = 0; ai < 2; ++ai)
#pragma unroll
            for (int m = 0; m < 4; ++m) {
                const size_t off = ((size_t)u.pm * 256 + ai * 128 + wr * 64 + m * 16 + fr) * DM + col0;
#pragma unroll
                for (int bj = 0; bj < 2; ++bj)
#pragma unroll
                    for (int n = 0; n < 2; ++n) { const f32x4* sp = (const f32x4*)(base + off + 128 * bj + 4 * n); f32x4* dp = (f32x4*)(out + off + 128 * bj + 4 * n);
                        if (NT) { const f32x4 xs = __builtin_nontemporal_load(sp); __builtin_nontemporal_store(xs + gv[bj][n] * acc[ai][bj][m][n], dp); }
                        else { const f32x4 xs = *sp; *dp = xs + gv[bj][n] * acc[ai][bj][m][n]; } }
                if (m & 1) asm volatile("" ::: "memory");
            }
    }
};

__device__ __forceinline__ float dpp_shr1(float v) { return __builtin_bit_cast(float, __builtin_amdgcn_update_dpp(0, __builtin_bit_cast(int, v), 0x111, 0xF, 0xF, false)); }
__device__ __forceinline__ f32x4 dpp_shr1(f32x4 v) { f32x4 r; r[0] = dpp_shr1(v[0]); r[1] = dpp_shr1(v[1]); r[2] = dpp_shr1(v[2]); r[3] = dpp_shr1(v[3]); return r; }
struct EpiUp {
    static constexpr bool APERM = true;
    unsigned char* ws; const float *cw, *cb;
    __device__ __forceinline__ void operator()(const f32x4 (&acc)[2][2][4][2], const Unit& u, int wr, int wc, int fr, int fq, LAS float* red) const {
        asm volatile("" : "+v"(fr), "+v"(fq), "+s"(wr), "+s"(wc));
        const int j = u.pn; const int cc0 = 32 * wc + 8 * fq;
        bf16_t* const ACT = (bf16_t*)(ws + WS_ACT); float* const RAW4 = (float*)(ws + WS_RAW4);
#pragma unroll
        for (int n = 0; n < 2; ++n) {
            const int gcol = 128 * j + cc0 + 4 * n, vcol = DFF + gcol;
            const f32x4 wg0 = *(const f32x4*)(cw + gcol), wg1 = *(const f32x4*)(cw + DFF2 + gcol), wg2 = *(const f32x4*)(cw + 2 * DFF2 + gcol), bg = *(const f32x4*)(cb + gcol);
            const f32x4 wv0 = *(const f32x4*)(cw + vcol), wv1 = *(const f32x4*)(cw + DFF2 + vcol), wv2 = *(const f32x4*)(cw + 2 * DFF2 + vcol), bv = *(const f32x4*)(cb + vcol);
#pragma unroll
            for (int ai = 0; ai < 2; ++ai) {
                const size_t blk = (size_t)u.pm * 4 + 2 * ai + wr;
                const f32x4 g2s = dpp_shr1(acc[ai][0][2][n]), g3s = dpp_shr1(acc[ai][0][3][n]), v2s = dpp_shr1(acc[ai][1][2][n]), v3s = dpp_shr1(acc[ai][1][3][n]);
#pragma unroll
                for (int m = 0; m < 4; ++m) {
                    const f32x4 gr = acc[ai][0][m][n], vr = acc[ai][1][m][n];
                    const f32x4 gp1 = m == 0 ? g3s : acc[ai][0][m - 1 < 0 ? 0 : m - 1][n], gp2 = m == 0 ? g2s : (m == 1 ? g3s : acc[ai][0][m - 2 < 0 ? 0 : m - 2][n]);
                    const f32x4 vp1 = m == 0 ? v3s : acc[ai][1][m - 1 < 0 ? 0 : m - 1][n], vp2 = m == 0 ? v2s : (m == 1 ? v3s : acc[ai][1][m - 2 < 0 ? 0 : m - 2][n]);
                    const f32x4 G = wg0 * gp2 + wg1 * gp1 + wg2 * gr + bg, V = wv0 * vp2 + wv1 * vp1 + wv2 * vr + bv;
                    f32x4 a;
#pragma unroll
                    for (int e = 0; e < 4; ++e) a[e] = G[e] * __builtin_amdgcn_rcpf(1.0f + __builtin_amdgcn_exp2f(-LOG2E * G[e])) * V[e];
                    const size_t row = blk * 64 + 4 * fr + m;
                    if (m >= 2 || fr > 0) *(u32x2*)(ACT + row * DFF + 128 * j + cc0 + 4 * n) = pack4(a);
                    if (m < 2 && fr == 0) { float* rp = RAW4 + (blk * 4 + m) * DFF2 + 256 * j + cc0 + 4 * n; *(f32x4*)rp = gr; *(f32x4*)(rp + 128) = vr; }
                    if (m >= 2 && fr == 15) { float* rp = RAW4 + (blk * 4 + m) * DFF2 + 256 * j + cc0 + 4 * n; *(f32x4*)rp = gr; *(f32x4*)(rp + 128) = vr; }
                }
            }
        }
    }
};

namespace att {
__device__ __forceinline__ int crow(int r, int hi) { return (r & 3) + 8 * (r >> 2) + 4 * hi; }
__device__ __forceinline__ void glds16(const void* gsrc, unsigned lds_dst) { unsigned keep;
    asm volatile("s_mov_b32 %0, m0\n\ts_mov_b32 m0, %2\n\ts_nop 0\n\tglobal_load_lds_dwordx4 %1, off\n\ts_mov_b32 m0, %0" : "=&s"(keep) : "v"(gsrc), "s"(lds_dst) : "memory"); }
__device__ __forceinline__ float max3f(float a, float b, float c) { float r; asm("v_max3_f32 %0, %1, %2, %3" : "=v"(r) : "v"(a), "v"(b), "v"(c)); return r; }
__device__ __forceinline__ float rowmax(const f32x16& p0, const f32x16& p1) {
    float a = max3f(p0[0], p0[1], p1[0]), b = max3f(p0[2], p0[3], p1[1]); a = max3f(a, p1[2], p1[3]);
#pragma unroll
    for (int r = 4; r < 16; r += 4) { a = max3f(a, p0[r], p0[r + 1]); b = max3f(b, p0[r + 2], p0[r + 3]); a = max3f(a, p1[r], p1[r + 1]); b = max3f(b, p1[r + 2], p1[r + 3]); }
    const float m = fmaxf(a, b);
    auto rr = __builtin_amdgcn_permlane32_swap(__float_as_uint(m), __float_as_uint(m), false, false);
    return fmaxf(__uint_as_float(rr[0]), __uint_as_float(rr[1]));
}
typedef short v4i16_t __attribute__((ext_vector_type(4)));
__device__ __forceinline__ s16x4 vtr(const LAS unsigned char* p) { return __builtin_bit_cast(s16x4, __builtin_amdgcn_ds_read_tr16_b64_v4i16((LAS v4i16_t*)p)); }
__device__ __forceinline__ void pv(f32x16* o, const LAS unsigned char* vp, bf16x8 pa0, bf16x8 pa1, bf16x8 pa2, bf16x8 pa3) {
#pragma unroll
    for (int d0 = 0; d0 < 2; ++d0) { s16x4 lo[4], hi[4];
        __builtin_amdgcn_sched_barrier(0);
#pragma unroll
        for (int ks = 0; ks < 4; ++ks) { lo[ks] = vtr(vp + d0 * 4096 + ks * 1024); hi[ks] = vtr(vp + d0 * 4096 + ks * 1024 + 512); }
#define PK(k) (bf16x8){lo[k][0], lo[k][1], lo[k][2], lo[k][3], hi[k][0], hi[k][1], hi[k][2], hi[k][3]}
        o[d0] = __builtin_amdgcn_mfma_f32_32x32x16_bf16(pa0, PK(0), o[d0], 0, 0, 0);
        o[d0] = __builtin_amdgcn_mfma_f32_32x32x16_bf16(pa1, PK(1), o[d0], 0, 0, 0);
        o[d0] = __builtin_amdgcn_mfma_f32_32x32x16_bf16(pa2, PK(2), o[d0], 0, 0, 0);
        o[d0] = __builtin_amdgcn_mfma_f32_32x32x16_bf16(pa3, PK(3), o[d0], 0, 0, 0);
#undef PK
    }
}
constexpr int NSLOT = 4;
constexpr int ATT_LDS_BYTES = 3 * 12288 + 3 * 8192 + 8 * 256 + 8 * 4096 + 2048;

template <int DQK, bool CA, int THR>
__device__ __forceinline__ void attn_unit(int tid, int b, int h, int u, const bf16_t* Q, const bf16_t* K, const bf16_t* V, bf16_t* O, const float* relb, LAS unsigned char* shm) {
    constexpr int ND = DQK / 16, NG = 2 * ND, NCH = DQK / 8, KSLOT = NCH * 1024, VSLOT = 8192, NS = 3;
    constexpr int NPK = (DQK == 96) ? 2 : 1, NP = NPK + 1;
    constexpr int LDS_K = 0, LDS_V = NS * KSLOT, LDS_WS = LDS_V + NS * VSLOT, LDS_OST = LDS_WS + 8 * 256, LDS_TAB = LDS_OST + 8 * 4096;
    constexpr int LDQ = CA ? 512 : 768, LDV = 512, LDO = 1024, OCOL = CA ? 512 : 0;
    const int lane = tid & 63, r32 = lane & 31, hi = lane >> 5; const int wid = __builtin_amdgcn_readfirstlane(tid >> 6);
    const long rowbase = (long)b * SEQ; const int q0 = u * 256;
    const bf16_t* Qw = Q + (rowbase + q0 + wid * 32) * LDQ + h * DQK;
    const unsigned lds0 = (unsigned)(uintptr_t)shm;
    LAS float* wsf = (LAS float*)(shm + LDS_WS) + wid * 64;
    LAS float* tab = (LAS float*)(shm + LDS_TAB);
    const int t0 = CA ? (4 * u - 8 > 0 ? 4 * u - 8 : 0) : 0, t1 = 4 * u + 3, cw = 4 * u + (wid >> 1);
    const int NT = t1 - t0 + 1;
    const bf16_t* Kh = K + (rowbase + (long)t0 * 64) * LDQ + h * DQK; const bf16_t* Vh = V + (rowbase + (long)t0 * 64) * LDV + h * 64;
    const bf16_t* ksrc = Kh + (long)lane * LDQ + wid * 8;
    const bf16_t* ksrc2 = Kh + (long)lane * LDQ + (8 + (wid & 3)) * 8;
    const bf16_t* vsrc = Vh + (long)(16 * (wid & 3) + (lane >> 2)) * LDV + (wid >> 2) * 32 + (lane & 3) * 8;
#define SBAR() __builtin_amdgcn_sched_barrier(0)
#define PIN(x) asm volatile("" : "+v"(x))
#define DMA_K(tau, sl) do { glds16(ksrc + (long)(tau) * 64 * LDQ, (unsigned)__builtin_amdgcn_readfirstlane(lds0 + LDS_K + (sl) * KSLOT + wid * 1024)); \
        if (DQK == 96) glds16(ksrc2 + (long)(tau) * 64 * LDQ, (unsigned)__builtin_amdgcn_readfirstlane(lds0 + LDS_K + (sl) * KSLOT + (8 + (wid & 3)) * 1024)); } while (0)
#define DMA_V(tau, sl) glds16(vsrc + (long)(tau) * 64 * LDV, (unsigned)__builtin_amdgcn_readfirstlane(lds0 + LDS_V + (sl) * VSLOT + wid * 1024))
#define WAIT_BAR(N) asm volatile("s_waitcnt vmcnt(%0) lgkmcnt(0)\n\ts_barrier" :: "n"(N) : "memory")
#define TVALID(tau) (CA ? ((tau) + t0 <= cw && (tau) + t0 >= cw - 8) : ((tau) + t0 <= cw))
    if (CA) { for (int i = tid; i < 320; i += 512) tab[i] = relb[h * 257 + (i < 256 ? i : 256)] * LOG2E; }
    DMA_K(0, 0); DMA_V(0, 0); DMA_K(1, 1); DMA_K(2, 2);
    bf16x8 qr[ND];
#pragma unroll
    for (int d0 = 0; d0 < ND; ++d0) qr[d0] = *(const bf16x8*)(Qw + (long)r32 * LDQ + d0 * 16 + hi * 8);
#pragma unroll
    for (int d0 = 0; d0 < ND; ++d0) asm volatile("" :: "v"(qr[d0]));
    float mrun = -1e30f, l_reg = 0.f; f32x16 o[2]; o[0] = f32x16{}; o[1] = f32x16{};
    const LAS unsigned char* vp0 = shm + LDS_V + ((lane >> 4) & 1) * 32 + (lane & 3) * 8 + (4 * hi + ((lane & 15) >> 2)) * 64;
    const LAS unsigned char* kp0 = shm + LDS_K + hi * 1024 + r32 * 16;
    bf16x8 kf[NG]; s16x4 vlo[8], vhi[8]; u32x4 pw0, pw1, pw2, pw3; f32x16 pA0, pA1, pB0, pB1; bool resc = false;
#define BIAS_TILE(P0, P1, tau) do { if (CA) { const int dist = cw - ((tau) + t0); \
            if (dist >= 3 || dist < 0) { const float c = tab[256]; _Pragma("unroll") for (int r = 0; r < 16; ++r) { P0[r] += c; P1[r] += c; } } \
            else { const int bi = 64 * dist + 32 * (wid & 1) + r32 + 128 - 4 * hi; \
                _Pragma("unroll") for (int r = 0; r < 16; ++r) { P0[r] += tab[bi - ((r & 3) + 8 * (r >> 2))]; P1[r] += tab[bi - 32 - ((r & 3) + 8 * (r >> 2))]; } } } } while (0)
#define DECIDE(P0, P1) do { const float rm = rowmax(P0, P1); resc = false; \
        if (__any(rm > mrun + (float)THR)) { const float mn = fmaxf(mrun, rm), f = __builtin_amdgcn_exp2f(mrun - mn); mrun = mn; l_reg *= f; if (hi == 0) wsf[r32] = f; resc = true; } } while (0)
#define RESC() do { if (resc) { _Pragma("unroll") for (int r = 0; r < 16; ++r) { const float fr_ = wsf[crow(r, hi)]; o[0][r] *= fr_; o[1][r] *= fr_; } } } while (0)
#define VRD(i, vp_) do { vlo[i] = vtr((vp_) + ((i) >> 2) * 4096 + ((i) & 3) * 1024); vhi[i] = vtr((vp_) + ((i) >> 2) * 4096 + ((i) & 3) * 1024 + 512); } while (0)
#define VFR(i) (bf16x8){vlo[i][0], vlo[i][1], vlo[i][2], vlo[i][3], vhi[i][0], vhi[i][1], vhi[i][2], vhi[i][3]}
#define PEL(P0, P1, e) ((e) < 16 ? P0[(e) & 15] : P1[(e) & 15])
#define PWSET(w, val) do { if ((w) < 4) pw0[(w) & 3] = (val); else if ((w) < 8) pw1[(w) & 3] = (val); else if ((w) < 12) pw2[(w) & 3] = (val); else pw3[(w) & 3] = (val); } while (0)
#define PWGET(k) ((k) == 0 ? pw0 : (k) == 1 ? pw1 : (k) == 2 ? pw2 : pw3)
#define PHASE_A(C0, C1, P0, P1, tau, vsl) do { const LAS unsigned char* vp_ = vp0 + (vsl) * VSLOT; float sacc = 0.f; \
        const float ci_ = TVALID(tau) ? 0.f : -INFINITY; f32x16 cz_; _Pragma("unroll") for (int r = 0; r < 16; ++r) cz_[r] = ci_; SBAR(); \
        _Pragma("unroll") for (int i = 0; i < NG; ++i) { \
            if (i < 8) { VRD((i >> 1) + 4 * (i & 1), vp_); SBAR(); } \
            if ((i & 1) == 0) C0 = __builtin_amdgcn_mfma_f32_32x32x16_bf16(kf[i], qr[i >> 1], i < 2 ? cz_ : C0, 0, 0, 0); \
            else C1 = __builtin_amdgcn_mfma_f32_32x32x16_bf16(kf[i], qr[i >> 1], i < 2 ? cz_ : C1, 0, 0, 0); \
            _Pragma("unroll") for (int e = (32 * i) / NG; e < (32 * (i + 1)) / NG; ++e) sacc += PEL(P0, P1, e); \
            PIN(sacc); \
            _Pragma("unroll") for (int w = (16 * i) / NG; w < (16 * (i + 1)) / NG; ++w) PWSET(w, cvtpk(PEL(P0, P1, 2 * w), PEL(P0, P1, 2 * w + 1))); \
            PIN(pw0); PIN(pw1); PIN(pw2); PIN(pw3); SBAR(); } \
        l_reg += sacc; } while (0)
#define PHASE_B(C0, C1, GL, ksl) do { const LAS unsigned char* kb_ = kp0 + (ksl) * KSLOT; \
        _Pragma("unroll") for (int j = 0; j < 8; ++j) { \
            if (GL) { _Pragma("unroll") for (int rr = (NG * j) / 8; rr < (NG * (j + 1)) / 8; ++rr) kf[rr] = *(const LAS bf16x8*)(kb_ + (rr >> 1) * 2048 + (rr & 1) * 512); SBAR(); } \
            o[j & 1] = __builtin_amdgcn_mfma_f32_32x32x16_bf16(__builtin_bit_cast(bf16x8, PWGET(j >> 1)), VFR((j >> 1) + 4 * (j & 1)), o[j & 1], 0, 0, 0); \
            _Pragma("unroll") for (int e = 4 * j; e < 4 * j + 4; ++e) { if (e < 16) C0[e & 15] = __builtin_amdgcn_exp2f(C0[e & 15] - mrun); else C1[e & 15] = __builtin_amdgcn_exp2f(C1[e & 15] - mrun); } \
            PIN(C0); PIN(C1); SBAR(); } } while (0)
    WAIT_BAR(1 + 2 * NPK);
    { const float ci_ = TVALID(0) ? 0.f : -INFINITY; f32x16 cz_;
#pragma unroll
      for (int r = 0; r < 16; ++r) cz_[r] = ci_;
#pragma unroll
      for (int d0 = 0; d0 < ND; ++d0) { const bf16x8 b0 = *(const LAS bf16x8*)(kp0 + d0 * 2048), b1 = *(const LAS bf16x8*)(kp0 + d0 * 2048 + 512);
          pA0 = __builtin_amdgcn_mfma_f32_32x32x16_bf16(b0, qr[d0], d0 == 0 ? cz_ : pA0, 0, 0, 0); pA1 = __builtin_amdgcn_mfma_f32_32x32x16_bf16(b1, qr[d0], d0 == 0 ? cz_ : pA1, 0, 0, 0); } }
    BIAS_TILE(pA0, pA1, 0); DECIDE(pA0, pA1);
#pragma unroll
    for (int r = 0; r < 16; ++r) { pA0[r] = __builtin_amdgcn_exp2f(pA0[r] - mrun); pA1[r] = __builtin_amdgcn_exp2f(pA1[r] - mrun); }
    WAIT_BAR(0);
    DMA_K(3, 0); DMA_V(1, 1);
#pragma unroll
    for (int rr = 0; rr < NG; ++rr) kf[rr] = *(const LAS bf16x8*)(kp0 + 1 * KSLOT + (rr >> 1) * 2048 + (rr & 1) * 512);
    WAIT_BAR(NP);
    int sl_prev = 0, sl_cur = 1, sl_next = 2;
#define ROT() do { sl_prev = sl_cur; sl_cur = sl_next; sl_next = (sl_next == NS - 1) ? 0 : sl_next + 1; } while (0)
#define STEP(C0, C1, P0, P1, tau, GK, GV, GL) do { SBAR(); \
        PHASE_A(C0, C1, P0, P1, tau, sl_prev); \
        if (GK) DMA_K((tau) + 3, sl_cur); if (GV) DMA_V((tau) + 1, sl_next); \
        BIAS_TILE(C0, C1, tau); DECIDE(C0, C1); SBAR(); \
        PHASE_B(C0, C1, GL, sl_next); } while (0)
#define ENDW(tau) do { if ((tau) + 3 < NT) { WAIT_BAR(NP); } else if ((tau) + 2 < NT) { WAIT_BAR(1); } else { WAIT_BAR(0); } } while (0)
    int tau = 1;
    for (; tau + 5 < NT; tau += 2) {
        STEP(pB0, pB1, pA0, pA1, tau, true, true, true);     WAIT_BAR(NP); RESC(); ROT();
        STEP(pA0, pA1, pB0, pB1, tau + 1, true, true, true); WAIT_BAR(NP); RESC(); ROT();
    }
    for (; tau + 1 < NT; tau += 2) {
        STEP(pB0, pB1, pA0, pA1, tau, (tau + 3 < NT), (tau + 1 < NT), (tau + 1 < NT));     ENDW(tau);     RESC(); ROT();
        STEP(pA0, pA1, pB0, pB1, tau + 1, (tau + 4 < NT), (tau + 2 < NT), (tau + 2 < NT)); ENDW(tau + 1); RESC(); ROT();
    }
    STEP(pB0, pB1, pA0, pA1, NT - 1, false, false, false); RESC();
    { float sacc = 0.f;
#pragma unroll
      for (int r = 0; r < 16; ++r) sacc += pB0[r] + pB1[r];
      l_reg += sacc;
      pw0 = (u32x4){cvtpk(pB0[0], pB0[1]), cvtpk(pB0[2], pB0[3]), cvtpk(pB0[4], pB0[5]), cvtpk(pB0[6], pB0[7])}; pw1 = (u32x4){cvtpk(pB0[8], pB0[9]), cvtpk(pB0[10], pB0[11]), cvtpk(pB0[12], pB0[13]), cvtpk(pB0[14], pB0[15])};
      pw2 = (u32x4){cvtpk(pB1[0], pB1[1]), cvtpk(pB1[2], pB1[3]), cvtpk(pB1[4], pB1[5]), cvtpk(pB1[6], pB1[7])}; pw3 = (u32x4){cvtpk(pB1[8], pB1[9]), cvtpk(pB1[10], pB1[11]), cvtpk(pB1[12], pB1[13]), cvtpk(pB1[14], pB1[15])};
      pv(o, vp0 + sl_cur * VSLOT, __builtin_bit_cast(bf16x8, pw0), __builtin_bit_cast(bf16x8, pw1), __builtin_bit_cast(bf16x8, pw2), __builtin_bit_cast(bf16x8, pw3)); }
    { auto rr = __builtin_amdgcn_permlane32_swap(__float_as_uint(l_reg), __float_as_uint(l_reg), false, false); l_reg = __uint_as_float(rr[0]) + __uint_as_float(rr[1]); }
    if (hi == 0) wsf[32 + r32] = l_reg;
    float rli[16];
#pragma unroll
    for (int r = 0; r < 16; ++r) rli[r] = __builtin_amdgcn_rcpf(wsf[32 + crow(r, hi)]);
    bf16_t* Ow = O + (rowbase + q0 + wid * 32) * LDO + OCOL + h * 64;
    { LAS bf16_t* stg = (LAS bf16_t*)(shm + LDS_OST) + wid * 2048;
#pragma unroll
        for (int r = 0; r < 16; ++r) { const int orow = crow(r, hi);
#pragma unroll
            for (int d0 = 0; d0 < 2; ++d0) { const unsigned w = cvtpk(o[d0][r] * rli[r], 0.f); stg[orow * 64 + d0 * 32 + r32] = (bf16_t)(w & 0xffffu); } }
#pragma unroll
        for (int i = 0; i < 4; ++i) { const int row = i * 8 + (lane >> 3), ch = lane & 7; const u32x4 v = *(const LAS u32x4*)(stg + row * 64 + ch * 8); *(u32x4*)(Ow + (long)row * LDO + ch * 8) = v; } }
    asm volatile("s_waitcnt lgkmcnt(0)\n\ts_barrier" ::: "memory");
#undef SBAR
#undef PIN
#undef DMA_K
#undef DMA_V
#undef WAIT_BAR
#undef TVALID
#undef BIAS_TILE
#undef DECIDE
#undef RESC
#undef VRD
#undef VFR
#undef PEL
#undef PWSET
#undef PWGET
#undef PHASE_A
#undef PHASE_B
#undef ROT
#undef STEP
#undef ENDW
}
}

constexpr int NWAVES = 8;
constexpr int NPHASE = 10;
constexpr int N_LAUNCHES = MK_N_LAUNCHES;
static_assert(N_LAUNCHES == 1 || N_LAUNCHES == NPHASE, "MK_N_LAUNCHES is 1 or 10");

constexpr int RING_BYTES = 131072, LDSCTL_OFF = RING_BYTES, MISC_OFF = LDSCTL_OFF + 320, XL_OFF = LDSCTL_OFF + 1024, LDS_BYTES = 147456;
static_assert(XL_OFF + 8192 <= LDS_BYTES && att::ATT_LDS_BYTES <= RING_BYTES, "LDS map");

typedef GAS unsigned gu32;
#define RLX_AGENT __ATOMIC_RELAXED, __HIP_MEMORY_SCOPE_AGENT

#define XB_TMO      128
#define XB_XCNT(j)  (256  + 64 * (j))
#define XB_XSUB(j)  (1280 + 64 * (j))
#define XB_XGEN(j)  (2304 + 64 * (j))
#define XB_TOP      3328
#define XB_TOPGEN   3392
#define XCD_BAR_WORDS 3456
#define XB_SPIN_CAP (1u << 18)
__device__ __forceinline__ unsigned xb_ld(unsigned* p)              { return __hip_atomic_load(p, __ATOMIC_RELAXED, __HIP_MEMORY_SCOPE_AGENT); }
__device__ __forceinline__ unsigned xb_add(unsigned* p, unsigned v) { return __hip_atomic_fetch_add(p, v, __ATOMIC_RELAXED, __HIP_MEMORY_SCOPE_AGENT); }
__device__ __forceinline__ unsigned xb_xcc_id() { return (unsigned)__builtin_amdgcn_s_getreg((3 << 11) | 20) & 0xFu; }
#define XB_SPIN(cond, bar) do { unsigned _sp = 0; while (cond) { __builtin_amdgcn_s_sleep(1); \
    if ((++_sp & 255u) == 0u) { if (xb_ld(&(bar)[XB_TMO])) break; if (_sp > XB_SPIN_CAP) { atomicAdd(&(bar)[XB_TMO], 1u); break; } } } } while (0)
struct XcdBarrier { unsigned* bar; unsigned x; volatile LAS unsigned* st; };
__device__ __forceinline__ XcdBarrier xcd_barrier_post(unsigned* bar, volatile LAS unsigned* st) {
    XcdBarrier b; b.bar = bar; b.x = xb_xcc_id(); b.st = st;
    if (threadIdx.x == 0) (void)xb_add(&bar[XB_XCNT(b.x)], 1u);
    return b;
}
__device__ __forceinline__ void xcd_barrier_complete(unsigned* bar, unsigned x, unsigned& nloc, unsigned& nx) {
    const unsigned G = gridDim.x * gridDim.y * gridDim.z;
    unsigned sum, cnt, mine, sp = 0u;
    for (;;) {
        sum = 0u; cnt = 0u; mine = 0u;
#pragma unroll
        for (unsigned j = 0; j < 16; ++j) { const unsigned c = xb_ld(&bar[XB_XCNT(j)]); sum += c; cnt += (c > 0u) ? 1u : 0u; mine = (j == x) ? c : mine; }
        if (sum == G) break;
        __builtin_amdgcn_s_sleep(1);
        if ((++sp & 255u) == 0u) { if (xb_ld(&bar[XB_TMO])) break; if (sp > XB_SPIN_CAP) { atomicAdd(&bar[XB_TMO], 1u); break; } }
    }
    nloc = mine > 0u ? mine : 1u; nx = cnt > 0u ? cnt : 1u;
}
__device__ __forceinline__ void xcd_barrier(const XcdBarrier& b) {
    asm volatile("s_waitcnt vmcnt(0)" ::: "memory");
    __syncthreads();
    if (threadIdx.x == 0) {
        unsigned* bar = b.bar;
        __builtin_amdgcn_s_waitcnt(0);
        unsigned nloc = b.st[0], nx = b.st[1];
        if (nloc == 0u) { xcd_barrier_complete(bar, b.x, nloc, nx); b.st[0] = nloc; b.st[1] = nx; }
        const unsigned old = xb_add(&bar[XB_XSUB(b.x)], 1u);
        const unsigned gen = old / nloc;
        if (old + 1u == (gen + 1u) * nloc) {
            __builtin_amdgcn_fence(__ATOMIC_RELEASE, "agent");
            asm volatile("s_waitcnt vmcnt(0)" ::: "memory");
            const unsigned og = xb_add(&bar[XB_TOP], 1u);
            const unsigned tg = og / nx;
            if (og + 1u == (tg + 1u) * nx) xb_add(&bar[XB_TOPGEN], 1u);
            else XB_SPIN(xb_ld(&bar[XB_TOPGEN]) == tg, bar);
            __builtin_amdgcn_fence(__ATOMIC_ACQUIRE, "agent");
            xb_add(&bar[XB_XGEN(b.x)], 1u);
            asm volatile("s_waitcnt vmcnt(0)" ::: "memory");
        } else {
            XB_SPIN(xb_ld(&bar[XB_XGEN(b.x)]) == gen, bar);
            __builtin_amdgcn_fence(__ATOMIC_ACQUIRE, "agent");
            asm volatile("s_waitcnt vmcnt(0)" ::: "memory");
        }
    }
    __syncthreads();
}

struct Args { const void* in[22]; float* out; unsigned char* ws; int ph_lo, ph_hi, li, pad; };
#define ARGF(k) ((const float*)args.in[k])
struct Frame {
    LAS unsigned char* lds; LAS float* xl;
    int tid, lane, wave, vcu, G;
    unsigned char* ws;
};

template <int WHICH> __device__ __forceinline__ int wmap(int n) {
    if (WHICH == 0) {
        if (n < 256) return n;
        if (n < 512) { const int c = n - 256; return c < 160 ? 256 + c : -1; }
        if (n < 1536) { const int t4 = (n - 512) >> 8, which = t4 >> 1, jj = t4 & 1, c = (n - 512) & 255, bj = c >> 7, wc = (c >> 5) & 3, i = c & 31; return 416 + which * 512 + (4 * jj + wc) * 64 + 32 * bj + i; }
        return 416 + 1024 + (n - 1536);
    } else if (WHICH == 1) {
        const int pn = n >> 8, c = n & 255, bj = c >> 7, wc = (c >> 5) & 3, i = c & 31, head = 2 * pn + bj;
        if (wc < 2) return head * 96 + 32 * wc + i;
        if (wc == 2) { const int fq = i >> 3, nn = (i >> 2) & 1, e = i & 3; return head * 96 + 64 + 4 * fq + e + 16 * nn; }
        return -1;
    } else if (WHICH == 2) {
        const int pn = n >> 8, c = n & 255, bj = c >> 7, wc = (c >> 5) & 3, i = c & 31, head = 2 * pn + bj;
        return wc < 2 ? head * 128 + 32 * wc + i : head * 128 + 64 + 32 * (wc - 2) + i;
    } else if (WHICH == 4) {
        const int j = n >> 8, c = n & 255; return c < 128 ? 128 * j + c : DFF + 128 * j + (c - 128);
    }
    return n;
}
template <int WHICH> __device__ __forceinline__ void cvt_item(const float* W, int K, int N, bf16_t* WT, int KP, int NP, LAS float* scr, int item, int lane) {
    const int nblk = NP / 32, kb = item / nblk, nb = item % nblk, k0 = 64 * kb, n0 = 32 * nb;
    const int src = wmap<WHICH>(n0 + (lane & 31)); const bool live = (src >= 0) && (k0 < K);
    float wv[32];
#pragma unroll
    for (int i = 0; i < 32; ++i) { const int kk = 2 * i + (lane >> 5); wv[i] = live ? __builtin_nontemporal_load(W + (size_t)(k0 + kk) * N + src) : 0.f; }
#pragma unroll
    for (int i = 0; i < 32; ++i) { const int kk = 2 * i + (lane >> 5); scr[kk * 33 + (lane & 31)] = wv[i]; }
    asm volatile("s_waitcnt lgkmcnt(0)" ::: "memory");
    const int c = lane & 7;
#pragma unroll
    for (int j = 0; j < 4; ++j) { const int n = (lane >> 3) + 8 * j; const LAS float* s = scr + (8 * c) * 33 + n;
        u32x4 o; o.x = cvtpk(s[0 * 33], s[1 * 33]); o.y = cvtpk(s[2 * 33], s[3 * 33]); o.z = cvtpk(s[4 * 33], s[5 * 33]); o.w = cvtpk(s[6 * 33], s[7 * 33]);
        *(u32x4*)(WT + (size_t)(n0 + n) * KP + k0 + 8 * c) = o; }
    asm volatile("s_waitcnt lgkmcnt(0)" ::: "memory");
}
__device__ __forceinline__ void p0_prologue(Frame& F, const Args& args) {
    LAS float* scr = (LAS float*)(F.lds) + F.wave * 4096;
    const int gw = F.vcu * NWAVES + F.wave, NGW = F.G * NWAVES;
    constexpr int I0 = 16 * 64, I1 = 4 * 32, I2 = 4 * 32, I3 = 16 * 32, I4 = 16 * 176, I5 = 44 * 32;
    constexpr int NITEMS = I0 + I1 + I2 + I3 + I4 + I5;
    for (int it = gw; it < NITEMS; it += NGW) {
        int r = it;
        if (r < I0) { cvt_item<0>(ARGF(6), 1024, 1952, (bf16_t*)(F.ws + WS_WIN), 1024, 2048, scr, r, F.lane); continue; } r -= I0;
        if (r < I1) { cvt_item<1>(ARGF(9), 256, 768, (bf16_t*)(F.ws + WS_WQUP), 256, 1024, scr, r, F.lane); continue; } r -= I1;
        if (r < I2) { cvt_item<2>(ARGF(10), 128, 1024, (bf16_t*)(F.ws + WS_WKVUP), 256, 1024, scr, r, F.lane); continue; } r -= I2;
        if (r < I3) { cvt_item<3>(ARGF(16), 1024, 1024, (bf16_t*)(F.ws + WS_WOUT), 1024, 1024, scr, r, F.lane); continue; } r -= I3;
        if (r < I4) { cvt_item<4>(ARGF(18), 1024, DFF2, (bf16_t*)(F.ws + WS_WUP), 1024, DFF2, scr, r, F.lane); continue; } r -= I4;
        cvt_item<5>(ARGF(21), DFF, 1024, (bf16_t*)(F.ws + WS_WDOWN), DFF, 1024, scr, r, F.lane);
    }
    {
        float* cosT = (float*)(F.ws + WS_COS); float* sinT = (float*)(F.ws + WS_SIN);
        const int gt = F.vcu * (NWAVES * 64) + F.tid, NT = F.G * NWAVES * 64;
        for (int idx = gt; idx < MTOK * 16; idx += NT) {
            const int m = idx >> 4, i = idx & 15;
            const float inv = __builtin_amdgcn_exp2f(-(float)i * (13.287712379549449f / 16.0f));
            const float ang = (float)((const int*)args.in[2])[m] * inv;
            const float n = rintf(ang * 0.15915494309189535f);
            float r = fmaf(-n, 6.2831854820251465f, ang); r = fmaf(-n, -1.7484555e-7f, r);
            cosT[idx] = __cosf(r); sinT[idx] = __sinf(r);
        }
    }
}
__device__ __forceinline__ void p0_mod(Frame& F, const Args& args) {
    LAS float* scr = (LAS float*)(F.lds) + F.wave * 4096;
    if (F.vcu < 192) {
        const int n0 = F.vcu * 32, kbase = F.wave * 128, col = F.lane & 31, kh = F.lane >> 5;
        for (int idx = F.lane; idx < 2048; idx += 64) { const int b = idx >> 7, k = idx & 127; const float xv = ARGF(1)[b * 1024 + kbase + k]; scr[k * 16 + b] = xv / (1.0f + __expf(-xv)); }
        asm volatile("s_waitcnt lgkmcnt(0)" ::: "memory");
        f32x4 a0 = {0.f, 0.f, 0.f, 0.f}, a1 = a0, a2 = a0, a3 = a0;
#pragma unroll 8
        for (int i = 0; i < 64; ++i) { const int k = 2 * i + kh;
            const float w = ARGF(3)[(size_t)(kbase + k) * NMOD + n0 + col];
            const LAS f32x4* sp = (const LAS f32x4*)(scr + k * 16);
            a0 += sp[0] * w; a1 += sp[1] * w; a2 += sp[2] * w; a3 += sp[3] * w;
        }
#pragma unroll
        for (int e = 0; e < 4; ++e) { a0[e] += __shfl_xor(a0[e], 32); a1[e] += __shfl_xor(a1[e], 32); a2[e] += __shfl_xor(a2[e], 32); a3[e] += __shfl_xor(a3[e], 32); }
        if (kh == 0) {
#pragma unroll
            for (int e = 0; e < 4; ++e) { scr[2048 + (0 + e) * 32 + col] = a0[e]; scr[2048 + (4 + e) * 32 + col] = a1[e]; scr[2048 + (8 + e) * 32 + col] = a2[e]; scr[2048 + (12 + e) * 32 + col] = a3[e]; } }
        __syncthreads();
        float* MOD = (float*)(F.ws + WS_MOD);
        { const int b = 2 * F.wave + kh; float s = ARGF(4)[n0 + col];
#pragma unroll
            for (int w2 = 0; w2 < 8; ++w2) s += ((LAS float*)F.lds)[w2 * 4096 + 2048 + b * 32 + col];
            MOD[(size_t)b * NMOD + n0 + col] = s; }
    }
}
__device__ __forceinline__ float wave_sum(float v) {
#pragma unroll
    for (int o = 1; o < 64; o <<= 1) v += __shfl_xor(v, o);
    return v;
}
__device__ __forceinline__ void norm_rows(Frame& F, const float* X, const float* g, int shift_off, int scale_off, bf16_t* out) {
    const float* MOD = (const float*)(F.ws + WS_MOD);
    const int gw = F.vcu * NWAVES + F.wave, NGW = F.G * NWAVES;
    for (int m = gw; m < MTOK; m += NGW) {
        const int b = m >> 11;
        const f32x4* xr = (const f32x4*)(X + (size_t)m * DM) + F.lane;
        f32x4 v[4]; float s = 0.f;
#pragma unroll
        for (int j = 0; j < 4; ++j) { v[j] = xr[64 * j]; s += dot4(v[j]); }
        const float r = rsqrtf(wave_sum(s) * (1.0f / DM) + EPS);
        const f32x4* gp = (const f32x4*)g + F.lane; const f32x4* shp = (const f32x4*)(MOD + (size_t)b * NMOD + shift_off) + F.lane; const f32x4* scp = (const f32x4*)(MOD + (size_t)b * NMOD + scale_off) + F.lane;
        u32x2* o8 = (u32x2*)(out + (size_t)m * DM) + F.lane;
#pragma unroll
        for (int j = 0; j < 4; ++j) { const f32x4 y = v[j] * r * gp[64 * j] * (scp[64 * j] + 1.0f) + shp[64 * j]; o8[64 * j] = pack4(y); }
    }
}
__device__ __forceinline__ void conv_fixup(Frame& F, const Args& args) {
    const float* RAW4 = (const float*)(F.ws + WS_RAW4); bf16_t* ACT = (bf16_t*)(F.ws + WS_ACT);
    const int gt = F.vcu * (NWAVES * 64) + F.tid, NT = F.G * NWAVES * 64;
    for (int idx = gt; idx < 512 * DFF; idx += NT) {
        const int blk = idx / DFF, c = idx - blk * DFF, j = c >> 7, cc = c & 127;
        const bool first = (blk & 31) == 0;
        float o[2][2];
#pragma unroll
        for (int half = 0; half < 2; ++half) {
            const int tcol = 256 * j + 128 * half + cc, ocol = half * DFF + c;
            const float w0 = ARGF(19)[ocol], w1 = ARGF(19)[DFF2 + ocol], w2 = ARGF(19)[2 * DFF2 + ocol], bb = ARGF(20)[ocol];
            const float pm2 = first ? 0.f : RAW4[((size_t)(blk - 1) * 4 + 2) * DFF2 + tcol], pm1 = first ? 0.f : RAW4[((size_t)(blk - 1) * 4 + 3) * DFF2 + tcol];
            const float r0 = RAW4[((size_t)blk * 4 + 0) * DFF2 + tcol], r1 = RAW4[((size_t)blk * 4 + 1) * DFF2 + tcol];
            o[half][0] = w0 * pm2 + w1 * pm1 + w2 * r0 + bb; o[half][1] = w0 * pm1 + w1 * r0 + w2 * r1 + bb;
        }
#pragma unroll
        for (int rr = 0; rr < 2; ++rr) { const float G = o[0][rr], a = G / (1.0f + __expf(-G)) * o[1][rr];
            ACT[((size_t)blk * 64 + rr) * DFF + c] = (bf16_t)(cvtpk(a, 0.f) & 0xffffu); }
    }
}

__global__ void __launch_bounds__(NWAVES * 64, 2) fwd_kernel(Args args) {
    extern __shared__ __attribute__((aligned(16))) unsigned char lds_raw[];
    Frame F;
    F.lds = (LAS unsigned char*)lds_raw; F.xl = (LAS float*)(F.lds + XL_OFF);
    F.tid = threadIdx.x; F.lane = F.tid & 63; F.wave = __builtin_amdgcn_readfirstlane(F.tid >> 6);
    F.G = gridDim.x; { const int bx = blockIdx.x; F.vcu = (F.G % 8 == 0) ? (bx % 8) * (F.G / 8) + bx / 8 : bx; }
    F.ws = args.ws;
    unsigned char* ws = args.ws;
    for (int u = F.tid; u < (LDS_BYTES - LDSCTL_OFF) / 4; u += NWAVES * 64) ((LAS unsigned*)(F.lds + LDSCTL_OFF))[u] = 0u;
    __syncthreads();
    XcdBarrier bar; bar.bar = (unsigned*)(ws + WS_CTL) + CW_BAR; bar.x = 0; bar.st = nullptr;
    if (N_LAUNCHES == 1) bar = xcd_barrier_post((unsigned*)(ws + WS_CTL) + CW_BAR, (volatile LAS unsigned*)(F.lds + MISC_OFF) + 8);
#define GRID_BAR() do { if (N_LAUNCHES == 1) xcd_barrier(bar); } while (0)
    const int lo = args.ph_lo, hi = args.ph_hi;
#ifndef PH_MASK
#define PH_MASK 0x3ff
#endif
#define IN(k) (((PH_MASK >> (k)) & 1) && lo <= (k) && (k) < hi)
#define BOTH(k) (IN(k) && IN((k) + 1))
    float* MOD = (float*)(ws + WS_MOD);
    bf16_t* XN = (bf16_t*)(ws + WS_XN);

#define REFRESH_TID() do { int t_ = threadIdx.x; asm volatile("" : "+v"(t_)); t_ &= 511; F.tid = t_; F.lane = t_ & 63; } while (0)
    if (IN(0)) { REFRESH_TID(); p0_mod(F, args); if (BOTH(0)) GRID_BAR(); }
    if (IN(1)) { REFRESH_TID(); p0_prologue(F, args); norm_rows(F, ARGF(0), ARGF(5), 0, DM, XN); if (BOTH(1)) GRID_BAR(); }
    if (IN(2)) {
        pg8::Gemm g{XN, (const bf16_t*)(ws + WS_WIN), MTOK, 2048, 1024, nullptr, 1 << 30}; pg8::StaticOrder S; S.init(MTOK, 2048, F.G, (int)blockIdx.x);
        EpiIn E{ws, ARGF(7), ARGF(8), ARGF(13), ARGF(14)};
        pg8::gemm_phase(F.lds, F.xl, g, S, E);
        if (BOTH(2)) GRID_BAR();
    }
    if (IN(3)) {
        pg8::Gemm g{(const bf16_t*)(ws + WS_QLN), (const bf16_t*)(ws + WS_WQUP), MTOK, 2048, 256, (const bf16_t*)(ws + WS_KVLN), 4}; pg8::StaticOrder S; S.init(MTOK, 2048, F.G, (int)blockIdx.x);
        EpiQKV E{EpiQ{ws, ARGF(11)}, EpiKV{ws, ARGF(12)}};
        pg8::gemm_phase(F.lds, F.xl, g, S, E);
        if (BOTH(3)) GRID_BAR();
    }
    if (IN(4)) {
        bf16_t* OM = (bf16_t*)(ws + WS_OM);
        int atid = threadIdx.x; asm volatile("" : "+v"(atid)); atid &= 511;
        for (int i = 0; ; ++i) {
            int kind, bh, qb;
            if (F.G == 256) { if (i >= 8) break; bh = F.vcu >> 1; const int par = F.vcu & 1;
                if (i < 4) { kind = 0; const int s = 2 * par + (i >> 1); qb = (i & 1) ? 7 - s : s; } else { kind = 1; qb = 2 * (i - 4) + par; } }
            else { const int j = F.vcu + i * F.G; if (j >= 2048) break; kind = j >> 10; bh = (j & 1023) >> 3; qb = j & 7; }
            if (kind == 0) att::attn_unit<96, false, 8>(atid, bh >> 3, bh & 7, qb, (const bf16_t*)(ws + WS_QM), (const bf16_t*)(ws + WS_KM), (const bf16_t*)(ws + WS_VM), OM, nullptr, F.lds);
            else att::attn_unit<64, true, 8>(atid, bh >> 3, bh & 7, qb, (const bf16_t*)(ws + WS_CQ), (const bf16_t*)(ws + WS_CK), (const bf16_t*)(ws + WS_CV), OM, ARGF(15), F.lds);
        }
        if (BOTH(4)) GRID_BAR();
    }
    if (IN(5)) {
        pg8::Gemm g{(const bf16_t*)(ws + WS_OM), (const bf16_t*)(ws + WS_WOUT), MTOK, 1024, 1024, nullptr, 1 << 30}; pg8::StaticOrder S; S.init(MTOK, 1024, F.G, (int)blockIdx.x);
        EpiRes<false> E{ARGF(0), (float*)(ws + WS_X1), MOD + 2 * DM};
        pg8::gemm_phase(F.lds, F.xl, g, S, E);
        if (BOTH(5)) GRID_BAR();
    }
    if (IN(6)) { REFRESH_TID(); norm_rows(F, (const float*)(ws + WS_X1), ARGF(17), 3 * DM, 4 * DM, XN); if (BOTH(6)) GRID_BAR(); }
    if (IN(7)) {
        pg8::Gemm g{XN, (const bf16_t*)(ws + WS_WUP), MTOK, DFF2, 1024, nullptr, 1 << 30}; pg8::StaticOrder S; S.init(MTOK, DFF2, F.G, (int)blockIdx.x);
        EpiUp E{ws, ARGF(19), ARGF(20)};
        pg8::gemm_phase(F.lds, F.xl, g, S, E);
        if (BOTH(7)) GRID_BAR();
    }
    if (IN(8)) { REFRESH_TID(); conv_fixup(F, args); if (BOTH(8)) GRID_BAR(); }
    if (IN(9)) {
        pg8::Gemm g{(const bf16_t*)(ws + WS_ACT), (const bf16_t*)(ws + WS_WDOWN), MTOK, 1024, DFF, nullptr, 1 << 30}; pg8::StaticOrder S; S.init(MTOK, 1024, F.G, (int)blockIdx.x);
        EpiRes<false> E{(const float*)(ws + WS_X1), args.out, MOD + 5 * DM};
        pg8::gemm_phase(F.lds, F.xl, g, S, E);
    }
#undef IN
#undef BOTH
}

extern "C" void kernel_launch(void* const* d_in, const int* in_sizes, int n_in, void* d_out, int out_size, void* d_ws, size_t ws_size, hipStream_t stream) {
    static int grid = 0;
    if (grid == 0) {
        if (n_in != 22 || in_sizes[0] != MTOK * DM || out_size != MTOK * DM || ws_size < WS_END) {
            fprintf(stderr, "kernel_launch: unexpected shapes (n_in %d, in0 %d, out %d, ws %zu); nothing launched\n", n_in, n_in > 0 ? in_sizes[0] : -1, out_size, ws_size); grid = -1; return; }
        int dev = 0, cus = 0, per_cu = 0;
        if (hipGetDevice(&dev) != hipSuccess || hipDeviceGetAttribute(&cus, hipDeviceAttributeMultiprocessorCount, dev) != hipSuccess) { grid = -1; return; }
        if (hipFuncSetAttribute((const void*)fwd_kernel, hipFuncAttributeMaxDynamicSharedMemorySize, LDS_BYTES) != hipSuccess) { fprintf(stderr, "kernel_launch: hipFuncSetAttribute failed\n"); grid = -1; return; }
        if (hipOccupancyMaxActiveBlocksPerMultiprocessor(&per_cu, (const void*)fwd_kernel, NWAVES * 64, LDS_BYTES) != hipSuccess || per_cu < 1)
            fprintf(stderr, "kernel_launch: note: occupancy query reports %d workgroups per CU\n", per_cu);
        (void)hipGetLastError();
        grid = cus;
    }
    if (grid < 0) return;
    Args a{};
    for (int i = 0; i < 22; ++i) a.in[i] = d_in[i];
    a.out = (float*)d_out; a.ws = (unsigned char*)d_ws;
#ifndef PROBE_DUP
#define PROBE_DUP -1
#endif
    const int nl = (PROBE_DUP >= 0) ? 2 : N_LAUNCHES;
    for (int li = 0; li < nl; ++li) {
        if (hipMemsetAsync((char*)d_ws + WS_CTL, 0, CTL_ZERO_BYTES, stream) != hipSuccess) { fprintf(stderr, "kernel_launch: memset failed\n"); return; }
        a.ph_lo = (N_LAUNCHES == 1) ? 0 : li; a.ph_hi = (N_LAUNCHES == 1) ? NPHASE : li + 1; a.li = li;
        if (PROBE_DUP >= 0) { a.ph_lo = li == 0 ? 0 : PROBE_DUP; a.ph_hi = li == 0 ? PROBE_DUP + 1 : NPHASE; }
        hipLaunchKernelGGL(fwd_kernel, dim3(grid), dim3(NWAVES * 64), LDS_BYTES, stream, a);
        const hipError_t le = hipPeekAtLastError();
        if (le != hipSuccess) { fprintf(stderr, "kernel_launch: launch %d failed: %s\n", li, hipGetErrorName(le)); break; }
    }
}
```

```cpp
#include <hip/hip_runtime.h>
#include <cstdio>
#include <cstdint>

#define LAS __attribute__((address_space(3)))
#define GAS __attribute__((address_space(1)))
typedef unsigned short bf16_t;
typedef short bf16x8 __attribute__((ext_vector_type(8)));
typedef short s16x4 __attribute__((ext_vector_type(4)));
typedef float f32x2 __attribute__((ext_vector_type(2)));
typedef float f32x4 __attribute__((ext_vector_type(4)));
typedef float f32x16 __attribute__((ext_vector_type(16)));
typedef unsigned u32x2 __attribute__((ext_vector_type(2)));
typedef unsigned u32x4 __attribute__((ext_vector_type(4)));
typedef __bf16 bf16x2_t __attribute__((ext_vector_type(2)));

#ifndef MK_N_LAUNCHES
#define MK_N_LAUNCHES 1
#endif

constexpr int BATCH = 16, SEQ = 2048, DM = 1024, MTOK = BATCH * SEQ;
constexpr int NMOD = 6 * DM;
constexpr int DFF = 2816, DFF2 = 5632;
constexpr float EPS = 1e-6f;
constexpr float LOG2E = 1.4426950408889634f;
constexpr float C2_MLA = 0.10206207261596577f * LOG2E;
constexpr float C2_CA = 0.125f * LOG2E;

__device__ __forceinline__ unsigned cvtpk(float lo, float hi) { f32x2 v = {lo, hi}; bf16x2_t b = __builtin_convertvector(v, bf16x2_t); return __builtin_bit_cast(unsigned, b); }
__device__ __forceinline__ u32x4 pack8(f32x4 a, f32x4 b) { u32x4 w; w.x = cvtpk(a[0], a[1]); w.y = cvtpk(a[2], a[3]); w.z = cvtpk(b[0], b[1]); w.w = cvtpk(b[2], b[3]); return w; }
__device__ __forceinline__ u32x2 pack4(f32x4 a) { u32x2 w; w.x = cvtpk(a[0], a[1]); w.y = cvtpk(a[2], a[3]); return w; }
__device__ __forceinline__ float dot4(f32x4 a) { return (a[0] * a[0] + a[1] * a[1]) + (a[2] * a[2] + a[3] * a[3]); }
#define LDS_BARRIER() do { asm volatile("s_waitcnt lgkmcnt(0)" ::: "memory"); __builtin_amdgcn_s_barrier(); asm volatile("" ::: "memory"); } while (0)

namespace pg8 {
constexpr int BM = 256, BK = 64, HALF = 128, HTB = HALF * BK * 2, STAGE_BYTES = 8 * HTB, NXCD = 8, WGM = 8;
__host__ __device__ __forceinline__ int lds_byte(int r, int c) { const int st = (r >> 4) * 2 + (c >> 5), rr = r & 15, cc = c & 31, ob = rr * 64 + cc * 2; return st * 1024 + (ob ^ (((ob >> 9) & 1) << 5)); }
__host__ __device__ __forceinline__ void stage_rc(int b, int& R, int& C) { const int st = b / 1024, sb = b % 1024, swz = sb ^ (((sb >> 9) & 1) << 5); R = (st >> 1) * 16 + swz / 64; C = (st & 1) * 32 + (swz % 64) / 2; }
__host__ __device__ __forceinline__ int perm32(int rho) { const int n = rho >> 4, i = rho & 15; return 8 * (i >> 2) + 4 * n + (i & 3); }

struct Unit { int pm, pn; };
struct Gemm { const bf16_t* A; const bf16_t* Bt; int M, N, K; const bf16_t* A2; int nsplit; };

struct StaticOrder {
    int nM, nN, nwg, G, c;
    __host__ __device__ void init(int M, int N, int G_, int c_) { nM = M / BM; nN = N / BM; nwg = nM * nN; G = G_; c = c_; }
    __host__ __device__ bool next(int i, Unit& u) const {
        const long L = (long)i * G + c; if (L >= nwg) return false;
        int wgid = (int)L; { const int q = nwg / NXCD, r = nwg % NXCD, xcd = wgid % NXCD, off = wgid / NXCD; wgid = (xcd < r ? xcd * (q + 1) : r * (q + 1) + (xcd - r) * q) + off; }
        const int nig = WGM * nN, gid = wgid / nig, fm = gid * WGM, gsz = (nM - fm) < WGM ? (nM - fm) : WGM;
        u.pm = fm + ((wgid % nig) % gsz); u.pn = (wgid % nig) / gsz; return true;
    }
};

template <class Epi, class Sched>
__device__ __forceinline__ void gemm_phase(LAS unsigned char* lds, LAS float* xl, const Gemm g, const Sched& S, const Epi& E) {
    int tid = threadIdx.x; asm volatile("" : "+v"(tid)); tid &= 511;
    const int wid = __builtin_amdgcn_readfirstlane(tid >> 6), lane = tid & 63, wr = wid >> 2, wc = wid & 3, fr = lane & 15, fq = lane >> 4;
    const int K = g.K, nt = K / BK;
    unsigned voffA[2], voffB[2];
#pragma unroll
    for (int i = 0; i < 2; ++i) { int R, C; stage_rc(tid * 16 + i * 8192, R, C); const int Rb = (R & ~31) + perm32(R & 31);
        const int Ra = Epi::APERM ? ((R & 64) | ((R & 15) << 2) | ((R >> 4) & 3)) : R;
        voffA[i] = (unsigned)(Ra * K + C) * 2u; voffB[i] = (unsigned)(Rb * K + C) * 2u; }
    const size_t kstep = (size_t)(BK * 2);
    const size_t hstep = (size_t)HALF * K * 2;
    const size_t tstep = 2 * hstep;
    const unsigned ldsw = (unsigned)wid * 1024u;
    const int aoff = lds_byte(wr * 64 + fr, fq * 8), boff = lds_byte(wc * 32 + fr, fq * 8);
#define PG8_SA(b, h) (((b) * 2 + (h)) * HTB)
#define PG8_SB(b, h) ((4 + (b) * 2 + (h)) * HTB)
#define PG8_STAGE(bufoff, gbase, voff) do { _Pragma("unroll") for (int _i = 0; _i < 2; ++_i) \
        __builtin_amdgcn_global_load_lds((const unsigned*)((const char*)(gbase) + (voff)[_i]), (LAS unsigned*)(lds + (bufoff) + ldsw + _i * 8192), 16, 0, 0); } while (0)
#define PG8_LDA(dst, b, h) do { _Pragma("unroll") for (int m = 0; m < 4; ++m) _Pragma("unroll") for (int k = 0; k < 2; ++k) dst[m][k] = *(const LAS bf16x8*)(lds + PG8_SA(b, h) + aoff + m * 2048 + k * 1024); } while (0)
#define PG8_LDB(dst, b, h) do { _Pragma("unroll") for (int n = 0; n < 2; ++n) _Pragma("unroll") for (int k = 0; k < 2; ++k) dst[n][k] = *(const LAS bf16x8*)(lds + PG8_SB(b, h) + boff + n * 2048 + k * 1024); } while (0)
#define PG8_MMA(ai, bj, At, Bt) do { __builtin_amdgcn_s_setprio(1); _Pragma("unroll") for (int m = 0; m < 4; ++m) _Pragma("unroll") for (int n = 0; n < 2; ++n) _Pragma("unroll") for (int k = 0; k < 2; ++k) \
        acc[ai][bj][m][n] = __builtin_amdgcn_mfma_f32_16x16x32_bf16(Bt[n][k], At[m][k], acc[ai][bj][m][n], 0, 0, 0); __builtin_amdgcn_s_setprio(0); } while (0)
#define PG8_WAIT_V(n) asm volatile("s_waitcnt vmcnt(" #n ")" ::: "memory")
#define PG8_WAIT_L(n) asm volatile("s_waitcnt lgkmcnt(" #n ")" ::: "memory")
#define PG8_BAR __builtin_amdgcn_s_barrier()
#define PG8_SCHED __builtin_amdgcn_sched_barrier(0)
    Unit cur, nxt; int ui = 0;
    if (!S.next(0, cur)) return;
    f32x4 acc[2][2][4][2];
#pragma unroll
    for (int a = 0; a < 2; ++a)
#pragma unroll
        for (int b = 0; b < 2; ++b)
#pragma unroll
            for (int m = 0; m < 4; ++m)
#pragma unroll
                for (int n = 0; n < 2; ++n) acc[a][b][m][n] = (f32x4){0.f, 0.f, 0.f, 0.f};
    bf16x8 At[4][2], B0[2][2], B1[2][2];
    const char* cA = (const char*)(cur.pn < g.nsplit ? g.A : g.A2) + (size_t)cur.pm * tstep; const char* cB = (const char*)g.Bt + (size_t)cur.pn * tstep;
    PG8_STAGE(PG8_SB(0, 0), cB, voffB); PG8_STAGE(PG8_SB(0, 1), cB + hstep, voffB); PG8_STAGE(PG8_SA(0, 0), cA, voffA); PG8_STAGE(PG8_SA(0, 1), cA + hstep, voffA);
    if (wr == 1) PG8_BAR;
    PG8_WAIT_V(2); PG8_BAR;
    PG8_STAGE(PG8_SB(1, 0), cB + kstep, voffB); PG8_STAGE(PG8_SA(1, 0), cA + kstep, voffA); PG8_STAGE(PG8_SB(1, 1), cB + hstep + kstep, voffB);
    PG8_WAIT_V(6); PG8_BAR;
    for (;;) {
        const bool has_next = S.next(ui + 1, nxt);
        const char* nA = has_next ? (const char*)(nxt.pn < g.nsplit ? g.A : g.A2) + (size_t)nxt.pm * tstep : cA; const char* nB = has_next ? (const char*)g.Bt + (size_t)nxt.pn * tstep : cB;
        for (int t = 0; t < nt; t += 2) {
            const bool last = (t == nt - 2);
            const char* a1 = cA + (size_t)(t + 1) * kstep;
            const char* a2 = last ? nA : cA + (size_t)(t + 2) * kstep; const char* b2 = last ? nB : cB + (size_t)(t + 2) * kstep;
            const char* a3 = a2 + kstep; const char* b3 = b2 + kstep;
            PG8_LDB(B0, 0, 0); PG8_LDB(B1, 0, 1); PG8_SCHED; PG8_LDA(At, 0, 0); PG8_STAGE(PG8_SA(1, 1), a1 + hstep, voffA);
            PG8_WAIT_V(8); PG8_WAIT_L(0); PG8_BAR; PG8_MMA(0, 0, At, B0); PG8_MMA(0, 1, At, B1); PG8_BAR; PG8_SCHED;
            PG8_LDA(At, 0, 1); PG8_STAGE(PG8_SB(0, 0), b2, voffB); PG8_STAGE(PG8_SB(0, 1), b2 + hstep, voffB); PG8_STAGE(PG8_SA(0, 0), a2, voffA);
            PG8_WAIT_V(8); PG8_WAIT_L(0); PG8_BAR; PG8_MMA(1, 0, At, B0); PG8_MMA(1, 1, At, B1); PG8_BAR; PG8_SCHED;
            PG8_LDB(B0, 1, 0); PG8_LDB(B1, 1, 1); PG8_SCHED; PG8_LDA(At, 1, 0); PG8_STAGE(PG8_SA(0, 1), a2 + hstep, voffA);
            PG8_WAIT_V(8); PG8_WAIT_L(0); PG8_BAR; PG8_MMA(0, 0, At, B0); PG8_MMA(0, 1, At, B1); PG8_BAR; PG8_SCHED;
            PG8_LDA(At, 1, 1); PG8_STAGE(PG8_SB(1, 0), b3, voffB); PG8_STAGE(PG8_SB(1, 1), b3 + hstep, voffB); PG8_STAGE(PG8_SA(1, 0), a3, voffA);
            PG8_WAIT_V(8); PG8_WAIT_L(0); PG8_BAR; PG8_MMA(1, 0, At, B0); PG8_MMA(1, 1, At, B1); PG8_BAR; PG8_SCHED;
        }
        if (wr == 0) PG8_BAR;
        E(acc, cur, wr, wc, fr, fq, xl);
        if (!has_next) break;
#pragma unroll
        for (int a = 0; a < 2; ++a)
#pragma unroll
            for (int b = 0; b < 2; ++b)
#pragma unroll
                for (int m = 0; m < 4; ++m)
#pragma unroll
                    for (int n = 0; n < 2; ++n) acc[a][b][m][n] = (f32x4){0.f, 0.f, 0.f, 0.f};
        cur = nxt; cA = nA; cB = nB; ++ui;
        if (wr == 1) PG8_BAR;
    }
    PG8_WAIT_V(0);
    PG8_BAR;
#undef PG8_SA
#undef PG8_SB
#undef PG8_STAGE
#undef PG8_LDA
#undef PG8_LDB
#undef PG8_MMA
#undef PG8_WAIT_V
#undef PG8_WAIT_L
#undef PG8_BAR
#undef PG8_SCHED
}
}
using pg8::Unit;

constexpr size_t MiB = 1u << 20;
constexpr size_t WS_CTL = 0, CTL_ZERO_BYTES = 64 * 1024;
constexpr size_t WS_PART = 35 * (1u << 20), PART_BYTES = (size_t)32768 * 4 * 8;
constexpr size_t WS_MOD = 1 * MiB;
constexpr size_t WS_COS = 2 * MiB, WS_SIN = 4 * MiB;
constexpr size_t WS_KR = 6 * MiB;
constexpr size_t WS_SSR = 10 * MiB;
constexpr size_t WS_WIN = 11 * MiB;
constexpr size_t WS_WQUP = 15 * MiB;
constexpr size_t WS_WKVUP = WS_WQUP + 512 * 1024;
constexpr size_t WS_WOUT = 16 * MiB;
constexpr size_t WS_WUP = 18 * MiB;
constexpr size_t WS_WDOWN = 29 * MiB;
constexpr size_t WS_XN = 36 * MiB;
constexpr size_t WS_QLN = 100 * MiB, WS_KVLN = 116 * MiB;
constexpr size_t WS_CQ = 132 * MiB, WS_CK = 164 * MiB, WS_CV = 196 * MiB;
constexpr size_t WS_QM = 228 * MiB, WS_KM = 276 * MiB;
constexpr size_t WS_VM = 324 * MiB;
constexpr size_t WS_OM = WS_XN;
constexpr size_t WS_ACT = 100 * MiB;
constexpr size_t WS_X1 = 276 * MiB;
constexpr size_t WS_RAW4 = 404 * MiB;
constexpr size_t WS_H2 = 448 * MiB;
constexpr size_t WS_END = 512 * MiB;
static_assert(WS_ACT + (size_t)MTOK * DFF * 2 <= WS_X1 && WS_X1 + (size_t)MTOK * DM * 4 <= WS_RAW4 && WS_RAW4 + (size_t)512 * 4 * DFF2 * 4 <= WS_END, "overlay map");
constexpr int CW_BAR = 1024;


struct EpiIn {
    static constexpr bool APERM = false;
    unsigned char* ws; const float *g_ql, *g_kvl, *g_caq, *g_cak;
    __device__ __forceinline__ void operator()(const f32x4 (&acc)[2][2][4][2], const Unit& u, int wr, int wc, int fr, int fq, LAS float* red) const {
        asm volatile("" : "+v"(fr), "+v"(fq), "+s"(wr), "+s"(wc));
        const int rl0 = wr * 64 + fr; const size_t row0 = (size_t)u.pm * 256 + rl0; const int pn = u.pn;
        bf16_t* const QLN = (bf16_t*)(ws + WS_QLN); bf16_t* const KVLN = (bf16_t*)(ws + WS_KVLN); bf16_t* const CQ = (bf16_t*)(ws + WS_CQ); bf16_t* const CK = (bf16_t*)(ws + WS_CK); bf16_t* const CV = (bf16_t*)(ws + WS_CV);
        float* const KR = (float*)(ws + WS_KR); float* const SSR = (float*)(ws + WS_SSR);
        if (pn >= 6) {
            bf16_t* base = CV + (pn - 6) * 256 + wc * 32 + 8 * fq;
#pragma unroll
            for (int ai = 0; ai < 2; ++ai)
#pragma unroll
                for (int m = 0; m < 4; ++m) { bf16_t* rp = base + (row0 + ai * 128 + m * 16) * 512;
#pragma unroll
                    for (int bj = 0; bj < 2; ++bj) *(u32x4*)(rp + bj * 128) = pack8(acc[ai][bj][m][0], acc[ai][bj][m][1]); }
        } else if (pn >= 2) {
            const bool isq = pn < 4; const int head = 4 * ((pn - 2) & 1) + wc; const float* g = isq ? g_caq : g_cak; const float sc = isq ? C2_CA : 1.0f;
            f32x4 gv[2][2];
#pragma unroll
            for (int bj = 0; bj < 2; ++bj)
#pragma unroll
                for (int n = 0; n < 2; ++n) gv[bj][n] = *(const f32x4*)(g + 32 * bj + 8 * fq + 4 * n) * sc;
            bf16_t* base = (isq ? CQ : CK) + head * 64 + 8 * fq;
#pragma unroll
            for (int ai = 0; ai < 2; ++ai)
#pragma unroll
                for (int m = 0; m < 4; ++m) {
                    float ss = (dot4(acc[ai][0][m][0]) + dot4(acc[ai][0][m][1])) + (dot4(acc[ai][1][m][0]) + dot4(acc[ai][1][m][1]));
                    ss += __shfl_xor(ss, 16); ss += __shfl_xor(ss, 32);
                    const float r = rsqrtf(ss * (1.0f / 64.0f) + EPS);
                    bf16_t* rp = base + (row0 + ai * 128 + m * 16) * 512;
#pragma unroll
                    for (int bj = 0; bj < 2; ++bj) *(u32x4*)(rp + bj * 32) = pack8(acc[ai][bj][m][0] * r * gv[bj][0], acc[ai][bj][m][1] * r * gv[bj][1]);
                }
        } else if (pn == 0) {
#pragma unroll
            for (int ai = 0; ai < 2; ++ai)
#pragma unroll
                for (int m = 0; m < 4; ++m) {
                    float ss = (dot4(acc[ai][0][m][0]) + dot4(acc[ai][0][m][1])) + (dot4(acc[ai][1][m][0]) + dot4(acc[ai][1][m][1]));
                    ss += __shfl_xor(ss, 16); ss += __shfl_xor(ss, 32);
                    if (fq == 0) red[(ai * 128 + m * 16 + rl0) * 8 + wc] = ss;
                }
            LDS_BARRIER();
            f32x4 gv[2][2];
#pragma unroll
            for (int bj = 0; bj < 2; ++bj)
#pragma unroll
                for (int n = 0; n < 2; ++n) gv[bj][n] = *(const f32x4*)(g_ql + 128 * bj + 32 * wc + 8 * fq + 4 * n);
            bf16_t* base = QLN + wc * 32 + 8 * fq;
#pragma unroll
            for (int ai = 0; ai < 2; ++ai)
#pragma unroll
                for (int m = 0; m < 4; ++m) {
                    const f32x4 t = *(const LAS f32x4*)(red + (ai * 128 + m * 16 + rl0) * 8);
                    const float r = rsqrtf(((t[0] + t[1]) + (t[2] + t[3])) * (1.0f / 256.0f) + EPS);
                    bf16_t* rp = base + (row0 + ai * 128 + m * 16) * 256;
#pragma unroll
                    for (int bj = 0; bj < 2; ++bj) *(u32x4*)(rp + bj * 128) = pack8(acc[ai][bj][m][0] * r * gv[bj][0], acc[ai][bj][m][1] * r * gv[bj][1]);
                }
        } else {
#pragma unroll
            for (int ai = 0; ai < 2; ++ai)
#pragma unroll
                for (int m = 0; m < 4; ++m) {
                    float ss = dot4(acc[ai][0][m][0]) + dot4(acc[ai][0][m][1]);
                    ss += __shfl_xor(ss, 16); ss += __shfl_xor(ss, 32);
                    if (fq == 0) red[(ai * 128 + m * 16 + rl0) * 8 + wc] = ss;
                }
            LDS_BARRIER();
            f32x4 gv[2];
#pragma unroll
            for (int n = 0; n < 2; ++n) gv[n] = *(const f32x4*)(g_kvl + 32 * wc + 8 * fq + 4 * n);
            bf16_t* base = KVLN + wc * 32 + 8 * fq;
#pragma unroll
            for (int ai = 0; ai < 2; ++ai)
#pragma unroll
                for (int m = 0; m < 4; ++m) {
                    const f32x4 t = *(const LAS f32x4*)(red + (ai * 128 + m * 16 + rl0) * 8);
                    const float r = rsqrtf(((t[0] + t[1]) + (t[2] + t[3])) * (1.0f / 128.0f) + EPS);
                    const size_t row = row0 + ai * 128 + m * 16;
                    bf16_t* rp = base + row * 256;
                    *(u32x4*)(rp) = pack8(acc[ai][0][m][0] * r * gv[0], acc[ai][0][m][1] * r * gv[1]);
                    *(u32x4*)(rp + 128) = (u32x4){0u, 0u, 0u, 0u};
                    if (wc == 0) {
                        *(f32x4*)(KR + row * 32 + 8 * fq) = acc[ai][1][m][0]; *(f32x4*)(KR + row * 32 + 8 * fq + 4) = acc[ai][1][m][1];
                        float sr = dot4(acc[ai][1][m][0]) + dot4(acc[ai][1][m][1]);
                        sr += __shfl_xor(sr, 16); sr += __shfl_xor(sr, 32);
                        if (fq == 0) SSR[row] = sr;
                    }
                }
        }
    }
};

struct EpiQ {
    static constexpr bool APERM = false;
    unsigned char* ws; const float* g;
    __device__ __forceinline__ void operator()(const f32x4 (&acc)[2][2][4][2], const Unit& u, int wr, int wc, int fr, int fq, LAS float* red) const {
        asm volatile("" : "+v"(fr), "+v"(fq), "+s"(wr), "+s"(wc));
        const int rl0 = wr * 64 + fr; const size_t row0 = (size_t)u.pm * 256 + rl0;
        bf16_t* const QM = (bf16_t*)(ws + WS_QM); const float* const cosT = (const float*)(ws + WS_COS); const float* const sinT = (const float*)(ws + WS_SIN);
#pragma unroll
        for (int ai = 0; ai < 2; ++ai)
#pragma unroll
            for (int m = 0; m < 4; ++m)
#pragma unroll
                for (int bj = 0; bj < 2; ++bj) {
                    float ss = dot4(acc[ai][bj][m][0]) + dot4(acc[ai][bj][m][1]);
                    ss += __shfl_xor(ss, 16); ss += __shfl_xor(ss, 32);
                    if (fq == 0) red[(ai * 128 + m * 16 + rl0) * 8 + bj * 4 + wc] = ss;
                }
        LDS_BARRIER();
        if (wc < 2) {
            const f32x4 g0 = *(const f32x4*)(g + 32 * wc + 8 * fq) * C2_MLA, g1 = *(const f32x4*)(g + 32 * wc + 8 * fq + 4) * C2_MLA;
#pragma unroll
            for (int ai = 0; ai < 2; ++ai)
#pragma unroll
                for (int m = 0; m < 4; ++m) {
                    const size_t row = row0 + ai * 128 + m * 16;
#pragma unroll
                    for (int bj = 0; bj < 2; ++bj) {
                        const f32x4 t = *(const LAS f32x4*)(red + (ai * 128 + m * 16 + rl0) * 8 + bj * 4);
                        const float r = rsqrtf(((t[0] + t[1]) + (t[2] + t[3])) * (1.0f / 96.0f) + EPS);
                        *(u32x4*)(QM + row * 768 + (2 * u.pn + bj) * 96 + 32 * wc + 8 * fq) = pack8(acc[ai][bj][m][0] * r * g0, acc[ai][bj][m][1] * r * g1);
                    }
                }
        } else if (wc == 2) {
            const f32x4 g0 = *(const f32x4*)(g + 64 + 4 * fq) * C2_MLA, g1 = *(const f32x4*)(g + 80 + 4 * fq) * C2_MLA;
#pragma unroll
            for (int ai = 0; ai < 2; ++ai)
#pragma unroll
                for (int m = 0; m < 4; ++m) {
                    const size_t row = row0 + ai * 128 + m * 16;
                    const f32x4 cs = *(const f32x4*)(cosT + row * 16 + 4 * fq), sn = *(const f32x4*)(sinT + row * 16 + 4 * fq);
#pragma unroll
                    for (int bj = 0; bj < 2; ++bj) {
                        const f32x4 t = *(const LAS f32x4*)(red + (ai * 128 + m * 16 + rl0) * 8 + bj * 4);
                        const float r = rsqrtf(((t[0] + t[1]) + (t[2] + t[3])) * (1.0f / 96.0f) + EPS);
                        bf16_t* hp = QM + row * 768 + (2 * u.pn + bj) * 96;
                        const f32x4 x1 = acc[ai][bj][m][0] * r * g0, x2 = acc[ai][bj][m][1] * r * g1;
                        *(u32x2*)(hp + 64 + 4 * fq) = pack4(x1 * cs - x2 * sn); *(u32x2*)(hp + 80 + 4 * fq) = pack4(x2 * cs + x1 * sn);
                    }
                    asm volatile("" ::: "memory");
                }
        }
    }
};

struct EpiKV {
    static constexpr bool APERM = false;
    unsigned char* ws; const float* g;
    __device__ __forceinline__ void operator()(const f32x4 (&acc)[2][2][4][2], const Unit& u, int wr, int wc, int fr, int fq, LAS float* red) const {
        asm volatile("" : "+v"(fr), "+v"(fq), "+s"(wr), "+s"(wc));
        const int rl0 = wr * 64 + fr; const size_t row0 = (size_t)u.pm * 256 + rl0;
        bf16_t* const KM = (bf16_t*)(ws + WS_KM); bf16_t* const VM = (bf16_t*)(ws + WS_VM); const float* const cosT = (const float*)(ws + WS_COS); const float* const sinT = (const float*)(ws + WS_SIN);
        const float* const KR = (const float*)(ws + WS_KR); const float* const SSR = (const float*)(ws + WS_SSR);
        if (wc < 2) {
#pragma unroll
            for (int ai = 0; ai < 2; ++ai)
#pragma unroll
                for (int m = 0; m < 4; ++m)
#pragma unroll
                    for (int bj = 0; bj < 2; ++bj) {
                        float ss = dot4(acc[ai][bj][m][0]) + dot4(acc[ai][bj][m][1]);
                        ss += __shfl_xor(ss, 16); ss += __shfl_xor(ss, 32);
                        if (fq == 0) red[(ai * 128 + m * 16 + rl0) * 8 + bj * 2 + wc] = ss;
                    }
        }
        LDS_BARRIER();
        if (wc < 2) {
            const f32x4 g0 = *(const f32x4*)(g + 32 * wc + 8 * fq), g1 = *(const f32x4*)(g + 32 * wc + 8 * fq + 4);
#pragma unroll
            for (int ai = 0; ai < 2; ++ai)
#pragma unroll
                for (int m = 0; m < 4; ++m) {
                    const size_t row = row0 + ai * 128 + m * 16;
                    const float ssr = SSR[row];
                    const f32x4 t = *(const LAS f32x4*)(red + (ai * 128 + m * 16 + rl0) * 8);
#pragma unroll
                    for (int bj = 0; bj < 2; ++bj) {
                        const float rk = rsqrtf((t[2 * bj] + t[2 * bj + 1] + ssr) * (1.0f / 96.0f) + EPS);
                        *(u32x4*)(KM + row * 768 + (2 * u.pn + bj) * 96 + 32 * wc + 8 * fq) = pack8(acc[ai][bj][m][0] * rk * g0, acc[ai][bj][m][1] * rk * g1);
                    }
                    asm volatile("" ::: "memory");
                }
        } else {
            const int bj0 = wc - 2, h0 = 2 * u.pn + bj0;
            const f32x4 g0 = *(const f32x4*)(g + 64 + 4 * fq), g1 = *(const f32x4*)(g + 80 + 4 * fq);
#pragma unroll
            for (int ai = 0; ai < 2; ++ai)
#pragma unroll
                for (int m = 0; m < 4; ++m) {
                    const size_t row = row0 + ai * 128 + m * 16;
#pragma unroll
                    for (int bj = 0; bj < 2; ++bj) *(u32x4*)(VM + row * 512 + (2 * u.pn + bj) * 64 + 32 * (wc - 2) + 8 * fq) = pack8(acc[ai][bj][m][0], acc[ai][bj][m][1]);
                    const f32x2 t = *(const LAS f32x2*)(red + (ai * 128 + m * 16 + rl0) * 8 + 2 * bj0);
                    const float rk = rsqrtf((t[0] + t[1] + SSR[row]) * (1.0f / 96.0f) + EPS);
                    const f32x4 cs = *(const f32x4*)(cosT + row * 16 + 4 * fq), sn = *(const f32x4*)(sinT + row * 16 + 4 * fq);
                    const f32x4 x1 = *(const f32x4*)(KR + row * 32 + 4 * fq) * rk * g0, x2 = *(const f32x4*)(KR + row * 32 + 16 + 4 * fq) * rk * g1;
                    bf16_t* hp = KM + row * 768 + h0 * 96;
                    *(u32x2*)(hp + 64 + 4 * fq) = pack4(x1 * cs - x2 * sn); *(u32x2*)(hp + 80 + 4 * fq) = pack4(x2 * cs + x1 * sn);
                    asm volatile("" ::: "memory");
                }
        }
    }
};

struct EpiQKV {
    static constexpr bool APERM = false;
    EpiQ q; EpiKV kv;
    __device__ __forceinline__ void operator()(const f32x4 (&acc)[2][2][4][2], const Unit& u, int wr, int wc, int fr, int fq, LAS float* red) const {
        if (u.pn < 4) q(acc, u, wr, wc, fr, fq, red);
        else { Unit v; v.pm = u.pm; v.pn = u.pn - 4; kv(acc, v, wr, wc, fr, fq, red); }
    }
};

template <bool NT> struct EpiRes {
    static constexpr bool APERM = false;
    const float* base; float* out; const float* gate;
    __device__ __forceinline__ void operator()(const f32x4 (&acc)[2][2][4][2], const Unit& u, int wr, int wc, int fr, int fq, LAS float* red) const {
        asm volatile("" : "+v"(fr), "+v"(fq), "+s"(wr), "+s"(wc));
        const int b = u.pm >> 3; const int col0 = u.pn * 256 + wc * 32 + 8 * fq;
        f32x4 gv[2][2];
#pragma unroll
        for (int bj = 0; bj < 2; ++bj)
#pragma unroll
            for (int n = 0; n < 2; ++n) gv[bj][n] = *(const f32x4*)(gate + (size_t)b * NMOD + col0 + 128 * bj + 4 * n);
#pragma unroll
        for (int ai = 0; ai < 2; ++ai)
#pragma unroll
            for (int m = 0; m < 4; ++m) {
                const size_t off = ((size_t)u.pm * 256 + ai * 128 + wr * 64 + m * 16 + fr) * DM + col0;
#pragma unroll
                for (int bj = 0; bj < 2; ++bj)
#pragma unroll
                    for (int n = 0; n < 2; ++n) { const f32x4* sp = (const f32x4*)(base + off + 128 * bj + 4 * n); f32x4* dp = (f32x4*)(out + off + 128 * bj + 4 * n);
                        if (NT) { const f32x4 xs = __builtin_nontemporal_load(sp); __builtin_nontemporal_store(xs + gv[bj][n] * acc[ai][bj][m][n], dp); }
                        else { const f32x4 xs = *sp; *dp = xs + gv[bj][n] * acc[ai][bj][m][n]; } }
                if (m & 1) asm volatile("" ::: "memory");
            }
    }
};

struct EpiResNorm {
    static constexpr bool APERM = false;
    const float* base; unsigned char* ws; const float* gate; const float* gn;
    __device__ __forceinline__ void operator()(f32x4 (&acc)[2][2][4][2], const Unit& u, int wr, int wc, int fr, int fq, LAS float* red) const {
        asm volatile("" : "+v"(fr), "+v"(fq), "+s"(wr), "+s"(wc));
        const int b = u.pm >> 3; const int col0 = u.pn * 256 + wc * 32 + 8 * fq; const int rl0 = wr * 64 + fr;
        float* const X1 = (float*)(ws + WS_X1); bf16_t* const H2 = (bf16_t*)(ws + WS_H2); const float* const MOD = (const float*)(ws + WS_MOD);
        {
            f32x4 gv[2][2];
#pragma unroll
            for (int bj = 0; bj < 2; ++bj)
#pragma unroll
                for (int n = 0; n < 2; ++n) gv[bj][n] = *(const f32x4*)(gate + (size_t)b * NMOD + col0 + 128 * bj + 4 * n);
#pragma unroll
            for (int ai = 0; ai < 2; ++ai)
#pragma unroll
                for (int m = 0; m < 4; ++m) {
                    const size_t off = ((size_t)u.pm * 256 + ai * 128 + m * 16 + rl0) * DM + col0; float ss = 0.f;
#pragma unroll
                    for (int bj = 0; bj < 2; ++bj)
#pragma unroll
                        for (int n = 0; n < 2; ++n) { const f32x4 xs = *(const f32x4*)(base + off + 128 * bj + 4 * n); const f32x4 v = xs + gv[bj][n] * acc[ai][bj][m][n]; acc[ai][bj][m][n] = v; *(f32x4*)(X1 + off + 128 * bj + 4 * n) = v; ss += dot4(v); }
                    ss += __shfl_xor(ss, 16); ss += __shfl_xor(ss, 32);
                    if (fq == 0) red[(ai * 128 + m * 16 + rl0) * 8 + wc] = ss;
                    if (m & 1) asm volatile("" ::: "memory");
                }
        }
        LDS_BARRIER();
        const int tid = threadIdx.x;
        if (tid < 256) {
            const f32x4 t = *(const LAS f32x4*)(red + tid * 8);
            const float mine = (t[0] + t[1]) + (t[2] + t[3]);
            unsigned long long* slot = (unsigned long long*)(ws + WS_PART) + ((size_t)u.pm * 256 + tid) * 4;
            __hip_atomic_store(slot + u.pn, (1ull << 32) | (unsigned long long)__float_as_uint(mine), __ATOMIC_RELAXED, __HIP_MEMORY_SCOPE_AGENT);
            float tot = mine;
#pragma unroll
            for (int k = 1; k < 4; ++k) { const int pk = (u.pn + k) & 3; unsigned long long w; unsigned sp = 0;
                for (;;) { w = __hip_atomic_load(slot + pk, __ATOMIC_RELAXED, __HIP_MEMORY_SCOPE_AGENT); if ((unsigned)(w >> 32) == 1u || ++sp > (1u << 22)) break; __builtin_amdgcn_s_sleep(1); }
                tot += __uint_as_float((unsigned)w); }
            red[tid * 8 + 4] = rsqrtf(tot * (1.0f / DM) + EPS);
        }
        LDS_BARRIER();
        {
            f32x4 Gv[2][2], Sv[2][2];
#pragma unroll
            for (int bj = 0; bj < 2; ++bj)
#pragma unroll
                for (int n = 0; n < 2; ++n) { const int c = col0 + 128 * bj + 4 * n;
                    Gv[bj][n] = *(const f32x4*)(gn + c) * (*(const f32x4*)(MOD + (size_t)b * NMOD + 4 * DM + c) + 1.0f); Sv[bj][n] = *(const f32x4*)(MOD + (size_t)b * NMOD + 3 * DM + c); }
#pragma unroll
            for (int ai = 0; ai < 2; ++ai)
#pragma unroll
                for (int m = 0; m < 4; ++m) {
                    const float r = red[(ai * 128 + m * 16 + rl0) * 8 + 4];
                    bf16_t* rp = H2 + ((size_t)u.pm * 256 + ai * 128 + m * 16 + rl0) * DM + col0;
#pragma unroll
                    for (int bj = 0; bj < 2; ++bj) *(u32x4*)(rp + 128 * bj) = pack8(acc[ai][bj][m][0] * r * Gv[bj][0] + Sv[bj][0], acc[ai][bj][m][1] * r * Gv[bj][1] + Sv[bj][1]);
                }
        }
    }
};

__device__ __forceinline__ float dpp_shr1(float v) { return __builtin_bit_cast(float, __builtin_amdgcn_update_dpp(0, __builtin_bit_cast(int, v), 0x111, 0xF, 0xF, false)); }
__device__ __forceinline__ f32x4 dpp_shr1(f32x4 v) { f32x4 r; r[0] = dpp_shr1(v[0]); r[1] = dpp_shr1(v[1]); r[2] = dpp_shr1(v[2]); r[3] = dpp_shr1(v[3]); return r; }
struct EpiUp {
    static constexpr bool APERM = true;
    unsigned char* ws; const float *cw, *cb;
    __device__ __forceinline__ void operator()(const f32x4 (&acc)[2][2][4][2], const Unit& u, int wr, int wc, int fr, int fq, LAS float* red) const {
        asm volatile("" : "+v"(fr), "+v"(fq), "+s"(wr), "+s"(wc));
        const int j = u.pn; const int cc0 = 32 * wc + 8 * fq;
        bf16_t* const ACT = (bf16_t*)(ws + WS_ACT); float* const RAW4 = (float*)(ws + WS_RAW4);
#pragma unroll
        for (int n = 0; n < 2; ++n) {
            const int gcol = 128 * j + cc0 + 4 * n, vcol = DFF + gcol;
            const f32x4 wg0 = *(const f32x4*)(cw + gcol), wg1 = *(const f32x4*)(cw + DFF2 + gcol), wg2 = *(const f32x4*)(cw + 2 * DFF2 + gcol), bg = *(const f32x4*)(cb + gcol);
            const f32x4 wv0 = *(const f32x4*)(cw + vcol), wv1 = *(const f32x4*)(cw + DFF2 + vcol), wv2 = *(const f32x4*)(cw + 2 * DFF2 + vcol), bv = *(const f32x4*)(cb + vcol);
#pragma unroll
            for (int ai = 0; ai < 2; ++ai) {
                const size_t blk = (size_t)u.pm * 4 + 2 * ai + wr;
                const f32x4 g2s = dpp_shr1(acc[ai][0][2][n]), g3s = dpp_shr1(acc[ai][0][3][n]), v2s = dpp_shr1(acc[ai][1][2][n]), v3s = dpp_shr1(acc[ai][1][3][n]);
#pragma unroll
                for (int m = 0; m < 4; ++m) {
                    const f32x4 gr = acc[ai][0][m][n], vr = acc[ai][1][m][n];
                    const f32x4 gp1 = m == 0 ? g3s : acc[ai][0][m - 1 < 0 ? 0 : m - 1][n], gp2 = m == 0 ? g2s : (m == 1 ? g3s : acc[ai][0][m - 2 < 0 ? 0 : m - 2][n]);
                    const f32x4 vp1 = m == 0 ? v3s : acc[ai][1][m - 1 < 0 ? 0 : m - 1][n], vp2 = m == 0 ? v2s : (m == 1 ? v3s : acc[ai][1][m - 2 < 0 ? 0 : m - 2][n]);
                    const f32x4 G = wg0 * gp2 + wg1 * gp1 + wg2 * gr + bg, V = wv0 * vp2 + wv1 * vp1 + wv2 * vr + bv;
                    f32x4 a;
#pragma unroll
                    for (int e = 0; e < 4; ++e) a[e] = G[e] * __builtin_amdgcn_rcpf(1.0f + __builtin_amdgcn_exp2f(-LOG2E * G[e])) * V[e];
                    const size_t row = blk * 64 + 4 * fr + m;
                    if (m >= 2 || fr > 0) *(u32x2*)(ACT + row * DFF + 128 * j + cc0 + 4 * n) = pack4(a);
                    if (m < 2 && fr == 0) { float* rp = RAW4 + (blk * 4 + m) * DFF2 + 256 * j + cc0 + 4 * n; *(f32x4*)rp = gr; *(f32x4*)(rp + 128) = vr; }
                    if (m >= 2 && fr == 15) { float* rp = RAW4 + (blk * 4 + m) * DFF2 + 256 * j + cc0 + 4 * n; *(f32x4*)rp = gr; *(f32x4*)(rp + 128) = vr; }
                }
            }
        }
    }
};

namespace att {
__device__ __forceinline__ int crow(int r, int hi) { return (r & 3) + 8 * (r >> 2) + 4 * hi; }
__device__ __forceinline__ void glds16(const void* gsrc, unsigned lds_dst) { unsigned keep;
    asm volatile("s_mov_b32 %0, m0\n\ts_mov_b32 m0, %2\n\ts_nop 0\n\tglobal_load_lds_dwordx4 %1, off\n\ts_mov_b32 m0, %0" : "=&s"(keep) : "v"(gsrc), "s"(lds_dst) : "memory"); }
__device__ __forceinline__ float max3f(float a, float b, float c) { float r; asm("v_max3_f32 %0, %1, %2, %3" : "=v"(r) : "v"(a), "v"(b), "v"(c)); return r; }
__device__ __forceinline__ float rowmax(const f32x16& p0, const f32x16& p1) {
    float a = max3f(p0[0], p0[1], p1[0]), b = max3f(p0[2], p0[3], p1[1]); a = max3f(a, p1[2], p1[3]);
#pragma unroll
    for (int r = 4; r < 16; r += 4) { a = max3f(a, p0[r], p0[r + 1]); b = max3f(b, p0[r + 2], p0[r + 3]); a = max3f(a, p1[r], p1[r + 1]); b = max3f(b, p1[r + 2], p1[r + 3]); }
    const float m = fmaxf(a, b);
    auto rr = __builtin_amdgcn_permlane32_swap(__float_as_uint(m), __float_as_uint(m), false, false);
    return fmaxf(__uint_as_float(rr[0]), __uint_as_float(rr[1]));
}
typedef short v4i16_t __attribute__((ext_vector_type(4)));
__device__ __forceinline__ s16x4 vtr(const LAS unsigned char* p) { return __builtin_bit_cast(s16x4, __builtin_amdgcn_ds_read_tr16_b64_v4i16((LAS v4i16_t*)p)); }
__device__ __forceinline__ void pv(f32x16* o, const LAS unsigned char* vp, bf16x8 pa0, bf16x8 pa1, bf16x8 pa2, bf16x8 pa3) {
#pragma unroll
    for (int d0 = 0; d0 < 2; ++d0) { s16x4 lo[4], hi[4];
        __builtin_amdgcn_sched_barrier(0);
#pragma unroll
        for (int ks = 0; ks < 4; ++ks) { lo[ks] = vtr(vp + d0 * 4096 + ks * 1024); hi[ks] = vtr(vp + d0 * 4096 + ks * 1024 + 512); }
#define PK(k) (bf16x8){lo[k][0], lo[k][1], lo[k][2], lo[k][3], hi[k][0], hi[k][1], hi[k][2], hi[k][3]}
        o[d0] = __builtin_amdgcn_mfma_f32_32x32x16_bf16(pa0, PK(0), o[d0], 0, 0, 0);
        o[d0] = __builtin_amdgcn_mfma_f32_32x32x16_bf16(pa1, PK(1), o[d0], 0, 0, 0);
        o[d0] = __builtin_amdgcn_mfma_f32_32x32x16_bf16(pa2, PK(2), o[d0], 0, 0, 0);
        o[d0] = __builtin_amdgcn_mfma_f32_32x32x16_bf16(pa3, PK(3), o[d0], 0, 0, 0);
#undef PK
    }
}
constexpr int NSLOT = 4;
constexpr int ATT_LDS_BYTES = 3 * 12288 + 3 * 8192 + 8 * 256 + 8 * 4096 + 2048;

template <int DQK, bool CA, int THR>
__device__ __forceinline__ void attn_unit(int tid, int b, int h, int u, const bf16_t* Q, const bf16_t* K, const bf16_t* V, bf16_t* O, const float* relb, LAS unsigned char* shm) {
    constexpr int ND = DQK / 16, NG = 2 * ND, NCH = DQK / 8, KSLOT = NCH * 1024, VSLOT = 8192, NS = 3;
    constexpr int NPK = (DQK == 96) ? 2 : 1, NP = NPK + 1;
    constexpr int LDS_K = 0, LDS_V = NS * KSLOT, LDS_WS = LDS_V + NS * VSLOT, LDS_OST = LDS_WS + 8 * 256, LDS_TAB = LDS_OST + 8 * 4096;
    constexpr int LDQ = CA ? 512 : 768, LDV = 512, LDO = 1024, OCOL = CA ? 512 : 0;
    const int lane = tid & 63, r32 = lane & 31, hi = lane >> 5; const int wid = __builtin_amdgcn_readfirstlane(tid >> 6);
    const long rowbase = (long)b * SEQ; const int q0 = u * 256;
    const bf16_t* Qw = Q + (rowbase + q0 + wid * 32) * LDQ + h * DQK;
    const unsigned lds0 = (unsigned)(uintptr_t)shm;
    LAS float* wsf = (LAS float*)(shm + LDS_WS) + wid * 64;
    LAS float* tab = (LAS float*)(shm + LDS_TAB);
    const int t0 = CA ? (4 * u - 8 > 0 ? 4 * u - 8 : 0) : 0, t1 = 4 * u + 3, cw = 4 * u + (wid >> 1);
    const int NT = t1 - t0 + 1;
    const bf16_t* Kh = K + (rowbase + (long)t0 * 64) * LDQ + h * DQK; const bf16_t* Vh = V + (rowbase + (long)t0 * 64) * LDV + h * 64;
    const bf16_t* ksrc = Kh + (long)lane * LDQ + wid * 8;
    const bf16_t* ksrc2 = Kh + (long)lane * LDQ + (8 + (wid & 3)) * 8;
    const bf16_t* vsrc = Vh + (long)(16 * (wid & 3) + (lane >> 2)) * LDV + (wid >> 2) * 32 + (lane & 3) * 8;
#define SBAR() __builtin_amdgcn_sched_barrier(0)
#define PIN(x) asm volatile("" : "+v"(x))
#define DMA_K(tau, sl) do { glds16(ksrc + (long)(tau) * 64 * LDQ, (unsigned)__builtin_amdgcn_readfirstlane(lds0 + LDS_K + (sl) * KSLOT + wid * 1024)); \
        if (DQK == 96) glds16(ksrc2 + (long)(tau) * 64 * LDQ, (unsigned)__builtin_amdgcn_readfirstlane(lds0 + LDS_K + (sl) * KSLOT + (8 + (wid & 3)) * 1024)); } while (0)
#define DMA_V(tau, sl) glds16(vsrc + (long)(tau) * 64 * LDV, (unsigned)__builtin_amdgcn_readfirstlane(lds0 + LDS_V + (sl) * VSLOT + wid * 1024))
#define WAIT_BAR(N) asm volatile("s_waitcnt vmcnt(%0) lgkmcnt(0)\n\ts_barrier" :: "n"(N) : "memory")
#define TVALID(tau) (CA ? ((tau) + t0 <= cw && (tau) + t0 >= cw - 8) : ((tau) + t0 <= cw))
    if (CA) { for (int i = tid; i < 320; i += 512) tab[i] = relb[h * 257 + (i < 256 ? i : 256)] * LOG2E; }
    DMA_K(0, 0); DMA_V(0, 0); DMA_K(1, 1); DMA_K(2, 2);
    bf16x8 qr[ND];
#pragma unroll
    for (int d0 = 0; d0 < ND; ++d0) qr[d0] = *(const bf16x8*)(Qw + (long)r32 * LDQ + d0 * 16 + hi * 8);
#pragma unroll
    for (int d0 = 0; d0 < ND; ++d0) asm volatile("" :: "v"(qr[d0]));
    float mrun = -1e30f, l_reg = 0.f; f32x16 o[2]; o[0] = f32x16{}; o[1] = f32x16{};
    const LAS unsigned char* vp0 = shm + LDS_V + ((lane >> 4) & 1) * 32 + (lane & 3) * 8 + (4 * hi + ((lane & 15) >> 2)) * 64;
    const LAS unsigned char* kp0 = shm + LDS_K + hi * 1024 + r32 * 16;
    bf16x8 kf[NG]; s16x4 vlo[8], vhi[8]; u32x4 pw0, pw1, pw2, pw3; f32x16 pA0, pA1, pB0, pB1; bool resc = false;
#define BIAS_TILE(P0, P1, tau) do { if (CA) { const int dist = cw - ((tau) + t0); \
            if (dist >= 3 || dist < 0) { const float c = tab[256]; _Pragma("unroll") for (int r = 0; r < 16; ++r) { P0[r] += c; P1[r] += c; } } \
            else { const int bi = 64 * dist + 32 * (wid & 1) + r32 + 128 - 4 * hi; \
                _Pragma("unroll") for (int r = 0; r < 16; ++r) { P0[r] += tab[bi - ((r & 3) + 8 * (r >> 2))]; P1[r] += tab[bi - 32 - ((r & 3) + 8 * (r >> 2))]; } } } } while (0)
#define DECIDE(P0, P1) do { const float rm = rowmax(P0, P1); resc = false; \
        if (__any(rm > mrun + (float)THR)) { const float mn = fmaxf(mrun, rm), f = __builtin_amdgcn_exp2f(mrun - mn); mrun = mn; l_reg *= f; if (hi == 0) wsf[r32] = f; resc = true; } } while (0)
#define RESC() do { if (resc) { _Pragma("unroll") for (int r = 0; r < 16; ++r) { const float fr_ = wsf[crow(r, hi)]; o[0][r] *= fr_; o[1][r] *= fr_; } } } while (0)
#define VRD(i, vp_) do { vlo[i] = vtr((vp_) + ((i) >> 2) * 4096 + ((i) & 3) * 1024); vhi[i] = vtr((vp_) + ((i) >> 2) * 4096 + ((i) & 3) * 1024 + 512); } while (0)
#define VFR(i) (bf16x8){vlo[i][0], vlo[i][1], vlo[i][2], vlo[i][3], vhi[i][0], vhi[i][1], vhi[i][2], vhi[i][3]}
#define PEL(P0, P1, e) ((e) < 16 ? P0[(e) & 15] : P1[(e) & 15])
#define PWSET(w, val) do { if ((w) < 4) pw0[(w) & 3] = (val); else if ((w) < 8) pw1[(w) & 3] = (val); else if ((w) < 12) pw2[(w) & 3] = (val); else pw3[(w) & 3] = (val); } while (0)
#define PWGET(k) ((k) == 0 ? pw0 : (k) == 1 ? pw1 : (k) == 2 ? pw2 : pw3)
#define PHASE_A(C0, C1, P0, P1, tau, vsl) do { const LAS unsigned char* vp_ = vp0 + (vsl) * VSLOT; float sacc = 0.f; \
        const float ci_ = TVALID(tau) ? 0.f : -INFINITY; f32x16 cz_; _Pragma("unroll") for (int r = 0; r < 16; ++r) cz_[r] = ci_; SBAR(); \
        _Pragma("unroll") for (int i = 0; i < NG; ++i) { \
            if (i < 8) { VRD((i >> 1) + 4 * (i & 1), vp_); SBAR(); } \
            if ((i & 1) == 0) C0 = __builtin_amdgcn_mfma_f32_32x32x16_bf16(kf[i], qr[i >> 1], i < 2 ? cz_ : C0, 0, 0, 0); \
            else C1 = __builtin_amdgcn_mfma_f32_32x32x16_bf16(kf[i], qr[i >> 1], i < 2 ? cz_ : C1, 0, 0, 0); \
            _Pragma("unroll") for (int e = (32 * i) / NG; e < (32 * (i + 1)) / NG; ++e) sacc += PEL(P0, P1, e); \
            PIN(sacc); \
            _Pragma("unroll") for (int w = (16 * i) / NG; w < (16 * (i + 1)) / NG; ++w) PWSET(w, cvtpk(PEL(P0, P1, 2 * w), PEL(P0, P1, 2 * w + 1))); \
            PIN(pw0); PIN(pw1); PIN(pw2); PIN(pw3); SBAR(); } \
        l_reg += sacc; } while (0)
#define PHASE_B(C0, C1, GL, ksl) do { const LAS unsigned char* kb_ = kp0 + (ksl) * KSLOT; \
        _Pragma("unroll") for (int j = 0; j < 8; ++j) { \
            if (GL) { _Pragma("unroll") for (int rr = (NG * j) / 8; rr < (NG * (j + 1)) / 8; ++rr) kf[rr] = *(const LAS bf16x8*)(kb_ + (rr >> 1) * 2048 + (rr & 1) * 512); SBAR(); } \
            o[j & 1] = __builtin_amdgcn_mfma_f32_32x32x16_bf16(__builtin_bit_cast(bf16x8, PWGET(j >> 1)), VFR((j >> 1) + 4 * (j & 1)), o[j & 1], 0, 0, 0); \
            _Pragma("unroll") for (int e = 4 * j; e < 4 * j + 4; ++e) { if (e < 16) C0[e & 15] = __builtin_amdgcn_exp2f(C0[e & 15] - mrun); else C1[e & 15] = __builtin_amdgcn_exp2f(C1[e & 15] - mrun); } \
            PIN(C0); PIN(C1); SBAR(); } } while (0)
    WAIT_BAR(1 + 2 * NPK);
    { const float ci_ = TVALID(0) ? 0.f : -INFINITY; f32x16 cz_;
#pragma unroll
      for (int r = 0; r < 16; ++r) cz_[r] = ci_;
#pragma unroll
      for (int d0 = 0; d0 < ND; ++d0) { const bf16x8 b0 = *(const LAS bf16x8*)(kp0 + d0 * 2048), b1 = *(const LAS bf16x8*)(kp0 + d0 * 2048 + 512);
          pA0 = __builtin_amdgcn_mfma_f32_32x32x16_bf16(b0, qr[d0], d0 == 0 ? cz_ : pA0, 0, 0, 0); pA1 = __builtin_amdgcn_mfma_f32_32x32x16_bf16(b1, qr[d0], d0 == 0 ? cz_ : pA1, 0, 0, 0); } }
    BIAS_TILE(pA0, pA1, 0); DECIDE(pA0, pA1);
#pragma unroll
    for (int r = 0; r < 16; ++r) { pA0[r] = __builtin_amdgcn_exp2f(pA0[r] - mrun); pA1[r] = __builtin_amdgcn_exp2f(pA1[r] - mrun); }
    WAIT_BAR(0);
    DMA_K(3, 0); DMA_V(1, 1);
#pragma unroll
    for (int rr = 0; rr < NG; ++rr) kf[rr] = *(const LAS bf16x8*)(kp0 + 1 * KSLOT + (rr >> 1) * 2048 + (rr & 1) * 512);
    WAIT_BAR(NP);
    int sl_prev = 0, sl_cur = 1, sl_next = 2;
#define ROT() do { sl_prev = sl_cur; sl_cur = sl_next; sl_next = (sl_next == NS - 1) ? 0 : sl_next + 1; } while (0)
#define STEP(C0, C1, P0, P1, tau, GK, GV, GL) do { SBAR(); \
        PHASE_A(C0, C1, P0, P1, tau, sl_prev); \
        if (GK) DMA_K((tau) + 3, sl_cur); if (GV) DMA_V((tau) + 1, sl_next); \
        BIAS_TILE(C0, C1, tau); DECIDE(C0, C1); SBAR(); \
        PHASE_B(C0, C1, GL, sl_next); } while (0)
#define ENDW(tau) do { if ((tau) + 3 < NT) { WAIT_BAR(NP); } else if ((tau) + 2 < NT) { WAIT_BAR(1); } else { WAIT_BAR(0); } } while (0)
    int tau = 1;
    for (; tau + 5 < NT; tau += 2) {
        STEP(pB0, pB1, pA0, pA1, tau, true, true, true);     WAIT_BAR(NP); RESC(); ROT();
        STEP(pA0, pA1, pB0, pB1, tau + 1, true, true, true); WAIT_BAR(NP); RESC(); ROT();
    }
    for (; tau + 1 < NT; tau += 2) {
        STEP(pB0, pB1, pA0, pA1, tau, (tau + 3 < NT), (tau + 1 < NT), (tau + 1 < NT));     ENDW(tau);     RESC(); ROT();
        STEP(pA0, pA1, pB0, pB1, tau + 1, (tau + 4 < NT), (tau + 2 < NT), (tau + 2 < NT)); ENDW(tau + 1); RESC(); ROT();
    }
    STEP(pB0, pB1, pA0, pA1, NT - 1, false, false, false); RESC();
    { float sacc = 0.f;
#pragma unroll
      for (int r = 0; r < 16; ++r) sacc += pB0[r] + pB1[r];
      l_reg += sacc;
      pw0 = (u32x4){cvtpk(pB0[0], pB0[1]), cvtpk(pB0[2], pB0[3]), cvtpk(pB0[4], pB0[5]), cvtpk(pB0[6], pB0[7])}; pw1 = (u32x4){cvtpk(pB0[8], pB0[9]), cvtpk(pB0[10], pB0[11]), cvtpk(pB0[12], pB0[13]), cvtpk(pB0[14], pB0[15])};
      pw2 = (u32x4){cvtpk(pB1[0], pB1[1]), cvtpk(pB1[2], pB1[3]), cvtpk(pB1[4], pB1[5]), cvtpk(pB1[6], pB1[7])}; pw3 = (u32x4){cvtpk(pB1[8], pB1[9]), cvtpk(pB1[10], pB1[11]), cvtpk(pB1[12], pB1[13]), cvtpk(pB1[14], pB1[15])};
      pv(o, vp0 + sl_cur * VSLOT, __builtin_bit_cast(bf16x8, pw0), __builtin_bit_cast(bf16x8, pw1), __builtin_bit_cast(bf16x8, pw2), __builtin_bit_cast(bf16x8, pw3)); }
    { auto rr = __builtin_amdgcn_permlane32_swap(__float_as_uint(l_reg), __float_as_uint(l_reg), false, false); l_reg = __uint_as_float(rr[0]) + __uint_as_float(rr[1]); }
    if (hi == 0) wsf[32 + r32] = l_reg;
    float rli[16];
#pragma unroll
    for (int r = 0; r < 16; ++r) rli[r] = __builtin_amdgcn_rcpf(wsf[32 + crow(r, hi)]);
    bf16_t* Ow = O + (rowbase + q0 + wid * 32) * LDO + OCOL + h * 64;
    { LAS bf16_t* stg = (LAS bf16_t*)(shm + LDS_OST) + wid * 2048;
#pragma unroll
        for (int r = 0; r < 16; ++r) { const int orow = crow(r, hi);
#pragma unroll
            for (int d0 = 0; d0 < 2; ++d0) { const unsigned w = cvtpk(o[d0][r] * rli[r], 0.f); stg[orow * 64 + d0 * 32 + r32] = (bf16_t)(w & 0xffffu); } }
#pragma unroll
        for (int i = 0; i < 4; ++i) { const int row = i * 8 + (lane >> 3), ch = lane & 7; const u32x4 v = *(const LAS u32x4*)(stg + row * 64 + ch * 8); *(u32x4*)(Ow + (long)row * LDO + ch * 8) = v; } }
    asm volatile("s_waitcnt lgkmcnt(0)\n\ts_barrier" ::: "memory");
#undef SBAR
#undef PIN
#undef DMA_K
#undef DMA_V
#undef WAIT_BAR
#undef TVALID
#undef BIAS_TILE
#undef DECIDE
#undef RESC
#undef VRD
#undef VFR
#undef PEL
#undef PWSET
#undef PWGET
#undef PHASE_A
#undef PHASE_B
#undef ROT
#undef STEP
#undef ENDW
}
}

constexpr int NWAVES = 8;
constexpr int NPHASE = 10;
constexpr int N_LAUNCHES = MK_N_LAUNCHES;
static_assert(N_LAUNCHES == 1 || N_LAUNCHES == NPHASE, "MK_N_LAUNCHES is 1 or 10");

constexpr int RING_BYTES = 131072, LDSCTL_OFF = RING_BYTES, MISC_OFF = LDSCTL_OFF + 320, XL_OFF = LDSCTL_OFF + 1024, LDS_BYTES = 147456;
static_assert(XL_OFF + 8192 <= LDS_BYTES && att::ATT_LDS_BYTES <= RING_BYTES, "LDS map");

typedef GAS unsigned gu32;
#define RLX_AGENT __ATOMIC_RELAXED, __HIP_MEMORY_SCOPE_AGENT

#define XB_TMO      128
#define XB_XCNT(j)  (256  + 64 * (j))
#define XB_XSUB(j)  (1280 + 64 * (j))
#define XB_XGEN(j)  (2304 + 64 * (j))
#define XB_TOP      3328
#define XB_TOPGEN   3392
#define XCD_BAR_WORDS 3456
#define XB_SPIN_CAP (1u << 18)
__device__ __forceinline__ unsigned xb_ld(unsigned* p)              { return __hip_atomic_load(p, __ATOMIC_RELAXED, __HIP_MEMORY_SCOPE_AGENT); }
__device__ __forceinline__ unsigned xb_add(unsigned* p, unsigned v) { return __hip_atomic_fetch_add(p, v, __ATOMIC_RELAXED, __HIP_MEMORY_SCOPE_AGENT); }
__device__ __forceinline__ unsigned xb_xcc_id() { return (unsigned)__builtin_amdgcn_s_getreg((3 << 11) | 20) & 0xFu; }
#define XB_SPIN(cond, bar) do { unsigned _sp = 0; while (cond) { __builtin_amdgcn_s_sleep(1); \
    if ((++_sp & 255u) == 0u) { if (xb_ld(&(bar)[XB_TMO])) break; if (_sp > XB_SPIN_CAP) { atomicAdd(&(bar)[XB_TMO], 1u); break; } } } } while (0)
struct XcdBarrier { unsigned* bar; unsigned x; volatile LAS unsigned* st; };
__device__ __forceinline__ XcdBarrier xcd_barrier_post(unsigned* bar, volatile LAS unsigned* st) {
    XcdBarrier b; b.bar = bar; b.x = xb_xcc_id(); b.st = st;
    if (threadIdx.x == 0) (void)xb_add(&bar[XB_XCNT(b.x)], 1u);
    return b;
}
__device__ __forceinline__ void xcd_barrier_complete(unsigned* bar, unsigned x, unsigned& nloc, unsigned& nx) {
    const unsigned G = gridDim.x * gridDim.y * gridDim.z;
    unsigned sum, cnt, mine, sp = 0u;
    for (;;) {
        sum = 0u; cnt = 0u; mine = 0u;
#pragma unroll
        for (unsigned j = 0; j < 16; ++j) { const unsigned c = xb_ld(&bar[XB_XCNT(j)]); sum += c; cnt += (c > 0u) ? 1u : 0u; mine = (j == x) ? c : mine; }
        if (sum == G) break;
        __builtin_amdgcn_s_sleep(1);
        if ((++sp & 255u) == 0u) { if (xb_ld(&bar[XB_TMO])) break; if (sp > XB_SPIN_CAP) { atomicAdd(&bar[XB_TMO], 1u); break; } }
    }
    nloc = mine > 0u ? mine : 1u; nx = cnt > 0u ? cnt : 1u;
}
__device__ __forceinline__ void xcd_barrier(const XcdBarrier& b) {
    asm volatile("s_waitcnt vmcnt(0)" ::: "memory");
    __syncthreads();
    if (threadIdx.x == 0) {
        unsigned* bar = b.bar;
        __builtin_amdgcn_s_waitcnt(0);
        unsigned nloc = b.st[0], nx = b.st[1];
        if (nloc == 0u) { xcd_barrier_complete(bar, b.x, nloc, nx); b.st[0] = nloc; b.st[1] = nx; }
        const unsigned old = xb_add(&bar[XB_XSUB(b.x)], 1u);
        const unsigned gen = old / nloc;
        if (old + 1u == (gen + 1u) * nloc) {
            __builtin_amdgcn_fence(__ATOMIC_RELEASE, "agent");
            asm volatile("s_waitcnt vmcnt(0)" ::: "memory");
            const unsigned og = xb_add(&bar[XB_TOP], 1u);
            const unsigned tg = og / nx;
            if (og + 1u == (tg + 1u) * nx) xb_add(&bar[XB_TOPGEN], 1u);
            else XB_SPIN(xb_ld(&bar[XB_TOPGEN]) == tg, bar);
            __builtin_amdgcn_fence(__ATOMIC_ACQUIRE, "agent");
            xb_add(&bar[XB_XGEN(b.x)], 1u);
            asm volatile("s_waitcnt vmcnt(0)" ::: "memory");
        } else {
            XB_SPIN(xb_ld(&bar[XB_XGEN(b.x)]) == gen, bar);
            __builtin_amdgcn_fence(__ATOMIC_ACQUIRE, "agent");
            asm volatile("s_waitcnt vmcnt(0)" ::: "memory");
        }
    }
    __syncthreads();
}

struct Args { const void* in[22]; float* out; unsigned char* ws; int ph_lo, ph_hi, li, pad; };
#define ARGF(k) ((const float*)args.in[k])
struct Frame {
    LAS unsigned char* lds; LAS float* xl;
    int tid, lane, wave, vcu, G;
    unsigned char* ws;
};

template <int WHICH> __device__ __forceinline__ int wmap(int n) {
    if (WHICH == 0) {
        if (n < 256) return n;
        if (n < 512) { const int c = n - 256; return c < 160 ? 256 + c : -1; }
        if (n < 1536) { const int t4 = (n - 512) >> 8, which = t4 >> 1, jj = t4 & 1, c = (n - 512) & 255, bj = c >> 7, wc = (c >> 5) & 3, i = c & 31; return 416 + which * 512 + (4 * jj + wc) * 64 + 32 * bj + i; }
        return 416 + 1024 + (n - 1536);
    } else if (WHICH == 1) {
        const int pn = n >> 8, c = n & 255, bj = c >> 7, wc = (c >> 5) & 3, i = c & 31, head = 2 * pn + bj;
        if (wc < 2) return head * 96 + 32 * wc + i;
        if (wc == 2) { const int fq = i >> 3, nn = (i >> 2) & 1, e = i & 3; return head * 96 + 64 + 4 * fq + e + 16 * nn; }
        return -1;
    } else if (WHICH == 2) {
        const int pn = n >> 8, c = n & 255, bj = c >> 7, wc = (c >> 5) & 3, i = c & 31, head = 2 * pn + bj;
        return wc < 2 ? head * 128 + 32 * wc + i : head * 128 + 64 + 32 * (wc - 2) + i;
    } else if (WHICH == 4) {
        const int j = n >> 8, c = n & 255; return c < 128 ? 128 * j + c : DFF + 128 * j + (c - 128);
    }
    return n;
}
template <int WHICH> __device__ __forceinline__ void cvt_item(const float* W, int K, int N, bf16_t* WT, int KP, int NP, LAS float* scr, int item, int lane) {
    const int nblk = NP / 32, kb = item / nblk, nb = item % nblk, k0 = 64 * kb, n0 = 32 * nb;
    const int src = wmap<WHICH>(n0 + (lane & 31)); const bool live = (src >= 0) && (k0 < K);
    float wv[32];
#pragma unroll
    for (int i = 0; i < 32; ++i) { const int kk = 2 * i + (lane >> 5); wv[i] = live ? __builtin_nontemporal_load(W + (size_t)(k0 + kk) * N + src) : 0.f; }
#pragma unroll
    for (int i = 0; i < 32; ++i) { const int kk = 2 * i + (lane >> 5); scr[kk * 33 + (lane & 31)] = wv[i]; }
    asm volatile("s_waitcnt lgkmcnt(0)" ::: "memory");
    const int c = lane & 7;
#pragma unroll
    for (int j = 0; j < 4; ++j) { const int n = (lane >> 3) + 8 * j; const LAS float* s = scr + (8 * c) * 33 + n;
        u32x4 o; o.x = cvtpk(s[0 * 33], s[1 * 33]); o.y = cvtpk(s[2 * 33], s[3 * 33]); o.z = cvtpk(s[4 * 33], s[5 * 33]); o.w = cvtpk(s[6 * 33], s[7 * 33]);
        *(u32x4*)(WT + (size_t)(n0 + n) * KP + k0 + 8 * c) = o; }
    asm volatile("s_waitcnt lgkmcnt(0)" ::: "memory");
}
__device__ __forceinline__ void p0_prologue(Frame& F, const Args& args) {
    LAS float* scr = (LAS float*)(F.lds) + F.wave * 4096;
    const int gw = F.vcu * NWAVES + F.wave, NGW = F.G * NWAVES;
    constexpr int I0 = 16 * 64, I1 = 4 * 32, I2 = 4 * 32, I3 = 16 * 32, I4 = 16 * 176, I5 = 44 * 32;
    constexpr int NITEMS = I0 + I1 + I2 + I3 + I4 + I5;
    for (int it = gw; it < NITEMS; it += NGW) {
        int r = it;
        if (r < I0) { cvt_item<0>(ARGF(6), 1024, 1952, (bf16_t*)(F.ws + WS_WIN), 1024, 2048, scr, r, F.lane); continue; } r -= I0;
        if (r < I1) { cvt_item<1>(ARGF(9), 256, 768, (bf16_t*)(F.ws + WS_WQUP), 256, 1024, scr, r, F.lane); continue; } r -= I1;
        if (r < I2) { cvt_item<2>(ARGF(10), 128, 1024, (bf16_t*)(F.ws + WS_WKVUP), 256, 1024, scr, r, F.lane); continue; } r -= I2;
        if (r < I3) { cvt_item<3>(ARGF(16), 1024, 1024, (bf16_t*)(F.ws + WS_WOUT), 1024, 1024, scr, r, F.lane); continue; } r -= I3;
        if (r < I4) { cvt_item<4>(ARGF(18), 1024, DFF2, (bf16_t*)(F.ws + WS_WUP), 1024, DFF2, scr, r, F.lane); continue; } r -= I4;
        cvt_item<5>(ARGF(21), DFF, 1024, (bf16_t*)(F.ws + WS_WDOWN), DFF, 1024, scr, r, F.lane);
    }
    {
        float* cosT = (float*)(F.ws + WS_COS); float* sinT = (float*)(F.ws + WS_SIN);
        const int gt = F.vcu * (NWAVES * 64) + F.tid, NT = F.G * NWAVES * 64;
        for (int idx = gt; idx < MTOK * 16; idx += NT) {
            const int m = idx >> 4, i = idx & 15;
            const float inv = __builtin_amdgcn_exp2f(-(float)i * (13.287712379549449f / 16.0f));
            const float ang = (float)((const int*)args.in[2])[m] * inv;
            const float n = rintf(ang * 0.15915494309189535f);
            float r = fmaf(-n, 6.2831854820251465f, ang); r = fmaf(-n, -1.7484555e-7f, r);
            cosT[idx] = __cosf(r); sinT[idx] = __sinf(r);
        }
    }
}
__device__ __forceinline__ void p0_mod(Frame& F, const Args& args) {
    LAS float* scr = (LAS float*)(F.lds) + F.wave * 4096;
    if (F.vcu < 192) {
        const int n0 = F.vcu * 32, kbase = F.wave * 128, col = F.lane & 31, kh = F.lane >> 5;
        for (int idx = F.lane; idx < 2048; idx += 64) { const int b = idx >> 7, k = idx & 127; const float xv = ARGF(1)[b * 1024 + kbase + k]; scr[k * 16 + b] = xv / (1.0f + __expf(-xv)); }
        asm volatile("s_waitcnt lgkmcnt(0)" ::: "memory");
        f32x4 a0 = {0.f, 0.f, 0.f, 0.f}, a1 = a0, a2 = a0, a3 = a0;
#pragma unroll 8
        for (int i = 0; i < 64; ++i) { const int k = 2 * i + kh;
            const float w = ARGF(3)[(size_t)(kbase + k) * NMOD + n0 + col];
            const LAS f32x4* sp = (const LAS f32x4*)(scr + k * 16);
            a0 += sp[0] * w; a1 += sp[1] * w; a2 += sp[2] * w; a3 += sp[3] * w;
        }
#pragma unroll
        for (int e = 0; e < 4; ++e) { a0[e] += __shfl_xor(a0[e], 32); a1[e] += __shfl_xor(a1[e], 32); a2[e] += __shfl_xor(a2[e], 32); a3[e] += __shfl_xor(a3[e], 32); }
        if (kh == 0) {
#pragma unroll
            for (int e = 0; e < 4; ++e) { scr[2048 + (0 + e) * 32 + col] = a0[e]; scr[2048 + (4 + e) * 32 + col] = a1[e]; scr[2048 + (8 + e) * 32 + col] = a2[e]; scr[2048 + (12 + e) * 32 + col] = a3[e]; } }
        __syncthreads();
        float* MOD = (float*)(F.ws + WS_MOD);
        { const int b = 2 * F.wave + kh; float s = ARGF(4)[n0 + col];
#pragma unroll
            for (int w2 = 0; w2 < 8; ++w2) s += ((LAS float*)F.lds)[w2 * 4096 + 2048 + b * 32 + col];
            MOD[(size_t)b * NMOD + n0 + col] = s; }
    }
}
__device__ __forceinline__ float wave_sum(float v) {
#pragma unroll
    for (int o = 1; o < 64; o <<= 1) v += __shfl_xor(v, o);
    return v;
}
__device__ __forceinline__ void norm_rows(Frame& F, const float* X, const float* g, int shift_off, int scale_off, bf16_t* out) {
    const float* MOD = (const float*)(F.ws + WS_MOD);
    const int gw = F.vcu * NWAVES + F.wave, NGW = F.G * NWAVES;
    for (int m = gw; m < MTOK; m += NGW) {
        const int b = m >> 11;
        const f32x4* xr = (const f32x4*)(X + (size_t)m * DM) + F.lane;
        f32x4 v[4]; float s = 0.f;
#pragma unroll
        for (int j = 0; j < 4; ++j) { v[j] = xr[64 * j]; s += dot4(v[j]); }
        const float r = rsqrtf(wave_sum(s) * (1.0f / DM) + EPS);
        const f32x4* gp = (const f32x4*)g + F.lane; const f32x4* shp = (const f32x4*)(MOD + (size_t)b * NMOD + shift_off) + F.lane; const f32x4* scp = (const f32x4*)(MOD + (size_t)b * NMOD + scale_off) + F.lane;
        u32x2* o8 = (u32x2*)(out + (size_t)m * DM) + F.lane;
#pragma unroll
        for (int j = 0; j < 4; ++j) { const f32x4 y = v[j] * r * gp[64 * j] * (scp[64 * j] + 1.0f) + shp[64 * j]; o8[64 * j] = pack4(y); }
    }
}
__device__ __forceinline__ void conv_fixup(Frame& F, const Args& args) {
    const float* RAW4 = (const float*)(F.ws + WS_RAW4); bf16_t* ACT = (bf16_t*)(F.ws + WS_ACT);
    const int gt = F.vcu * (NWAVES * 64) + F.tid, NT = F.G * NWAVES * 64;
    for (int idx = gt; idx < 512 * DFF; idx += NT) {
        const int blk = idx / DFF, c = idx - blk * DFF, j = c >> 7, cc = c & 127;
        const bool first = (blk & 31) == 0;
        float o[2][2];
#pragma unroll
        for (int half = 0; half < 2; ++half) {
            const int tcol = 256 * j + 128 * half + cc, ocol = half * DFF + c;
            const float w0 = ARGF(19)[ocol], w1 = ARGF(19)[DFF2 + ocol], w2 = ARGF(19)[2 * DFF2 + ocol], bb = ARGF(20)[ocol];
            const float pm2 = first ? 0.f : RAW4[((size_t)(blk - 1) * 4 + 2) * DFF2 + tcol], pm1 = first ? 0.f : RAW4[((size_t)(blk - 1) * 4 + 3) * DFF2 + tcol];
            const float r0 = RAW4[((size_t)blk * 4 + 0) * DFF2 + tcol], r1 = RAW4[((size_t)blk * 4 + 1) * DFF2 + tcol];
            o[half][0] = w0 * pm2 + w1 * pm1 + w2 * r0 + bb; o[half][1] = w0 * pm1 + w1 * r0 + w2 * r1 + bb;
        }
#pragma unroll
        for (int rr = 0; rr < 2; ++rr) { const float G = o[0][rr], a = G / (1.0f + __expf(-G)) * o[1][rr];
            ACT[((size_t)blk * 64 + rr) * DFF + c] = (bf16_t)(cvtpk(a, 0.f) & 0xffffu); }
    }
}

__global__ void __launch_bounds__(NWAVES * 64, 2) fwd_kernel(Args args) {
    extern __shared__ __attribute__((aligned(16))) unsigned char lds_raw[];
    Frame F;
    F.lds = (LAS unsigned char*)lds_raw; F.xl = (LAS float*)(F.lds + XL_OFF);
    F.tid = threadIdx.x; F.lane = F.tid & 63; F.wave = __builtin_amdgcn_readfirstlane(F.tid >> 6);
    F.G = gridDim.x; { const int bx = blockIdx.x; F.vcu = (F.G % 8 == 0) ? (bx % 8) * (F.G / 8) + bx / 8 : bx; }
    F.ws = args.ws;
    unsigned char* ws = args.ws;
    for (int u = F.tid; u < (LDS_BYTES - LDSCTL_OFF) / 4; u += NWAVES * 64) ((LAS unsigned*)(F.lds + LDSCTL_OFF))[u] = 0u;
    __syncthreads();
    XcdBarrier bar; bar.bar = (unsigned*)(ws + WS_CTL) + CW_BAR; bar.x = 0; bar.st = nullptr;
    if (N_LAUNCHES == 1) bar = xcd_barrier_post((unsigned*)(ws + WS_CTL) + CW_BAR, (volatile LAS unsigned*)(F.lds + MISC_OFF) + 8);
#define GRID_BAR() do { if (N_LAUNCHES == 1) xcd_barrier(bar); } while (0)
    const int lo = args.ph_lo, hi = args.ph_hi;
#ifndef PH_MASK
#define PH_MASK 0x3ff
#endif
#define IN(k) (((PH_MASK >> (k)) & 1) && lo <= (k) && (k) < hi)
#define BOTH(k) (IN(k) && IN((k) + 1))
    float* MOD = (float*)(ws + WS_MOD);
    bf16_t* XN = (bf16_t*)(ws + WS_XN);

#define REFRESH_TID() do { int t_ = threadIdx.x; asm volatile("" : "+v"(t_)); t_ &= 511; F.tid = t_; F.lane = t_ & 63; } while (0)
    if (IN(0)) { REFRESH_TID(); p0_mod(F, args); if (BOTH(0)) GRID_BAR(); }
    if (IN(1)) { REFRESH_TID(); p0_prologue(F, args); norm_rows(F, ARGF(0), ARGF(5), 0, DM, XN); if (BOTH(1)) GRID_BAR(); }
    if (IN(2)) {
        pg8::Gemm g{XN, (const bf16_t*)(ws + WS_WIN), MTOK, 2048, 1024, nullptr, 1 << 30}; pg8::StaticOrder S; S.init(MTOK, 2048, F.G, (int)blockIdx.x);
        EpiIn E{ws, ARGF(7), ARGF(8), ARGF(13), ARGF(14)};
        pg8::gemm_phase(F.lds, F.xl, g, S, E);
        if (BOTH(2)) GRID_BAR();
    }
    if (IN(3)) {
        pg8::Gemm g{(const bf16_t*)(ws + WS_QLN), (const bf16_t*)(ws + WS_WQUP), MTOK, 2048, 256, (const bf16_t*)(ws + WS_KVLN), 4}; pg8::StaticOrder S; S.init(MTOK, 2048, F.G, (int)blockIdx.x);
        EpiQKV E{EpiQ{ws, ARGF(11)}, EpiKV{ws, ARGF(12)}};
        pg8::gemm_phase(F.lds, F.xl, g, S, E);
        if (BOTH(3)) GRID_BAR();
    }
    if (IN(4)) {
        bf16_t* OM = (bf16_t*)(ws + WS_OM);
        int atid = threadIdx.x; asm volatile("" : "+v"(atid)); atid &= 511;
        for (int i = 0; ; ++i) {
            int kind, bh, qb;
            if (F.G == 256) { if (i >= 8) break; bh = F.vcu >> 1; const int par = F.vcu & 1;
                if (i < 4) { kind = 0; const int s = 2 * par + (i >> 1); qb = (i & 1) ? 7 - s : s; } else { kind = 1; qb = 2 * (i - 4) + par; } }
            else { const int j = F.vcu + i * F.G; if (j >= 2048) break; kind = j >> 10; bh = (j & 1023) >> 3; qb = j & 7; }
            if (kind == 0) att::attn_unit<96, false, 8>(atid, bh >> 3, bh & 7, qb, (const bf16_t*)(ws + WS_QM), (const bf16_t*)(ws + WS_KM), (const bf16_t*)(ws + WS_VM), OM, nullptr, F.lds);
            else att::attn_unit<64, true, 8>(atid, bh >> 3, bh & 7, qb, (const bf16_t*)(ws + WS_CQ), (const bf16_t*)(ws + WS_CK), (const bf16_t*)(ws + WS_CV), OM, ARGF(15), F.lds);
        }
        if (BOTH(4)) GRID_BAR();
    }
    if (IN(5)) {
        pg8::Gemm g{(const bf16_t*)(ws + WS_OM), (const bf16_t*)(ws + WS_WOUT), MTOK, 1024, 1024, nullptr, 1 << 30}; pg8::StaticOrder S; S.init(MTOK, 1024, F.G, (int)blockIdx.x);
        if (F.G == 256) { EpiResNorm E{ARGF(0), ws, MOD + 2 * DM, ARGF(17)}; pg8::gemm_phase(F.lds, F.xl, g, S, E); }
        else { EpiRes<false> E{ARGF(0), (float*)(ws + WS_X1), MOD + 2 * DM}; pg8::gemm_phase(F.lds, F.xl, g, S, E); }
        if (BOTH(5)) GRID_BAR();
    }
    if (IN(6)) { if (F.G != 256) { REFRESH_TID(); norm_rows(F, (const float*)(ws + WS_X1), ARGF(17), 3 * DM, 4 * DM, (bf16_t*)(ws + WS_H2)); if (BOTH(6)) GRID_BAR(); } }
    if (IN(7)) {
        pg8::Gemm g{(const bf16_t*)(ws + WS_H2), (const bf16_t*)(ws + WS_WUP), MTOK, DFF2, 1024, nullptr, 1 << 30}; pg8::StaticOrder S; S.init(MTOK, DFF2, F.G, (int)blockIdx.x);
        EpiUp E{ws, ARGF(19), ARGF(20)};
        pg8::gemm_phase(F.lds, F.xl, g, S, E);
        if (BOTH(7)) GRID_BAR();
    }
    if (IN(8)) { REFRESH_TID(); conv_fixup(F, args); if (BOTH(8)) GRID_BAR(); }
    if (IN(9)) {
        pg8::Gemm g{(const bf16_t*)(ws + WS_ACT), (const bf16_t*)(ws + WS_WDOWN), MTOK, 1024, DFF, nullptr, 1 << 30}; pg8::StaticOrder S; S.init(MTOK, 1024, F.G, (int)blockIdx.x);
        EpiRes<false> E{(const float*)(ws + WS_X1), args.out, MOD + 5 * DM};
        pg8::gemm_phase(F.lds, F.xl, g, S, E);
    }
#undef IN
#undef BOTH
}

extern "C" void kernel_launch(void* const* d_in, const int* in_sizes, int n_in, void* d_out, int out_size, void* d_ws, size_t ws_size, hipStream_t stream) {
    static int grid = 0;
    if (grid == 0) {
        if (n_in != 22 || in_sizes[0] != MTOK * DM || out_size != MTOK * DM || ws_size < WS_END) {
            fprintf(stderr, "kernel_launch: unexpected shapes (n_in %d, in0 %d, out %d, ws %zu); nothing launched\n", n_in, n_in > 0 ? in_sizes[0] : -1, out_size, ws_size); grid = -1; return; }
        int dev = 0, cus = 0, per_cu = 0;
        if (hipGetDevice(&dev) != hipSuccess || hipDeviceGetAttribute(&cus, hipDeviceAttributeMultiprocessorCount, dev) != hipSuccess) { grid = -1; return; }
        if (hipFuncSetAttribute((const void*)fwd_kernel, hipFuncAttributeMaxDynamicSharedMemorySize, LDS_BYTES) != hipSuccess) { fprintf(stderr, "kernel_launch: hipFuncSetAttribute failed\n"); grid = -1; return; }
        if (hipOccupancyMaxActiveBlocksPerMultiprocessor(&per_cu, (const void*)fwd_kernel, NWAVES * 64, LDS_BYTES) != hipSuccess || per_cu < 1)
            fprintf(stderr, "kernel_launch: note: occupancy query reports %d workgroups per CU\n", per_cu);
        (void)hipGetLastError();
        grid = cus;
    }
    if (grid < 0) return;
    Args a{};
    for (int i = 0; i < 22; ++i) a.in[i] = d_in[i];
    a.out = (float*)d_out; a.ws = (unsigned char*)d_ws;
#ifndef PROBE_DUP
#define PROBE_DUP -1
#endif
    const int nl = (PROBE_DUP >= 0) ? 2 : N_LAUNCHES;
    for (int li = 0; li < nl; ++li) {
        if (li == 0 && hipMemsetAsync((char*)d_ws + WS_PART, 0, PART_BYTES, stream) != hipSuccess) { fprintf(stderr, "kernel_launch: memset failed\n"); return; }
        if (hipMemsetAsync((char*)d_ws + WS_CTL, 0, CTL_ZERO_BYTES, stream) != hipSuccess) { fprintf(stderr, "kernel_launch: memset failed\n"); return; }
        a.ph_lo = (N_LAUNCHES == 1) ? 0 : li; a.ph_hi = (N_LAUNCHES == 1) ? NPHASE : li + 1; a.li = li;
        if (PROBE_DUP >= 0) { a.ph_lo = li == 0 ? 0 : PROBE_DUP; a.ph_hi = li == 0 ? PROBE_DUP + 1 : NPHASE; }
        hipLaunchKernelGGL(fwd_kernel, dim3(grid), dim3(NWAVES * 64), LDS_BYTES, stream, a);
        const hipError_t le = hipPeekAtLastError();
        if (le != hipSuccess) { fprintf(stderr, "kernel_launch: launch %d failed: %s\n", li, hipGetErrorName(le)); break; }
    }
}
```

```cpp
#include <hip/hip_runtime.h>
#include <cstdio>
#include <cstdint>

#define LAS __attribute__((address_space(3)))
#define GAS __attribute__((address_space(1)))
typedef unsigned short bf16_t;
typedef short bf16x8 __attribute__((ext_vector_type(8)));
typedef short s16x4 __attribute__((ext_vector_type(4)));
typedef short s16x2 __attribute__((ext_vector_type(2)));
typedef float f32x2 __attribute__((ext_vector_type(2)));
typedef float f32x4 __attribute__((ext_vector_type(4)));
typedef float f32x16 __attribute__((ext_vector_type(16)));
typedef unsigned u32x2 __attribute__((ext_vector_type(2)));
typedef unsigned u32x4 __attribute__((ext_vector_type(4)));
typedef int i32x2 __attribute__((ext_vector_type(2)));
typedef int i32x4 __attribute__((ext_vector_type(4)));
typedef int i32x8 __attribute__((ext_vector_type(8)));
typedef __bf16 bf16x2_t __attribute__((ext_vector_type(2)));

#ifndef MK_N_LAUNCHES
#define MK_N_LAUNCHES 1
#endif

constexpr int BATCH = 16, SEQ = 2048, DM = 1024, MTOK = BATCH * SEQ;
constexpr int NMOD = 6 * DM;
constexpr int DFF = 2816, DFF2 = 5632;
constexpr float EPS = 1e-6f;
constexpr float LOG2E = 1.4426950408889634f;
constexpr float C2_MLA = 0.10206207261596577f * LOG2E;
constexpr float C2_CA = 0.125f * LOG2E;

__device__ __forceinline__ unsigned cvtpk(float lo, float hi) { f32x2 v = {lo, hi}; bf16x2_t b = __builtin_convertvector(v, bf16x2_t); return __builtin_bit_cast(unsigned, b); }
__device__ __forceinline__ u32x4 pack8(f32x4 a, f32x4 b) { u32x4 w; w.x = cvtpk(a[0], a[1]); w.y = cvtpk(a[2], a[3]); w.z = cvtpk(b[0], b[1]); w.w = cvtpk(b[2], b[3]); return w; }
__device__ __forceinline__ u32x2 pack4(f32x4 a) { u32x2 w; w.x = cvtpk(a[0], a[1]); w.y = cvtpk(a[2], a[3]); return w; }
__device__ __forceinline__ float xsum16(float v) { auto r = __builtin_amdgcn_permlane16_swap(__float_as_uint(v), __float_as_uint(v), false, false); return __uint_as_float(r[0]) + __uint_as_float(r[1]); }
__device__ __forceinline__ float xsum32(float v) { auto r = __builtin_amdgcn_permlane32_swap(__float_as_uint(v), __float_as_uint(v), false, false); return __uint_as_float(r[0]) + __uint_as_float(r[1]); }
__device__ __forceinline__ float row16_sum(float v) {
    v += __builtin_bit_cast(float, __builtin_amdgcn_update_dpp(0, __builtin_bit_cast(int, v), 0xB1, 0xF, 0xF, true));
    v += __builtin_bit_cast(float, __builtin_amdgcn_update_dpp(0, __builtin_bit_cast(int, v), 0x4E, 0xF, 0xF, true));
    v += __builtin_bit_cast(float, __builtin_amdgcn_update_dpp(0, __builtin_bit_cast(int, v), 0x141, 0xF, 0xF, true));
    v += __builtin_bit_cast(float, __builtin_amdgcn_update_dpp(0, __builtin_bit_cast(int, v), 0x140, 0xF, 0xF, true));
    return v; }
__device__ __forceinline__ void colsum8(const f32x4 (&acc)[2][2][4][2], int bj, int fr, float* dst) {
    f32x4 s0 = acc[0][bj][0][0] + acc[1][bj][0][0], s1 = acc[0][bj][0][1] + acc[1][bj][0][1];
#pragma unroll
    for (int m = 1; m < 4; ++m) { s0 += acc[0][bj][m][0] + acc[1][bj][m][0]; s1 += acc[0][bj][m][1] + acc[1][bj][m][1]; }
#pragma unroll
    for (int e = 0; e < 4; ++e) { s0[e] = row16_sum(s0[e]); s1[e] = row16_sum(s1[e]); }
    if (fr == 0) { *(f32x4*)dst = s0; *(f32x4*)(dst + 4) = s1; }
}
__device__ __forceinline__ float dot4(f32x4 a) { return (a[0] * a[0] + a[1] * a[1]) + (a[2] * a[2] + a[3] * a[3]); }
__device__ __forceinline__ int undef_i32() { int w; asm volatile("" : "=v"(w)); return w; }
__device__ __forceinline__ unsigned pk_fp8x4(float a, float b, float c, float d) { int w = undef_i32();
    w = __builtin_amdgcn_cvt_pk_fp8_f32(__builtin_amdgcn_fmed3f(a, -448.f, 448.f), __builtin_amdgcn_fmed3f(b, -448.f, 448.f), w, false);
    w = __builtin_amdgcn_cvt_pk_fp8_f32(__builtin_amdgcn_fmed3f(c, -448.f, 448.f), __builtin_amdgcn_fmed3f(d, -448.f, 448.f), w, true); return (unsigned)w; }
__device__ __forceinline__ u32x2 f8x8(f32x4 a, f32x4 b) { return (u32x2){pk_fp8x4(a[0], a[1], a[2], a[3]), pk_fp8x4(b[0], b[1], b[2], b[3])}; }
__device__ __forceinline__ unsigned pk_fp8x4u(float a, float b, float c, float d) { int w = undef_i32(); w = __builtin_amdgcn_cvt_pk_fp8_f32(a, b, w, false); w = __builtin_amdgcn_cvt_pk_fp8_f32(c, d, w, true); return (unsigned)w; }
__device__ __forceinline__ u32x2 f8x8u(f32x4 a, f32x4 b) { return (u32x2){pk_fp8x4u(a[0], a[1], a[2], a[3]), pk_fp8x4u(b[0], b[1], b[2], b[3])}; }
__device__ __forceinline__ void st8pair(unsigned char* pa, unsigned char* pb, u32x2 a, u32x2 b, int fq) {
    auto r0 = __builtin_amdgcn_permlane16_swap(a.x, b.x, false, false); auto r1 = __builtin_amdgcn_permlane16_swap(a.y, b.y, false, false);
    *(u32x4*)((fq & 1) ? pb - 8 : pa) = (u32x4){r0[0], r1[0], r0[1], r1[1]}; }
__device__ __forceinline__ void glds16_(const void* gsrc, unsigned lds_dst) { unsigned keep;
    asm volatile("s_mov_b32 %0, m0\n\ts_mov_b32 m0, %2\n\ts_nop 0\n\tglobal_load_lds_dwordx4 %1, off\n\ts_mov_b32 m0, %0" : "=&s"(keep) : "v"(gsrc), "s"(lds_dst) : "memory"); }
#ifndef WT_STORES
#define WT_STORES 0
#endif
__device__ __forceinline__ void st16(void* p, u32x4 v) {
#if WT_STORES
    asm volatile("global_store_dwordx4 %0, %1, off sc1\n\ts_nop 1" :: "v"(p), "v"(v) : "memory");
#else
    *(u32x4*)p = v;
#endif
}
__device__ __forceinline__ void st16o(const void* sbase, unsigned voff, u32x4 v) {
#if WT_STORES
    asm volatile("global_store_dwordx4 %0, %1, %2 sc1\n\ts_nop 1" :: "v"(voff), "v"(v), "s"(sbase) : "memory");
#else
    *(u32x4*)((unsigned char*)sbase + voff) = v;
#endif
}
__device__ __forceinline__ int tid_from_wave(int wave) { int ln; asm volatile("v_mbcnt_lo_u32_b32 %0, -1, 0\n\tv_mbcnt_hi_u32_b32 %0, -1, %0" : "=v"(ln));
    return wave * 64 + ln; }
#define LDS_BARRIER() do { asm volatile("s_waitcnt lgkmcnt(0)" ::: "memory"); __builtin_amdgcn_s_barrier(); asm volatile("" ::: "memory"); } while (0)

#ifndef PG8_ASMDMA
#define PG8_ASMDMA 1
#endif
namespace pg8 {
constexpr int BM = 256, BK = 64, HALF = 128, HTB = HALF * BK * 2, STAGE_BYTES = 8 * HTB, NXCD = 8, WGM = 8;
__host__ __device__ __forceinline__ int lds_byte(int r, int c) { const int st = (r >> 4) * 2 + (c >> 5), rr = r & 15, cc = c & 31, ob = rr * 64 + cc * 2; return st * 1024 + (ob ^ (((ob >> 9) & 1) << 5)); }
__host__ __device__ __forceinline__ void stage_rc(int b, int& R, int& C) { const int st = b / 1024, sb = b % 1024, swz = sb ^ (((sb >> 9) & 1) << 5); R = (st >> 1) * 16 + swz / 64; C = (st & 1) * 32 + (swz % 64) / 2; }
__host__ __device__ __forceinline__ int perm32(int rho) { const int n = rho >> 4, i = rho & 15; return 8 * (i >> 2) + 4 * n + (i & 3); }

struct Unit { int pm, pn; };
struct Gemm { const bf16_t* A; const bf16_t* Bt; int M, N, K; const bf16_t* A2; int nsplit; };

struct StaticOrder {
    int nM, nN, nwg, G, c;
    __host__ __device__ void init(int M, int N, int G_, int c_) { nM = M / BM; nN = N / BM; nwg = nM * nN; G = G_; c = c_; }
    __host__ __device__ bool next(int i, Unit& u) const {
        const long L = (long)i * G + c; if (L >= nwg) return false;
        int wgid = (int)L; { const int q = nwg / NXCD, r = nwg % NXCD, xcd = wgid % NXCD, off = wgid / NXCD; wgid = (xcd < r ? xcd * (q + 1) : r * (q + 1) + (xcd - r) * q) + off; }
        const int nig = WGM * nN, gid = wgid / nig, fm = gid * WGM, gsz = (nM - fm) < WGM ? (nM - fm) : WGM;
        u.pm = fm + ((wgid % nig) % gsz); u.pn = (wgid % nig) / gsz; return true;
    }
};

template <class Epi, class Sched>
__device__ __forceinline__ void gemm_phase(LAS unsigned char* lds, LAS float* xl, const Gemm g, const Sched& S, const Epi& E, int wave_id) {
    int tid = tid_from_wave(wave_id); asm volatile("" : "+v"(tid)); tid &= 511;
    const int wid = __builtin_amdgcn_readfirstlane(tid >> 6), lane = tid & 63, wr = wid >> 2, wc = wid & 3, fr = lane & 15, fq = lane >> 4;
    const int K = g.K, nt = K / BK;
    unsigned voffA[2], voffB[2];
#pragma unroll
    for (int i = 0; i < 2; ++i) { int R, C; stage_rc(tid * 16 + i * 8192, R, C); const int Rb = (R & ~31) + perm32(R & 31);
        const int Ra = Epi::APERM ? ((R & 64) | ((R & 15) << 2) | ((R >> 4) & 3)) : R;
        voffA[i] = (unsigned)(Ra * K + C) * 2u; voffB[i] = (unsigned)(Rb * K + C) * 2u; }
    const size_t kstep = (size_t)(BK * 2);
    const size_t hstep = (size_t)HALF * K * 2;
    const size_t tstep = 2 * hstep;
    const unsigned ldsw = (unsigned)wid * 1024u; const unsigned ldsb = (unsigned)__builtin_amdgcn_readfirstlane((int)((unsigned)(uintptr_t)lds + ldsw));
    const int aoff = lds_byte(wr * 64 + fr, fq * 8), boff = lds_byte(wc * 32 + fr, fq * 8);
#define PG8_SA(b, h) (((b) * 2 + (h)) * HTB)
#define PG8_SB(b, h) ((4 + (b) * 2 + (h)) * HTB)
#if PG8_ASMDMA
#define PG8_STAGE(bufoff, gbase, voff) do { _Pragma("unroll") for (int _i = 0; _i < 2; ++_i) \
        asm volatile("s_mov_b32 m0, %2\n\ts_nop 0\n\tglobal_load_lds_dwordx4 %0, %1" :: "v"((voff)[_i]), "s"((const void*)(gbase)), "s"(ldsb + (unsigned)((bufoff) + _i * 8192)) : "memory", "m0"); } while (0)
#else
#define PG8_STAGE(bufoff, gbase, voff) do { _Pragma("unroll") for (int _i = 0; _i < 2; ++_i) \
        __builtin_amdgcn_global_load_lds((const unsigned*)((const char*)(gbase) + (voff)[_i]), (LAS unsigned*)(lds + (bufoff) + ldsw + _i * 8192), 16, 0, 0); } while (0)
#endif
#define PG8_LDA(dst, b, h) do { if constexpr (Epi::FP8) { _Pragma("unroll") for (int m = 0; m < 4; ++m) { const i32x4 lo_ = *(const LAS i32x4*)(lds + PG8_SA(b, h) + aoff + m * 2048), hi_ = *(const LAS i32x4*)(lds + PG8_SA(b, h) + aoff + m * 2048 + 1024); dst##8[m] = __builtin_shufflevector(lo_, hi_, 0, 1, 2, 3, 4, 5, 6, 7); } } \
        else { _Pragma("unroll") for (int m = 0; m < 4; ++m) _Pragma("unroll") for (int k = 0; k < 2; ++k) dst[m][k] = *(const LAS bf16x8*)(lds + PG8_SA(b, h) + aoff + m * 2048 + k * 1024); } } while (0)
#define PG8_LDB(dst, b, h) do { if constexpr (Epi::FP8) { _Pragma("unroll") for (int n = 0; n < 2; ++n) { const i32x4 lo_ = *(const LAS i32x4*)(lds + PG8_SB(b, h) + boff + n * 2048), hi_ = *(const LAS i32x4*)(lds + PG8_SB(b, h) + boff + n * 2048 + 1024); dst##8[n] = __builtin_shufflevector(lo_, hi_, 0, 1, 2, 3, 4, 5, 6, 7); } } \
        else { _Pragma("unroll") for (int n = 0; n < 2; ++n) _Pragma("unroll") for (int k = 0; k < 2; ++k) dst[n][k] = *(const LAS bf16x8*)(lds + PG8_SB(b, h) + boff + n * 2048 + k * 1024); } } while (0)
#define PG8_MMA(ai, bj, At, Bt) do { __builtin_amdgcn_s_setprio(1); if constexpr (Epi::FP8) { _Pragma("unroll") for (int m = 0; m < 4; ++m) _Pragma("unroll") for (int n = 0; n < 2; ++n) \
            acc[ai][bj][m][n] = __builtin_amdgcn_mfma_scale_f32_16x16x128_f8f6f4(Bt##8[n], At##8[m], acc[ai][bj][m][n], 0, 0, 0, 0, 0, 0); } \
        else { _Pragma("unroll") for (int m = 0; m < 4; ++m) _Pragma("unroll") for (int n = 0; n < 2; ++n) _Pragma("unroll") for (int k = 0; k < 2; ++k) \
            acc[ai][bj][m][n] = __builtin_amdgcn_mfma_f32_16x16x32_bf16(Bt[n][k], At[m][k], acc[ai][bj][m][n], 0, 0, 0); } __builtin_amdgcn_s_setprio(0); } while (0)
#define PG8_WAIT_V(n) asm volatile("s_waitcnt vmcnt(" #n ")" ::: "memory")
#define PG8_WAIT_L(n) asm volatile("s_waitcnt lgkmcnt(" #n ")" ::: "memory")
#define PG8_BAR __builtin_amdgcn_s_barrier()
#define PG8_SCHED __builtin_amdgcn_sched_barrier(0)
    Unit cur, nxt; int ui = 0;
    if (!S.next(0, cur)) return;
    f32x4 acc[2][2][4][2];
    { float z0; asm volatile("v_mov_b32 %0, 0" : "=v"(z0));
#pragma unroll
    for (int a = 0; a < 2; ++a)
#pragma unroll
        for (int b = 0; b < 2; ++b)
#pragma unroll
            for (int m = 0; m < 4; ++m)
#pragma unroll
                for (int n = 0; n < 2; ++n) acc[a][b][m][n] = (f32x4){z0, z0, z0, z0}; }
    bf16x8 At[4][2], B0[2][2], B1[2][2]; i32x8 At8[4], B08[2], B18[2];
    const char* cA = (const char*)(cur.pn < g.nsplit ? g.A : g.A2) + (size_t)cur.pm * tstep; const char* cB = (const char*)g.Bt + (size_t)cur.pn * tstep;
    if constexpr (Epi::PREFETCH) E.prefetch(cur, xl, 0, wid, lane);
    PG8_STAGE(PG8_SB(0, 0), cB, voffB); PG8_STAGE(PG8_SB(0, 1), cB + hstep, voffB); PG8_STAGE(PG8_SA(0, 0), cA, voffA); PG8_STAGE(PG8_SA(0, 1), cA + hstep, voffA);
    if (wr == 1) PG8_BAR;
    PG8_WAIT_V(2); PG8_BAR;
    PG8_STAGE(PG8_SB(1, 0), cB + kstep, voffB); PG8_STAGE(PG8_SA(1, 0), cA + kstep, voffA); PG8_STAGE(PG8_SB(1, 1), cB + hstep + kstep, voffB);
    PG8_WAIT_V(6); PG8_BAR;
    for (;;) {
        const bool has_next = S.next(ui + 1, nxt);
        const char* nA = has_next ? (const char*)(nxt.pn < g.nsplit ? g.A : g.A2) + (size_t)nxt.pm * tstep : cA; const char* nB = has_next ? (const char*)g.Bt + (size_t)nxt.pn * tstep : cB;
#pragma nounroll
        for (int t = 0; t < nt; t += 2) {
            const bool last = (t == nt - 2);
            const char* a1 = cA + (size_t)(t + 1) * kstep;
            const char* a2 = last ? nA : cA + (size_t)(t + 2) * kstep; const char* b2 = last ? nB : cB + (size_t)(t + 2) * kstep;
            const char* a3 = a2 + kstep; const char* b3 = b2 + kstep;
            PG8_LDB(B0, 0, 0); PG8_LDB(B1, 0, 1); PG8_SCHED; PG8_LDA(At, 0, 0); PG8_STAGE(PG8_SA(1, 1), a1 + hstep, voffA);
            PG8_WAIT_V(8); PG8_WAIT_L(0); PG8_BAR; PG8_MMA(0, 0, At, B0); PG8_MMA(0, 1, At, B1); PG8_BAR; PG8_SCHED;
            PG8_LDA(At, 0, 1); PG8_STAGE(PG8_SB(0, 0), b2, voffB); PG8_STAGE(PG8_SB(0, 1), b2 + hstep, voffB); PG8_STAGE(PG8_SA(0, 0), a2, voffA);
            PG8_WAIT_V(8); PG8_WAIT_L(0); PG8_BAR; PG8_MMA(1, 0, At, B0); PG8_MMA(1, 1, At, B1); PG8_BAR; PG8_SCHED;
            PG8_LDB(B0, 1, 0); PG8_LDB(B1, 1, 1); PG8_SCHED; PG8_LDA(At, 1, 0); PG8_STAGE(PG8_SA(0, 1), a2 + hstep, voffA);
            PG8_WAIT_V(8); PG8_WAIT_L(0); PG8_BAR; PG8_MMA(0, 0, At, B0); PG8_MMA(0, 1, At, B1); PG8_BAR; PG8_SCHED;
            PG8_LDA(At, 1, 1); PG8_STAGE(PG8_SB(1, 0), b3, voffB); PG8_STAGE(PG8_SB(1, 1), b3 + hstep, voffB); PG8_STAGE(PG8_SA(1, 0), a3, voffA);
            PG8_WAIT_V(8); PG8_WAIT_L(0); PG8_BAR; PG8_MMA(1, 0, At, B0); PG8_MMA(1, 1, At, B1); PG8_BAR; PG8_SCHED;
        }
        if (wr == 0) PG8_BAR;
        { const int le_ = tid_from_wave(0), fre = le_ & 15, fqe = le_ >> 4;
        if constexpr (Epi::FP8) { if constexpr (Epi::PREFETCH) E.pre(acc, cur, wc, fqe, xl, ui & 1); else E.pre(acc, cur, wc, fqe); }
        if constexpr (Epi::PREFETCH) { E(acc, cur, wr, wc, fre, fqe, xl, ui & 1); if (has_next) E.prefetch(nxt, xl, (ui + 1) & 1, wid, le_); }
        else E(acc, cur, wr, wc, fre, fqe, xl); }
        if (!has_next) break;
        { float z0; asm volatile("v_mov_b32 %0, 0" : "=v"(z0));
#pragma unroll
        for (int a = 0; a < 2; ++a)
#pragma unroll
            for (int b = 0; b < 2; ++b)
#pragma unroll
                for (int m = 0; m < 4; ++m)
#pragma unroll
                    for (int n = 0; n < 2; ++n) acc[a][b][m][n] = (f32x4){z0, z0, z0, z0}; }
        cur = nxt; cA = nA; cB = nB; ++ui;
        if (wr == 1) PG8_BAR;
    }
    PG8_WAIT_V(0);
    PG8_BAR;
#undef PG8_SA
#undef PG8_SB
#undef PG8_STAGE
#undef PG8_LDA
#undef PG8_LDB
#undef PG8_MMA
#undef PG8_WAIT_V
#undef PG8_WAIT_L
#undef PG8_BAR
#undef PG8_SCHED
}
}
using pg8::Unit;

constexpr size_t MiB = 1u << 20;
constexpr size_t WS_CTL = 0, CTL_ZERO_BYTES = 64 * 1024;
constexpr size_t WS_PART = 35 * (1u << 20), PART_BYTES = (size_t)32768 * 4 * 8;
constexpr size_t WS_MOD = 1 * MiB;
constexpr size_t WS_BIAS2 = 1 * MiB + 640 * 1024;
constexpr size_t WS_PARTV = 13 * MiB;
constexpr size_t WS_REF = 1 * MiB + 768 * 1024;
constexpr size_t WS_BIAS = 1 * MiB + 512 * 1024;
constexpr size_t WS_COS = 2 * MiB, WS_SIN = 4 * MiB;
constexpr size_t WS_KR = 6 * MiB;
constexpr size_t WS_SSR = 10 * MiB;
constexpr size_t WS_WIN = 11 * MiB;
constexpr size_t WS_WQUP = 15 * MiB;
constexpr size_t WS_WKVUP = WS_WQUP + 512 * 1024;
constexpr size_t WS_WOUT = 16 * MiB;
constexpr size_t WS_WUP = 18 * MiB;
constexpr size_t WS_WDOWN = 29 * MiB;
constexpr size_t WS_XN = 36 * MiB;
constexpr size_t WS_QLN = 100 * MiB, WS_KVLN = 116 * MiB;
constexpr size_t WS_CQ = 132 * MiB, WS_CK = 164 * MiB, WS_CV = 196 * MiB;
constexpr size_t WS_QM = 228 * MiB, WS_KM = 276 * MiB;
constexpr size_t WS_VM = 324 * MiB;
constexpr size_t WS_OM = WS_XN;
constexpr size_t WS_ACT = 100 * MiB;
constexpr size_t WS_X1 = 276 * MiB;
constexpr size_t WS_RAW4 = 404 * MiB;
constexpr size_t WS_H2 = 448 * MiB;
constexpr size_t WS_END = 512 * MiB;
static_assert(WS_ACT + (size_t)MTOK * DFF * 2 <= WS_X1 && WS_X1 + (size_t)MTOK * DM * 4 <= WS_RAW4 && WS_RAW4 + (size_t)512 * 4 * DFF2 * 4 <= WS_END, "overlay map");
constexpr int CW_BAR = 1024;


constexpr float F8_QS = 8.0f, F8_KS = 0.125f;
constexpr float F8_O_SCALE = 64.0f, F8_WOUT_SCALE = 1024.0f;
constexpr float F8_ACT_SCALE = 8.0f, F8_WIN_SCALE = 1024.0f;
constexpr int XL_CONST = 2048;
__device__ __forceinline__ void f8_pre_lds(f32x4 (&acc)[2][2][4][2], const LAS float* side, float descale, int wc, int fq) {
    asm volatile("" : "+v"(fq), "+s"(wc));
    const LAS float* sp = side + wc * 32 + 8 * fq;
    f32x4 bv[2][2];
#pragma unroll
    for (int bj = 0; bj < 2; ++bj)
#pragma unroll
        for (int n = 0; n < 2; ++n) bv[bj][n] = *(const LAS f32x4*)(sp + 128 * bj + 4 * n);
#pragma unroll
    for (int a = 0; a < 2; ++a)
#pragma unroll
        for (int bj = 0; bj < 2; ++bj)
#pragma unroll
            for (int m = 0; m < 4; ++m)
#pragma unroll
                for (int n = 0; n < 2; ++n) acc[a][bj][m][n] = acc[a][bj][m][n] * descale + bv[bj][n];
}
struct EpiIn {
    static constexpr bool APERM = false, PREFETCH = true, FP8 = true; static constexpr float DESCALE = 1.0f / (F8_ACT_SCALE * F8_WIN_SCALE);
    unsigned char* ws;
    __device__ __forceinline__ void prefetch(const Unit& u, LAS float* xl, int par, int wid, int lane) const {
        asm volatile("" : "+v"(lane));
        if (wid == 0) glds16_((const float*)(ws + WS_BIAS) + (size_t)(u.pm >> 3) * 2048 + u.pn * 256 + 4 * lane, (unsigned)__builtin_amdgcn_readfirstlane((unsigned)(uintptr_t)(xl + XL_CONST + 512 + par * 256)));
    }
    __device__ __forceinline__ void pre(f32x4 (&acc)[2][2][4][2], const Unit& u, int wc, int fq, LAS float* xl, int par) const { f8_pre_lds(acc, xl + XL_CONST + 512 + par * 256, DESCALE, wc, fq); }
    __device__ __forceinline__ void operator()(const f32x4 (&acc)[2][2][4][2], const Unit& u, int wr, int wc, int fr, int fq, LAS float* red, int  ) const {
        asm volatile("" : "+v"(fr), "+v"(fq), "+s"(wr), "+s"(wc));
        const int rl0 = wr * 64 + fr; const size_t row0 = (size_t)u.pm * 256 + rl0; const int pn = u.pn;
        bf16_t* const QLN = (bf16_t*)(ws + WS_QLN); bf16_t* const KVLN = (bf16_t*)(ws + WS_KVLN); bf16_t* const CQ = (bf16_t*)(ws + WS_CQ); bf16_t* const CK = (bf16_t*)(ws + WS_CK); bf16_t* const CV = (bf16_t*)(ws + WS_CV);
        float* const KR = (float*)(ws + WS_KR); float* const SSR = (float*)(ws + WS_SSR);
        if (pn >= 6) {
            { float* pv = (float*)(ws + WS_PARTV) + ((size_t)u.pm * 2 + wr) * 1024 + 512 + (pn - 6) * 256 + wc * 32 + 8 * fq;
              colsum8(acc, 0, fr, pv); colsum8(acc, 1, fr, pv + 128); }
            unsigned char* base = (unsigned char*)CV + (pn - 6) * 256 + wc * 32 + 8 * fq;
#pragma unroll
            for (int ai = 0; ai < 2; ++ai)
#pragma unroll
                for (int mp = 0; mp < 2; ++mp) { unsigned char* ra = base + (row0 + ai * 128 + (2 * mp) * 16) * 512; unsigned char* rb = ra + 16 * 512;
#pragma unroll
                    for (int bj = 0; bj < 2; ++bj) st8pair(ra + bj * 128, rb + bj * 128, f8x8(acc[ai][bj][2 * mp][0], acc[ai][bj][2 * mp][1]), f8x8(acc[ai][bj][2 * mp + 1][0], acc[ai][bj][2 * mp + 1][1]), fq); }
        } else if (pn >= 2) {
            const bool isq = pn < 4; const int head = 4 * ((pn - 2) & 1) + wc; const LAS float* g = red + XL_CONST + (isq ? 384 : 448); const float sc = isq ? C2_CA * F8_QS : F8_KS;
            f32x4 gv[2][2];
#pragma unroll
            for (int bj = 0; bj < 2; ++bj)
#pragma unroll
                for (int n = 0; n < 2; ++n) gv[bj][n] = *(const LAS f32x4*)(g + 32 * bj + 8 * fq + 4 * n) * sc;
            unsigned char* base = (unsigned char*)(isq ? CQ : CK) + head * 64 + 8 * fq;
#pragma unroll
            for (int ai = 0; ai < 2; ++ai)
#pragma unroll
                for (int mp = 0; mp < 2; ++mp) { float rr[2];
#pragma unroll
                    for (int mm = 0; mm < 2; ++mm) { const int m = 2 * mp + mm;
                        float ss = (dot4(acc[ai][0][m][0]) + dot4(acc[ai][0][m][1])) + (dot4(acc[ai][1][m][0]) + dot4(acc[ai][1][m][1]));
                        ss = xsum32(xsum16(ss));
                        rr[mm] = __builtin_amdgcn_rsqf(ss * (1.0f / 64.0f) + EPS); }
                    unsigned char* ra = base + (row0 + ai * 128 + (2 * mp) * 16) * 512; unsigned char* rb = ra + 16 * 512;
#pragma unroll
                    for (int bj = 0; bj < 2; ++bj) st8pair(ra + bj * 32, rb + bj * 32, f8x8u(acc[ai][bj][2 * mp][0] * rr[0] * gv[bj][0], acc[ai][bj][2 * mp][1] * rr[0] * gv[bj][1]),
                                                           f8x8u(acc[ai][bj][2 * mp + 1][0] * rr[1] * gv[bj][0], acc[ai][bj][2 * mp + 1][1] * rr[1] * gv[bj][1]), fq);
                }
        } else if (pn == 0) {
#pragma unroll
            for (int ai = 0; ai < 2; ++ai)
#pragma unroll
                for (int m = 0; m < 4; ++m) {
                    float ss = (dot4(acc[ai][0][m][0]) + dot4(acc[ai][0][m][1])) + (dot4(acc[ai][1][m][0]) + dot4(acc[ai][1][m][1]));
                    ss = xsum32(xsum16(ss));
                    if (fq == 0) red[(ai * 128 + m * 16 + rl0) * 8 + wc] = ss;
                }
            LDS_BARRIER();
            f32x4 gv[2][2];
#pragma unroll
            for (int bj = 0; bj < 2; ++bj)
#pragma unroll
                for (int n = 0; n < 2; ++n) gv[bj][n] = *(const LAS f32x4*)(red + XL_CONST + 128 * bj + 32 * wc + 8 * fq + 4 * n);
            bf16_t* base = QLN + wc * 32 + 8 * fq;
#pragma unroll
            for (int ai = 0; ai < 2; ++ai)
#pragma unroll
                for (int m = 0; m < 4; ++m) {
                    const f32x4 t = *(const LAS f32x4*)(red + (ai * 128 + m * 16 + rl0) * 8);
                    const float r = __builtin_amdgcn_rsqf(((t[0] + t[1]) + (t[2] + t[3])) * (1.0f / 256.0f) + EPS);
                    bf16_t* rp = base + (row0 + ai * 128 + m * 16) * 256;
#pragma unroll
                    for (int bj = 0; bj < 2; ++bj) st16(rp + bj * 128, pack8(acc[ai][bj][m][0] * r * gv[bj][0], acc[ai][bj][m][1] * r * gv[bj][1]));
                }
        } else {
#pragma unroll
            for (int ai = 0; ai < 2; ++ai)
#pragma unroll
                for (int m = 0; m < 4; ++m) {
                    float ss = dot4(acc[ai][0][m][0]) + dot4(acc[ai][0][m][1]);
                    ss = xsum32(xsum16(ss));
                    if (fq == 0) red[(ai * 128 + m * 16 + rl0) * 8 + wc] = ss;
                }
            LDS_BARRIER();
            f32x4 gv[2];
#pragma unroll
            for (int n = 0; n < 2; ++n) gv[n] = *(const LAS f32x4*)(red + XL_CONST + 256 + 32 * wc + 8 * fq + 4 * n);
            bf16_t* base = KVLN + wc * 32 + 8 * fq;
#pragma unroll
            for (int ai = 0; ai < 2; ++ai)
#pragma unroll
                for (int m = 0; m < 4; ++m) {
                    const f32x4 t = *(const LAS f32x4*)(red + (ai * 128 + m * 16 + rl0) * 8);
                    const float r = __builtin_amdgcn_rsqf(((t[0] + t[1]) + (t[2] + t[3])) * (1.0f / 128.0f) + EPS);
                    const size_t row = row0 + ai * 128 + m * 16;
                    bf16_t* rp = base + row * 256;
                    st16(rp, pack8(acc[ai][0][m][0] * r * gv[0], acc[ai][0][m][1] * r * gv[1]));
                    { unsigned z0; asm volatile("v_mov_b32 %0, 0" : "=v"(z0)); st16(rp + 128, (u32x4){z0, z0, z0, z0}); }
                    if (wc == 0) {
                        *(f32x4*)(KR + row * 32 + 8 * fq) = acc[ai][1][m][0]; *(f32x4*)(KR + row * 32 + 8 * fq + 4) = acc[ai][1][m][1];
                        float sr = dot4(acc[ai][1][m][0]) + dot4(acc[ai][1][m][1]);
                        sr = xsum32(xsum16(sr));
                        if (fq == 0) SSR[row] = sr;
                    }
                }
        }
    }
};

struct EpiQ {
    static constexpr bool APERM = false, PREFETCH = false, FP8 = false;
    unsigned char* ws; const float* g;
    __device__ __forceinline__ void operator()(const f32x4 (&acc)[2][2][4][2], const Unit& u, int wr, int wc, int fr, int fq, LAS float* red) const {
        asm volatile("" : "+v"(fr), "+v"(fq), "+s"(wr), "+s"(wc));
        const int rl0 = wr * 64 + fr; const size_t row0 = (size_t)u.pm * 256 + rl0;
        bf16_t* const QM = (bf16_t*)(ws + WS_QM); const float* const cosT = (const float*)(ws + WS_COS); const float* const sinT = (const float*)(ws + WS_SIN);
#pragma unroll
        for (int ai = 0; ai < 2; ++ai)
#pragma unroll
            for (int m = 0; m < 4; ++m)
#pragma unroll
                for (int bj = 0; bj < 2; ++bj) {
                    float ss = dot4(acc[ai][bj][m][0]) + dot4(acc[ai][bj][m][1]);
                    ss = xsum32(xsum16(ss));
                    if (fq == 0) red[(ai * 128 + m * 16 + rl0) * 8 + bj * 4 + wc] = ss;
                }
        LDS_BARRIER();
        if (wc < 2) {
            const f32x4 g0 = *(const f32x4*)(g + 32 * wc + 8 * fq) * (C2_MLA * F8_QS), g1 = *(const f32x4*)(g + 32 * wc + 8 * fq + 4) * (C2_MLA * F8_QS);
#pragma unroll
            for (int ai = 0; ai < 2; ++ai)
#pragma unroll
                for (int mp = 0; mp < 2; ++mp) {
                    const size_t row = row0 + ai * 128 + (2 * mp) * 16;
#pragma unroll
                    for (int bj = 0; bj < 2; ++bj) { u32x2 d[2];
#pragma unroll
                        for (int mm = 0; mm < 2; ++mm) { const int m = 2 * mp + mm;
                            const f32x4 t = *(const LAS f32x4*)(red + (ai * 128 + m * 16 + rl0) * 8 + bj * 4);
                            const float r = __builtin_amdgcn_rsqf(((t[0] + t[1]) + (t[2] + t[3])) * (1.0f / 96.0f) + EPS);
                            d[mm] = f8x8u(acc[ai][bj][m][0] * r * g0, acc[ai][bj][m][1] * r * g1); }
                        unsigned char* pa = (unsigned char*)QM + ((unsigned)row * 768u + (2 * u.pn + bj) * 96u + 32u * wc + 8u * fq);
                        st8pair(pa, pa + 16 * 768, d[0], d[1], fq);
                    }
                }
        } else if (wc == 2) {
            const f32x4 g0 = *(const f32x4*)(g + 64 + 4 * fq) * (C2_MLA * F8_QS), g1 = *(const f32x4*)(g + 80 + 4 * fq) * (C2_MLA * F8_QS);
            f32x4 csv[2][4], snv[2][4];
#pragma unroll
            for (int ai = 0; ai < 2; ++ai)
#pragma unroll
                for (int m = 0; m < 4; ++m) { const unsigned ro = ((unsigned)row0 + ai * 128 + m * 16) * 64u + 16u * fq; csv[ai][m] = *(const f32x4*)((const unsigned char*)cosT + ro); snv[ai][m] = *(const f32x4*)((const unsigned char*)sinT + ro); }
#pragma unroll
            for (int ai = 0; ai < 2; ++ai) {
#pragma unroll
                for (int m = 0; m < 4; ++m) {
                    const unsigned rowu = (unsigned)row0 + ai * 128 + m * 16;
#pragma unroll
                    for (int bj = 0; bj < 2; ++bj) {
                        const f32x4 t = *(const LAS f32x4*)(red + (ai * 128 + m * 16 + rl0) * 8 + bj * 4);
                        const float r = __builtin_amdgcn_rsqf(((t[0] + t[1]) + (t[2] + t[3])) * (1.0f / 96.0f) + EPS);
                        unsigned char* hp = (unsigned char*)QM + (rowu * 768u + (2 * u.pn + bj) * 96u);
                        const f32x4 x1 = acc[ai][bj][m][0] * r * g0, x2 = acc[ai][bj][m][1] * r * g1;
                        { const f32x4 ya = x1 * csv[ai][m] - x2 * snv[ai][m], yb = x2 * csv[ai][m] + x1 * snv[ai][m]; *(unsigned*)(hp + 64 + 4 * fq) = pk_fp8x4u(ya[0], ya[1], ya[2], ya[3]); *(unsigned*)(hp + 80 + 4 * fq) = pk_fp8x4u(yb[0], yb[1], yb[2], yb[3]); }
                    }
                }
                asm volatile("" ::: "memory");
            }
        }
    }
};

struct EpiKV {
    static constexpr bool APERM = false, PREFETCH = false, FP8 = false;
    unsigned char* ws; const float* g;
    __device__ __forceinline__ void operator()(const f32x4 (&acc)[2][2][4][2], const Unit& u, int wr, int wc, int fr, int fq, LAS float* red) const {
        asm volatile("" : "+v"(fr), "+v"(fq), "+s"(wr), "+s"(wc));
        const int rl0 = wr * 64 + fr; const size_t row0 = (size_t)u.pm * 256 + rl0;
        bf16_t* const KM = (bf16_t*)(ws + WS_KM); bf16_t* const VM = (bf16_t*)(ws + WS_VM); const float* const cosT = (const float*)(ws + WS_COS); const float* const sinT = (const float*)(ws + WS_SIN);
        const float* const KR = (const float*)(ws + WS_KR); const float* const SSR = (const float*)(ws + WS_SSR);
        if (wc < 2) {
#pragma unroll
            for (int ai = 0; ai < 2; ++ai)
#pragma unroll
                for (int m = 0; m < 4; ++m)
#pragma unroll
                    for (int bj = 0; bj < 2; ++bj) {
                        float ss = dot4(acc[ai][bj][m][0]) + dot4(acc[ai][bj][m][1]);
                        ss = xsum32(xsum16(ss));
                        if (fq == 0) red[(ai * 128 + m * 16 + rl0) * 8 + bj * 2 + wc] = ss;
                    }
        }
        LDS_BARRIER();
        if (wc < 2) {
            const f32x4 g0 = *(const f32x4*)(g + 32 * wc + 8 * fq) * F8_KS, g1 = *(const f32x4*)(g + 32 * wc + 8 * fq + 4) * F8_KS;
            float ssrv[2][4];
#pragma unroll
            for (int ai = 0; ai < 2; ++ai)
#pragma unroll
                for (int m = 0; m < 4; ++m) ssrv[ai][m] = SSR[row0 + ai * 128 + m * 16];
#pragma unroll
            for (int ai = 0; ai < 2; ++ai)
#pragma unroll
                for (int mp = 0; mp < 2; ++mp) {
                    const size_t row = row0 + ai * 128 + (2 * mp) * 16;
                    const f32x4 t0 = *(const LAS f32x4*)(red + (ai * 128 + (2 * mp) * 16 + rl0) * 8), t1 = *(const LAS f32x4*)(red + (ai * 128 + (2 * mp + 1) * 16 + rl0) * 8);
#pragma unroll
                    for (int bj = 0; bj < 2; ++bj) {
                        const float rk0 = __builtin_amdgcn_rsqf((t0[2 * bj] + t0[2 * bj + 1] + ssrv[ai][2 * mp]) * (1.0f / 96.0f) + EPS), rk1 = __builtin_amdgcn_rsqf((t1[2 * bj] + t1[2 * bj + 1] + ssrv[ai][2 * mp + 1]) * (1.0f / 96.0f) + EPS);
                        unsigned char* pa = (unsigned char*)KM + ((unsigned)row * 768u + (2 * u.pn + bj) * 96u + 32u * wc + 8u * fq);
                        st8pair(pa, pa + 16 * 768, f8x8u(acc[ai][bj][2 * mp][0] * rk0 * g0, acc[ai][bj][2 * mp][1] * rk0 * g1), f8x8u(acc[ai][bj][2 * mp + 1][0] * rk1 * g0, acc[ai][bj][2 * mp + 1][1] * rk1 * g1), fq);
                    }
                    asm volatile("" ::: "memory");
                }
        } else {
            const int bj0 = wc - 2, h0 = 2 * u.pn + bj0;
            { float* pv = (float*)(ws + WS_PARTV) + ((size_t)u.pm * 2 + wr) * 1024 + (2 * u.pn) * 64 + 32 * (wc - 2) + 8 * fq;
              colsum8(acc, 0, fr, pv); colsum8(acc, 1, fr, pv + 64); }
            const f32x4 g0 = *(const f32x4*)(g + 64 + 4 * fq) * F8_KS, g1 = *(const f32x4*)(g + 80 + 4 * fq) * F8_KS;
#pragma unroll
            for (int ai = 0; ai < 2; ++ai)
#pragma unroll
              for (int mp = 0; mp < 2; ++mp) { const unsigned rowa = (unsigned)row0 + ai * 128 + (2 * mp) * 16;
#pragma unroll
                  for (int bj = 0; bj < 2; ++bj) { unsigned char* pa = (unsigned char*)VM + (rowa * 512u + (2 * u.pn + bj) * 64u + 32u * (wc - 2) + 8u * fq);
                      st8pair(pa, pa + 16 * 512, f8x8(acc[ai][bj][2 * mp][0], acc[ai][bj][2 * mp][1]), f8x8(acc[ai][bj][2 * mp + 1][0], acc[ai][bj][2 * mp + 1][1]), fq); } }
            asm volatile("" ::: "memory");
#pragma unroll
            for (int ai = 0; ai < 2; ++ai) {
                f32x4 csv[4], snv[4], k1v[4], k2v[4]; float ssrv[4];
#pragma unroll
                for (int m = 0; m < 4; ++m) { const unsigned rowu = (unsigned)row0 + ai * 128 + m * 16; csv[m] = *(const f32x4*)((const unsigned char*)cosT + rowu * 64u + 16u * fq); snv[m] = *(const f32x4*)((const unsigned char*)sinT + rowu * 64u + 16u * fq);
                    k1v[m] = *(const f32x4*)((const unsigned char*)KR + rowu * 128u + 16u * fq); k2v[m] = *(const f32x4*)((const unsigned char*)KR + rowu * 128u + 64u + 16u * fq); ssrv[m] = *(const float*)((const unsigned char*)SSR + rowu * 4u); }
#pragma unroll
                for (int m = 0; m < 4; ++m) {
                    const unsigned rowu = (unsigned)row0 + ai * 128 + m * 16;
                    const f32x2 t = *(const LAS f32x2*)(red + (ai * 128 + m * 16 + rl0) * 8 + 2 * bj0);
                    const float rk = __builtin_amdgcn_rsqf((t[0] + t[1] + ssrv[m]) * (1.0f / 96.0f) + EPS);
                    const f32x4 x1 = k1v[m] * rk * g0, x2 = k2v[m] * rk * g1;
                    unsigned char* hp = (unsigned char*)KM + (rowu * 768u + h0 * 96u);
                    { const f32x4 ya = x1 * csv[m] - x2 * snv[m], yb = x2 * csv[m] + x1 * snv[m]; *(unsigned*)(hp + 64 + 4 * fq) = pk_fp8x4u(ya[0], ya[1], ya[2], ya[3]); *(unsigned*)(hp + 80 + 4 * fq) = pk_fp8x4u(yb[0], yb[1], yb[2], yb[3]); }
                }
                asm volatile("" ::: "memory");
            }
        }
    }
};

struct EpiQKV {
    static constexpr bool APERM = false, PREFETCH = false, FP8 = false;
    EpiQ q; EpiKV kv;
    __device__ __forceinline__ void operator()(const f32x4 (&acc)[2][2][4][2], const Unit& u, int wr, int wc, int fr, int fq, LAS float* red) const {
        if (u.pn < 4) q(acc, u, wr, wc, fr, fq, red);
        else { Unit v; v.pm = u.pm; v.pn = u.pn - 4; kv(acc, v, wr, wc, fr, fq, red); }
    }
};

__device__ __forceinline__ void f8_pre(f32x4 (&acc)[2][2][4][2], const float* side, int ld, float descale, const Unit& u, int wc, int fq) {
    asm volatile("" : "+v"(fq), "+s"(wc));
    const char* sb = (const char*)(side + (size_t)(u.pm >> 3) * ld + u.pn * 256 + wc * 32); const unsigned vo = (unsigned)fq * 32u;
    f32x4 bv[2][2];
#pragma unroll
    for (int bj = 0; bj < 2; ++bj)
#pragma unroll
        for (int n = 0; n < 2; ++n) bv[bj][n] = *(const f32x4*)(sb + vo + (128 * bj + 4 * n) * 4);
#pragma unroll
    for (int a = 0; a < 2; ++a)
#pragma unroll
        for (int bj = 0; bj < 2; ++bj)
#pragma unroll
            for (int m = 0; m < 4; ++m)
#pragma unroll
                for (int n = 0; n < 2; ++n) acc[a][bj][m][n] = acc[a][bj][m][n] * descale + bv[bj][n];
}
template <bool RES_BF16, bool OUT_BF16, bool F8 = false> struct EpiRes {
    static constexpr bool APERM = false, PREFETCH = false, FP8 = F8;
    __device__ __forceinline__ void pre(f32x4 (&acc)[2][2][4][2], const Unit& u, int wc, int fq) const { f8_pre(acc, side, 1024, 1.0f / (F8_O_SCALE * F8_WOUT_SCALE), u, wc, fq); }
    const void* base; void* out; const float* gate; const float* side = nullptr;
    __device__ __forceinline__ void operator()(const f32x4 (&acc)[2][2][4][2], const Unit& u, int wr, int wc, int fr, int fq, LAS float* red) const {
        asm volatile("" : "+v"(fr), "+v"(fq), "+s"(wr), "+s"(wc));
        const int b = u.pm >> 3; const int col0 = u.pn * 256 + wc * 32 + 8 * fq;
        f32x4 gv[2][2];
#pragma unroll
        for (int bj = 0; bj < 2; ++bj)
#pragma unroll
            for (int n = 0; n < 2; ++n) gv[bj][n] = *(const f32x4*)(gate + (size_t)b * NMOD + col0 + 128 * bj + 4 * n);
        if (RES_BF16) {
            u32x4 raw[2][4][2];
#pragma unroll
            for (int ai = 0; ai < 2; ++ai)
#pragma unroll
                for (int m = 0; m < 4; ++m)
#pragma unroll
                    for (int bj = 0; bj < 2; ++bj) raw[ai][m][bj] = *(const u32x4*)((const bf16_t*)base + ((size_t)u.pm * 256 + ai * 128 + wr * 64 + fr) * DM + col0 + (size_t)m * 16 * DM + 128 * bj);
#pragma unroll
            for (int ai = 0; ai < 2; ++ai) {
                const size_t off0 = ((size_t)u.pm * 256 + ai * 128 + wr * 64 + fr) * DM + col0;
#pragma unroll
                for (int m = 0; m < 4; ++m)
#pragma unroll
                    for (int bj = 0; bj < 2; ++bj) { const u32x4 w = raw[ai][m][bj];
                        const f32x4 x0 = (f32x4){__uint_as_float(w.x << 16), __uint_as_float(w.x & 0xffff0000u), __uint_as_float(w.y << 16), __uint_as_float(w.y & 0xffff0000u)};
                        const f32x4 x1 = (f32x4){__uint_as_float(w.z << 16), __uint_as_float(w.z & 0xffff0000u), __uint_as_float(w.w << 16), __uint_as_float(w.w & 0xffff0000u)};
                        const f32x4 v0 = x0 + gv[bj][0] * acc[ai][bj][m][0], v1 = x1 + gv[bj][1] * acc[ai][bj][m][1];
                        if (OUT_BF16) st16((bf16_t*)out + off0 + (size_t)m * 16 * DM + 128 * bj, pack8(v0, v1));
                        else { *(f32x4*)((float*)out + off0 + (size_t)m * 16 * DM + 128 * bj) = v0; *(f32x4*)((float*)out + off0 + (size_t)m * 16 * DM + 128 * bj + 4) = v1; } }
                asm volatile("" ::: "memory");
            }
        } else {
#pragma unroll
        for (int ai = 0; ai < 2; ++ai) {
            const size_t off0 = ((size_t)u.pm * 256 + ai * 128 + wr * 64 + fr) * DM + col0;
            f32x4 xs[4][2][2];
#pragma unroll
            for (int m = 0; m < 4; ++m)
#pragma unroll
                for (int bj = 0; bj < 2; ++bj)
#pragma unroll
                    for (int n = 0; n < 2; ++n) xs[m][bj][n] = *(const f32x4*)((const float*)base + off0 + (size_t)m * 16 * DM + 128 * bj + 4 * n);
#pragma unroll
            for (int m = 0; m < 4; ++m)
#pragma unroll
                for (int bj = 0; bj < 2; ++bj) {
                    const f32x4 v0 = xs[m][bj][0] + gv[bj][0] * acc[ai][bj][m][0], v1 = xs[m][bj][1] + gv[bj][1] * acc[ai][bj][m][1];
                    if (OUT_BF16) st16((bf16_t*)out + off0 + (size_t)m * 16 * DM + 128 * bj, pack8(v0, v1));
                    else { *(f32x4*)((float*)out + off0 + (size_t)m * 16 * DM + 128 * bj) = v0; *(f32x4*)((float*)out + off0 + (size_t)m * 16 * DM + 128 * bj + 4) = v1; }
                }
            asm volatile("" ::: "memory");
        }
        }
    }
};

struct EpiResNorm {
    static constexpr bool APERM = false, PREFETCH = true, FP8 = true;
    __device__ __forceinline__ void prefetch(const Unit& u, LAS float* xl, int par, int wid, int lane) const {
        asm volatile("" : "+v"(lane));
        if (wid < 5) { const int b = u.pm >> 3; const float* MODb = (const float*)(ws + WS_MOD) + (size_t)b * NMOD;
            const float* src = wid == 0 ? (const float*)(ws + WS_BIAS2) + (size_t)b * 1024 : wid == 1 ? gate + (size_t)b * NMOD : wid == 2 ? gn : wid == 3 ? MODb + 4 * DM : MODb + 3 * DM;
            glds16_(src + u.pn * 256 + 4 * lane, (unsigned)__builtin_amdgcn_readfirstlane((unsigned)(uintptr_t)(xl + XL_CONST + par * 1280 + wid * 256))); }
    }
    __device__ __forceinline__ void pre(f32x4 (&acc)[2][2][4][2], const Unit& u, int wc, int fq, LAS float* xl, int par) const { f8_pre_lds(acc, xl + XL_CONST + par * 1280, 1.0f / (F8_O_SCALE * F8_WOUT_SCALE), wc, fq); }
    const float* base; unsigned char* ws; const float* gate; const float* gn;
    __device__ __forceinline__ void operator()(f32x4 (&acc)[2][2][4][2], const Unit& u, int wr, int wc, int fr, int fq, LAS float* red, int par) const {
        asm volatile("" : "+v"(fr), "+v"(fq), "+s"(wr), "+s"(wc));
        const int b = u.pm >> 3; const int col0 = u.pn * 256 + wc * 32 + 8 * fq; const int rl0 = wr * 64 + fr;
        const LAS float* cst = red + XL_CONST + par * 1280 + wc * 32 + 8 * fq;
        bf16_t* const X1 = (bf16_t*)(ws + WS_X1); bf16_t* const H2 = (bf16_t*)(ws + WS_H2); const float* const MOD = (const float*)(ws + WS_MOD);
        {
            f32x4 gv[2][2];
#pragma unroll
            for (int bj = 0; bj < 2; ++bj)
#pragma unroll
                for (int n = 0; n < 2; ++n) gv[bj][n] = *(const LAS f32x4*)(cst + 256 + 128 * bj + 4 * n);
#pragma unroll
            for (int ai = 0; ai < 2; ++ai) {
                const size_t off0 = ((size_t)u.pm * 256 + ai * 128 + rl0) * DM + col0;
                f32x4 xs[4][2][2];
#pragma unroll
                for (int m = 0; m < 4; ++m)
#pragma unroll
                    for (int bj = 0; bj < 2; ++bj)
#pragma unroll
                        for (int n = 0; n < 2; ++n) xs[m][bj][n] = *(const f32x4*)(base + off0 + (size_t)m * 16 * DM + 128 * bj + 4 * n);
#pragma unroll
                for (int m = 0; m < 4; ++m) { float ss = 0.f;
#pragma unroll
                    for (int bj = 0; bj < 2; ++bj) {
#pragma unroll
                        for (int n = 0; n < 2; ++n) { const f32x4 v = xs[m][bj][n] + gv[bj][n] * acc[ai][bj][m][n]; acc[ai][bj][m][n] = v; ss += dot4(v); }
                        st16(X1 + off0 + (size_t)m * 16 * DM + 128 * bj, pack8(acc[ai][bj][m][0], acc[ai][bj][m][1])); }
                    ss = xsum32(xsum16(ss));
                    if (fq == 0) red[(ai * 128 + m * 16 + rl0) * 8 + wc] = ss;
                }
                asm volatile("" ::: "memory");
            }
        }
        LDS_BARRIER();
        const int tid = tid_from_wave(wr * 4 + wc);
        if (tid < 256) {
            const f32x4 t = *(const LAS f32x4*)(red + tid * 8);
            const float mine = (t[0] + t[1]) + (t[2] + t[3]);
            unsigned long long* slot = (unsigned long long*)(ws + WS_PART) + ((size_t)u.pm * 256 + tid) * 4;
            { unsigned tg; asm volatile("v_mov_b32 %0, 1" : "=v"(tg));
              __hip_atomic_store(slot + u.pn, ((unsigned long long)tg << 32) | (unsigned long long)__float_as_uint(mine), __ATOMIC_RELAXED, __HIP_MEMORY_SCOPE_AGENT); }
            float tot = mine;
#pragma unroll
            for (int k = 1; k < 4; ++k) { const int pk = (u.pn + k) & 3; unsigned long long w; unsigned sp = 0;
                for (;;) { w = __hip_atomic_load(slot + pk, __ATOMIC_RELAXED, __HIP_MEMORY_SCOPE_AGENT); if ((unsigned)(w >> 32) == 1u || ++sp > (1u << 22)) break; __builtin_amdgcn_s_sleep(1); }
                tot += __uint_as_float((unsigned)w); }
            red[tid * 8 + 4] = __builtin_amdgcn_rsqf(tot * (1.0f / DM) + EPS);
        }
        LDS_BARRIER();
        {
            f32x4 Gv[2][2], Sv[2][2];
#pragma unroll
            for (int bj = 0; bj < 2; ++bj)
#pragma unroll
                for (int n = 0; n < 2; ++n) { const int c = col0 + 128 * bj + 4 * n;
                    Gv[bj][n] = *(const LAS f32x4*)(cst + 512 + 128 * bj + 4 * n) * (*(const LAS f32x4*)(cst + 768 + 128 * bj + 4 * n) + 1.0f); Sv[bj][n] = *(const LAS f32x4*)(cst + 1024 + 128 * bj + 4 * n); (void)c; }
#pragma unroll
            for (int ai = 0; ai < 2; ++ai)
#pragma unroll
                for (int m = 0; m < 4; ++m) {
                    const float r = red[(ai * 128 + m * 16 + rl0) * 8 + 4];
                    bf16_t* rp = H2 + ((size_t)u.pm * 256 + ai * 128 + m * 16 + rl0) * DM + col0;
#pragma unroll
                    for (int bj = 0; bj < 2; ++bj) st16(rp + 128 * bj, pack8(acc[ai][bj][m][0] * r * Gv[bj][0] + Sv[bj][0], acc[ai][bj][m][1] * r * Gv[bj][1] + Sv[bj][1]));
                }
        }
    }
};

__device__ __forceinline__ float dpp_shr1(float v) { return __builtin_bit_cast(float, __builtin_amdgcn_update_dpp(0, __builtin_bit_cast(int, v), 0x111, 0xF, 0xF, true)); }
__device__ __forceinline__ f32x4 dpp_shr1(f32x4 v) { f32x4 r; r[0] = dpp_shr1(v[0]); r[1] = dpp_shr1(v[1]); r[2] = dpp_shr1(v[2]); r[3] = dpp_shr1(v[3]); return r; }
struct EpiUp {
    static constexpr bool APERM = true, PREFETCH = true, FP8 = false;
    unsigned char* ws; const float *cw, *cb;
    __device__ __forceinline__ void prefetch(const Unit& u, LAS float* xl, int par, int wid, int lane) const {
        asm volatile("" : "+v"(lane));
        if (wid < 4) { const float* src = (wid < 3 ? cw + (size_t)wid * DFF2 : cb) + (lane < 32 ? 128 * u.pn + 4 * lane : DFF + 128 * u.pn + 4 * (lane - 32));
            glds16_(src, (unsigned)__builtin_amdgcn_readfirstlane((unsigned)(uintptr_t)(xl + par * 1024 + wid * 256))); }
    }
    __device__ __forceinline__ void operator()(const f32x4 (&acc)[2][2][4][2], const Unit& u, int wr, int wc, int fr, int fq, LAS float* xl, int par) const {
        asm volatile("" : "+v"(fr), "+v"(fq), "+s"(wr), "+s"(wc));
        const int j = u.pn; const int cc0 = 32 * wc + 8 * fq;
        bf16_t* const ACT = (bf16_t*)(ws + WS_ACT); bf16_t* const RAW4 = (bf16_t*)(ws + WS_RAW4);
        const LAS float* W = xl + par * 1024 + cc0;
#pragma unroll
        for (int ai = 0; ai < 2; ++ai) {
            const size_t blk = (size_t)u.pm * 4 + 2 * ai + wr;
            u32x2 pend[4];
#pragma unroll
            for (int n = 0; n < 2; ++n) {
                const f32x4 wg0 = *(const LAS f32x4*)(W + 4 * n), wg1 = *(const LAS f32x4*)(W + 256 + 4 * n), wg2 = *(const LAS f32x4*)(W + 512 + 4 * n), bg = *(const LAS f32x4*)(W + 768 + 4 * n);
                const f32x4 wv0 = *(const LAS f32x4*)(W + 128 + 4 * n), wv1 = *(const LAS f32x4*)(W + 384 + 4 * n), wv2 = *(const LAS f32x4*)(W + 640 + 4 * n), bv = *(const LAS f32x4*)(W + 896 + 4 * n);
                const f32x4 g2s = dpp_shr1(acc[ai][0][2][n]), g3s = dpp_shr1(acc[ai][0][3][n]), v2s = dpp_shr1(acc[ai][1][2][n]), v3s = dpp_shr1(acc[ai][1][3][n]);
#pragma unroll
                for (int m = 0; m < 4; ++m) {
                    const f32x4 gr = acc[ai][0][m][n], vr = acc[ai][1][m][n];
                    const f32x4 gp1 = m == 0 ? g3s : acc[ai][0][m - 1 < 0 ? 0 : m - 1][n], gp2 = m == 0 ? g2s : (m == 1 ? g3s : acc[ai][0][m - 2 < 0 ? 0 : m - 2][n]);
                    const f32x4 vp1 = m == 0 ? v3s : acc[ai][1][m - 1 < 0 ? 0 : m - 1][n], vp2 = m == 0 ? v2s : (m == 1 ? v3s : acc[ai][1][m - 2 < 0 ? 0 : m - 2][n]);
                    const f32x4 G = wg2 * gr + (wg1 * gp1 + (wg0 * gp2 + bg)), V = wv2 * vr + (wv1 * vp1 + (wv0 * vp2 + bv));
                    f32x4 a;
#pragma unroll
                    for (int e = 0; e < 4; ++e) a[e] = G[e] * __builtin_amdgcn_rcpf(1.0f + __builtin_amdgcn_exp2f(-LOG2E * G[e])) * V[e];
                    if (n == 0) pend[m] = pack4(a);
                    else if (m >= 2 || fr > 0) { const u32x2 hi2 = pack4(a); const unsigned boff = (((unsigned)blk * 64u + 4u * fr + m) * DFF + 128u * j + cc0) * 2u;
                        st16o(ACT, boff, (u32x4){pend[m].x, pend[m].y, hi2.x, hi2.y}); }
                    if ((m < 2 && fr == 0) || (m >= 2 && fr == 15)) { const unsigned roff = (((unsigned)blk * 4u + m) * DFF2 + 256u * j + cc0 + 4u * n) * 2u; *(u32x2*)((unsigned char*)RAW4 + roff) = pack4(gr); *(u32x2*)((unsigned char*)RAW4 + roff + 256u) = pack4(vr); }
                }
            }
            asm volatile("" ::: "memory");
        }
    }
};

namespace att {
__device__ __forceinline__ int crow(int r, int hi) { return (r & 3) + 8 * (r >> 2) + 4 * hi; }
__device__ __forceinline__ void glds16(const void* gsrc, unsigned lds_dst) { unsigned keep;
    asm volatile("s_mov_b32 %0, m0\n\ts_mov_b32 m0, %2\n\ts_nop 0\n\tglobal_load_lds_dwordx4 %1, off\n\ts_mov_b32 m0, %0" : "=&s"(keep) : "v"(gsrc), "s"(lds_dst) : "memory"); }
__device__ __forceinline__ void glds16s(const void* sbase, unsigned voff, unsigned lds_dst) { unsigned keep;
    asm volatile("s_mov_b32 %0, m0\n\ts_mov_b32 m0, %3\n\ts_nop 0\n\tglobal_load_lds_dwordx4 %1, %2\n\ts_mov_b32 m0, %0" : "=&s"(keep) : "v"(voff), "s"(sbase), "s"(lds_dst) : "memory"); }
__device__ __forceinline__ float max3f(float a, float b, float c) { float r; asm("v_max3_f32 %0, %1, %2, %3" : "=v"(r) : "v"(a), "v"(b), "v"(c)); return r; }
__device__ __forceinline__ float rowmax(const f32x16& p0, const f32x16& p1) {
    float a = max3f(p0[0], p0[1], p1[0]), b = max3f(p0[2], p0[3], p1[1]); a = max3f(a, p1[2], p1[3]);
#pragma unroll
    for (int r = 4; r < 16; r += 4) { a = max3f(a, p0[r], p0[r + 1]); b = max3f(b, p0[r + 2], p0[r + 3]); a = max3f(a, p1[r], p1[r + 1]); b = max3f(b, p1[r + 2], p1[r + 3]); }
    const float m = fmaxf(a, b);
    auto rr = __builtin_amdgcn_permlane32_swap(__float_as_uint(m), __float_as_uint(m), false, false);
    return fmaxf(__uint_as_float(rr[0]), __uint_as_float(rr[1]));
}
typedef short v4i16_t __attribute__((ext_vector_type(4)));
__device__ __forceinline__ s16x4 vtr(const LAS unsigned char* p) { return __builtin_bit_cast(s16x4, __builtin_amdgcn_ds_read_tr16_b64_v4i16((LAS v4i16_t*)p)); }
__device__ __forceinline__ void pv(f32x16* o, const LAS unsigned char* vp, bf16x8 pa0, bf16x8 pa1, bf16x8 pa2, bf16x8 pa3) {
#pragma unroll
    for (int d0 = 0; d0 < 2; ++d0) { s16x4 lo[4], hi[4];
        __builtin_amdgcn_sched_barrier(0);
#pragma unroll
        for (int ks = 0; ks < 4; ++ks) { lo[ks] = vtr(vp + d0 * 4096 + ks * 1024); hi[ks] = vtr(vp + d0 * 4096 + ks * 1024 + 512); }
#define PK(k) (bf16x8){lo[k][0], lo[k][1], lo[k][2], lo[k][3], hi[k][0], hi[k][1], hi[k][2], hi[k][3]}
        o[d0] = __builtin_amdgcn_mfma_f32_32x32x16_bf16(pa0, PK(0), o[d0], 0, 0, 0);
        o[d0] = __builtin_amdgcn_mfma_f32_32x32x16_bf16(pa1, PK(1), o[d0], 0, 0, 0);
        o[d0] = __builtin_amdgcn_mfma_f32_32x32x16_bf16(pa2, PK(2), o[d0], 0, 0, 0);
        o[d0] = __builtin_amdgcn_mfma_f32_32x32x16_bf16(pa3, PK(3), o[d0], 0, 0, 0);
#undef PK
    }
}
constexpr int NSLOT = 4;
constexpr int ATT_LDS_BYTES = 3 * 6144 + 3 * 4096 + 8 * 256 + 2048 + 3 * 16384 + 8 * 2048 + 4096;

__device__ __forceinline__ float wave_max(float v) {
#pragma unroll
    for (int o = 1; o < 64; o <<= 1) v = fmaxf(v, __shfl_xor(v, o));
    return v;
}
template <int DQK, bool CA>
__device__ __forceinline__ void attn_run(int tid, int b, int h, unsigned ulist, int nu, const unsigned char* Q, const unsigned char* K, const unsigned char* V, unsigned char* O, float* REF, unsigned* refcnt, const float* PARTV, const float* relb, float S0, LAS unsigned char* shm) {
    constexpr int NQ = (DQK + 63) / 64, NGQ = 2 * NQ, NQL = 2 * NQ, NCH = DQK / 16, KSLOT = NCH * 1024, VSLOT = 4096, NS = 3;
    constexpr int LDS_K = 0, LDS_V = NS * KSLOT, LDS_WS = LDS_V + NS * VSLOT, LDS_TAB = LDS_WS + 8 * 256, LDS_IMG = LDS_TAB + 2048, LDS_OST = LDS_IMG + (CA ? 3 * 16384 : 0), LDS_VB = LDS_OST + 8 * 2048;
    constexpr int LDQ = CA ? 512 : 768, LDV = 512, LDO = 1024, OCOL = CA ? 512 : 0;
    const int lane = tid & 63, r32 = lane & 31, hi = lane >> 5; const int wid = __builtin_amdgcn_readfirstlane(tid >> 6);
    const long rowbase = (long)b * SEQ; const int tidl = wid * 64 + lane;
    const unsigned lds0 = (unsigned)(uintptr_t)shm;
    LAS float* tab = (LAS float*)(shm + LDS_TAB);
    const unsigned char* Kb = K + rowbase * LDQ + h * DQK; const unsigned char* Vb = V + rowbase * LDV + h * 64;
    const bool kw = wid < NCH, vw = wid >= 4;
    const unsigned kvoff = (unsigned)(lane * LDQ + (wid < NCH ? wid : 0) * 16);
    const unsigned vvoff = (unsigned)((16 * (wid & 3) + (lane >> 2)) * LDV + (lane & 3) * 16);
#define SBAR() __builtin_amdgcn_sched_barrier(0)
#define PIN(x) asm volatile("" : "+v"(x))
#define DMA_K(t, sl) do { if (kw) glds16s(Kb + (long)(t) * 64 * LDQ, kvoff, (unsigned)__builtin_amdgcn_readfirstlane(lds0 + LDS_K + (sl) * KSLOT + wid * 1024)); } while (0)
#define DMA_V(t, sl) do { if (vw) glds16s(Vb + (long)(t) * 64 * LDV, vvoff, (unsigned)__builtin_amdgcn_readfirstlane(lds0 + LDS_V + (sl) * VSLOT + (wid & 3) * 1024)); } while (0)
#define WAIT_BAR(N) asm volatile("s_waitcnt vmcnt(%0) lgkmcnt(0)\n\ts_barrier" :: "n"(N) : "memory")
#define WAIT_KV(nK, nV, X) do { if (kw && vw) WAIT_BAR((nK) + (nV) + (X)); else if (kw) WAIT_BAR((nK) + (X)); else if (vw) WAIT_BAR((nV) + (X)); else WAIT_BAR(X); } while (0)
#define TVALID(tau) (CA ? ((tau) + t0 <= cw && (tau) + t0 >= cw - 8) : ((tau) + t0 <= cw))
#define TABS(x) ((x) < NT ? t0 + (x) : t0n + (x) - NT)
#define T0OF(u_) (CA ? (4 * (u_) - 8 > 0 ? 4 * (u_) - 8 : 0) : 0)
#define QLOAD(u_) do { const unsigned char* Qw_ = Q + (rowbase + (u_) * 256 + wid * 32) * LDQ + h * DQK; const int lq_ = tid_from_wave(0); const unsigned qo_ = (unsigned)((lq_ & 31) * LDQ); \
        _Pragma("unroll") for (int p = 0; p < NQ; ++p) { const unsigned po_ = qo_ + ((p == 1 && DQK == 96) ? 64u : (unsigned)(p * 64 + (lq_ >> 5) * 32)); \
            const i32x4 lo_ = *(const i32x4*)(Qw_ + po_), hi_ = *(const i32x4*)(Qw_ + po_ + 16); qr[p] = __builtin_shufflevector(lo_, hi_, 0, 1, 2, 3, 4, 5, 6, 7); } } while (0)
#define QREADY() do { _Pragma("unroll") for (int p = 0; p < NQ; ++p) asm volatile("" :: "v"(qr[p])); \
        if (DQK == 96) { _Pragma("unroll") for (int e = 0; e < 8; ++e) qr[NQ - 1][e] = hi ? 0 : qr[NQ - 1][e]; } } while (0)
#ifndef SH_EXTRA
#define SH_EXTRA 0
#endif
    float SHI = fmaxf(ceilf(S0 - 15.5f), 0.0f) + SH_EXTRA; float pscale = __builtin_amdgcn_exp2f(SHI);
    float tabc = 0.f;
    const LAS unsigned char* vp0 = shm + LDS_V + (4 * hi + (((lane & 15) >> 1) & 3) + 8 * ((lane & 15) >> 3)) * 64 + ((lane >> 4) & 1) * 16 + (lane & 1) * 8;
    const LAS unsigned char* kp0 = shm + LDS_K + hi * 2048 + r32 * 16;
    const LAS unsigned char* kp1 = shm + LDS_K + 4096 + r32 * 16;
    const LAS unsigned char* imgp = shm + LDS_IMG + (wid & 1) * 8192 + lane * 16;
    i32x8 qr[NQ]; i32x8 kf[NGQ]  ; i32x8 vb[2]; i32x8 pw; f32x16 pA0, pA1, pB0, pB1;
    i32x8 ones8;
#pragma unroll
    for (int e = 0; e < 8; ++e) ones8[e] = 0x38383838;
    PIN(ones8);
    int sl_prev = 0, sl_cur = 0, sl_next = 1;
#define ROT() do { sl_prev = sl_cur; sl_cur = sl_next; sl_next = (sl_next == NS - 1) ? 0 : sl_next + 1; } while (0)
#define KFL(g, ks_) do { const LAS unsigned char* a_ = (((g) >> 1) ? kp1 : kp0) + (ks_) + ((g) & 1) * 512; const i32x4 lo_ = *(const LAS i32x4*)(a_), hi_ = *(const LAS i32x4*)(a_ + 1024); kf[g] = __builtin_shufflevector(lo_, hi_, 0, 1, 2, 3, 4, 5, 6, 7); } while (0)
#define QKM(kfr, qfr, C) __builtin_amdgcn_mfma_scale_f32_32x32x64_f8f6f4(kfr, qfr, C, 0, 0, 0, 0, 0, 0)
#define VRD(i, vp_) do { const i32x2 t_ = __builtin_amdgcn_ds_read_tr8_b64_v2i32((LAS i32x2*)((vp_) + ((i) & 3) * 1024 + ((i) >> 2) * 32)); vb[(i) >> 2][2 * ((i) & 3)] = t_[0]; vb[(i) >> 2][2 * ((i) & 3) + 1] = t_[1]; } while (0)
#define PEL(P0, P1, e) ((e) < 16 ? P0[(e) & 15] : P1[(e) & 15])
#define PWSET(w, P0, P1) do { s16x2 x_ = __builtin_bit_cast(s16x2, undef_i32()); x_ = __builtin_amdgcn_cvt_scalef32_pk_bf8_f32(x_, PEL(P0, P1, 4 * (w)), PEL(P0, P1, 4 * (w) + 1), psc_, false); \
        x_ = __builtin_amdgcn_cvt_scalef32_pk_bf8_f32(x_, PEL(P0, P1, 4 * (w) + 2), PEL(P0, P1, 4 * (w) + 3), psc_, true); pw[w] = __builtin_bit_cast(int, x_); } while (0)
#define PVM(d0) o[d0] = __builtin_amdgcn_mfma_scale_f32_32x32x64_f8f6f4(pw, vb[d0], o[d0], 1, 0, 0, 0, 0, 0)
#define PVL() lacc = __builtin_amdgcn_mfma_scale_f32_32x32x64_f8f6f4(pw, ones8, lacc, 1, 0, 0, 0, 0, 0)
#define QK_FIRST(C0, C1, A0, A1, tau) do { const int dist_ = cw - ((tau) + t0); \
        if (CA && TVALID(tau) && dist_ < 3) { const LAS unsigned char* ip_ = imgp + dist_ * 16384; \
            _Pragma("unroll") for (int g = 0; g < 4; ++g) { const f32x4 x_ = *(const LAS f32x4*)(ip_ + g * 1024); C0[4 * g] = x_[0]; C0[4 * g + 1] = x_[1]; C0[4 * g + 2] = x_[2]; C0[4 * g + 3] = x_[3]; } \
            C0 = QKM(A0, qr[0], C0); \
            _Pragma("unroll") for (int g = 0; g < 4; ++g) { const f32x4 y_ = *(const LAS f32x4*)(ip_ + (g + 4) * 1024); C1[4 * g] = y_[0]; C1[4 * g + 1] = y_[1]; C1[4 * g + 2] = y_[2]; C1[4 * g + 3] = y_[3]; } \
            C1 = QKM(A1, qr[0], C1); } \
        else { const f32x16 cz_ = f32x16{}; C0 = QKM(A0, qr[0], cz_); C1 = QKM(A1, qr[0], cz_); } } while (0)
#define FILLA(i0, i1) do { _Pragma("unroll") for (int w = (8 * (i0)) / NGQ; w < (8 * (i1)) / NGQ; ++w) PWSET(w, P0_, P1_); \
        PIN(pw); } while (0)
#define PHASE_A(C0, C1, P0, P1, tau, vsl, GK, GV, kdst, vdst) do { const LAS unsigned char* vp_ = vp0 + (vsl) * VSLOT; f32x16& P0_ = P0; f32x16& P1_ = P1; \
        const float psc_ = TVALID((tau) - 1) ? pscale : 0x1p100f;        \
        VRD(0, vp_); VRD(1, vp_); SBAR(); \
        QK_FIRST(C0, C1, kf[0], kf[1], tau); \
        FILLA(0, 2); SBAR(); \
        _Pragma("unroll") for (int i = 2; i < NGQ; ++i) { \
            VRD(2 * i - 2, vp_); VRD(2 * i - 1, vp_); SBAR(); \
            if ((i & 1) == 0) C0 = QKM(kf[i], qr[i >> 1], C0); else C1 = QKM(kf[i], qr[i >> 1], C1); \
            FILLA(i, i + 1); \
            if (i == NGQ - 2 && (GK)) DMA_K(TABS((tau) + 3), kdst); if (i == NGQ - 1 && (GV)) DMA_V(TABS((tau) + 1), vdst);     \
            SBAR(); } \
        if (NGQ == 2) { VRD(2, vp_); VRD(3, vp_); VRD(4, vp_); VRD(5, vp_); if (GK) DMA_K(TABS((tau) + 3), kdst); if (GV) DMA_V(TABS((tau) + 1), vdst); SBAR(); } \
        } while (0)
#define PHASE_B(C0, C1, GL, ksl, vsl) do { const int kso_ = (ksl) * KSLOT; const LAS unsigned char* vq_ = vp0 + (vsl) * VSLOT; \
        _Pragma("unroll") for (int j = 0; j < 3; ++j) { \
            if (GL) { _Pragma("unroll") for (int g = (NGQ * j + 2) / 3; g < (NGQ * (j + 1) + 2) / 3; ++g) KFL(g, kso_); SBAR(); } \
            if (j == 0) { PVM(0); VRD(6, vq_); VRD(7, vq_); }       \
            else if (j == 1) PVM(1); else PVL(); \
            _Pragma("unroll") for (int e = (32 * j) / 3; e < (32 * (j + 1)) / 3; ++e) { if (e < 16) C0[e & 15] = __builtin_amdgcn_exp2f(C0[e & 15]); else C1[e & 15] = __builtin_amdgcn_exp2f(C1[e & 15]); } \
            PIN(C0); PIN(C1); SBAR(); } } while (0)
#define STEP(C0, C1, P0, P1, tau, GK, GV, GL) do { SBAR(); \
        PHASE_A(C0, C1, P0, P1, tau, sl_prev, GK, GV, sl_cur, sl_next); SBAR(); \
        PHASE_B(C0, C1, GL, sl_next, sl_prev); } while (0)
#define ENDW(tau) do { if (has_next || (tau) + 3 < NT) { WAIT_KV(1, 1, 0); } else if ((tau) + 2 < NT) { WAIT_KV(0, 1, 0); } else { WAIT_BAR(0); } } while (0)
    for (int ui = 0; ui < nu; ++ui) {
        const int u = (int)((ulist >> (8 * ui)) & 255u); const bool has_next = ui + 1 < nu; const int un = has_next ? (int)((ulist >> (8 * (ui + 1))) & 255u) : 0;
        const int t0 = T0OF(u), t1 = 4 * u + 3, cw = 4 * u + (wid >> 1), NT = t1 - t0 + 1, t0n = T0OF(un);
        f32x16 o[2], lacc; o[0] = f32x16{}; o[1] = f32x16{}; lacc = f32x16{};
        int s0, s1, s2;
        if (ui == 0) {
            s0 = 0; s1 = 1; s2 = 2;
            DMA_K(t0 + 0, 0); DMA_V(t0 + 0, 0); DMA_K(t0 + 1, 1); DMA_K(t0 + 2, 2);
            QLOAD(u);
            if (CA) { for (int i = tidl; i < 320; i += 512) tab[i] = relb[h * 257 + (i < 256 ? i : 256)] * LOG2E; }
            if (wid == 0) { const int t2 = tid_from_wave(0); const float* pv = PARTV + (size_t)b * 16 * 1024 + OCOL + h * 64 + t2; float sm = 0.f;
#pragma unroll
                for (int j = 0; j < 16; ++j) sm += pv[j * 1024];
                sm *= (1.0f / SEQ); ((LAS float*)(shm + LDS_VB))[512 + t2] = sm; REF[(size_t)b * 1024 + OCOL + h * 64 + t2] = sm;
                asm volatile("s_waitcnt vmcnt(0)" ::: "memory"); __builtin_amdgcn_fence(__ATOMIC_RELEASE, "agent");
                if (t2 == 0) __hip_atomic_fetch_add(refcnt, 1u, __ATOMIC_RELAXED, __HIP_MEMORY_SCOPE_AGENT); }
            QREADY();
            if (CA) {
                asm volatile("s_waitcnt lgkmcnt(0)\n\ts_barrier" ::: "memory");
                float bm = 0.f; for (int i = lane; i < 257; i += 64) bm = fmaxf(bm, fabsf(tab[i]));
                S0 += 2.0f * wave_max(bm); SHI = fmaxf(ceilf(S0 - 15.5f), 0.0f) + SH_EXTRA; pscale = __builtin_amdgcn_exp2f(SHI); tabc = tab[256];
                LAS float* img = (LAS float*)(shm + LDS_IMG);
                for (int i = tidl; i < 3 * 2 * 8 * 256; i += 512) { const int e = i & 3, ln = (i >> 2) & 63, g = (i >> 8) & 7, hf = (i >> 11) & 1, ds = i >> 12;
                    img[i] = tab[64 * ds + 32 * hf + (ln & 31) + 128 - 4 * (ln >> 5) - (e + 8 * (g & 3)) - 32 * (g >> 2)] - tabc; }
            }
            WAIT_KV(2, 1, 0);
        } else {
            s0 = sl_cur; s1 = sl_next; s2 = (s1 == NS - 1) ? 0 : s1 + 1;
            QREADY();
        }
        { const int ks0_ = s0 * KSLOT;
#pragma unroll
          for (int g = 0; g < NGQ; ++g) KFL(g, ks0_);
          QK_FIRST(pA0, pA1, kf[0], kf[1], 0);
#pragma unroll
          for (int g = 2; g < NGQ; ++g) { if ((g & 1) == 0) pA0 = QKM(kf[g], qr[g >> 1], pA0); else pA1 = QKM(kf[g], qr[g >> 1], pA1); } }
#pragma unroll
        for (int r = 0; r < 16; ++r) { pA0[r] = __builtin_amdgcn_exp2f(pA0[r]); pA1[r] = __builtin_amdgcn_exp2f(pA1[r]); }
        WAIT_BAR(0);
        DMA_K(TABS(3), s0); DMA_V(TABS(1), s1);
        { const int ks1_ = s1 * KSLOT;
#pragma unroll
          for (int g = 0; g < NGQ; ++g) KFL(g, ks1_); }
        WAIT_KV(1, 1, 0);
        sl_prev = s0; sl_cur = s1; sl_next = s2;
        int tau = 1;
        for (; tau + 5 < NT; tau += 2) {
            STEP(pB0, pB1, pA0, pA1, tau, true, true, true);     WAIT_KV(1, 1, 0); ROT();
            STEP(pA0, pA1, pB0, pB1, tau + 1, true, true, true); WAIT_KV(1, 1, 0); ROT();
        }
        for (; tau + 1 < NT; tau += 2) {
            STEP(pB0, pB1, pA0, pA1, tau, (has_next || tau + 3 < NT), (has_next || tau + 1 < NT), (tau + 1 < NT));     ENDW(tau);     ROT();
            STEP(pA0, pA1, pB0, pB1, tau + 1, (has_next || tau + 4 < NT), (has_next || tau + 2 < NT), (tau + 2 < NT)); ENDW(tau + 1); ROT();
        }
        STEP(pB0, pB1, pA0, pA1, NT - 1, has_next, has_next, false);
        int vdr = sl_cur;
        if (has_next) { QLOAD(un);
            WAIT_KV(1, 1, NQL); ROT(); vdr = sl_prev; }
        { { const LAS unsigned char* vd_ = vp0 + vdr * VSLOT; const float psc_ = TVALID(NT - 1) ? pscale : 0x1p100f;
#pragma unroll
            for (int i = 0; i < 8; ++i) VRD(i, vd_);
#pragma unroll
            for (int w = 0; w < 8; ++w) PWSET(w, pB0, pB1);
            PVM(0); PVM(1); PVL(); } }
        { const int le = tid_from_wave(0), r32e = le & 31, hie = le >> 5;
          float rli[16];
#pragma unroll
          for (int r = 0; r < 16; ++r) rli[r] = __builtin_amdgcn_rcpf(lacc[r]);
          unsigned char* Ow = O + (rowbase + u * 256 + wid * 32) * LDO + OCOL + h * 64;
          LAS unsigned char* stg = shm + LDS_OST + wid * 2048;
          const LAS float* vbm = (const LAS float*)(shm + LDS_VB) + 512; const float vb0 = vbm[r32e], vb1 = vbm[32 + r32e];
#pragma unroll
          for (int r = 0; r < 16; ++r) { const int orow = crow(r, hie);
              const float y0 = (o[0][r] * rli[r] - vb0) * F8_O_SCALE, y1 = (o[1][r] * rli[r] - vb1) * F8_O_SCALE;
              const unsigned w = (unsigned)__builtin_amdgcn_cvt_pk_fp8_f32(__builtin_amdgcn_fmed3f(y0, -448.f, 448.f), __builtin_amdgcn_fmed3f(y1, -448.f, 448.f), undef_i32(), false);
              stg[orow * 64 + r32e] = (unsigned char)(w & 255u); stg[orow * 64 + 32 + r32e] = (unsigned char)((w >> 8) & 255u); }
#pragma unroll
          for (int i = 0; i < 2; ++i) { const int row = i * 16 + (le >> 2), ch = le & 3; const u32x4 v = *(const LAS u32x4*)(stg + row * 64 + ch * 16); st16((char*)Ow + (unsigned)(row * LDO + ch * 16), v); } }
    }
    asm volatile("s_waitcnt lgkmcnt(0)\n\ts_barrier" ::: "memory");
#undef SBAR
#undef PIN
#undef DMA_K
#undef WAIT_KV
#undef QREADY
#undef KFL
#undef QKM
#undef FILLA
#undef DMA_V
#undef WAIT_BAR
#undef TVALID
#undef TABS
#undef T0OF
#undef QLOAD
#undef VRD
#undef PVM
#undef PVL
#undef PEL
#undef PWSET
#undef QK_FIRST
#undef PHASE_A
#undef PHASE_B
#undef ROT
#undef STEP
#undef ENDW
}
}

constexpr int NWAVES = 8;
constexpr int NPHASE = 10;
constexpr int N_LAUNCHES = MK_N_LAUNCHES;
static_assert(N_LAUNCHES == 1 || N_LAUNCHES == NPHASE, "MK_N_LAUNCHES is 1 or 10");

constexpr int RING_BYTES = 131072, XL_OFF = RING_BYTES, LDS_BYTES = 155648, LDSCTL_OFF = LDS_BYTES - 1024, MISC_OFF = LDSCTL_OFF + 320;
static_assert(XL_OFF + 8192 + 12288 <= LDSCTL_OFF && att::ATT_LDS_BYTES <= LDSCTL_OFF, "LDS map");

typedef GAS unsigned gu32;
#define RLX_AGENT __ATOMIC_RELAXED, __HIP_MEMORY_SCOPE_AGENT

#define XB_TMO      128
#define XB_XCNT(j)  (256  + 64 * (j))
#define XB_XSUB(j)  (1280 + 64 * (j))
#define XB_XGEN(j)  (2304 + 64 * (j))
#define XB_TOP      3328
#define XB_TOPGEN   3392
#define XCD_BAR_WORDS 3456
#define XB_SPIN_CAP (1u << 18)
__device__ __forceinline__ unsigned xb_ld(unsigned* p)              { return __hip_atomic_load(p, __ATOMIC_RELAXED, __HIP_MEMORY_SCOPE_AGENT); }
__device__ __forceinline__ unsigned xb_add(unsigned* p, unsigned v) { return __hip_atomic_fetch_add(p, v, __ATOMIC_RELAXED, __HIP_MEMORY_SCOPE_AGENT); }
__device__ __forceinline__ unsigned xb_xcc_id() { return (unsigned)__builtin_amdgcn_s_getreg((3 << 11) | 20) & 0xFu; }
#define XB_SPIN(cond, bar) do { unsigned _sp = 0; while (cond) { __builtin_amdgcn_s_sleep(1); \
    if ((++_sp & 255u) == 0u) { if (xb_ld(&(bar)[XB_TMO])) break; if (_sp > XB_SPIN_CAP) { atomicAdd(&(bar)[XB_TMO], 1u); break; } } } } while (0)
struct XcdBarrier { unsigned* bar; unsigned x; volatile LAS unsigned* st; int wave; };
__device__ __forceinline__ XcdBarrier xcd_barrier_post(unsigned* bar, volatile LAS unsigned* st, int wave) {
    XcdBarrier b; b.bar = bar; b.x = xb_xcc_id(); b.st = st; b.wave = wave;
    if (tid_from_wave(wave) == 0) (void)xb_add(&bar[XB_XCNT(b.x)], 1u);
    return b;
}
__device__ __forceinline__ void xcd_barrier_complete(unsigned* bar, unsigned x, unsigned& nloc, unsigned& nx) {
    const unsigned G = gridDim.x * gridDim.y * gridDim.z;
    unsigned sum, cnt, mine, sp = 0u;
    for (;;) {
        sum = 0u; cnt = 0u; mine = 0u;
#pragma unroll
        for (unsigned j = 0; j < 16; ++j) { const unsigned c = xb_ld(&bar[XB_XCNT(j)]); sum += c; cnt += (c > 0u) ? 1u : 0u; mine = (j == x) ? c : mine; }
        if (sum == G) break;
        __builtin_amdgcn_s_sleep(1);
        if ((++sp & 255u) == 0u) { if (xb_ld(&bar[XB_TMO])) break; if (sp > XB_SPIN_CAP) { atomicAdd(&bar[XB_TMO], 1u); break; } }
    }
    nloc = mine > 0u ? mine : 1u; nx = cnt > 0u ? cnt : 1u;
}
__device__ __forceinline__ void xcd_barrier(const XcdBarrier& b) {
    asm volatile("s_waitcnt vmcnt(0)" ::: "memory");
    __syncthreads();
    if (tid_from_wave(b.wave) == 0) {
        unsigned* bar = b.bar;
        __builtin_amdgcn_s_waitcnt(0);
        unsigned nloc = b.st[0], nx = b.st[1];
        if (nloc == 0u) { xcd_barrier_complete(bar, b.x, nloc, nx); b.st[0] = nloc; b.st[1] = nx; }
        const unsigned old = xb_add(&bar[XB_XSUB(b.x)], 1u);
        const unsigned gen = old / nloc;
        if (old + 1u == (gen + 1u) * nloc) {
            __builtin_amdgcn_fence(__ATOMIC_RELEASE, "agent");
            asm volatile("s_waitcnt vmcnt(0)" ::: "memory");
            const unsigned og = xb_add(&bar[XB_TOP], 1u);
            const unsigned tg = og / nx;
            if (og + 1u == (tg + 1u) * nx) xb_add(&bar[XB_TOPGEN], 1u);
            else XB_SPIN(xb_ld(&bar[XB_TOPGEN]) == tg, bar);
            __builtin_amdgcn_fence(__ATOMIC_ACQUIRE, "agent");
            xb_add(&bar[XB_XGEN(b.x)], 1u);
            asm volatile("s_waitcnt vmcnt(0)" ::: "memory");
        } else {
            XB_SPIN(xb_ld(&bar[XB_XGEN(b.x)]) == gen, bar);
            __builtin_amdgcn_fence(__ATOMIC_ACQUIRE, "agent");
            asm volatile("s_waitcnt vmcnt(0)" ::: "memory");
        }
    }
    __syncthreads();
}

struct Args { const void* in[22]; float* out; unsigned char* ws; int ph_lo, ph_hi, li, pad; };
#define ARGF(k) ((const float*)args.in[k])
struct Frame {
    LAS unsigned char* lds; LAS float* xl;
    int tid, lane, wave, vcu, G;
    unsigned char* ws;
};

template <int WHICH> __device__ __forceinline__ int wmap(int n) {
    if (WHICH == 0) {
        if (n < 256) return n;
        if (n < 512) { const int c = n - 256; return c < 160 ? 256 + c : -1; }
        if (n < 1536) { const int t4 = (n - 512) >> 8, which = t4 >> 1, jj = t4 & 1, c = (n - 512) & 255, bj = c >> 7, wc = (c >> 5) & 3, i = c & 31; return 416 + which * 512 + (4 * jj + wc) * 64 + 32 * bj + i; }
        return 416 + 1024 + (n - 1536);
    } else if (WHICH == 1) {
        const int pn = n >> 8, c = n & 255, bj = c >> 7, wc = (c >> 5) & 3, i = c & 31, head = 2 * pn + bj;
        if (wc < 2) return head * 96 + 32 * wc + i;
        if (wc == 2) { const int fq = i >> 3, nn = (i >> 2) & 1, e = i & 3; return head * 96 + 64 + 4 * fq + e + 16 * nn; }
        return -1;
    } else if (WHICH == 2) {
        const int pn = n >> 8, c = n & 255, bj = c >> 7, wc = (c >> 5) & 3, i = c & 31, head = 2 * pn + bj;
        return wc < 2 ? head * 128 + 32 * wc + i : head * 128 + 64 + 32 * (wc - 2) + i;
    } else if (WHICH == 4) {
        const int j = n >> 8, c = n & 255; return c < 128 ? 128 * j + c : DFF + 128 * j + (c - 128);
    }
    return n;
}
template <int WHICH, bool F8 = false> __device__ __forceinline__ void cvt_item(const float* W, int K, int N, bf16_t* WT, int KP, int NP, LAS float* scr, int item, int lane, float f8s = 1.0f) {
    const int nblk = NP / 32, kb = item / nblk, nb = item % nblk, k0 = 64 * kb, n0 = 32 * nb;
    const int src = wmap<WHICH>(n0 + (lane & 31)); const bool live = (src >= 0) && (k0 < K);
    float wv[32];
#pragma unroll
    for (int i = 0; i < 32; ++i) { const int kk = 2 * i + (lane >> 5); wv[i] = live ? __builtin_nontemporal_load(W + (size_t)(k0 + kk) * N + src) : 0.f; }
#pragma unroll
    for (int i = 0; i < 32; ++i) { const int kk = 2 * i + (lane >> 5); scr[kk * 33 + (lane & 31)] = wv[i]; }
    asm volatile("s_waitcnt lgkmcnt(0)" ::: "memory");
    const int c = lane & 7;
#pragma unroll
    for (int j = 0; j < 4; ++j) { const int n = (lane >> 3) + 8 * j; const LAS float* s = scr + (8 * c) * 33 + n;
        if (F8) { u32x2 o; o.x = pk_fp8x4(s[0 * 33] * f8s, s[1 * 33] * f8s, s[2 * 33] * f8s, s[3 * 33] * f8s); o.y = pk_fp8x4(s[4 * 33] * f8s, s[5 * 33] * f8s, s[6 * 33] * f8s, s[7 * 33] * f8s);
            *(u32x2*)((unsigned char*)WT + (size_t)(n0 + n) * KP + k0 + 8 * c) = o; }
        else { u32x4 o; o.x = cvtpk(s[0 * 33], s[1 * 33]); o.y = cvtpk(s[2 * 33], s[3 * 33]); o.z = cvtpk(s[4 * 33], s[5 * 33]); o.w = cvtpk(s[6 * 33], s[7 * 33]);
            *(u32x4*)(WT + (size_t)(n0 + n) * KP + k0 + 8 * c) = o; } }
    asm volatile("s_waitcnt lgkmcnt(0)" ::: "memory");
}
__device__ __forceinline__ void p0_prologue(Frame& F, const Args& args) {
    LAS float* scr = (LAS float*)(F.lds) + F.wave * 4096;
    const int gw = F.vcu * NWAVES + F.wave, NGW = F.G * NWAVES;
    constexpr int I0 = 16 * 64, I1 = 4 * 32, I2 = 4 * 32, I3 = 16 * 32, I4 = 16 * 176, I5 = 44 * 32;
    constexpr int NITEMS = I0 + I1 + I2 + I3 + I4 + I5;
    for (int it = gw; it < NITEMS; it += NGW) {
        int r = it;
        if (r < I0) { cvt_item<0, true>(ARGF(6), 1024, 1952, (bf16_t*)(F.ws + WS_WIN), 1024, 2048, scr, r, F.lane, F8_WIN_SCALE); continue; } r -= I0;
        if (r < I1) { cvt_item<1>(ARGF(9), 256, 768, (bf16_t*)(F.ws + WS_WQUP), 256, 1024, scr, r, F.lane); continue; } r -= I1;
        if (r < I2) { cvt_item<2>(ARGF(10), 128, 1024, (bf16_t*)(F.ws + WS_WKVUP), 256, 1024, scr, r, F.lane); continue; } r -= I2;
        if (r < I3) { cvt_item<3, true>(ARGF(16), 1024, 1024, (bf16_t*)(F.ws + WS_WOUT), 1024, 1024, scr, r, F.lane, F8_WOUT_SCALE); continue; } r -= I3;
        if (r < I4) { cvt_item<4>(ARGF(18), 1024, DFF2, (bf16_t*)(F.ws + WS_WUP), 1024, DFF2, scr, r, F.lane); continue; } r -= I4;
        cvt_item<5>(ARGF(21), DFF, 1024, (bf16_t*)(F.ws + WS_WDOWN), DFF, 1024, scr, r, F.lane);
    }
    { u32x4* P = (u32x4*)(F.ws + WS_PART); const int NT = F.G * NWAVES * 64;
      for (int i = F.vcu * (NWAVES * 64) + F.tid; i < (int)(PART_BYTES / 16); i += NT) P[i] = (u32x4){0u, 0u, 0u, 0u}; }
    {
        float* cosT = (float*)(F.ws + WS_COS); float* sinT = (float*)(F.ws + WS_SIN);
        const int gt = F.vcu * (NWAVES * 64) + F.tid, NT = F.G * NWAVES * 64;
        for (int idx0 = gt; idx0 < MTOK * 16; idx0 += 4 * NT) {
            int pos[4];
#pragma unroll
            for (int j = 0; j < 4; ++j) { const int idx = idx0 + j * NT; pos[j] = idx < MTOK * 16 ? ((const int*)args.in[2])[idx >> 4] : 0; }
#pragma unroll
            for (int j = 0; j < 4; ++j) { const int idx = idx0 + j * NT; if (idx < MTOK * 16) { const int i = idx & 15;
                const float inv = __builtin_amdgcn_exp2f(-(float)i * (13.287712379549449f / 16.0f));
                const float ang = (float)pos[j] * inv;
                const float n = rintf(ang * 0.15915494309189535f);
                float r = fmaf(-n, 6.2831854820251465f, ang); r = fmaf(-n, -1.7484555e-7f, r);
                cosT[idx] = __cosf(r); sinT[idx] = __sinf(r); } }
        }
    }
}
constexpr int CW_MODCNT = 64, MOD_ITEMS = 192;
__device__ __forceinline__ void p0_mod(Frame& F, const Args& args) {
    LAS float* scr = (LAS float*)(F.lds) + F.wave * 4096;
    for (int item = F.vcu; item < MOD_ITEMS; item += F.G) {
        int kbase = F.wave * 128; asm volatile("" : "+s"(kbase));
        const int n0 = item * 32, col = F.lane & 31, kh = F.lane >> 5;
        { float tv[32];
          unsigned l4 = (unsigned)F.lane * 4u; asm volatile("" : "+v"(l4));
#pragma unroll
          for (int i = 0; i < 32; ++i) tv[i] = *(const float*)((const char*)(ARGF(1) + (i >> 1) * 1024 + kbase + 64 * (i & 1)) + l4);
#pragma unroll
          for (int i = 0; i < 32; ++i) { const int idx = F.lane + 64 * i, b = idx >> 7, k = idx & 127; const float xv = tv[i]; scr[k * 16 + b] = xv / (1.0f + __expf(-xv)); } }
        asm volatile("s_waitcnt lgkmcnt(0)" ::: "memory");
        f32x4 a0 = {0.f, 0.f, 0.f, 0.f}, a1 = a0, a2 = a0, a3 = a0;
        const unsigned wvo = (unsigned)(kh * NMOD + col) * 4u;
#pragma unroll
        for (int i0 = 0; i0 < 64; i0 += 32) { float wv[32];
#pragma unroll
            for (int i = 0; i < 32; ++i) wv[i] = *(const float*)((const char*)(ARGF(3) + (size_t)(kbase + 2 * (i0 + i)) * NMOD + n0) + wvo);
#pragma unroll
            for (int i = 0; i < 32; ++i) { const int k = 2 * (i0 + i) + kh; const float w = wv[i];
                const LAS f32x4* sp = (const LAS f32x4*)(scr + k * 16);
                a0 += sp[0] * w; a1 += sp[1] * w; a2 += sp[2] * w; a3 += sp[3] * w; } }
#pragma unroll
        for (int e = 0; e < 4; ++e) { a0[e] += __shfl_xor(a0[e], 32); a1[e] += __shfl_xor(a1[e], 32); a2[e] += __shfl_xor(a2[e], 32); a3[e] += __shfl_xor(a3[e], 32); }
        if (kh == 0) {
#pragma unroll
            for (int e = 0; e < 4; ++e) { scr[2048 + (0 + e) * 32 + col] = a0[e]; scr[2048 + (4 + e) * 32 + col] = a1[e]; scr[2048 + (8 + e) * 32 + col] = a2[e]; scr[2048 + (12 + e) * 32 + col] = a3[e]; } }
        __syncthreads();
        float* MOD = (float*)(F.ws + WS_MOD);
        { const int b = 2 * F.wave + kh; float s = ARGF(4)[n0 + col];
#pragma unroll
            for (int w2 = 0; w2 < 8; ++w2) s += ((LAS float*)F.lds)[w2 * 4096 + 2048 + b * 32 + col];
            MOD[(size_t)b * NMOD + n0 + col] = s; }
        asm volatile("s_waitcnt vmcnt(0)" ::: "memory");
        __syncthreads();
        if (F.tid == 0) { __builtin_amdgcn_fence(__ATOMIC_RELEASE, "agent"); asm volatile("s_waitcnt vmcnt(0)" ::: "memory");
            __hip_atomic_fetch_add((unsigned*)(F.ws + WS_CTL) + CW_MODCNT, 1u, __ATOMIC_RELAXED, __HIP_MEMORY_SCOPE_AGENT); }
    }
}
__device__ __forceinline__ void mod_wait(Frame& F) {
    if (F.tid == 0) { unsigned sp = 0;
        while (__hip_atomic_load((unsigned*)(F.ws + WS_CTL) + CW_MODCNT, __ATOMIC_RELAXED, __HIP_MEMORY_SCOPE_AGENT) < (unsigned)MOD_ITEMS && ++sp < (1u << 22)) __builtin_amdgcn_s_sleep(2);
        __builtin_amdgcn_fence(__ATOMIC_ACQUIRE, "agent"); asm volatile("s_waitcnt vmcnt(0)" ::: "memory"); }
    __syncthreads();
}
template <bool IDMAP> __device__ __forceinline__ void gemv16_item(Frame& F, const float* W, int ldw, const float* IN, int ldin, float* OUT, int ldout, int item) {
    LAS float* scr = (LAS float*)(F.lds) + F.wave * 4096;
    {
        int kbase = F.wave * 128; asm volatile("" : "+s"(kbase));
        const int col = F.lane & 7, kh = F.lane >> 3; const int src = IDMAP ? item * 8 + col : wmap<0>(item * 8 + col);
        { float tv[32];
          unsigned l4 = (unsigned)F.lane * 4u; asm volatile("" : "+v"(l4));
#pragma unroll
          for (int i = 0; i < 32; ++i) tv[i] = *(const float*)((const char*)(IN + (size_t)(i >> 1) * ldin + kbase + 64 * (i & 1)) + l4);
#pragma unroll
          for (int i = 0; i < 32; ++i) { const int idx = F.lane + 64 * i, b = idx >> 7, k = idx & 127; scr[k * 16 + b] = tv[i]; } }
        asm volatile("s_waitcnt lgkmcnt(0)" ::: "memory");
        f32x4 a0 = {0.f, 0.f, 0.f, 0.f}, a1 = a0, a2 = a0, a3 = a0;
        float wv[16]; const unsigned wvo = (unsigned)(kh * ldw + (src >= 0 ? src : 0)) * 4u; const float msk = src >= 0 ? 1.0f : 0.0f;
#pragma unroll
        for (int i = 0; i < 16; ++i) wv[i] = *(const float*)((const char*)(W + (size_t)(kbase + 8 * i) * ldw) + wvo);
#pragma unroll
        for (int i = 0; i < 16; ++i) { const int k = 8 * i + kh; const float w = wv[i] * msk;
            if ((i & 3) == 0) __builtin_amdgcn_sched_barrier(0);
            const LAS f32x4* sp = (const LAS f32x4*)(scr + k * 16);
            a0 += sp[0] * w; a1 += sp[1] * w; a2 += sp[2] * w; a3 += sp[3] * w;
        }
#pragma unroll
        for (int o = 8; o < 64; o <<= 1)
#pragma unroll
            for (int e = 0; e < 4; ++e) { a0[e] += __shfl_xor(a0[e], o); a1[e] += __shfl_xor(a1[e], o); a2[e] += __shfl_xor(a2[e], o); a3[e] += __shfl_xor(a3[e], o); }
        if (kh == 0) {
#pragma unroll
            for (int e = 0; e < 4; ++e) { scr[2048 + (0 + e) * 8 + col] = a0[e]; scr[2048 + (4 + e) * 8 + col] = a1[e]; scr[2048 + (8 + e) * 8 + col] = a2[e]; scr[2048 + (12 + e) * 8 + col] = a3[e]; } }
        __syncthreads();
        if (F.tid < 128) { float sm = 0.f;
#pragma unroll
            for (int w2 = 0; w2 < 8; ++w2) sm += ((LAS float*)F.lds)[w2 * 4096 + 2048 + F.tid];
            OUT[(size_t)(F.tid >> 3) * ldout + item * 8 + (F.tid & 7)] = sm; }
        __syncthreads();
    }
}
template <bool IDMAP> __device__ __forceinline__ void gemv16(Frame& F, const float* W, int ldw, const float* IN, int ldin, float* OUT, int ldout, int nitems) {
    for (int item = F.vcu; item < nitems; item += F.G) gemv16_item<IDMAP>(F, W, ldw, IN, ldin, OUT, ldout, item);
}
constexpr int CW_B2CNT = 96, CW_REFCNT = 112;
__device__ __forceinline__ void p4_bias(Frame& F, const Args& args, int item) {
    if (F.tid == 0) { unsigned sp = 0; unsigned* cnt = (unsigned*)(F.ws + WS_CTL) + CW_REFCNT;
        while (__hip_atomic_load(cnt, __ATOMIC_RELAXED, __HIP_MEMORY_SCOPE_AGENT) < 2u * (unsigned)F.G && ++sp < (1u << 22)) __builtin_amdgcn_s_sleep(2);
        __builtin_amdgcn_fence(__ATOMIC_ACQUIRE, "agent"); asm volatile("s_waitcnt vmcnt(0)" ::: "memory"); }
    __syncthreads();
    gemv16_item<true>(F, ARGF(16), 1024, (const float*)(F.ws + WS_REF), 1024, (float*)(F.ws + WS_BIAS2), 1024, item);
}
__device__ __forceinline__ void p5_bias(Frame& F, const Args& args) {
    gemv16<true>(F, ARGF(16), 1024, (const float*)(F.ws + WS_REF), 1024, (float*)(F.ws + WS_BIAS2), 1024, 128);
    unsigned* cnt = (unsigned*)(F.ws + WS_CTL) + CW_B2CNT;
    int mine = 0; for (int item = F.vcu; item < 128; item += F.G) ++mine;
    asm volatile("s_waitcnt vmcnt(0)" ::: "memory");
    __syncthreads();
    if (F.tid == 0) {
        if (mine) { __builtin_amdgcn_fence(__ATOMIC_RELEASE, "agent"); asm volatile("s_waitcnt vmcnt(0)" ::: "memory"); __hip_atomic_fetch_add(cnt, (unsigned)mine, __ATOMIC_RELAXED, __HIP_MEMORY_SCOPE_AGENT); }
        unsigned sp = 0;
        while (__hip_atomic_load(cnt, __ATOMIC_RELAXED, __HIP_MEMORY_SCOPE_AGENT) < 128u && ++sp < (1u << 22)) __builtin_amdgcn_s_sleep(2);
        __builtin_amdgcn_fence(__ATOMIC_ACQUIRE, "agent"); asm volatile("s_waitcnt vmcnt(0)" ::: "memory"); }
    __syncthreads();
}
__device__ __forceinline__ float wave_sum(float v) {
#pragma unroll
    for (int o = 1; o < 64; o <<= 1) v += __shfl_xor(v, o);
    return v;
}
template <bool XBF16 = false, bool OUTF8 = false> __device__ __forceinline__ void norm_rows(Frame& F, const float* X, const float* g, int shift_off, int scale_off, bf16_t* out) {
    const float* MOD = (const float*)(F.ws + WS_MOD);
    const int gw = F.vcu * NWAVES + F.wave, NGW = F.G * NWAVES;
    for (int base = gw * 16; base < MTOK; base += NGW * 16) {
        const int b = base >> 11;
        f32x4 gm[4], sh[4];
        { const f32x4* gp = (const f32x4*)g + 4 * F.lane; const f32x4* shp = (const f32x4*)(MOD + (size_t)b * NMOD + shift_off) + 4 * F.lane; const f32x4* scp = (const f32x4*)(MOD + (size_t)b * NMOD + scale_off) + 4 * F.lane;
#pragma unroll
          for (int j = 0; j < 4; ++j) { gm[j] = gp[j] * (scp[j] + 1.0f) * (OUTF8 ? F8_ACT_SCALE : 1.0f); if (!OUTF8) sh[j] = shp[j]; } }
        for (int i0 = 0; i0 < 16; i0 += 4) {
            f32x4 v[4][4]; float sq[4];
#pragma unroll
            for (int rr = 0; rr < 4; ++rr) { const size_t m = (size_t)(base + i0 + rr);
                if (XBF16) { const u32x2* xr = (const u32x2*)((const bf16_t*)X + m * DM) + 4 * F.lane;
#pragma unroll
                    for (int j = 0; j < 4; ++j) { const u32x2 w = xr[j]; v[rr][j] = (f32x4){__uint_as_float(w.x << 16), __uint_as_float(w.x & 0xffff0000u), __uint_as_float(w.y << 16), __uint_as_float(w.y & 0xffff0000u)}; } }
                else { const f32x4* xr = (const f32x4*)(X + m * DM) + 4 * F.lane;
#pragma unroll
                    for (int j = 0; j < 4; ++j) v[rr][j] = xr[j]; } }
#pragma unroll
            for (int rr = 0; rr < 4; ++rr) { float s = 0.f;
#pragma unroll
                for (int j = 0; j < 4; ++j) s += dot4(v[rr][j]);
                sq[rr] = s; }
#pragma unroll
            for (int o = 1; o < 64; o <<= 1)
#pragma unroll
                for (int rr = 0; rr < 4; ++rr) sq[rr] += __shfl_xor(sq[rr], o);
#pragma unroll
            for (int rr = 0; rr < 4; ++rr) { const size_t m = (size_t)(base + i0 + rr);
                const float r = __builtin_amdgcn_rsqf(sq[rr] * (1.0f / DM) + EPS);
                if (OUTF8) { u32x4 w;
#pragma unroll
                    for (int j = 0; j < 4; ++j) { const f32x4 y = v[rr][j] * r * gm[j]; w[j] = pk_fp8x4(y[0], y[1], y[2], y[3]); }
                    *((u32x4*)((unsigned char*)out + m * DM) + F.lane) = w; }
                else { u32x2* o8 = (u32x2*)(out + m * DM) + 4 * F.lane;
#pragma unroll
                    for (int j = 0; j < 4; ++j) { const f32x4 y = v[rr][j] * r * gm[j] + sh[j]; o8[j] = pack4(y); } } }
        }
    }
}
__device__ __forceinline__ void conv_fixup(Frame& F, const Args& args) {
    const unsigned char* RAW4 = F.ws + WS_RAW4; bf16_t* ACT = (bf16_t*)(F.ws + WS_ACT);
    constexpr int NCP = DFF / 2;
    const int gt = F.vcu * (NWAVES * 64) + F.tid, NT = F.G * NWAVES * 64, NGRP = NT / NCP;
    const int grp = gt / NCP, cp = gt - grp * NCP, c = 2 * cp, j = c >> 7, cc = c & 127;
    if (grp >= NGRP) return;
    f32x2 w0[2], w1[2], w2[2], bb[2];
#pragma unroll
    for (int half = 0; half < 2; ++half) { const int ocol = half * DFF + c;
        w0[half] = *(const f32x2*)(ARGF(19) + ocol); w1[half] = *(const f32x2*)(ARGF(19) + DFF2 + ocol); w2[half] = *(const f32x2*)(ARGF(19) + 2 * DFF2 + ocol); bb[half] = *(const f32x2*)(ARGF(20) + ocol); }
#define RAW2(row, tcol) (*(const unsigned*)(RAW4 + ((size_t)(row) * DFF2 + (tcol)) * 2))
#define LO(w) __uint_as_float((w) << 16)
#define HI(w) __uint_as_float((w) & 0xffff0000u)
#pragma unroll 3
    for (int blk = grp; blk < 512; blk += NGRP) {
        const bool first = (blk & 31) == 0;
        f32x2 o[2][2];
#pragma unroll
        for (int half = 0; half < 2; ++half) {
            const int tcol = 256 * j + 128 * half + cc;
            const unsigned q2 = first ? 0u : RAW2((blk - 1) * 4 + 2, tcol), q1 = first ? 0u : RAW2((blk - 1) * 4 + 3, tcol), r0 = RAW2(blk * 4 + 0, tcol), r1 = RAW2(blk * 4 + 1, tcol);
            const f32x2 pm2 = {LO(q2), HI(q2)}, pm1 = {LO(q1), HI(q1)}, x0 = {LO(r0), HI(r0)}, x1 = {LO(r1), HI(r1)};
            o[half][0] = w2[half] * x0 + (w1[half] * pm1 + (w0[half] * pm2 + bb[half])); o[half][1] = w2[half] * x1 + (w1[half] * x0 + (w0[half] * pm1 + bb[half]));
        }
#pragma unroll
        for (int rr = 0; rr < 2; ++rr) { const f32x2 G = o[0][rr]; f32x2 a;
#pragma unroll
            for (int e = 0; e < 2; ++e) a[e] = G[e] / (1.0f + __expf(-G[e])) * o[1][rr][e];
            *(unsigned*)(ACT + ((size_t)blk * 64 + rr) * DFF + c) = cvtpk(a[0], a[1]); }
    }
#undef RAW2
#undef LO
#undef HI
}

__device__ __forceinline__ void stagger_delay(unsigned us10) { const unsigned long long t0 = __builtin_amdgcn_s_memrealtime(); while (__builtin_amdgcn_s_memrealtime() - t0 < (unsigned long long)us10 * 10ull) __builtin_amdgcn_s_sleep(8); }
#ifndef STAG5
#define STAG5 0
#endif
#ifndef STAG9
#define STAG9 0
#endif
__global__ void __launch_bounds__(NWAVES * 64, 2) fwd_kernel(Args args) {
    extern __shared__ __attribute__((aligned(16))) unsigned char lds_raw[];
    Frame F;
    F.lds = (LAS unsigned char*)lds_raw; F.xl = (LAS float*)(F.lds + XL_OFF);
    F.tid = threadIdx.x; F.lane = F.tid & 63; F.wave = __builtin_amdgcn_readfirstlane(F.tid >> 6);
    F.G = gridDim.x; { const int bx = blockIdx.x; F.vcu = (F.G % 8 == 0) ? (bx % 8) * (F.G / 8) + bx / 8 : bx; }
    F.ws = args.ws;
    unsigned char* ws = args.ws;
    for (int u = F.tid; u < (LDS_BYTES - LDSCTL_OFF) / 4; u += NWAVES * 64) ((LAS unsigned*)(F.lds + LDSCTL_OFF))[u] = 0u;
    __syncthreads();
    XcdBarrier bar; bar.bar = (unsigned*)(ws + WS_CTL) + CW_BAR; bar.x = 0; bar.st = nullptr; bar.wave = F.wave;
    if (N_LAUNCHES == 1) bar = xcd_barrier_post((unsigned*)(ws + WS_CTL) + CW_BAR, (volatile LAS unsigned*)(F.lds + MISC_OFF) + 8, F.wave);
#define GRID_BAR() do { if (N_LAUNCHES == 1) xcd_barrier(bar); } while (0)
    const int lo = args.ph_lo, hi = args.ph_hi;
#ifndef PH_MASK
#define PH_MASK 0x3ff
#endif
#define IN(k) (((PH_MASK >> (k)) & 1) && lo <= (k) && (k) < hi)
#define BOTH(k) (IN(k) && IN((k) + 1))
    float* MOD = (float*)(ws + WS_MOD);
    bf16_t* XN = (bf16_t*)(ws + WS_XN);

#define REFRESH_TID() do { int t_ = tid_from_wave(F.wave); asm volatile("" : "+v"(t_)); t_ &= 511; F.tid = t_; F.lane = t_ & 63; } while (0)
    if (IN(0)) { REFRESH_TID(); p0_mod(F, args); p0_prologue(F, args); mod_wait(F); gemv16<false>(F, ARGF(6), 1952, (const float*)(F.ws + WS_MOD), NMOD, (float*)(F.ws + WS_BIAS), 2048, 256); norm_rows<false, true>(F, ARGF(0), ARGF(5), 0, DM, XN); if (BOTH(1)) GRID_BAR(); }
    if (IN(2)) {
        pg8::Gemm g{XN, (const bf16_t*)(ws + WS_WIN), MTOK, 2048, 512  , nullptr, 1 << 30}; pg8::StaticOrder S; S.init(MTOK, 2048, F.G, (int)blockIdx.x);
        { const int t_ = tid_from_wave(F.wave); LAS float* cst = F.xl + XL_CONST;
          if (t_ < 256) cst[t_] = ARGF(7)[t_]; else if (t_ < 384) cst[t_] = ARGF(8)[t_ - 256]; else if (t_ < 448) cst[t_] = ARGF(13)[t_ - 384]; else cst[t_] = ARGF(14)[t_ - 448]; }
        EpiIn E{ws};
        pg8::gemm_phase(F.lds, F.xl, g, S, E, F.wave);
        if (BOTH(2)) GRID_BAR();
    }
    if (IN(3)) {
        pg8::Gemm g{(const bf16_t*)(ws + WS_QLN), (const bf16_t*)(ws + WS_WQUP), MTOK, 2048, 256, (const bf16_t*)(ws + WS_KVLN), 4}; pg8::StaticOrder S; S.init(MTOK, 2048, F.G, (int)blockIdx.x);
        EpiQKV E{EpiQ{ws, ARGF(11)}, EpiKV{ws, ARGF(12)}};
        pg8::gemm_phase(F.lds, F.xl, g, S, E, F.wave);
        if (BOTH(3)) GRID_BAR();
    }
    if (IN(4)) {
        unsigned char* OM = ws + WS_OM; float* REF = (float*)(ws + WS_REF); const float* PARTV = (const float*)(ws + WS_PARTV); unsigned* refcnt = (unsigned*)(ws + WS_CTL) + CW_REFCNT;
        int atid = tid_from_wave(F.wave); asm volatile("" : "+v"(atid)); atid &= 511;
        float S0_mla, S0_ca;
        { const int ln = atid & 63; float a = 0.f, c = 0.f, d = 0.f, e = 0.f;
          for (int i = ln; i < 96; i += 64) { a = fmaxf(a, fabsf(ARGF(11)[i])); c = fmaxf(c, fabsf(ARGF(12)[i])); }
          if (ln < 64) { d = fabsf(ARGF(13)[ln]); e = fabsf(ARGF(14)[ln]); }
          S0_mla = att::wave_max(a) * att::wave_max(c) * 9.797958971132712f * LOG2E * 1.13f; S0_ca = att::wave_max(d) * att::wave_max(e) * 8.0f * LOG2E * 1.13f; }
        if (F.G == 256) {
            const int bh = F.vcu >> 1, par = F.vcu & 1;
            const unsigned ul_mla = (unsigned)(2 * par) | ((unsigned)(7 - 2 * par) << 8) | ((unsigned)(2 * par + 1) << 16) | ((unsigned)(6 - 2 * par) << 24);
            const unsigned ul_ca = (unsigned)par | ((unsigned)(2 + par) << 8) | ((unsigned)(4 + par) << 16) | ((unsigned)(6 + par) << 24);
            att::attn_run<96, false>(atid, bh >> 3, bh & 7, ul_mla, 4, (const unsigned char*)(ws + WS_QM), (const unsigned char*)(ws + WS_KM), (const unsigned char*)(ws + WS_VM), OM, REF, refcnt, PARTV, nullptr, S0_mla, F.lds);
            att::attn_run<64, true>(atid, bh >> 3, bh & 7, ul_ca, 4, (const unsigned char*)(ws + WS_CQ), (const unsigned char*)(ws + WS_CK), (const unsigned char*)(ws + WS_CV), OM, REF, refcnt, PARTV, ARGF(15), S0_ca, F.lds);
            if (par == 0) { REFRESH_TID(); p4_bias(F, args, bh); }
        } else {
            for (int j = F.vcu; j < 2048; j += F.G) { const int kind = j >> 10, bh = (j & 1023) >> 3; const unsigned qb = (unsigned)(j & 7);
                if (kind == 0) att::attn_run<96, false>(atid, bh >> 3, bh & 7, qb, 1, (const unsigned char*)(ws + WS_QM), (const unsigned char*)(ws + WS_KM), (const unsigned char*)(ws + WS_VM), OM, REF, refcnt, PARTV, nullptr, S0_mla, F.lds);
                else att::attn_run<64, true>(atid, bh >> 3, bh & 7, qb, 1, (const unsigned char*)(ws + WS_CQ), (const unsigned char*)(ws + WS_CK), (const unsigned char*)(ws + WS_CV), OM, REF, refcnt, PARTV, ARGF(15), S0_ca, F.lds); }
        }
        if (BOTH(4)) GRID_BAR();
    }
    if (IN(5)) {
        pg8::Gemm g{(const bf16_t*)(ws + WS_OM), (const bf16_t*)(ws + WS_WOUT), MTOK, 1024, 512  , nullptr, 1 << 30}; pg8::StaticOrder S; S.init(MTOK, 1024, F.G, (int)blockIdx.x);
        if (F.G != 256) { REFRESH_TID(); p5_bias(F, args); }
        if (F.G == 256) { EpiResNorm E{ARGF(0), ws, MOD + 2 * DM, ARGF(17)}; pg8::gemm_phase(F.lds, F.xl, g, S, E, F.wave); }
        else { EpiRes<false, true, true> E{ARGF(0), (void*)(ws + WS_X1), MOD + 2 * DM, (const float*)(ws + WS_BIAS2)}; pg8::gemm_phase(F.lds, F.xl, g, S, E, F.wave); }
        if (BOTH(5)) GRID_BAR();
    }
    if (IN(6)) { if (F.G != 256) { REFRESH_TID(); norm_rows<true>(F, (const float*)(ws + WS_X1), ARGF(17), 3 * DM, 4 * DM, (bf16_t*)(ws + WS_H2)); if (BOTH(6)) GRID_BAR(); } }
    if (IN(7)) {
        pg8::Gemm g{(const bf16_t*)(ws + WS_H2), (const bf16_t*)(ws + WS_WUP), MTOK, DFF2, 1024, nullptr, 1 << 30}; pg8::StaticOrder S; S.init(MTOK, DFF2, F.G, (int)blockIdx.x);
        EpiUp E{ws, ARGF(19), ARGF(20)};
        pg8::gemm_phase(F.lds, F.xl, g, S, E, F.wave);
        if (BOTH(7)) GRID_BAR();
    }
    if (IN(8)) { REFRESH_TID(); conv_fixup(F, args); if (BOTH(8)) GRID_BAR(); }
    if (IN(9)) {
        pg8::Gemm g{(const bf16_t*)(ws + WS_ACT), (const bf16_t*)(ws + WS_WDOWN), MTOK, 1024, DFF, nullptr, 1 << 30}; pg8::StaticOrder S; S.init(MTOK, 1024, F.G, (int)blockIdx.x);
        if (STAG9 && (F.vcu & 1)) stagger_delay(STAG9);
        EpiRes<true, false> E{(const void*)(ws + WS_X1), (void*)args.out, MOD + 5 * DM};
        pg8::gemm_phase(F.lds, F.xl, g, S, E, F.wave);
    }
#undef IN
#undef BOTH
}

extern "C" void kernel_launch(void* const* d_in, const int* in_sizes, int n_in, void* d_out, int out_size, void* d_ws, size_t ws_size, hipStream_t stream) {
    static int grid = 0;
    if (grid == 0) {
        if (n_in != 22 || in_sizes[0] != MTOK * DM || out_size != MTOK * DM || ws_size < WS_END) {
            fprintf(stderr, "kernel_launch: unexpected shapes (n_in %d, in0 %d, out %d, ws %zu); nothing launched\n", n_in, n_in > 0 ? in_sizes[0] : -1, out_size, ws_size); grid = -1; return; }
        int dev = 0, cus = 0, per_cu = 0;
        if (hipGetDevice(&dev) != hipSuccess || hipDeviceGetAttribute(&cus, hipDeviceAttributeMultiprocessorCount, dev) != hipSuccess) { grid = -1; return; }
        if (hipFuncSetAttribute((const void*)fwd_kernel, hipFuncAttributeMaxDynamicSharedMemorySize, LDS_BYTES) != hipSuccess) { fprintf(stderr, "kernel_launch: hipFuncSetAttribute failed\n"); grid = -1; return; }
        if (hipOccupancyMaxActiveBlocksPerMultiprocessor(&per_cu, (const void*)fwd_kernel, NWAVES * 64, LDS_BYTES) != hipSuccess || per_cu < 1)
            fprintf(stderr, "kernel_launch: note: occupancy query reports %d workgroups per CU\n", per_cu);
        (void)hipGetLastError();
        grid = cus;
    }
    if (grid < 0) return;
    Args a{};
    for (int i = 0; i < 22; ++i) a.in[i] = d_in[i];
    a.out = (float*)d_out; a.ws = (unsigned char*)d_ws;
#ifndef PROBE_DUP
#define PROBE_DUP -1
#endif
    const int nl = (PROBE_DUP >= 0) ? 2 : N_LAUNCHES;
    for (int li = 0; li < nl; ++li) {
        if (hipMemsetAsync((char*)d_ws + WS_CTL, 0, CTL_ZERO_BYTES, stream) != hipSuccess) { fprintf(stderr, "kernel_launch: memset failed\n"); return; }
        a.ph_lo = (N_LAUNCHES == 1) ? 0 : li; a.ph_hi = (N_LAUNCHES == 1) ? NPHASE : li + 1; a.li = li;
        if (PROBE_DUP >= 0) { a.ph_lo = li == 0 ? 0 : PROBE_DUP; a.ph_hi = li == 0 ? PROBE_DUP + 1 : NPHASE; }
        hipLaunchKernelGGL(fwd_kernel, dim3(grid), dim3(NWAVES * 64), LDS_BYTES, stream, a);
        const hipError_t le = hipPeekAtLastError();
        if (le != hipSuccess) { fprintf(stderr, "kernel_launch: launch %d failed: %s\n", li, hipGetErrorName(le)); break; }
    }
}
```

```cpp
#include <hip/hip_runtime.h>
#include <cstdio>
#include <cstdint>

#define LAS __attribute__((address_space(3)))
#define GAS __attribute__((address_space(1)))
typedef unsigned short bf16_t;
typedef short bf16x8 __attribute__((ext_vector_type(8)));
typedef short s16x4 __attribute__((ext_vector_type(4)));
typedef short s16x2 __attribute__((ext_vector_type(2)));
typedef float f32x2 __attribute__((ext_vector_type(2)));
typedef float f32x4 __attribute__((ext_vector_type(4)));
typedef float f32x16 __attribute__((ext_vector_type(16)));
typedef unsigned u32x2 __attribute__((ext_vector_type(2)));
typedef unsigned u32x4 __attribute__((ext_vector_type(4)));
typedef int i32x2 __attribute__((ext_vector_type(2)));
typedef int i32x4 __attribute__((ext_vector_type(4)));
typedef int i32x8 __attribute__((ext_vector_type(8)));
typedef __bf16 bf16x2_t __attribute__((ext_vector_type(2)));

#ifndef MK_N_LAUNCHES
#define MK_N_LAUNCHES 1
#endif

constexpr int BATCH = 16, SEQ = 2048, DM = 1024, MTOK = BATCH * SEQ;
constexpr int NMOD = 6 * DM;
constexpr int DFF = 2816, DFF2 = 5632;
constexpr float EPS = 1e-6f;
constexpr float LOG2E = 1.4426950408889634f;
constexpr float C2_MLA = 0.10206207261596577f * LOG2E;
constexpr float C2_CA = 0.125f * LOG2E;

__device__ __forceinline__ unsigned cvtpk(float lo, float hi) { f32x2 v = {lo, hi}; bf16x2_t b = __builtin_convertvector(v, bf16x2_t); return __builtin_bit_cast(unsigned, b); }
__device__ __forceinline__ u32x4 pack8(f32x4 a, f32x4 b) { u32x4 w; w.x = cvtpk(a[0], a[1]); w.y = cvtpk(a[2], a[3]); w.z = cvtpk(b[0], b[1]); w.w = cvtpk(b[2], b[3]); return w; }
__device__ __forceinline__ u32x2 pack4(f32x4 a) { u32x2 w; w.x = cvtpk(a[0], a[1]); w.y = cvtpk(a[2], a[3]); return w; }
__device__ __forceinline__ float xsum16(float v) { auto r = __builtin_amdgcn_permlane16_swap(__float_as_uint(v), __float_as_uint(v), false, false); return __uint_as_float(r[0]) + __uint_as_float(r[1]); }
__device__ __forceinline__ float xsum32(float v) { auto r = __builtin_amdgcn_permlane32_swap(__float_as_uint(v), __float_as_uint(v), false, false); return __uint_as_float(r[0]) + __uint_as_float(r[1]); }
__device__ __forceinline__ float row16_sum(float v) {
    v += __builtin_bit_cast(float, __builtin_amdgcn_update_dpp(0, __builtin_bit_cast(int, v), 0xB1, 0xF, 0xF, true));
    v += __builtin_bit_cast(float, __builtin_amdgcn_update_dpp(0, __builtin_bit_cast(int, v), 0x4E, 0xF, 0xF, true));
    v += __builtin_bit_cast(float, __builtin_amdgcn_update_dpp(0, __builtin_bit_cast(int, v), 0x141, 0xF, 0xF, true));
    v += __builtin_bit_cast(float, __builtin_amdgcn_update_dpp(0, __builtin_bit_cast(int, v), 0x140, 0xF, 0xF, true));
    return v; }
__device__ __forceinline__ void colsum8(const f32x4 (&acc)[2][2][4][2], int bj, int fr, float* dst) {
    f32x4 s0 = acc[0][bj][0][0] + acc[1][bj][0][0], s1 = acc[0][bj][0][1] + acc[1][bj][0][1];
#pragma unroll
    for (int m = 1; m < 4; ++m) { s0 += acc[0][bj][m][0] + acc[1][bj][m][0]; s1 += acc[0][bj][m][1] + acc[1][bj][m][1]; }
#pragma unroll
    for (int e = 0; e < 4; ++e) { s0[e] = row16_sum(s0[e]); s1[e] = row16_sum(s1[e]); }
    if (fr == 0) { *(f32x4*)dst = s0; *(f32x4*)(dst + 4) = s1; }
}
__device__ __forceinline__ float dot4(f32x4 a) { return (a[0] * a[0] + a[1] * a[1]) + (a[2] * a[2] + a[3] * a[3]); }
__device__ __forceinline__ int undef_i32() { int w; asm volatile("" : "=v"(w)); return w; }
__device__ __forceinline__ unsigned pk_fp8x4(float a, float b, float c, float d) { int w = undef_i32();
    w = __builtin_amdgcn_cvt_pk_fp8_f32(__builtin_amdgcn_fmed3f(a, -448.f, 448.f), __builtin_amdgcn_fmed3f(b, -448.f, 448.f), w, false);
    w = __builtin_amdgcn_cvt_pk_fp8_f32(__builtin_amdgcn_fmed3f(c, -448.f, 448.f), __builtin_amdgcn_fmed3f(d, -448.f, 448.f), w, true); return (unsigned)w; }
__device__ __forceinline__ u32x2 f8x8(f32x4 a, f32x4 b) { return (u32x2){pk_fp8x4(a[0], a[1], a[2], a[3]), pk_fp8x4(b[0], b[1], b[2], b[3])}; }
__device__ __forceinline__ unsigned pk_fp8x4u(float a, float b, float c, float d) { int w = undef_i32(); w = __builtin_amdgcn_cvt_pk_fp8_f32(a, b, w, false); w = __builtin_amdgcn_cvt_pk_fp8_f32(c, d, w, true); return (unsigned)w; }
__device__ __forceinline__ u32x2 f8x8u(f32x4 a, f32x4 b) { return (u32x2){pk_fp8x4u(a[0], a[1], a[2], a[3]), pk_fp8x4u(b[0], b[1], b[2], b[3])}; }
__device__ __forceinline__ void st8pair(unsigned char* pa, unsigned char* pb, u32x2 a, u32x2 b, int fq) {
    auto r0 = __builtin_amdgcn_permlane16_swap(a.x, b.x, false, false); auto r1 = __builtin_amdgcn_permlane16_swap(a.y, b.y, false, false);
    *(u32x4*)((fq & 1) ? pb - 8 : pa) = (u32x4){r0[0], r1[0], r0[1], r1[1]}; }
__device__ __forceinline__ void glds16_(const void* gsrc, unsigned lds_dst) { unsigned keep;
    asm volatile("s_mov_b32 %0, m0\n\ts_mov_b32 m0, %2\n\ts_nop 0\n\tglobal_load_lds_dwordx4 %1, off\n\ts_mov_b32 m0, %0" : "=&s"(keep) : "v"(gsrc), "s"(lds_dst) : "memory"); }
#ifndef WT_STORES
#define WT_STORES 0
#endif
__device__ __forceinline__ void st16(void* p, u32x4 v) {
#if WT_STORES
    asm volatile("global_store_dwordx4 %0, %1, off sc1\n\ts_nop 1" :: "v"(p), "v"(v) : "memory");
#else
    *(u32x4*)p = v;
#endif
}
__device__ __forceinline__ void st16o(const void* sbase, unsigned voff, u32x4 v) {
#if WT_STORES
    asm volatile("global_store_dwordx4 %0, %1, %2 sc1\n\ts_nop 1" :: "v"(voff), "v"(v), "s"(sbase) : "memory");
#else
    *(u32x4*)((unsigned char*)sbase + voff) = v;
#endif
}
__device__ __forceinline__ int tid_from_wave(int wave) { int ln; asm volatile("v_mbcnt_lo_u32_b32 %0, -1, 0\n\tv_mbcnt_hi_u32_b32 %0, -1, %0" : "=v"(ln));
    return wave * 64 + ln; }
#define LDS_BARRIER() do { asm volatile("s_waitcnt lgkmcnt(0)" ::: "memory"); __builtin_amdgcn_s_barrier(); asm volatile("" ::: "memory"); } while (0)

#ifndef PG8_ASMDMA
#define PG8_ASMDMA 1
#endif
namespace pg8 {
constexpr int BM = 256, BK = 64, HALF = 128, HTB = HALF * BK * 2, STAGE_BYTES = 8 * HTB, NXCD = 8, WGM = 8;
__host__ __device__ __forceinline__ int lds_byte(int r, int c) { const int st = (r >> 4) * 2 + (c >> 5), rr = r & 15, cc = c & 31, ob = rr * 64 + cc * 2; return st * 1024 + (ob ^ (((ob >> 9) & 1) << 5)); }
__host__ __device__ __forceinline__ void stage_rc(int b, int& R, int& C) { const int st = b / 1024, sb = b % 1024, swz = sb ^ (((sb >> 9) & 1) << 5); R = (st >> 1) * 16 + swz / 64; C = (st & 1) * 32 + (swz % 64) / 2; }
__host__ __device__ __forceinline__ int perm32(int rho) { const int n = rho >> 4, i = rho & 15; return 8 * (i >> 2) + 4 * n + (i & 3); }

struct Unit { int pm, pn; };
struct Gemm { const bf16_t* A; const bf16_t* Bt; int M, N, K; const bf16_t* A2; int nsplit; };

struct StaticOrder {
    int nM, nN, nwg, G, c;
    __host__ __device__ void init(int M, int N, int G_, int c_) { nM = M / BM; nN = N / BM; nwg = nM * nN; G = G_; c = c_; }
    __host__ __device__ bool next(int i, Unit& u) const {
        const long L = (long)i * G + c; if (L >= nwg) return false;
        int wgid = (int)L; { const int q = nwg / NXCD, r = nwg % NXCD, xcd = wgid % NXCD, off = wgid / NXCD; wgid = (xcd < r ? xcd * (q + 1) : r * (q + 1) + (xcd - r) * q) + off; }
        const int nig = WGM * nN, gid = wgid / nig, fm = gid * WGM, gsz = (nM - fm) < WGM ? (nM - fm) : WGM;
        u.pm = fm + ((wgid % nig) % gsz); u.pn = (wgid % nig) / gsz; return true;
    }
};

template <class Epi, class Sched>
__device__ __forceinline__ void gemm_phase(LAS unsigned char* lds, LAS float* xl, const Gemm g, const Sched& S, const Epi& E, int wave_id) {
    int tid = tid_from_wave(wave_id); asm volatile("" : "+v"(tid)); tid &= 511;
    const int wid = __builtin_amdgcn_readfirstlane(tid >> 6), lane = tid & 63, wr = wid >> 2, wc = wid & 3, fr = lane & 15, fq = lane >> 4;
    const int K = g.K, nt = K / BK;
    unsigned voffA[2], voffB[2];
#pragma unroll
    for (int i = 0; i < 2; ++i) { int R, C; stage_rc(tid * 16 + i * 8192, R, C); const int Rb = (R & ~31) + perm32(R & 31);
        const int Ra = Epi::APERM ? ((R & 64) | ((R & 15) << 2) | ((R >> 4) & 3)) : R;
        voffA[i] = (unsigned)(Ra * K + C) * 2u; voffB[i] = (unsigned)(Rb * K + C) * 2u; }
    const size_t kstep = (size_t)(BK * 2);
    const size_t hstep = (size_t)HALF * K * 2;
    const size_t tstep = 2 * hstep;
    const unsigned ldsw = (unsigned)wid * 1024u; const unsigned ldsb = (unsigned)__builtin_amdgcn_readfirstlane((int)((unsigned)(uintptr_t)lds + ldsw));
    const int aoff = lds_byte(wr * 64 + fr, fq * 8), boff = lds_byte(wc * 32 + fr, fq * 8);
#define PG8_SA(b, h) (((b) * 2 + (h)) * HTB)
#define PG8_SB(b, h) ((4 + (b) * 2 + (h)) * HTB)
#if PG8_ASMDMA
#define PG8_STAGE(bufoff, gbase, voff) do { _Pragma("unroll") for (int _i = 0; _i < 2; ++_i) \
        asm volatile("s_mov_b32 m0, %2\n\ts_nop 0\n\tglobal_load_lds_dwordx4 %0, %1" :: "v"((voff)[_i]), "s"((const void*)(gbase)), "s"(ldsb + (unsigned)((bufoff) + _i * 8192)) : "memory", "m0"); } while (0)
#else
#define PG8_STAGE(bufoff, gbase, voff) do { _Pragma("unroll") for (int _i = 0; _i < 2; ++_i) \
        __builtin_amdgcn_global_load_lds((const unsigned*)((const char*)(gbase) + (voff)[_i]), (LAS unsigned*)(lds + (bufoff) + ldsw + _i * 8192), 16, 0, 0); } while (0)
#endif
#define PG8_LDA(dst, b, h) do { if constexpr (Epi::FP8) { _Pragma("unroll") for (int m = 0; m < 4; ++m) { const i32x4 lo_ = *(const LAS i32x4*)(lds + PG8_SA(b, h) + aoff + m * 2048), hi_ = *(const LAS i32x4*)(lds + PG8_SA(b, h) + aoff + m * 2048 + 1024); dst##8[m] = __builtin_shufflevector(lo_, hi_, 0, 1, 2, 3, 4, 5, 6, 7); } } \
        else { _Pragma("unroll") for (int m = 0; m < 4; ++m) _Pragma("unroll") for (int k = 0; k < 2; ++k) dst[m][k] = *(const LAS bf16x8*)(lds + PG8_SA(b, h) + aoff + m * 2048 + k * 1024); } } while (0)
#define PG8_LDB(dst, b, h) do { if constexpr (Epi::FP8) { _Pragma("unroll") for (int n = 0; n < 2; ++n) { const i32x4 lo_ = *(const LAS i32x4*)(lds + PG8_SB(b, h) + boff + n * 2048), hi_ = *(const LAS i32x4*)(lds + PG8_SB(b, h) + boff + n * 2048 + 1024); dst##8[n] = __builtin_shufflevector(lo_, hi_, 0, 1, 2, 3, 4, 5, 6, 7); } } \
        else { _Pragma("unroll") for (int n = 0; n < 2; ++n) _Pragma("unroll") for (int k = 0; k < 2; ++k) dst[n][k] = *(const LAS bf16x8*)(lds + PG8_SB(b, h) + boff + n * 2048 + k * 1024); } } while (0)
#define PG8_MMA(ai, bj, At, Bt) do { __builtin_amdgcn_s_setprio(1); if constexpr (Epi::FP8) { _Pragma("unroll") for (int m = 0; m < 4; ++m) _Pragma("unroll") for (int n = 0; n < 2; ++n) \
            acc[ai][bj][m][n] = __builtin_amdgcn_mfma_scale_f32_16x16x128_f8f6f4(Bt##8[n], At##8[m], acc[ai][bj][m][n], 0, 0, 0, 0, 0, 0); } \
        else { _Pragma("unroll") for (int m = 0; m < 4; ++m) _Pragma("unroll") for (int n = 0; n < 2; ++n) _Pragma("unroll") for (int k = 0; k < 2; ++k) \
            acc[ai][bj][m][n] = __builtin_amdgcn_mfma_f32_16x16x32_bf16(Bt[n][k], At[m][k], acc[ai][bj][m][n], 0, 0, 0); } __builtin_amdgcn_s_setprio(0); } while (0)
#define PG8_WAIT_V(n) asm volatile("s_waitcnt vmcnt(" #n ")" ::: "memory")
#define PG8_WAIT_L(n) asm volatile("s_waitcnt lgkmcnt(" #n ")" ::: "memory")
#define PG8_BAR __builtin_amdgcn_s_barrier()
#define PG8_SCHED __builtin_amdgcn_sched_barrier(0)
    Unit cur, nxt; int ui = 0;
    if (!S.next(0, cur)) return;
    f32x4 acc[2][2][4][2];
    { float z0; asm volatile("v_mov_b32 %0, 0" : "=v"(z0));
#pragma unroll
    for (int a = 0; a < 2; ++a)
#pragma unroll
        for (int b = 0; b < 2; ++b)
#pragma unroll
            for (int m = 0; m < 4; ++m)
#pragma unroll
                for (int n = 0; n < 2; ++n) acc[a][b][m][n] = (f32x4){z0, z0, z0, z0}; }
    bf16x8 At[4][2], B0[2][2], B1[2][2]; i32x8 At8[4], B08[2], B18[2];
    const char* cA = (const char*)(cur.pn < g.nsplit ? g.A : g.A2) + (size_t)cur.pm * tstep; const char* cB = (const char*)g.Bt + (size_t)cur.pn * tstep;
    if constexpr (Epi::PREFETCH) E.prefetch(cur, xl, 0, wid, lane);
    PG8_STAGE(PG8_SB(0, 0), cB, voffB); PG8_STAGE(PG8_SB(0, 1), cB + hstep, voffB); PG8_STAGE(PG8_SA(0, 0), cA, voffA); PG8_STAGE(PG8_SA(0, 1), cA + hstep, voffA);
    if (wr == 1) PG8_BAR;
    PG8_WAIT_V(2); PG8_BAR;
    PG8_STAGE(PG8_SB(1, 0), cB + kstep, voffB); PG8_STAGE(PG8_SA(1, 0), cA + kstep, voffA); PG8_STAGE(PG8_SB(1, 1), cB + hstep + kstep, voffB);
    PG8_WAIT_V(6); PG8_BAR;
    for (;;) {
        const bool has_next = S.next(ui + 1, nxt);
        const char* nA = has_next ? (const char*)(nxt.pn < g.nsplit ? g.A : g.A2) + (size_t)nxt.pm * tstep : cA; const char* nB = has_next ? (const char*)g.Bt + (size_t)nxt.pn * tstep : cB;
#pragma nounroll
        for (int t = 0; t < nt; t += 2) {
            const bool last = (t == nt - 2);
            const char* a1 = cA + (size_t)(t + 1) * kstep;
            const char* a2 = last ? nA : cA + (size_t)(t + 2) * kstep; const char* b2 = last ? nB : cB + (size_t)(t + 2) * kstep;
            const char* a3 = a2 + kstep; const char* b3 = b2 + kstep;
            PG8_LDB(B0, 0, 0); PG8_LDB(B1, 0, 1); PG8_SCHED; PG8_LDA(At, 0, 0); PG8_STAGE(PG8_SA(1, 1), a1 + hstep, voffA);
            PG8_WAIT_V(8); PG8_WAIT_L(0); PG8_BAR; PG8_MMA(0, 0, At, B0); PG8_MMA(0, 1, At, B1); PG8_BAR; PG8_SCHED;
            PG8_LDA(At, 0, 1); PG8_STAGE(PG8_SB(0, 0), b2, voffB); PG8_STAGE(PG8_SB(0, 1), b2 + hstep, voffB); PG8_STAGE(PG8_SA(0, 0), a2, voffA);
            PG8_WAIT_V(8); PG8_WAIT_L(0); PG8_BAR; PG8_MMA(1, 0, At, B0); PG8_MMA(1, 1, At, B1); PG8_BAR; PG8_SCHED;
            PG8_LDB(B0, 1, 0); PG8_LDB(B1, 1, 1); PG8_SCHED; PG8_LDA(At, 1, 0); PG8_STAGE(PG8_SA(0, 1), a2 + hstep, voffA);
            PG8_WAIT_V(8); PG8_WAIT_L(0); PG8_BAR; PG8_MMA(0, 0, At, B0); PG8_MMA(0, 1, At, B1); PG8_BAR; PG8_SCHED;
            PG8_LDA(At, 1, 1); PG8_STAGE(PG8_SB(1, 0), b3, voffB); PG8_STAGE(PG8_SB(1, 1), b3 + hstep, voffB); PG8_STAGE(PG8_SA(1, 0), a3, voffA);
            PG8_WAIT_V(8); PG8_WAIT_L(0); PG8_BAR; PG8_MMA(1, 0, At, B0); PG8_MMA(1, 1, At, B1); PG8_BAR; PG8_SCHED;
        }
        if (wr == 0) PG8_BAR;
        { const int le_ = tid_from_wave(0), fre = le_ & 15, fqe = le_ >> 4;
        if constexpr (Epi::FP8) { if constexpr (Epi::PREFETCH) E.pre(acc, cur, wc, fqe, xl, ui & 1); else E.pre(acc, cur, wc, fqe); }
        if constexpr (Epi::PREFETCH) { E(acc, cur, wr, wc, fre, fqe, xl, ui & 1); if (has_next) E.prefetch(nxt, xl, (ui + 1) & 1, wid, le_); }
        else E(acc, cur, wr, wc, fre, fqe, xl); }
        if (!has_next) break;
        { float z0; asm volatile("v_mov_b32 %0, 0" : "=v"(z0));
#pragma unroll
        for (int a = 0; a < 2; ++a)
#pragma unroll
            for (int b = 0; b < 2; ++b)
#pragma unroll
                for (int m = 0; m < 4; ++m)
#pragma unroll
                    for (int n = 0; n < 2; ++n) acc[a][b][m][n] = (f32x4){z0, z0, z0, z0}; }
        cur = nxt; cA = nA; cB = nB; ++ui;
        if (wr == 1) PG8_BAR;
    }
    PG8_WAIT_V(0);
    PG8_BAR;
#undef PG8_SA
#undef PG8_SB
#undef PG8_STAGE
#undef PG8_LDA
#undef PG8_LDB
#undef PG8_MMA
#undef PG8_WAIT_V
#undef PG8_WAIT_L
#undef PG8_BAR
#undef PG8_SCHED
}
}
using pg8::Unit;

constexpr size_t MiB = 1u << 20;
constexpr size_t WS_CTL = 0, CTL_ZERO_BYTES = 64 * 1024;
constexpr size_t WS_PART = 35 * (1u << 20), PART_BYTES = (size_t)32768 * 4 * 8;
constexpr size_t WS_MOD = 1 * MiB;
constexpr size_t WS_BIAS2 = 1 * MiB + 640 * 1024;
constexpr size_t WS_PARTV = 13 * MiB;
constexpr size_t WS_REF = 1 * MiB + 768 * 1024;
constexpr size_t WS_BIAS = 1 * MiB + 512 * 1024;
constexpr size_t WS_COS = 2 * MiB, WS_SIN = 4 * MiB;
constexpr size_t WS_KR = 6 * MiB;
constexpr size_t WS_SSR = 10 * MiB;
constexpr size_t WS_WIN = 11 * MiB;
constexpr size_t WS_WQUP = 15 * MiB;
constexpr size_t WS_WKVUP = WS_WQUP + 512 * 1024;
constexpr size_t WS_WOUT = 16 * MiB;
constexpr size_t WS_WUP = 18 * MiB;
constexpr size_t WS_WDOWN = 29 * MiB;
constexpr size_t WS_XN = 36 * MiB;
constexpr size_t WS_QLN = 100 * MiB, WS_KVLN = 116 * MiB;
constexpr size_t WS_CQ = 132 * MiB, WS_CK = 164 * MiB, WS_CV = 196 * MiB;
constexpr size_t WS_QM = 228 * MiB, WS_KM = 276 * MiB;
constexpr size_t WS_VM = 324 * MiB;
constexpr size_t WS_OM = WS_XN;
constexpr size_t WS_ACT = 100 * MiB;
constexpr size_t WS_X1 = 276 * MiB;
constexpr size_t WS_RAW4 = 404 * MiB;
constexpr size_t WS_H2 = 448 * MiB;
constexpr size_t WS_END = 512 * MiB;
static_assert(WS_ACT + (size_t)MTOK * DFF * 2 <= WS_X1 && WS_X1 + (size_t)MTOK * DM * 4 <= WS_RAW4 && WS_RAW4 + (size_t)512 * 4 * DFF2 * 4 <= WS_END, "overlay map");
constexpr int CW_BAR = 1024;


constexpr float F8_QS = 8.0f, F8_KS = 0.125f;
constexpr float F8_O_SCALE = 64.0f, F8_WOUT_SCALE = 1024.0f;
constexpr float F8_ACT_SCALE = 8.0f, F8_WIN_SCALE = 1024.0f;
constexpr int XL_CONST = 2048;
__device__ __forceinline__ void f8_pre_lds(f32x4 (&acc)[2][2][4][2], const LAS float* side, float descale, int wc, int fq) {
    asm volatile("" : "+v"(fq), "+s"(wc));
    const LAS float* sp = side + wc * 32 + 8 * fq;
    f32x4 bv[2][2];
#pragma unroll
    for (int bj = 0; bj < 2; ++bj)
#pragma unroll
        for (int n = 0; n < 2; ++n) bv[bj][n] = *(const LAS f32x4*)(sp + 128 * bj + 4 * n);
#pragma unroll
    for (int a = 0; a < 2; ++a)
#pragma unroll
        for (int bj = 0; bj < 2; ++bj)
#pragma unroll
            for (int m = 0; m < 4; ++m)
#pragma unroll
                for (int n = 0; n < 2; ++n) acc[a][bj][m][n] = acc[a][bj][m][n] * descale + bv[bj][n];
}
struct EpiIn {
    static constexpr bool APERM = false, PREFETCH = true, FP8 = true; static constexpr float DESCALE = 1.0f / (F8_ACT_SCALE * F8_WIN_SCALE);
    unsigned char* ws;
    __device__ __forceinline__ void prefetch(const Unit& u, LAS float* xl, int par, int wid, int lane) const {
        asm volatile("" : "+v"(lane));
        if (wid == 0) glds16_((const float*)(ws + WS_BIAS) + (size_t)(u.pm >> 3) * 2048 + u.pn * 256 + 4 * lane, (unsigned)__builtin_amdgcn_readfirstlane((unsigned)(uintptr_t)(xl + XL_CONST + 512 + par * 256)));
    }
    __device__ __forceinline__ void pre(f32x4 (&acc)[2][2][4][2], const Unit& u, int wc, int fq, LAS float* xl, int par) const { f8_pre_lds(acc, xl + XL_CONST + 512 + par * 256, DESCALE, wc, fq); }
    __device__ __forceinline__ void operator()(const f32x4 (&acc)[2][2][4][2], const Unit& u, int wr, int wc, int fr, int fq, LAS float* red, int  ) const {
        asm volatile("" : "+v"(fr), "+v"(fq), "+s"(wr), "+s"(wc));
        const int rl0 = wr * 64 + fr; const size_t row0 = (size_t)u.pm * 256 + rl0; const int pn = u.pn;
        bf16_t* const QLN = (bf16_t*)(ws + WS_QLN); bf16_t* const KVLN = (bf16_t*)(ws + WS_KVLN); bf16_t* const CQ = (bf16_t*)(ws + WS_CQ); bf16_t* const CK = (bf16_t*)(ws + WS_CK); bf16_t* const CV = (bf16_t*)(ws + WS_CV);
        float* const KR = (float*)(ws + WS_KR); float* const SSR = (float*)(ws + WS_SSR);
        if (pn >= 6) {
            { float* pv = (float*)(ws + WS_PARTV) + ((size_t)u.pm * 2 + wr) * 1024 + 512 + (pn - 6) * 256 + wc * 32 + 8 * fq;
              colsum8(acc, 0, fr, pv); colsum8(acc, 1, fr, pv + 128); }
            unsigned char* base = (unsigned char*)CV + (pn - 6) * 256 + wc * 32 + 8 * fq;
#pragma unroll
            for (int ai = 0; ai < 2; ++ai)
#pragma unroll
                for (int mp = 0; mp < 2; ++mp) { unsigned char* ra = base + (row0 + ai * 128 + (2 * mp) * 16) * 512; unsigned char* rb = ra + 16 * 512;
#pragma unroll
                    for (int bj = 0; bj < 2; ++bj) st8pair(ra + bj * 128, rb + bj * 128, f8x8(acc[ai][bj][2 * mp][0], acc[ai][bj][2 * mp][1]), f8x8(acc[ai][bj][2 * mp + 1][0], acc[ai][bj][2 * mp + 1][1]), fq); }
        } else if (pn >= 2) {
            const bool isq = pn < 4; const int head = 4 * ((pn - 2) & 1) + wc; const LAS float* g = red + XL_CONST + (isq ? 384 : 448); const float sc = isq ? C2_CA * F8_QS : F8_KS;
            f32x4 gv[2][2];
#pragma unroll
            for (int bj = 0; bj < 2; ++bj)
#pragma unroll
                for (int n = 0; n < 2; ++n) gv[bj][n] = *(const LAS f32x4*)(g + 32 * bj + 8 * fq + 4 * n) * sc;
            unsigned char* base = (unsigned char*)(isq ? CQ : CK) + head * 64 + 8 * fq;
#pragma unroll
            for (int ai = 0; ai < 2; ++ai)
#pragma unroll
                for (int mp = 0; mp < 2; ++mp) { float rr[2];
#pragma unroll
                    for (int mm = 0; mm < 2; ++mm) { const int m = 2 * mp + mm;
                        float ss = (dot4(acc[ai][0][m][0]) + dot4(acc[ai][0][m][1])) + (dot4(acc[ai][1][m][0]) + dot4(acc[ai][1][m][1]));
                        ss = xsum32(xsum16(ss));
                        rr[mm] = __builtin_amdgcn_rsqf(ss * (1.0f / 64.0f) + EPS); }
                    unsigned char* ra = base + (row0 + ai * 128 + (2 * mp) * 16) * 512; unsigned char* rb = ra + 16 * 512;
#pragma unroll
                    for (int bj = 0; bj < 2; ++bj) st8pair(ra + bj * 32, rb + bj * 32, f8x8u(acc[ai][bj][2 * mp][0] * rr[0] * gv[bj][0], acc[ai][bj][2 * mp][1] * rr[0] * gv[bj][1]),
                                                           f8x8u(acc[ai][bj][2 * mp + 1][0] * rr[1] * gv[bj][0], acc[ai][bj][2 * mp + 1][1] * rr[1] * gv[bj][1]), fq);
                }
        } else if (pn == 0) {
#pragma unroll
            for (int ai = 0; ai < 2; ++ai)
#pragma unroll
                for (int m = 0; m < 4; ++m) {
                    float ss = (dot4(acc[ai][0][m][0]) + dot4(acc[ai][0][m][1])) + (dot4(acc[ai][1][m][0]) + dot4(acc[ai][1][m][1]));
                    ss = xsum32(xsum16(ss));
                    if (fq == 0) red[(ai * 128 + m * 16 + rl0) * 8 + wc] = ss;
                }
            LDS_BARRIER();
            f32x4 gv[2][2];
#pragma unroll
            for (int bj = 0; bj < 2; ++bj)
#pragma unroll
                for (int n = 0; n < 2; ++n) gv[bj][n] = *(const LAS f32x4*)(red + XL_CONST + 128 * bj + 32 * wc + 8 * fq + 4 * n);
            bf16_t* base = QLN + wc * 32 + 8 * fq;
#pragma unroll
            for (int ai = 0; ai < 2; ++ai)
#pragma unroll
                for (int m = 0; m < 4; ++m) {
                    const f32x4 t = *(const LAS f32x4*)(red + (ai * 128 + m * 16 + rl0) * 8);
                    const float r = __builtin_amdgcn_rsqf(((t[0] + t[1]) + (t[2] + t[3])) * (1.0f / 256.0f) + EPS);
                    bf16_t* rp = base + (row0 + ai * 128 + m * 16) * 256;
#pragma unroll
                    for (int bj = 0; bj < 2; ++bj) st16(rp + bj * 128, pack8(acc[ai][bj][m][0] * r * gv[bj][0], acc[ai][bj][m][1] * r * gv[bj][1]));
                }
        } else {
#pragma unroll
            for (int ai = 0; ai < 2; ++ai)
#pragma unroll
                for (int m = 0; m < 4; ++m) {
                    float ss = dot4(acc[ai][0][m][0]) + dot4(acc[ai][0][m][1]);
                    ss = xsum32(xsum16(ss));
                    if (fq == 0) red[(ai * 128 + m * 16 + rl0) * 8 + wc] = ss;
                }
            LDS_BARRIER();
            f32x4 gv[2];
#pragma unroll
            for (int n = 0; n < 2; ++n) gv[n] = *(const LAS f32x4*)(red + XL_CONST + 256 + 32 * wc + 8 * fq + 4 * n);
            bf16_t* base = KVLN + wc * 32 + 8 * fq;
#pragma unroll
            for (int ai = 0; ai < 2; ++ai)
#pragma unroll
                for (int m = 0; m < 4; ++m) {
                    const f32x4 t = *(const LAS f32x4*)(red + (ai * 128 + m * 16 + rl0) * 8);
                    const float r = __builtin_amdgcn_rsqf(((t[0] + t[1]) + (t[2] + t[3])) * (1.0f / 128.0f) + EPS);
                    const size_t row = row0 + ai * 128 + m * 16;
                    bf16_t* rp = base + row * 256;
                    st16(rp, pack8(acc[ai][0][m][0] * r * gv[0], acc[ai][0][m][1] * r * gv[1]));
                    { unsigned z0; asm volatile("v_mov_b32 %0, 0" : "=v"(z0)); st16(rp + 128, (u32x4){z0, z0, z0, z0}); }
                    if (wc == 0) {
                        *(f32x4*)(KR + row * 32 + 8 * fq) = acc[ai][1][m][0]; *(f32x4*)(KR + row * 32 + 8 * fq + 4) = acc[ai][1][m][1];
                        float sr = dot4(acc[ai][1][m][0]) + dot4(acc[ai][1][m][1]);
                        sr = xsum32(xsum16(sr));
                        if (fq == 0) SSR[row] = sr;
                    }
                }
        }
    }
};

struct EpiQ {
    static constexpr bool APERM = false, PREFETCH = false, FP8 = false;
    unsigned char* ws; const float* g;
    __device__ __forceinline__ void operator()(const f32x4 (&acc)[2][2][4][2], const Unit& u, int wr, int wc, int fr, int fq, LAS float* red) const {
        asm volatile("" : "+v"(fr), "+v"(fq), "+s"(wr), "+s"(wc));
        const int rl0 = wr * 64 + fr; const size_t row0 = (size_t)u.pm * 256 + rl0;
        bf16_t* const QM = (bf16_t*)(ws + WS_QM); const float* const cosT = (const float*)(ws + WS_COS); const float* const sinT = (const float*)(ws + WS_SIN);
#pragma unroll
        for (int ai = 0; ai < 2; ++ai)
#pragma unroll
            for (int m = 0; m < 4; ++m)
#pragma unroll
                for (int bj = 0; bj < 2; ++bj) {
                    float ss = dot4(acc[ai][bj][m][0]) + dot4(acc[ai][bj][m][1]);
                    ss = xsum32(xsum16(ss));
                    if (fq == 0) red[(ai * 128 + m * 16 + rl0) * 8 + bj * 4 + wc] = ss;
                }
        LDS_BARRIER();
        if (wc < 2) {
            const f32x4 g0 = *(const f32x4*)(g + 32 * wc + 8 * fq) * (C2_MLA * F8_QS), g1 = *(const f32x4*)(g + 32 * wc + 8 * fq + 4) * (C2_MLA * F8_QS);
#pragma unroll
            for (int ai = 0; ai < 2; ++ai)
#pragma unroll
                for (int mp = 0; mp < 2; ++mp) {
                    const size_t row = row0 + ai * 128 + (2 * mp) * 16;
#pragma unroll
                    for (int bj = 0; bj < 2; ++bj) { u32x2 d[2];
#pragma unroll
                        for (int mm = 0; mm < 2; ++mm) { const int m = 2 * mp + mm;
                            const f32x4 t = *(const LAS f32x4*)(red + (ai * 128 + m * 16 + rl0) * 8 + bj * 4);
                            const float r = __builtin_amdgcn_rsqf(((t[0] + t[1]) + (t[2] + t[3])) * (1.0f / 96.0f) + EPS);
                            d[mm] = f8x8u(acc[ai][bj][m][0] * r * g0, acc[ai][bj][m][1] * r * g1); }
                        unsigned char* pa = (unsigned char*)QM + ((unsigned)row * 768u + (2 * u.pn + bj) * 96u + 32u * wc + 8u * fq);
                        st8pair(pa, pa + 16 * 768, d[0], d[1], fq);
                    }
                }
        } else if (wc == 2) {
            const f32x4 g0 = *(const f32x4*)(g + 64 + 4 * fq) * (C2_MLA * F8_QS), g1 = *(const f32x4*)(g + 80 + 4 * fq) * (C2_MLA * F8_QS);
            f32x4 csv[2][4], snv[2][4];
#pragma unroll
            for (int ai = 0; ai < 2; ++ai)
#pragma unroll
                for (int m = 0; m < 4; ++m) { const unsigned ro = ((unsigned)row0 + ai * 128 + m * 16) * 64u + 16u * fq; csv[ai][m] = *(const f32x4*)((const unsigned char*)cosT + ro); snv[ai][m] = *(const f32x4*)((const unsigned char*)sinT + ro); }
#pragma unroll
            for (int ai = 0; ai < 2; ++ai) {
#pragma unroll
                for (int m = 0; m < 4; ++m) {
                    const unsigned rowu = (unsigned)row0 + ai * 128 + m * 16;
#pragma unroll
                    for (int bj = 0; bj < 2; ++bj) {
                        const f32x4 t = *(const LAS f32x4*)(red + (ai * 128 + m * 16 + rl0) * 8 + bj * 4);
                        const float r = __builtin_amdgcn_rsqf(((t[0] + t[1]) + (t[2] + t[3])) * (1.0f / 96.0f) + EPS);
                        unsigned char* hp = (unsigned char*)QM + (rowu * 768u + (2 * u.pn + bj) * 96u);
                        const f32x4 x1 = acc[ai][bj][m][0] * r * g0, x2 = acc[ai][bj][m][1] * r * g1;
                        { const f32x4 ya = x1 * csv[ai][m] - x2 * snv[ai][m], yb = x2 * csv[ai][m] + x1 * snv[ai][m]; *(unsigned*)(hp + 64 + 4 * fq) = pk_fp8x4u(ya[0], ya[1], ya[2], ya[3]); *(unsigned*)(hp + 80 + 4 * fq) = pk_fp8x4u(yb[0], yb[1], yb[2], yb[3]); }
                    }
                }
                asm volatile("" ::: "memory");
            }
        }
    }
};

struct EpiKV {
    static constexpr bool APERM = false, PREFETCH = false, FP8 = false;
    unsigned char* ws; const float* g;
    __device__ __forceinline__ void operator()(const f32x4 (&acc)[2][2][4][2], const Unit& u, int wr, int wc, int fr, int fq, LAS float* red) const {
        asm volatile("" : "+v"(fr), "+v"(fq), "+s"(wr), "+s"(wc));
        const int rl0 = wr * 64 + fr; const size_t row0 = (size_t)u.pm * 256 + rl0;
        bf16_t* const KM = (bf16_t*)(ws + WS_KM); bf16_t* const VM = (bf16_t*)(ws + WS_VM); const float* const cosT = (const float*)(ws + WS_COS); const float* const sinT = (const float*)(ws + WS_SIN);
        const float* const KR = (const float*)(ws + WS_KR); const float* const SSR = (const float*)(ws + WS_SSR);
        if (wc < 2) {
#pragma unroll
            for (int ai = 0; ai < 2; ++ai)
#pragma unroll
                for (int m = 0; m < 4; ++m)
#pragma unroll
                    for (int bj = 0; bj < 2; ++bj) {
                        float ss = dot4(acc[ai][bj][m][0]) + dot4(acc[ai][bj][m][1]);
                        ss = xsum32(xsum16(ss));
                        if (fq == 0) red[(ai * 128 + m * 16 + rl0) * 8 + bj * 2 + wc] = ss;
                    }
        }
        LDS_BARRIER();
        if (wc < 2) {
            const f32x4 g0 = *(const f32x4*)(g + 32 * wc + 8 * fq) * F8_KS, g1 = *(const f32x4*)(g + 32 * wc + 8 * fq + 4) * F8_KS;
            float ssrv[2][4];
#pragma unroll
            for (int ai = 0; ai < 2; ++ai)
#pragma unroll
                for (int m = 0; m < 4; ++m) ssrv[ai][m] = SSR[row0 + ai * 128 + m * 16];
#pragma unroll
            for (int ai = 0; ai < 2; ++ai)
#pragma unroll
                for (int mp = 0; mp < 2; ++mp) {
                    const size_t row = row0 + ai * 128 + (2 * mp) * 16;
                    const f32x4 t0 = *(const LAS f32x4*)(red + (ai * 128 + (2 * mp) * 16 + rl0) * 8), t1 = *(const LAS f32x4*)(red + (ai * 128 + (2 * mp + 1) * 16 + rl0) * 8);
#pragma unroll
                    for (int bj = 0; bj < 2; ++bj) {
                        const float rk0 = __builtin_amdgcn_rsqf((t0[2 * bj] + t0[2 * bj + 1] + ssrv[ai][2 * mp]) * (1.0f / 96.0f) + EPS), rk1 = __builtin_amdgcn_rsqf((t1[2 * bj] + t1[2 * bj + 1] + ssrv[ai][2 * mp + 1]) * (1.0f / 96.0f) + EPS);
                        unsigned char* pa = (unsigned char*)KM + ((unsigned)row * 768u + (2 * u.pn + bj) * 96u + 32u * wc + 8u * fq);
                        st8pair(pa, pa + 16 * 768, f8x8u(acc[ai][bj][2 * mp][0] * rk0 * g0, acc[ai][bj][2 * mp][1] * rk0 * g1), f8x8u(acc[ai][bj][2 * mp + 1][0] * rk1 * g0, acc[ai][bj][2 * mp + 1][1] * rk1 * g1), fq);
                    }
                    asm volatile("" ::: "memory");
                }
        } else {
            const int bj0 = wc - 2, h0 = 2 * u.pn + bj0;
            { float* pv = (float*)(ws + WS_PARTV) + ((size_t)u.pm * 2 + wr) * 1024 + (2 * u.pn) * 64 + 32 * (wc - 2) + 8 * fq;
              colsum8(acc, 0, fr, pv); colsum8(acc, 1, fr, pv + 64); }
            const f32x4 g0 = *(const f32x4*)(g + 64 + 4 * fq) * F8_KS, g1 = *(const f32x4*)(g + 80 + 4 * fq) * F8_KS;
#pragma unroll
            for (int ai = 0; ai < 2; ++ai)
#pragma unroll
              for (int mp = 0; mp < 2; ++mp) { const unsigned rowa = (unsigned)row0 + ai * 128 + (2 * mp) * 16;
#pragma unroll
                  for (int bj = 0; bj < 2; ++bj) { unsigned char* pa = (unsigned char*)VM + (rowa * 512u + (2 * u.pn + bj) * 64u + 32u * (wc - 2) + 8u * fq);
                      st8pair(pa, pa + 16 * 512, f8x8(acc[ai][bj][2 * mp][0], acc[ai][bj][2 * mp][1]), f8x8(acc[ai][bj][2 * mp + 1][0], acc[ai][bj][2 * mp + 1][1]), fq); } }
            asm volatile("" ::: "memory");
#pragma unroll
            for (int ai = 0; ai < 2; ++ai) {
                f32x4 csv[4], snv[4], k1v[4], k2v[4]; float ssrv[4];
#pragma unroll
                for (int m = 0; m < 4; ++m) { const unsigned rowu = (unsigned)row0 + ai * 128 + m * 16; csv[m] = *(const f32x4*)((const unsigned char*)cosT + rowu * 64u + 16u * fq); snv[m] = *(const f32x4*)((const unsigned char*)sinT + rowu * 64u + 16u * fq);
                    k1v[m] = *(const f32x4*)((const unsigned char*)KR + rowu * 128u + 16u * fq); k2v[m] = *(const f32x4*)((const unsigned char*)KR + rowu * 128u + 64u + 16u * fq); ssrv[m] = *(const float*)((const unsigned char*)SSR + rowu * 4u); }
#pragma unroll
                for (int m = 0; m < 4; ++m) {
                    const unsigned rowu = (unsigned)row0 + ai * 128 + m * 16;
                    const f32x2 t = *(const LAS f32x2*)(red + (ai * 128 + m * 16 + rl0) * 8 + 2 * bj0);
                    const float rk = __builtin_amdgcn_rsqf((t[0] + t[1] + ssrv[m]) * (1.0f / 96.0f) + EPS);
                    const f32x4 x1 = k1v[m] * rk * g0, x2 = k2v[m] * rk * g1;
                    unsigned char* hp = (unsigned char*)KM + (rowu * 768u + h0 * 96u);
                    { const f32x4 ya = x1 * csv[m] - x2 * snv[m], yb = x2 * csv[m] + x1 * snv[m]; *(unsigned*)(hp + 64 + 4 * fq) = pk_fp8x4u(ya[0], ya[1], ya[2], ya[3]); *(unsigned*)(hp + 80 + 4 * fq) = pk_fp8x4u(yb[0], yb[1], yb[2], yb[3]); }
                }
                asm volatile("" ::: "memory");
            }
        }
    }
};

struct EpiQKV {
    static constexpr bool APERM = false, PREFETCH = false, FP8 = false;
    EpiQ q; EpiKV kv;
    __device__ __forceinline__ void operator()(const f32x4 (&acc)[2][2][4][2], const Unit& u, int wr, int wc, int fr, int fq, LAS float* red) const {
        if (u.pn < 4) q(acc, u, wr, wc, fr, fq, red);
        else { Unit v; v.pm = u.pm; v.pn = u.pn - 4; kv(acc, v, wr, wc, fr, fq, red); }
    }
};

__device__ __forceinline__ void f8_pre(f32x4 (&acc)[2][2][4][2], const float* side, int ld, float descale, const Unit& u, int wc, int fq) {
    asm volatile("" : "+v"(fq), "+s"(wc));
    const char* sb = (const char*)(side + (size_t)(u.pm >> 3) * ld + u.pn * 256 + wc * 32); const unsigned vo = (unsigned)fq * 32u;
    f32x4 bv[2][2];
#pragma unroll
    for (int bj = 0; bj < 2; ++bj)
#pragma unroll
        for (int n = 0; n < 2; ++n) bv[bj][n] = *(const f32x4*)(sb + vo + (128 * bj + 4 * n) * 4);
#pragma unroll
    for (int a = 0; a < 2; ++a)
#pragma unroll
        for (int bj = 0; bj < 2; ++bj)
#pragma unroll
            for (int m = 0; m < 4; ++m)
#pragma unroll
                for (int n = 0; n < 2; ++n) acc[a][bj][m][n] = acc[a][bj][m][n] * descale + bv[bj][n];
}
template <bool RES_BF16, bool OUT_BF16, bool F8 = false> struct EpiRes {
    static constexpr bool APERM = false, PREFETCH = false, FP8 = F8;
    __device__ __forceinline__ void pre(f32x4 (&acc)[2][2][4][2], const Unit& u, int wc, int fq) const { f8_pre(acc, side, 1024, 1.0f / (F8_O_SCALE * F8_WOUT_SCALE), u, wc, fq); }
    const void* base; void* out; const float* gate; const float* side = nullptr;
    __device__ __forceinline__ void operator()(const f32x4 (&acc)[2][2][4][2], const Unit& u, int wr, int wc, int fr, int fq, LAS float* red) const {
        asm volatile("" : "+v"(fr), "+v"(fq), "+s"(wr), "+s"(wc));
        const int b = u.pm >> 3; const int col0 = u.pn * 256 + wc * 32 + 8 * fq;
        f32x4 gv[2][2];
#pragma unroll
        for (int bj = 0; bj < 2; ++bj)
#pragma unroll
            for (int n = 0; n < 2; ++n) gv[bj][n] = *(const f32x4*)(gate + (size_t)b * NMOD + col0 + 128 * bj + 4 * n);
        if (RES_BF16) {
            u32x4 raw[2][4][2];
#pragma unroll
            for (int ai = 0; ai < 2; ++ai)
#pragma unroll
                for (int m = 0; m < 4; ++m)
#pragma unroll
                    for (int bj = 0; bj < 2; ++bj) raw[ai][m][bj] = *(const u32x4*)((const bf16_t*)base + ((size_t)u.pm * 256 + ai * 128 + wr * 64 + fr) * DM + col0 + (size_t)m * 16 * DM + 128 * bj);
#pragma unroll
            for (int ai = 0; ai < 2; ++ai) {
                const size_t off0 = ((size_t)u.pm * 256 + ai * 128 + wr * 64 + fr) * DM + col0;
#pragma unroll
                for (int m = 0; m < 4; ++m)
#pragma unroll
                    for (int bj = 0; bj < 2; ++bj) { const u32x4 w = raw[ai][m][bj];
                        const f32x4 x0 = (f32x4){__uint_as_float(w.x << 16), __uint_as_float(w.x & 0xffff0000u), __uint_as_float(w.y << 16), __uint_as_float(w.y & 0xffff0000u)};
                        const f32x4 x1 = (f32x4){__uint_as_float(w.z << 16), __uint_as_float(w.z & 0xffff0000u), __uint_as_float(w.w << 16), __uint_as_float(w.w & 0xffff0000u)};
                        const f32x4 v0 = x0 + gv[bj][0] * acc[ai][bj][m][0], v1 = x1 + gv[bj][1] * acc[ai][bj][m][1];
                        if (OUT_BF16) st16((bf16_t*)out + off0 + (size_t)m * 16 * DM + 128 * bj, pack8(v0, v1));
                        else { *(f32x4*)((float*)out + off0 + (size_t)m * 16 * DM + 128 * bj) = v0; *(f32x4*)((float*)out + off0 + (size_t)m * 16 * DM + 128 * bj + 4) = v1; } }
                asm volatile("" ::: "memory");
            }
        } else {
#pragma unroll
        for (int ai = 0; ai < 2; ++ai) {
            const size_t off0 = ((size_t)u.pm * 256 + ai * 128 + wr * 64 + fr) * DM + col0;
            f32x4 xs[4][2][2];
#pragma unroll
            for (int m = 0; m < 4; ++m)
#pragma unroll
                for (int bj = 0; bj < 2; ++bj)
#pragma unroll
                    for (int n = 0; n < 2; ++n) xs[m][bj][n] = *(const f32x4*)((const float*)base + off0 + (size_t)m * 16 * DM + 128 * bj + 4 * n);
#pragma unroll
            for (int m = 0; m < 4; ++m)
#pragma unroll
                for (int bj = 0; bj < 2; ++bj) {
                    const f32x4 v0 = xs[m][bj][0] + gv[bj][0] * acc[ai][bj][m][0], v1 = xs[m][bj][1] + gv[bj][1] * acc[ai][bj][m][1];
                    if (OUT_BF16) st16((bf16_t*)out + off0 + (size_t)m * 16 * DM + 128 * bj, pack8(v0, v1));
                    else { *(f32x4*)((float*)out + off0 + (size_t)m * 16 * DM + 128 * bj) = v0; *(f32x4*)((float*)out + off0 + (size_t)m * 16 * DM + 128 * bj + 4) = v1; }
                }
            asm volatile("" ::: "memory");
        }
        }
    }
};

struct EpiResNorm {
    static constexpr bool APERM = false, PREFETCH = true, FP8 = true;
    __device__ __forceinline__ void prefetch(const Unit& u, LAS float* xl, int par, int wid, int lane) const {
        asm volatile("" : "+v"(lane));
        if (wid < 5) { const int b = u.pm >> 3; const float* MODb = (const float*)(ws + WS_MOD) + (size_t)b * NMOD;
            const float* src = wid == 0 ? (const float*)(ws + WS_BIAS2) + (size_t)b * 1024 : wid == 1 ? gate + (size_t)b * NMOD : wid == 2 ? gn : wid == 3 ? MODb + 4 * DM : MODb + 3 * DM;
            glds16_(src + u.pn * 256 + 4 * lane, (unsigned)__builtin_amdgcn_readfirstlane((unsigned)(uintptr_t)(xl + XL_CONST + par * 1280 + wid * 256))); }
    }
    __device__ __forceinline__ void pre(f32x4 (&acc)[2][2][4][2], const Unit& u, int wc, int fq, LAS float* xl, int par) const { f8_pre_lds(acc, xl + XL_CONST + par * 1280, 1.0f / (F8_O_SCALE * F8_WOUT_SCALE), wc, fq); }
    const float* base; unsigned char* ws; const float* gate; const float* gn;
    __device__ __forceinline__ void operator()(f32x4 (&acc)[2][2][4][2], const Unit& u, int wr, int wc, int fr, int fq, LAS float* red, int par) const {
        asm volatile("" : "+v"(fr), "+v"(fq), "+s"(wr), "+s"(wc));
        const int b = u.pm >> 3; const int col0 = u.pn * 256 + wc * 32 + 8 * fq; const int rl0 = wr * 64 + fr;
        const LAS float* cst = red + XL_CONST + par * 1280 + wc * 32 + 8 * fq;
        bf16_t* const X1 = (bf16_t*)(ws + WS_X1); bf16_t* const H2 = (bf16_t*)(ws + WS_H2); const float* const MOD = (const float*)(ws + WS_MOD);
        {
            f32x4 gv[2][2];
#pragma unroll
            for (int bj = 0; bj < 2; ++bj)
#pragma unroll
                for (int n = 0; n < 2; ++n) gv[bj][n] = *(const LAS f32x4*)(cst + 256 + 128 * bj + 4 * n);
#pragma unroll
            for (int ai = 0; ai < 2; ++ai) {
                const size_t off0 = ((size_t)u.pm * 256 + ai * 128 + rl0) * DM + col0;
                f32x4 xs[4][2][2];
#pragma unroll
                for (int m = 0; m < 4; ++m)
#pragma unroll
                    for (int bj = 0; bj < 2; ++bj)
#pragma unroll
                        for (int n = 0; n < 2; ++n) xs[m][bj][n] = *(const f32x4*)(base + off0 + (size_t)m * 16 * DM + 128 * bj + 4 * n);
#pragma unroll
                for (int m = 0; m < 4; ++m) { float ss = 0.f;
#pragma unroll
                    for (int bj = 0; bj < 2; ++bj) {
#pragma unroll
                        for (int n = 0; n < 2; ++n) { const f32x4 v = xs[m][bj][n] + gv[bj][n] * acc[ai][bj][m][n]; acc[ai][bj][m][n] = v; ss += dot4(v); }
                        st16(X1 + off0 + (size_t)m * 16 * DM + 128 * bj, pack8(acc[ai][bj][m][0], acc[ai][bj][m][1])); }
                    ss = xsum32(xsum16(ss));
                    if (fq == 0) red[(ai * 128 + m * 16 + rl0) * 8 + wc] = ss;
                }
                asm volatile("" ::: "memory");
            }
        }
        LDS_BARRIER();
        const int tid = tid_from_wave(wr * 4 + wc);
        if (tid < 256) {
            const f32x4 t = *(const LAS f32x4*)(red + tid * 8);
            const float mine = (t[0] + t[1]) + (t[2] + t[3]);
            unsigned long long* slot = (unsigned long long*)(ws + WS_PART) + ((size_t)u.pm * 256 + tid) * 4;
            { unsigned tg; asm volatile("v_mov_b32 %0, 1" : "=v"(tg));
              __hip_atomic_store(slot + u.pn, ((unsigned long long)tg << 32) | (unsigned long long)__float_as_uint(mine), __ATOMIC_RELAXED, __HIP_MEMORY_SCOPE_AGENT); }
            float tot = mine;
#pragma unroll
            for (int k = 1; k < 4; ++k) { const int pk = (u.pn + k) & 3; unsigned long long w; unsigned sp = 0;
                for (;;) { w = __hip_atomic_load(slot + pk, __ATOMIC_RELAXED, __HIP_MEMORY_SCOPE_AGENT); if ((unsigned)(w >> 32) == 1u || ++sp > (1u << 22)) break; __builtin_amdgcn_s_sleep(1); }
                tot += __uint_as_float((unsigned)w); }
            red[tid * 8 + 4] = __builtin_amdgcn_rsqf(tot * (1.0f / DM) + EPS);
        }
        LDS_BARRIER();
        {
            f32x4 Gv[2][2], Sv[2][2];
#pragma unroll
            for (int bj = 0; bj < 2; ++bj)
#pragma unroll
                for (int n = 0; n < 2; ++n) { const int c = col0 + 128 * bj + 4 * n;
                    Gv[bj][n] = *(const LAS f32x4*)(cst + 512 + 128 * bj + 4 * n) * (*(const LAS f32x4*)(cst + 768 + 128 * bj + 4 * n) + 1.0f); Sv[bj][n] = *(const LAS f32x4*)(cst + 1024 + 128 * bj + 4 * n); (void)c; }
#pragma unroll
            for (int ai = 0; ai < 2; ++ai)
#pragma unroll
                for (int m = 0; m < 4; ++m) {
                    const float r = red[(ai * 128 + m * 16 + rl0) * 8 + 4];
                    bf16_t* rp = H2 + ((size_t)u.pm * 256 + ai * 128 + m * 16 + rl0) * DM + col0;
#pragma unroll
                    for (int bj = 0; bj < 2; ++bj) st16(rp + 128 * bj, pack8(acc[ai][bj][m][0] * r * Gv[bj][0] + Sv[bj][0], acc[ai][bj][m][1] * r * Gv[bj][1] + Sv[bj][1]));
                }
        }
    }
};

__device__ __forceinline__ float dpp_shr1(float v) { return __builtin_bit_cast(float, __builtin_amdgcn_update_dpp(0, __builtin_bit_cast(int, v), 0x111, 0xF, 0xF, true)); }
__device__ __forceinline__ f32x4 dpp_shr1(f32x4 v) { f32x4 r; r[0] = dpp_shr1(v[0]); r[1] = dpp_shr1(v[1]); r[2] = dpp_shr1(v[2]); r[3] = dpp_shr1(v[3]); return r; }
struct EpiUp {
    static constexpr bool APERM = true, PREFETCH = true, FP8 = false;
    unsigned char* ws; const float *cw, *cb;
    __device__ __forceinline__ void prefetch(const Unit& u, LAS float* xl, int par, int wid, int lane) const {
        asm volatile("" : "+v"(lane));
        if (wid < 4) { const float* src = (wid < 3 ? cw + (size_t)wid * DFF2 : cb) + (lane < 32 ? 128 * u.pn + 4 * lane : DFF + 128 * u.pn + 4 * (lane - 32));
            glds16_(src, (unsigned)__builtin_amdgcn_readfirstlane((unsigned)(uintptr_t)(xl + par * 1024 + wid * 256))); }
    }
    __device__ __forceinline__ void operator()(const f32x4 (&acc)[2][2][4][2], const Unit& u, int wr, int wc, int fr, int fq, LAS float* xl, int par) const {
        asm volatile("" : "+v"(fr), "+v"(fq), "+s"(wr), "+s"(wc));
        const int j = u.pn; const int cc0 = 32 * wc + 8 * fq;
        bf16_t* const ACT = (bf16_t*)(ws + WS_ACT); bf16_t* const RAW4 = (bf16_t*)(ws + WS_RAW4);
        const LAS float* W = xl + par * 1024 + cc0;
#pragma unroll
        for (int ai = 0; ai < 2; ++ai) {
            const size_t blk = (size_t)u.pm * 4 + 2 * ai + wr;
            u32x2 pend[4];
#pragma unroll
            for (int n = 0; n < 2; ++n) {
                const f32x4 wg0 = *(const LAS f32x4*)(W + 4 * n), wg1 = *(const LAS f32x4*)(W + 256 + 4 * n), wg2 = *(const LAS f32x4*)(W + 512 + 4 * n), bg = *(const LAS f32x4*)(W + 768 + 4 * n);
                const f32x4 wv0 = *(const LAS f32x4*)(W + 128 + 4 * n), wv1 = *(const LAS f32x4*)(W + 384 + 4 * n), wv2 = *(const LAS f32x4*)(W + 640 + 4 * n), bv = *(const LAS f32x4*)(W + 896 + 4 * n);
                const f32x4 g2s = dpp_shr1(acc[ai][0][2][n]), g3s = dpp_shr1(acc[ai][0][3][n]), v2s = dpp_shr1(acc[ai][1][2][n]), v3s = dpp_shr1(acc[ai][1][3][n]);
#pragma unroll
                for (int m = 0; m < 4; ++m) {
                    const f32x4 gr = acc[ai][0][m][n], vr = acc[ai][1][m][n];
                    const f32x4 gp1 = m == 0 ? g3s : acc[ai][0][m - 1 < 0 ? 0 : m - 1][n], gp2 = m == 0 ? g2s : (m == 1 ? g3s : acc[ai][0][m - 2 < 0 ? 0 : m - 2][n]);
                    const f32x4 vp1 = m == 0 ? v3s : acc[ai][1][m - 1 < 0 ? 0 : m - 1][n], vp2 = m == 0 ? v2s : (m == 1 ? v3s : acc[ai][1][m - 2 < 0 ? 0 : m - 2][n]);
                    const f32x4 G = wg2 * gr + (wg1 * gp1 + (wg0 * gp2 + bg)), V = wv2 * vr + (wv1 * vp1 + (wv0 * vp2 + bv));
                    f32x4 a;
#pragma unroll
                    for (int e = 0; e < 4; ++e) a[e] = G[e] * __builtin_amdgcn_rcpf(1.0f + __builtin_amdgcn_exp2f(-LOG2E * G[e])) * V[e];
                    if (n == 0) pend[m] = pack4(a);
                    else if (m >= 2 || fr > 0) { const u32x2 hi2 = pack4(a); const unsigned boff = (((unsigned)blk * 64u + 4u * fr + m) * DFF + 128u * j + cc0) * 2u;
                        st16o(ACT, boff, (u32x4){pend[m].x, pend[m].y, hi2.x, hi2.y}); }
                    if ((m < 2 && fr == 0) || (m >= 2 && fr == 15)) { const unsigned roff = (((unsigned)blk * 4u + m) * DFF2 + 256u * j + cc0 + 4u * n) * 2u; *(u32x2*)((unsigned char*)RAW4 + roff) = pack4(gr); *(u32x2*)((unsigned char*)RAW4 + roff + 256u) = pack4(vr); }
                }
            }
            asm volatile("" ::: "memory");
        }
    }
};

namespace att {
__device__ __forceinline__ int crow(int r, int hi) { return (r & 3) + 8 * (r >> 2) + 4 * hi; }
__device__ __forceinline__ void glds16(const void* gsrc, unsigned lds_dst) { unsigned keep;
    asm volatile("s_mov_b32 %0, m0\n\ts_mov_b32 m0, %2\n\ts_nop 0\n\tglobal_load_lds_dwordx4 %1, off\n\ts_mov_b32 m0, %0" : "=&s"(keep) : "v"(gsrc), "s"(lds_dst) : "memory"); }
__device__ __forceinline__ void glds16s(const void* sbase, unsigned voff, unsigned lds_dst) { unsigned keep;
    asm volatile("s_mov_b32 %0, m0\n\ts_mov_b32 m0, %3\n\ts_nop 0\n\tglobal_load_lds_dwordx4 %1, %2\n\ts_mov_b32 m0, %0" : "=&s"(keep) : "v"(voff), "s"(sbase), "s"(lds_dst) : "memory"); }
__device__ __forceinline__ float max3f(float a, float b, float c) { float r; asm("v_max3_f32 %0, %1, %2, %3" : "=v"(r) : "v"(a), "v"(b), "v"(c)); return r; }
__device__ __forceinline__ float rowmax(const f32x16& p0, const f32x16& p1) {
    float a = max3f(p0[0], p0[1], p1[0]), b = max3f(p0[2], p0[3], p1[1]); a = max3f(a, p1[2], p1[3]);
#pragma unroll
    for (int r = 4; r < 16; r += 4) { a = max3f(a, p0[r], p0[r + 1]); b = max3f(b, p0[r + 2], p0[r + 3]); a = max3f(a, p1[r], p1[r + 1]); b = max3f(b, p1[r + 2], p1[r + 3]); }
    const float m = fmaxf(a, b);
    auto rr = __builtin_amdgcn_permlane32_swap(__float_as_uint(m), __float_as_uint(m), false, false);
    return fmaxf(__uint_as_float(rr[0]), __uint_as_float(rr[1]));
}
typedef short v4i16_t __attribute__((ext_vector_type(4)));
__device__ __forceinline__ s16x4 vtr(const LAS unsigned char* p) { return __builtin_bit_cast(s16x4, __builtin_amdgcn_ds_read_tr16_b64_v4i16((LAS v4i16_t*)p)); }
__device__ __forceinline__ void pv(f32x16* o, const LAS unsigned char* vp, bf16x8 pa0, bf16x8 pa1, bf16x8 pa2, bf16x8 pa3) {
#pragma unroll
    for (int d0 = 0; d0 < 2; ++d0) { s16x4 lo[4], hi[4];
        __builtin_amdgcn_sched_barrier(0);
#pragma unroll
        for (int ks = 0; ks < 4; ++ks) { lo[ks] = vtr(vp + d0 * 4096 + ks * 1024); hi[ks] = vtr(vp + d0 * 4096 + ks * 1024 + 512); }
#define PK(k) (bf16x8){lo[k][0], lo[k][1], lo[k][2], lo[k][3], hi[k][0], hi[k][1], hi[k][2], hi[k][3]}
        o[d0] = __builtin_amdgcn_mfma_f32_32x32x16_bf16(pa0, PK(0), o[d0], 0, 0, 0);
        o[d0] = __builtin_amdgcn_mfma_f32_32x32x16_bf16(pa1, PK(1), o[d0], 0, 0, 0);
        o[d0] = __builtin_amdgcn_mfma_f32_32x32x16_bf16(pa2, PK(2), o[d0], 0, 0, 0);
        o[d0] = __builtin_amdgcn_mfma_f32_32x32x16_bf16(pa3, PK(3), o[d0], 0, 0, 0);
#undef PK
    }
}
constexpr int NSLOT = 4;
constexpr int ATT_LDS_BYTES = 3 * 6144 + 3 * 4096 + 8 * 256 + 2048 + 3 * 16384 + 8 * 2048 + 4096;

__device__ __forceinline__ float wave_max(float v) {
#pragma unroll
    for (int o = 1; o < 64; o <<= 1) v = fmaxf(v, __shfl_xor(v, o));
    return v;
}
template <int DQK, bool CA>
__device__ __forceinline__ void attn_run(int tid, int b, int h, unsigned ulist, int nu, const unsigned char* Q, const unsigned char* K, const unsigned char* V, unsigned char* O, float* REF, unsigned* refcnt, const float* PARTV, const float* relb, float S0, LAS unsigned char* shm) {
    constexpr int NQ = (DQK + 63) / 64, NGQ = 2 * NQ, NQL = 2 * NQ, NCH = DQK / 16, KSLOT = NCH * 1024, VSLOT = 4096, NS = 3;
    constexpr int LDS_K = 0, LDS_V = NS * KSLOT, LDS_WS = LDS_V + NS * VSLOT, LDS_TAB = LDS_WS + 8 * 256, LDS_IMG = LDS_TAB + 2048, LDS_OST = LDS_IMG + (CA ? 3 * 16384 : 0), LDS_VB = LDS_OST + 8 * 2048;
    constexpr int LDQ = CA ? 512 : 768, LDV = 512, LDO = 1024, OCOL = CA ? 512 : 0;
    const int lane = tid & 63, r32 = lane & 31, hi = lane >> 5; const int wid = __builtin_amdgcn_readfirstlane(tid >> 6);
    const long rowbase = (long)b * SEQ; const int tidl = wid * 64 + lane;
    const unsigned lds0 = (unsigned)(uintptr_t)shm;
    LAS float* tab = (LAS float*)(shm + LDS_TAB);
    const unsigned char* Kb = K + rowbase * LDQ + h * DQK; const unsigned char* Vb = V + rowbase * LDV + h * 64;
    const bool kw = wid < NCH, vw = wid >= 4;
    const unsigned kvoff = (unsigned)(lane * LDQ + (wid < NCH ? wid : 0) * 16);
    const unsigned vvoff = (unsigned)((16 * (wid & 3) + (lane >> 2)) * LDV + (lane & 3) * 16);
#define SBAR() __builtin_amdgcn_sched_barrier(0)
#define PIN(x) asm volatile("" : "+v"(x))
#define DMA_K(t, sl) do { if (kw) glds16s(Kb + (long)(t) * 64 * LDQ, kvoff, (unsigned)__builtin_amdgcn_readfirstlane(lds0 + LDS_K + (sl) * KSLOT + wid * 1024)); } while (0)
#define DMA_V(t, sl) do { if (vw) glds16s(Vb + (long)(t) * 64 * LDV, vvoff, (unsigned)__builtin_amdgcn_readfirstlane(lds0 + LDS_V + (sl) * VSLOT + (wid & 3) * 1024)); } while (0)
#define WAIT_BAR(N) asm volatile("s_waitcnt vmcnt(%0) lgkmcnt(0)\n\ts_barrier" :: "n"(N) : "memory")
#define WAIT_KV(nK, nV, X) do { if (kw && vw) WAIT_BAR((nK) + (nV) + (X)); else if (kw) WAIT_BAR((nK) + (X)); else if (vw) WAIT_BAR((nV) + (X)); else WAIT_BAR(X); } while (0)
#define TVALID(tau) (CA ? ((tau) + t0 <= cw && (tau) + t0 >= cw - 8) : ((tau) + t0 <= cw))
#define TABS(x) ((x) < NT ? t0 + (x) : t0n + (x) - NT)
#define T0OF(u_) (CA ? (4 * (u_) - 8 > 0 ? 4 * (u_) - 8 : 0) : 0)
#define QLOAD(u_) do { const unsigned char* Qw_ = Q + (rowbase + (u_) * 256 + wid * 32) * LDQ + h * DQK; const int lq_ = tid_from_wave(0); const unsigned qo_ = (unsigned)((lq_ & 31) * LDQ); \
        _Pragma("unroll") for (int p = 0; p < NQ; ++p) { const unsigned po_ = qo_ + ((p == 1 && DQK == 96) ? 64u : (unsigned)(p * 64 + (lq_ >> 5) * 32)); \
            const i32x4 lo_ = *(const i32x4*)(Qw_ + po_), hi_ = *(const i32x4*)(Qw_ + po_ + 16); qr[p] = __builtin_shufflevector(lo_, hi_, 0, 1, 2, 3, 4, 5, 6, 7); } } while (0)
#define QREADY() do { _Pragma("unroll") for (int p = 0; p < NQ; ++p) asm volatile("" :: "v"(qr[p])); \
        if (DQK == 96) { _Pragma("unroll") for (int e = 0; e < 8; ++e) qr[NQ - 1][e] = hi ? 0 : qr[NQ - 1][e]; } } while (0)
#ifndef SH_EXTRA
#define SH_EXTRA 0
#endif
    float SHI = fmaxf(ceilf(S0 - 15.5f), 0.0f) + SH_EXTRA; float pcadd = 4.0f * (15.0f - SHI) + 0.5f;
    float tabc = 0.f;
    const LAS unsigned char* vp0 = shm + LDS_V + (4 * hi + (((lane & 15) >> 1) & 3) + 8 * ((lane & 15) >> 3)) * 64 + ((lane >> 4) & 1) * 16 + (lane & 1) * 8;
    const LAS unsigned char* kp0 = shm + LDS_K + hi * 2048 + r32 * 16;
    const LAS unsigned char* kp1 = shm + LDS_K + 4096 + r32 * 16;
    const LAS unsigned char* imgp = shm + LDS_IMG + (wid & 1) * 8192 + lane * 16;
    i32x8 qr[NQ]; i32x8 kf[NGQ]  ; i32x8 vb[2]; i32x8 pw; f32x16 pA0, pA1, pB0, pB1;
    i32x8 ones8;
#pragma unroll
    for (int e = 0; e < 8; ++e) ones8[e] = 0x38383838;
    PIN(ones8);
    int sl_prev = 0, sl_cur = 0, sl_next = 1;
#define ROT() do { sl_prev = sl_cur; sl_cur = sl_next; sl_next = (sl_next == NS - 1) ? 0 : sl_next + 1; } while (0)
#define KFL(g, ks_) do { const LAS unsigned char* a_ = (((g) >> 1) ? kp1 : kp0) + (ks_) + ((g) & 1) * 512; const i32x4 lo_ = *(const LAS i32x4*)(a_), hi_ = *(const LAS i32x4*)(a_ + 1024); kf[g] = __builtin_shufflevector(lo_, hi_, 0, 1, 2, 3, 4, 5, 6, 7); } while (0)
#define QKM(kfr, qfr, C) __builtin_amdgcn_mfma_scale_f32_32x32x64_f8f6f4(kfr, qfr, C, 0, 0, 0, 0, 0, 0)
#define VRD(i, vp_) do { const i32x2 t_ = __builtin_amdgcn_ds_read_tr8_b64_v2i32((LAS i32x2*)((vp_) + ((i) & 3) * 1024 + ((i) >> 2) * 32)); vb[(i) >> 2][2 * ((i) & 3)] = t_[0]; vb[(i) >> 2][2 * ((i) & 3) + 1] = t_[1]; } while (0)
#define PEL(P0, P1, e) ((e) < 16 ? P0[(e) & 15] : P1[(e) & 15])
#define PWSET(w, P0, P1) do { unsigned x_ = (unsigned)undef_i32(); x_ = __builtin_amdgcn_cvt_pk_u8_f32(PEL(P0, P1, 4 * (w)), 0, x_); x_ = __builtin_amdgcn_cvt_pk_u8_f32(PEL(P0, P1, 4 * (w) + 1), 1, x_); \
        x_ = __builtin_amdgcn_cvt_pk_u8_f32(PEL(P0, P1, 4 * (w) + 2), 2, x_); x_ = __builtin_amdgcn_cvt_pk_u8_f32(PEL(P0, P1, 4 * (w) + 3), 3, x_); pw[w] = (int)x_; } while (0)
#define PVM(d0) o[d0] = __builtin_amdgcn_mfma_scale_f32_32x32x64_f8f6f4(pw, vb[d0], o[d0], 1, 0, 0, 0, 0, 0)
#define PVL() lacc = __builtin_amdgcn_mfma_scale_f32_32x32x64_f8f6f4(pw, ones8, lacc, 1, 0, 0, 0, 0, 0)
#define QK_FIRST(C0, C1, A0, A1, tau) do { const int dist_ = cw - ((tau) + t0); \
        if (CA && TVALID(tau) && dist_ < 3) { const LAS unsigned char* ip_ = imgp + dist_ * 16384; \
            _Pragma("unroll") for (int g = 0; g < 4; ++g) { const f32x4 x_ = *(const LAS f32x4*)(ip_ + g * 1024); C0[4 * g] = x_[0]; C0[4 * g + 1] = x_[1]; C0[4 * g + 2] = x_[2]; C0[4 * g + 3] = x_[3]; } \
            C0 = QKM(A0, qr[0], C0); \
            _Pragma("unroll") for (int g = 0; g < 4; ++g) { const f32x4 y_ = *(const LAS f32x4*)(ip_ + (g + 4) * 1024); C1[4 * g] = y_[0]; C1[4 * g + 1] = y_[1]; C1[4 * g + 2] = y_[2]; C1[4 * g + 3] = y_[3]; } \
            C1 = QKM(A1, qr[0], C1); } \
        else if (TVALID(tau)) { const f32x16 cz_ = f32x16{}; C0 = QKM(A0, qr[0], cz_); C1 = QKM(A1, qr[0], cz_); }        \
        else { f32x16 cz_; _Pragma("unroll") for (int r = 0; r < 16; ++r) cz_[r] = -INFINITY; C0 = QKM(A0, qr[0], cz_); C1 = QKM(A1, qr[0], cz_); } } while (0)
#define FILLA(i0, i1) do { _Pragma("unroll") for (int w = (8 * (i0)) / NGQ; w < (8 * (i1)) / NGQ; ++w) PWSET(w, P0_, P1_); \
        PIN(pw); } while (0)
#define PHASE_A(C0, C1, P0, P1, tau, vsl, GK, GV, kdst, vdst) do { const LAS unsigned char* vp_ = vp0 + (vsl) * VSLOT; f32x16& P0_ = P0; f32x16& P1_ = P1; \
        VRD(0, vp_); VRD(1, vp_); SBAR(); \
        QK_FIRST(C0, C1, kf[0], kf[1], tau); \
        FILLA(0, 2); SBAR(); \
        _Pragma("unroll") for (int i = 2; i < NGQ; ++i) { \
            VRD(2 * i - 2, vp_); VRD(2 * i - 1, vp_); SBAR(); \
            if ((i & 1) == 0) C0 = QKM(kf[i], qr[i >> 1], C0); else C1 = QKM(kf[i], qr[i >> 1], C1); \
            FILLA(i, i + 1); \
            if (i == NGQ - 2 && (GK)) DMA_K(TABS((tau) + 3), kdst); if (i == NGQ - 1 && (GV)) DMA_V(TABS((tau) + 1), vdst);     \
            SBAR(); } \
        if (NGQ == 2) { VRD(2, vp_); VRD(3, vp_); VRD(4, vp_); VRD(5, vp_); if (GK) DMA_K(TABS((tau) + 3), kdst); if (GV) DMA_V(TABS((tau) + 1), vdst); SBAR(); } \
        } while (0)
#define PHASE_B(C0, C1, GL, ksl, vsl) do { const int kso_ = (ksl) * KSLOT; const LAS unsigned char* vq_ = vp0 + (vsl) * VSLOT; \
        _Pragma("unroll") for (int j = 0; j < 3; ++j) { \
            if (GL) { _Pragma("unroll") for (int g = (NGQ * j + 2) / 3; g < (NGQ * (j + 1) + 2) / 3; ++g) KFL(g, kso_); SBAR(); } \
            if (j == 0) { PVM(0); VRD(6, vq_); VRD(7, vq_); }       \
            else if (j == 1) PVM(1); else PVL(); \
            _Pragma("unroll") for (int e = (32 * j) / 3; e < (32 * (j + 1)) / 3; ++e) { if (e < 16) C0[e & 15] = __builtin_fmaf(C0[e & 15], 4.0f, pcadd); else C1[e & 15] = __builtin_fmaf(C1[e & 15], 4.0f, pcadd); }        \
            PIN(C0); PIN(C1); SBAR(); } } while (0)
#define STEP(C0, C1, P0, P1, tau, GK, GV, GL) do { SBAR(); \
        PHASE_A(C0, C1, P0, P1, tau, sl_prev, GK, GV, sl_cur, sl_next); SBAR(); \
        PHASE_B(C0, C1, GL, sl_next, sl_prev); } while (0)
#define ENDW(tau) do { if (has_next || (tau) + 3 < NT) { WAIT_KV(1, 1, 0); } else if ((tau) + 2 < NT) { WAIT_KV(0, 1, 0); } else { WAIT_BAR(0); } } while (0)
    for (int ui = 0; ui < nu; ++ui) {
        const int u = (int)((ulist >> (8 * ui)) & 255u); const bool has_next = ui + 1 < nu; const int un = has_next ? (int)((ulist >> (8 * (ui + 1))) & 255u) : 0;
        const int t0 = T0OF(u), t1 = 4 * u + 3, cw = 4 * u + (wid >> 1), NT = t1 - t0 + 1, t0n = T0OF(un);
        f32x16 o[2], lacc; o[0] = f32x16{}; o[1] = f32x16{}; lacc = f32x16{};
        int s0, s1, s2;
        if (ui == 0) {
            s0 = 0; s1 = 1; s2 = 2;
            DMA_K(t0 + 0, 0); DMA_V(t0 + 0, 0); DMA_K(t0 + 1, 1); DMA_K(t0 + 2, 2);
            QLOAD(u);
            if (CA) { for (int i = tidl; i < 320; i += 512) tab[i] = relb[h * 257 + (i < 256 ? i : 256)] * LOG2E; }
            if (wid == 0) { const int t2 = tid_from_wave(0); const float* pv = PARTV + (size_t)b * 16 * 1024 + OCOL + h * 64 + t2; float sm = 0.f;
#pragma unroll
                for (int j = 0; j < 16; ++j) sm += pv[j * 1024];
                sm *= (1.0f / SEQ); ((LAS float*)(shm + LDS_VB))[512 + t2] = sm; REF[(size_t)b * 1024 + OCOL + h * 64 + t2] = sm;
                asm volatile("s_waitcnt vmcnt(0)" ::: "memory"); __builtin_amdgcn_fence(__ATOMIC_RELEASE, "agent");
                if (t2 == 0) __hip_atomic_fetch_add(refcnt, 1u, __ATOMIC_RELAXED, __HIP_MEMORY_SCOPE_AGENT); }
            QREADY();
            if (CA) {
                asm volatile("s_waitcnt lgkmcnt(0)\n\ts_barrier" ::: "memory");
                float bm = 0.f; for (int i = lane; i < 257; i += 64) bm = fmaxf(bm, fabsf(tab[i]));
                S0 += 2.0f * wave_max(bm); SHI = fmaxf(ceilf(S0 - 15.5f), 0.0f) + SH_EXTRA; pcadd = 4.0f * (15.0f - SHI) + 0.5f; tabc = tab[256];
                LAS float* img = (LAS float*)(shm + LDS_IMG);
                for (int i = tidl; i < 3 * 2 * 8 * 256; i += 512) { const int e = i & 3, ln = (i >> 2) & 63, g = (i >> 8) & 7, hf = (i >> 11) & 1, ds = i >> 12;
                    img[i] = tab[64 * ds + 32 * hf + (ln & 31) + 128 - 4 * (ln >> 5) - (e + 8 * (g & 3)) - 32 * (g >> 2)] - tabc; }
            }
            WAIT_KV(2, 1, 0);
        } else {
            s0 = sl_cur; s1 = sl_next; s2 = (s1 == NS - 1) ? 0 : s1 + 1;
            QREADY();
        }
        { const int ks0_ = s0 * KSLOT;
#pragma unroll
          for (int g = 0; g < NGQ; ++g) KFL(g, ks0_);
          QK_FIRST(pA0, pA1, kf[0], kf[1], 0);
#pragma unroll
          for (int g = 2; g < NGQ; ++g) { if ((g & 1) == 0) pA0 = QKM(kf[g], qr[g >> 1], pA0); else pA1 = QKM(kf[g], qr[g >> 1], pA1); } }
#pragma unroll
        for (int r = 0; r < 16; ++r) { pA0[r] = __builtin_fmaf(pA0[r], 4.0f, pcadd); pA1[r] = __builtin_fmaf(pA1[r], 4.0f, pcadd); }
        WAIT_BAR(0);
        DMA_K(TABS(3), s0); DMA_V(TABS(1), s1);
        { const int ks1_ = s1 * KSLOT;
#pragma unroll
          for (int g = 0; g < NGQ; ++g) KFL(g, ks1_); }
        WAIT_KV(1, 1, 0);
        sl_prev = s0; sl_cur = s1; sl_next = s2;
        int tau = 1;
        for (; tau + 5 < NT; tau += 2) {
            STEP(pB0, pB1, pA0, pA1, tau, true, true, true);     WAIT_KV(1, 1, 0); ROT();
            STEP(pA0, pA1, pB0, pB1, tau + 1, true, true, true); WAIT_KV(1, 1, 0); ROT();
        }
        for (; tau + 1 < NT; tau += 2) {
            STEP(pB0, pB1, pA0, pA1, tau, (has_next || tau + 3 < NT), (has_next || tau + 1 < NT), (tau + 1 < NT));     ENDW(tau);     ROT();
            STEP(pA0, pA1, pB0, pB1, tau + 1, (has_next || tau + 4 < NT), (has_next || tau + 2 < NT), (tau + 2 < NT)); ENDW(tau + 1); ROT();
        }
        STEP(pB0, pB1, pA0, pA1, NT - 1, has_next, has_next, false);
        int vdr = sl_cur;
        if (has_next) { QLOAD(un);
            WAIT_KV(1, 1, NQL); ROT(); vdr = sl_prev; }
        { { const LAS unsigned char* vd_ = vp0 + vdr * VSLOT;
#pragma unroll
            for (int i = 0; i < 8; ++i) VRD(i, vd_);
#pragma unroll
            for (int w = 0; w < 8; ++w) PWSET(w, pB0, pB1);
            PVM(0); PVM(1); PVL(); } }
        { const int le = tid_from_wave(0), r32e = le & 31, hie = le >> 5;
          float rli[16];
#pragma unroll
          for (int r = 0; r < 16; ++r) rli[r] = __builtin_amdgcn_rcpf(lacc[r]);
          unsigned char* Ow = O + (rowbase + u * 256 + wid * 32) * LDO + OCOL + h * 64;
          LAS unsigned char* stg = shm + LDS_OST + wid * 2048;
          const LAS float* vbm = (const LAS float*)(shm + LDS_VB) + 512; const float vb0 = vbm[r32e], vb1 = vbm[32 + r32e];
#pragma unroll
          for (int r = 0; r < 16; ++r) { const int orow = crow(r, hie);
              const float y0 = (o[0][r] * rli[r] - vb0) * F8_O_SCALE, y1 = (o[1][r] * rli[r] - vb1) * F8_O_SCALE;
              const unsigned w = (unsigned)__builtin_amdgcn_cvt_pk_fp8_f32(__builtin_amdgcn_fmed3f(y0, -448.f, 448.f), __builtin_amdgcn_fmed3f(y1, -448.f, 448.f), undef_i32(), false);
              stg[orow * 64 + r32e] = (unsigned char)(w & 255u); stg[orow * 64 + 32 + r32e] = (unsigned char)((w >> 8) & 255u); }
#pragma unroll
          for (int i = 0; i < 2; ++i) { const int row = i * 16 + (le >> 2), ch = le & 3; const u32x4 v = *(const LAS u32x4*)(stg + row * 64 + ch * 16); st16((char*)Ow + (unsigned)(row * LDO + ch * 16), v); } }
    }
    asm volatile("s_waitcnt lgkmcnt(0)\n\ts_barrier" ::: "memory");
#undef SBAR
#undef PIN
#undef DMA_K
#undef WAIT_KV
#undef QREADY
#undef KFL
#undef QKM
#undef FILLA
#undef DMA_V
#undef WAIT_BAR
#undef TVALID
#undef TABS
#undef T0OF
#undef QLOAD
#undef VRD
#undef PVM
#undef PVL
#undef PEL
#undef PWSET
#undef QK_FIRST
#undef PHASE_A
#undef PHASE_B
#undef ROT
#undef STEP
#undef ENDW
}
}

constexpr int NWAVES = 8;
constexpr int NPHASE = 10;
constexpr int N_LAUNCHES = MK_N_LAUNCHES;
static_assert(N_LAUNCHES == 1 || N_LAUNCHES == NPHASE, "MK_N_LAUNCHES is 1 or 10");

constexpr int RING_BYTES = 131072, XL_OFF = RING_BYTES, LDS_BYTES = 155648, LDSCTL_OFF = LDS_BYTES - 1024, MISC_OFF = LDSCTL_OFF + 320;
static_assert(XL_OFF + 8192 + 12288 <= LDSCTL_OFF && att::ATT_LDS_BYTES <= LDSCTL_OFF, "LDS map");

typedef GAS unsigned gu32;
#define RLX_AGENT __ATOMIC_RELAXED, __HIP_MEMORY_SCOPE_AGENT

#define XB_TMO      128
#define XB_XCNT(j)  (256  + 64 * (j))
#define XB_XSUB(j)  (1280 + 64 * (j))
#define XB_XGEN(j)  (2304 + 64 * (j))
#define XB_TOP      3328
#define XB_TOPGEN   3392
#define XCD_BAR_WORDS 3456
#define XB_SPIN_CAP (1u << 18)
__device__ __forceinline__ unsigned xb_ld(unsigned* p)              { return __hip_atomic_load(p, __ATOMIC_RELAXED, __HIP_MEMORY_SCOPE_AGENT); }
__device__ __forceinline__ unsigned xb_add(unsigned* p, unsigned v) { return __hip_atomic_fetch_add(p, v, __ATOMIC_RELAXED, __HIP_MEMORY_SCOPE_AGENT); }
__device__ __forceinline__ unsigned xb_xcc_id() { return (unsigned)__builtin_amdgcn_s_getreg((3 << 11) | 20) & 0xFu; }
#define XB_SPIN(cond, bar) do { unsigned _sp = 0; while (cond) { __builtin_amdgcn_s_sleep(1); \
    if ((++_sp & 255u) == 0u) { if (xb_ld(&(bar)[XB_TMO])) break; if (_sp > XB_SPIN_CAP) { atomicAdd(&(bar)[XB_TMO], 1u); break; } } } } while (0)
struct XcdBarrier { unsigned* bar; unsigned x; volatile LAS unsigned* st; int wave; };
__device__ __forceinline__ XcdBarrier xcd_barrier_post(unsigned* bar, volatile LAS unsigned* st, int wave) {
    XcdBarrier b; b.bar = bar; b.x = xb_xcc_id(); b.st = st; b.wave = wave;
    if (tid_from_wave(wave) == 0) (void)xb_add(&bar[XB_XCNT(b.x)], 1u);
    return b;
}
__device__ __forceinline__ void xcd_barrier_complete(unsigned* bar, unsigned x, unsigned& nloc, unsigned& nx) {
    const unsigned G = gridDim.x * gridDim.y * gridDim.z;
    unsigned sum, cnt, mine, sp = 0u;
    for (;;) {
        sum = 0u; cnt = 0u; mine = 0u;
#pragma unroll
        for (unsigned j = 0; j < 16; ++j) { const unsigned c = xb_ld(&bar[XB_XCNT(j)]); sum += c; cnt += (c > 0u) ? 1u : 0u; mine = (j == x) ? c : mine; }
        if (sum == G) break;
        __builtin_amdgcn_s_sleep(1);
        if ((++sp & 255u) == 0u) { if (xb_ld(&bar[XB_TMO])) break; if (sp > XB_SPIN_CAP) { atomicAdd(&bar[XB_TMO], 1u); break; } }
    }
    nloc = mine > 0u ? mine : 1u; nx = cnt > 0u ? cnt : 1u;
}
__device__ __forceinline__ void xcd_barrier(const XcdBarrier& b) {
    asm volatile("s_waitcnt vmcnt(0)" ::: "memory");
    __syncthreads();
    if (tid_from_wave(b.wave) == 0) {
        unsigned* bar = b.bar;
        __builtin_amdgcn_s_waitcnt(0);
        unsigned nloc = b.st[0], nx = b.st[1];
        if (nloc == 0u) { xcd_barrier_complete(bar, b.x, nloc, nx); b.st[0] = nloc; b.st[1] = nx; }
        const unsigned old = xb_add(&bar[XB_XSUB(b.x)], 1u);
        const unsigned gen = old / nloc;
        if (old + 1u == (gen + 1u) * nloc) {
            __builtin_amdgcn_fence(__ATOMIC_RELEASE, "agent");
            asm volatile("s_waitcnt vmcnt(0)" ::: "memory");
            const unsigned og = xb_add(&bar[XB_TOP], 1u);
            const unsigned tg = og / nx;
            if (og + 1u == (tg + 1u) * nx) xb_add(&bar[XB_TOPGEN], 1u);
            else XB_SPIN(xb_ld(&bar[XB_TOPGEN]) == tg, bar);
            __builtin_amdgcn_fence(__ATOMIC_ACQUIRE, "agent");
            xb_add(&bar[XB_XGEN(b.x)], 1u);
            asm volatile("s_waitcnt vmcnt(0)" ::: "memory");
        } else {
            XB_SPIN(xb_ld(&bar[XB_XGEN(b.x)]) == gen, bar);
            __builtin_amdgcn_fence(__ATOMIC_ACQUIRE, "agent");
            asm volatile("s_waitcnt vmcnt(0)" ::: "memory");
        }
    }
    __syncthreads();
}

struct Args { const void* in[22]; float* out; unsigned char* ws; int ph_lo, ph_hi, li, pad; };
#define ARGF(k) ((const float*)args.in[k])
struct Frame {
    LAS unsigned char* lds; LAS float* xl;
    int tid, lane, wave, vcu, G;
    unsigned char* ws;
};

template <int WHICH> __device__ __forceinline__ int wmap(int n) {
    if (WHICH == 0) {
        if (n < 256) return n;
        if (n < 512) { const int c = n - 256; return c < 160 ? 256 + c : -1; }
        if (n < 1536) { const int t4 = (n - 512) >> 8, which = t4 >> 1, jj = t4 & 1, c = (n - 512) & 255, bj = c >> 7, wc = (c >> 5) & 3, i = c & 31; return 416 + which * 512 + (4 * jj + wc) * 64 + 32 * bj + i; }
        return 416 + 1024 + (n - 1536);
    } else if (WHICH == 1) {
        const int pn = n >> 8, c = n & 255, bj = c >> 7, wc = (c >> 5) & 3, i = c & 31, head = 2 * pn + bj;
        if (wc < 2) return head * 96 + 32 * wc + i;
        if (wc == 2) { const int fq = i >> 3, nn = (i >> 2) & 1, e = i & 3; return head * 96 + 64 + 4 * fq + e + 16 * nn; }
        return -1;
    } else if (WHICH == 2) {
        const int pn = n >> 8, c = n & 255, bj = c >> 7, wc = (c >> 5) & 3, i = c & 31, head = 2 * pn + bj;
        return wc < 2 ? head * 128 + 32 * wc + i : head * 128 + 64 + 32 * (wc - 2) + i;
    } else if (WHICH == 4) {
        const int j = n >> 8, c = n & 255; return c < 128 ? 128 * j + c : DFF + 128 * j + (c - 128);
    }
    return n;
}
template <int WHICH, bool F8 = false> __device__ __forceinline__ void cvt_item(const float* W, int K, int N, bf16_t* WT, int KP, int NP, LAS float* scr, int item, int lane, float f8s = 1.0f) {
    const int nblk = NP / 32, kb = item / nblk, nb = item % nblk, k0 = 64 * kb, n0 = 32 * nb;
    const int src = wmap<WHICH>(n0 + (lane & 31)); const bool live = (src >= 0) && (k0 < K);
    float wv[32];
#pragma unroll
    for (int i = 0; i < 32; ++i) { const int kk = 2 * i + (lane >> 5); wv[i] = live ? __builtin_nontemporal_load(W + (size_t)(k0 + kk) * N + src) : 0.f; }
#pragma unroll
    for (int i = 0; i < 32; ++i) { const int kk = 2 * i + (lane >> 5); scr[kk * 33 + (lane & 31)] = wv[i]; }
    asm volatile("s_waitcnt lgkmcnt(0)" ::: "memory");
    const int c = lane & 7;
#pragma unroll
    for (int j = 0; j < 4; ++j) { const int n = (lane >> 3) + 8 * j; const LAS float* s = scr + (8 * c) * 33 + n;
        if (F8) { u32x2 o; o.x = pk_fp8x4(s[0 * 33] * f8s, s[1 * 33] * f8s, s[2 * 33] * f8s, s[3 * 33] * f8s); o.y = pk_fp8x4(s[4 * 33] * f8s, s[5 * 33] * f8s, s[6 * 33] * f8s, s[7 * 33] * f8s);
            *(u32x2*)((unsigned char*)WT + (size_t)(n0 + n) * KP + k0 + 8 * c) = o; }
        else { u32x4 o; o.x = cvtpk(s[0 * 33], s[1 * 33]); o.y = cvtpk(s[2 * 33], s[3 * 33]); o.z = cvtpk(s[4 * 33], s[5 * 33]); o.w = cvtpk(s[6 * 33], s[7 * 33]);
            *(u32x4*)(WT + (size_t)(n0 + n) * KP + k0 + 8 * c) = o; } }
    asm volatile("s_waitcnt lgkmcnt(0)" ::: "memory");
}
__device__ __forceinline__ void p0_prologue(Frame& F, const Args& args) {
    LAS float* scr = (LAS float*)(F.lds) + F.wave * 4096;
    const int gw = F.vcu * NWAVES + F.wave, NGW = F.G * NWAVES;
    constexpr int I0 = 16 * 64, I1 = 4 * 32, I2 = 4 * 32, I3 = 16 * 32, I4 = 16 * 176, I5 = 44 * 32;
    constexpr int NITEMS = I0 + I1 + I2 + I3 + I4 + I5;
    for (int it = gw; it < NITEMS; it += NGW) {
        int r = it;
        if (r < I0) { cvt_item<0, true>(ARGF(6), 1024, 1952, (bf16_t*)(F.ws + WS_WIN), 1024, 2048, scr, r, F.lane, F8_WIN_SCALE); continue; } r -= I0;
        if (r < I1) { cvt_item<1>(ARGF(9), 256, 768, (bf16_t*)(F.ws + WS_WQUP), 256, 1024, scr, r, F.lane); continue; } r -= I1;
        if (r < I2) { cvt_item<2>(ARGF(10), 128, 1024, (bf16_t*)(F.ws + WS_WKVUP), 256, 1024, scr, r, F.lane); continue; } r -= I2;
        if (r < I3) { cvt_item<3, true>(ARGF(16), 1024, 1024, (bf16_t*)(F.ws + WS_WOUT), 1024, 1024, scr, r, F.lane, F8_WOUT_SCALE); continue; } r -= I3;
        if (r < I4) { cvt_item<4>(ARGF(18), 1024, DFF2, (bf16_t*)(F.ws + WS_WUP), 1024, DFF2, scr, r, F.lane); continue; } r -= I4;
        cvt_item<5>(ARGF(21), DFF, 1024, (bf16_t*)(F.ws + WS_WDOWN), DFF, 1024, scr, r, F.lane);
    }
    { u32x4* P = (u32x4*)(F.ws + WS_PART); const int NT = F.G * NWAVES * 64;
      for (int i = F.vcu * (NWAVES * 64) + F.tid; i < (int)(PART_BYTES / 16); i += NT) P[i] = (u32x4){0u, 0u, 0u, 0u}; }
    {
        float* cosT = (float*)(F.ws + WS_COS); float* sinT = (float*)(F.ws + WS_SIN);
        const int gt = F.vcu * (NWAVES * 64) + F.tid, NT = F.G * NWAVES * 64;
        for (int idx0 = gt; idx0 < MTOK * 16; idx0 += 4 * NT) {
            int pos[4];
#pragma unroll
            for (int j = 0; j < 4; ++j) { const int idx = idx0 + j * NT; pos[j] = idx < MTOK * 16 ? ((const int*)args.in[2])[idx >> 4] : 0; }
#pragma unroll
            for (int j = 0; j < 4; ++j) { const int idx = idx0 + j * NT; if (idx < MTOK * 16) { const int i = idx & 15;
                const float inv = __builtin_amdgcn_exp2f(-(float)i * (13.287712379549449f / 16.0f));
                const float ang = (float)pos[j] * inv;
                const float n = rintf(ang * 0.15915494309189535f);
                float r = fmaf(-n, 6.2831854820251465f, ang); r = fmaf(-n, -1.7484555e-7f, r);
                cosT[idx] = __cosf(r); sinT[idx] = __sinf(r); } }
        }
    }
}
constexpr int CW_MODCNT = 64, MOD_ITEMS = 192;
__device__ __forceinline__ void p0_mod(Frame& F, const Args& args) {
    LAS float* scr = (LAS float*)(F.lds) + F.wave * 4096;
    for (int item = F.vcu; item < MOD_ITEMS; item += F.G) {
        int kbase = F.wave * 128; asm volatile("" : "+s"(kbase));
        const int n0 = item * 32, col = F.lane & 31, kh = F.lane >> 5;
        { float tv[32];
          unsigned l4 = (unsigned)F.lane * 4u; asm volatile("" : "+v"(l4));
#pragma unroll
          for (int i = 0; i < 32; ++i) tv[i] = *(const float*)((const char*)(ARGF(1) + (i >> 1) * 1024 + kbase + 64 * (i & 1)) + l4);
#pragma unroll
          for (int i = 0; i < 32; ++i) { const int idx = F.lane + 64 * i, b = idx >> 7, k = idx & 127; const float xv = tv[i]; scr[k * 16 + b] = xv / (1.0f + __expf(-xv)); } }
        asm volatile("s_waitcnt lgkmcnt(0)" ::: "memory");
        f32x4 a0 = {0.f, 0.f, 0.f, 0.f}, a1 = a0, a2 = a0, a3 = a0;
        const unsigned wvo = (unsigned)(kh * NMOD + col) * 4u;
#pragma unroll
        for (int i0 = 0; i0 < 64; i0 += 32) { float wv[32];
#pragma unroll
            for (int i = 0; i < 32; ++i) wv[i] = *(const float*)((const char*)(ARGF(3) + (size_t)(kbase + 2 * (i0 + i)) * NMOD + n0) + wvo);
#pragma unroll
            for (int i = 0; i < 32; ++i) { const int k = 2 * (i0 + i) + kh; const float w = wv[i];
                const LAS f32x4* sp = (const LAS f32x4*)(scr + k * 16);
                a0 += sp[0] * w; a1 += sp[1] * w; a2 += sp[2] * w; a3 += sp[3] * w; } }
#pragma unroll
        for (int e = 0; e < 4; ++e) { a0[e] += __shfl_xor(a0[e], 32); a1[e] += __shfl_xor(a1[e], 32); a2[e] += __shfl_xor(a2[e], 32); a3[e] += __shfl_xor(a3[e], 32); }
        if (kh == 0) {
#pragma unroll
            for (int e = 0; e < 4; ++e) { scr[2048 + (0 + e) * 32 + col] = a0[e]; scr[2048 + (4 + e) * 32 + col] = a1[e]; scr[2048 + (8 + e) * 32 + col] = a2[e]; scr[2048 + (12 + e) * 32 + col] = a3[e]; } }
        __syncthreads();
        float* MOD = (float*)(F.ws + WS_MOD);
        { const int b = 2 * F.wave + kh; float s = ARGF(4)[n0 + col];
#pragma unroll
            for (int w2 = 0; w2 < 8; ++w2) s += ((LAS float*)F.lds)[w2 * 4096 + 2048 + b * 32 + col];
            MOD[(size_t)b * NMOD + n0 + col] = s; }
        asm volatile("s_waitcnt vmcnt(0)" ::: "memory");
        __syncthreads();
        if (F.tid == 0) { __builtin_amdgcn_fence(__ATOMIC_RELEASE, "agent"); asm volatile("s_waitcnt vmcnt(0)" ::: "memory");
            __hip_atomic_fetch_add((unsigned*)(F.ws + WS_CTL) + CW_MODCNT, 1u, __ATOMIC_RELAXED, __HIP_MEMORY_SCOPE_AGENT); }
    }
}
__device__ __forceinline__ void mod_wait(Frame& F) {
    if (F.tid == 0) { unsigned sp = 0;
        while (__hip_atomic_load((unsigned*)(F.ws + WS_CTL) + CW_MODCNT, __ATOMIC_RELAXED, __HIP_MEMORY_SCOPE_AGENT) < (unsigned)MOD_ITEMS && ++sp < (1u << 22)) __builtin_amdgcn_s_sleep(2);
        __builtin_amdgcn_fence(__ATOMIC_ACQUIRE, "agent"); asm volatile("s_waitcnt vmcnt(0)" ::: "memory"); }
    __syncthreads();
}
template <bool IDMAP> __device__ __forceinline__ void gemv16_item(Frame& F, const float* W, int ldw, const float* IN, int ldin, float* OUT, int ldout, int item) {
    LAS float* scr = (LAS float*)(F.lds) + F.wave * 4096;
    {
        int kbase = F.wave * 128; asm volatile("" : "+s"(kbase));
        const int col = F.lane & 7, kh = F.lane >> 3; const int src = IDMAP ? item * 8 + col : wmap<0>(item * 8 + col);
        { float tv[32];
          unsigned l4 = (unsigned)F.lane * 4u; asm volatile("" : "+v"(l4));
#pragma unroll
          for (int i = 0; i < 32; ++i) tv[i] = *(const float*)((const char*)(IN + (size_t)(i >> 1) * ldin + kbase + 64 * (i & 1)) + l4);
#pragma unroll
          for (int i = 0; i < 32; ++i) { const int idx = F.lane + 64 * i, b = idx >> 7, k = idx & 127; scr[k * 16 + b] = tv[i]; } }
        asm volatile("s_waitcnt lgkmcnt(0)" ::: "memory");
        f32x4 a0 = {0.f, 0.f, 0.f, 0.f}, a1 = a0, a2 = a0, a3 = a0;
        float wv[16]; const unsigned wvo = (unsigned)(kh * ldw + (src >= 0 ? src : 0)) * 4u; const float msk = src >= 0 ? 1.0f : 0.0f;
#pragma unroll
        for (int i = 0; i < 16; ++i) wv[i] = *(const float*)((const char*)(W + (size_t)(kbase + 8 * i) * ldw) + wvo);
#pragma unroll
        for (int i = 0; i < 16; ++i) { const int k = 8 * i + kh; const float w = wv[i] * msk;
            if ((i & 3) == 0) __builtin_amdgcn_sched_barrier(0);
            const LAS f32x4* sp = (const LAS f32x4*)(scr + k * 16);
            a0 += sp[0] * w; a1 += sp[1] * w; a2 += sp[2] * w; a3 += sp[3] * w;
        }
#pragma unroll
        for (int o = 8; o < 64; o <<= 1)
#pragma unroll
            for (int e = 0; e < 4; ++e) { a0[e] += __shfl_xor(a0[e], o); a1[e] += __shfl_xor(a1[e], o); a2[e] += __shfl_xor(a2[e], o); a3[e] += __shfl_xor(a3[e], o); }
        if (kh == 0) {
#pragma unroll
            for (int e = 0; e < 4; ++e) { scr[2048 + (0 + e) * 8 + col] = a0[e]; scr[2048 + (4 + e) * 8 + col] = a1[e]; scr[2048 + (8 + e) * 8 + col] = a2[e]; scr[2048 + (12 + e) * 8 + col] = a3[e]; } }
        __syncthreads();
        if (F.tid < 128) { float sm = 0.f;
#pragma unroll
            for (int w2 = 0; w2 < 8; ++w2) sm += ((LAS float*)F.lds)[w2 * 4096 + 2048 + F.tid];
            OUT[(size_t)(F.tid >> 3) * ldout + item * 8 + (F.tid & 7)] = sm; }
        __syncthreads();
    }
}
template <bool IDMAP> __device__ __forceinline__ void gemv16(Frame& F, const float* W, int ldw, const float* IN, int ldin, float* OUT, int ldout, int nitems) {
    for (int item = F.vcu; item < nitems; item += F.G) gemv16_item<IDMAP>(F, W, ldw, IN, ldin, OUT, ldout, item);
}
constexpr int CW_B2CNT = 96, CW_REFCNT = 112;
__device__ __forceinline__ void p4_bias(Frame& F, const Args& args, int item) {
    if (F.tid == 0) { unsigned sp = 0; unsigned* cnt = (unsigned*)(F.ws + WS_CTL) + CW_REFCNT;
        while (__hip_atomic_load(cnt, __ATOMIC_RELAXED, __HIP_MEMORY_SCOPE_AGENT) < 2u * (unsigned)F.G && ++sp < (1u << 22)) __builtin_amdgcn_s_sleep(2);
        __builtin_amdgcn_fence(__ATOMIC_ACQUIRE, "agent"); asm volatile("s_waitcnt vmcnt(0)" ::: "memory"); }
    __syncthreads();
    gemv16_item<true>(F, ARGF(16), 1024, (const float*)(F.ws + WS_REF), 1024, (float*)(F.ws + WS_BIAS2), 1024, item);
}
__device__ __forceinline__ void p5_bias(Frame& F, const Args& args) {
    gemv16<true>(F, ARGF(16), 1024, (const float*)(F.ws + WS_REF), 1024, (float*)(F.ws + WS_BIAS2), 1024, 128);
    unsigned* cnt = (unsigned*)(F.ws + WS_CTL) + CW_B2CNT;
    int mine = 0; for (int item = F.vcu; item < 128; item += F.G) ++mine;
    asm volatile("s_waitcnt vmcnt(0)" ::: "memory");
    __syncthreads();
    if (F.tid == 0) {
        if (mine) { __builtin_amdgcn_fence(__ATOMIC_RELEASE, "agent"); asm volatile("s_waitcnt vmcnt(0)" ::: "memory"); __hip_atomic_fetch_add(cnt, (unsigned)mine, __ATOMIC_RELAXED, __HIP_MEMORY_SCOPE_AGENT); }
        unsigned sp = 0;
        while (__hip_atomic_load(cnt, __ATOMIC_RELAXED, __HIP_MEMORY_SCOPE_AGENT) < 128u && ++sp < (1u << 22)) __builtin_amdgcn_s_sleep(2);
        __builtin_amdgcn_fence(__ATOMIC_ACQUIRE, "agent"); asm volatile("s_waitcnt vmcnt(0)" ::: "memory"); }
    __syncthreads();
}
__device__ __forceinline__ float wave_sum(float v) {
#pragma unroll
    for (int o = 1; o < 64; o <<= 1) v += __shfl_xor(v, o);
    return v;
}
template <bool XBF16 = false, bool OUTF8 = false> __device__ __forceinline__ void norm_rows(Frame& F, const float* X, const float* g, int shift_off, int scale_off, bf16_t* out) {
    const float* MOD = (const float*)(F.ws + WS_MOD);
    const int gw = F.vcu * NWAVES + F.wave, NGW = F.G * NWAVES;
    for (int base = gw * 16; base < MTOK; base += NGW * 16) {
        const int b = base >> 11;
        f32x4 gm[4], sh[4];
        { const f32x4* gp = (const f32x4*)g + 4 * F.lane; const f32x4* shp = (const f32x4*)(MOD + (size_t)b * NMOD + shift_off) + 4 * F.lane; const f32x4* scp = (const f32x4*)(MOD + (size_t)b * NMOD + scale_off) + 4 * F.lane;
#pragma unroll
          for (int j = 0; j < 4; ++j) { gm[j] = gp[j] * (scp[j] + 1.0f) * (OUTF8 ? F8_ACT_SCALE : 1.0f); if (!OUTF8) sh[j] = shp[j]; } }
        for (int i0 = 0; i0 < 16; i0 += 4) {
            f32x4 v[4][4]; float sq[4];
#pragma unroll
            for (int rr = 0; rr < 4; ++rr) { const size_t m = (size_t)(base + i0 + rr);
                if (XBF16) { const u32x2* xr = (const u32x2*)((const bf16_t*)X + m * DM) + 4 * F.lane;
#pragma unroll
                    for (int j = 0; j < 4; ++j) { const u32x2 w = xr[j]; v[rr][j] = (f32x4){__uint_as_float(w.x << 16), __uint_as_float(w.x & 0xffff0000u), __uint_as_float(w.y << 16), __uint_as_float(w.y & 0xffff0000u)}; } }
                else { const f32x4* xr = (const f32x4*)(X + m * DM) + 4 * F.lane;
#pragma unroll
                    for (int j = 0; j < 4; ++j) v[rr][j] = xr[j]; } }
#pragma unroll
            for (int rr = 0; rr < 4; ++rr) { float s = 0.f;
#pragma unroll
                for (int j = 0; j < 4; ++j) s += dot4(v[rr][j]);
                sq[rr] = s; }
#pragma unroll
            for (int o = 1; o < 64; o <<= 1)
#pragma unroll
                for (int rr = 0; rr < 4; ++rr) sq[rr] += __shfl_xor(sq[rr], o);
#pragma unroll
            for (int rr = 0; rr < 4; ++rr) { const size_t m = (size_t)(base + i0 + rr);
                const float r = __builtin_amdgcn_rsqf(sq[rr] * (1.0f / DM) + EPS);
                if (OUTF8) { u32x4 w;
#pragma unroll
                    for (int j = 0; j < 4; ++j) { const f32x4 y = v[rr][j] * r * gm[j]; w[j] = pk_fp8x4(y[0], y[1], y[2], y[3]); }
                    *((u32x4*)((unsigned char*)out + m * DM) + F.lane) = w; }
                else { u32x2* o8 = (u32x2*)(out + m * DM) + 4 * F.lane;
#pragma unroll
                    for (int j = 0; j < 4; ++j) { const f32x4 y = v[rr][j] * r * gm[j] + sh[j]; o8[j] = pack4(y); } } }
        }
    }
}
__device__ __forceinline__ void conv_fixup(Frame& F, const Args& args) {
    const unsigned char* RAW4 = F.ws + WS_RAW4; bf16_t* ACT = (bf16_t*)(F.ws + WS_ACT);
    constexpr int NCP = DFF / 2;
    const int gt = F.vcu * (NWAVES * 64) + F.tid, NT = F.G * NWAVES * 64, NGRP = NT / NCP;
    const int grp = gt / NCP, cp = gt - grp * NCP, c = 2 * cp, j = c >> 7, cc = c & 127;
    if (grp >= NGRP) return;
    f32x2 w0[2], w1[2], w2[2], bb[2];
#pragma unroll
    for (int half = 0; half < 2; ++half) { const int ocol = half * DFF + c;
        w0[half] = *(const f32x2*)(ARGF(19) + ocol); w1[half] = *(const f32x2*)(ARGF(19) + DFF2 + ocol); w2[half] = *(const f32x2*)(ARGF(19) + 2 * DFF2 + ocol); bb[half] = *(const f32x2*)(ARGF(20) + ocol); }
#define RAW2(row, tcol) (*(const unsigned*)(RAW4 + ((size_t)(row) * DFF2 + (tcol)) * 2))
#define LO(w) __uint_as_float((w) << 16)
#define HI(w) __uint_as_float((w) & 0xffff0000u)
#pragma unroll 3
    for (int blk = grp; blk < 512; blk += NGRP) {
        const bool first = (blk & 31) == 0;
        f32x2 o[2][2];
#pragma unroll
        for (int half = 0; half < 2; ++half) {
            const int tcol = 256 * j + 128 * half + cc;
            const unsigned q2 = first ? 0u : RAW2((blk - 1) * 4 + 2, tcol), q1 = first ? 0u : RAW2((blk - 1) * 4 + 3, tcol), r0 = RAW2(blk * 4 + 0, tcol), r1 = RAW2(blk * 4 + 1, tcol);
            const f32x2 pm2 = {LO(q2), HI(q2)}, pm1 = {LO(q1), HI(q1)}, x0 = {LO(r0), HI(r0)}, x1 = {LO(r1), HI(r1)};
            o[half][0] = w2[half] * x0 + (w1[half] * pm1 + (w0[half] * pm2 + bb[half])); o[half][1] = w2[half] * x1 + (w1[half] * x0 + (w0[half] * pm1 + bb[half]));
        }
#pragma unroll
        for (int rr = 0; rr < 2; ++rr) { const f32x2 G = o[0][rr]; f32x2 a;
#pragma unroll
            for (int e = 0; e < 2; ++e) a[e] = G[e] / (1.0f + __expf(-G[e])) * o[1][rr][e];
            *(unsigned*)(ACT + ((size_t)blk * 64 + rr) * DFF + c) = cvtpk(a[0], a[1]); }
    }
#undef RAW2
#undef LO
#undef HI
}

__device__ __forceinline__ void stagger_delay(unsigned us10) { const unsigned long long t0 = __builtin_amdgcn_s_memrealtime(); while (__builtin_amdgcn_s_memrealtime() - t0 < (unsigned long long)us10 * 10ull) __builtin_amdgcn_s_sleep(8); }
#ifndef STAG5
#define STAG5 0
#endif
#ifndef STAG9
#define STAG9 0
#endif
__global__ void __launch_bounds__(NWAVES * 64, 2) fwd_kernel(Args args) {
    extern __shared__ __attribute__((aligned(16))) unsigned char lds_raw[];
    Frame F;
    F.lds = (LAS unsigned char*)lds_raw; F.xl = (LAS float*)(F.lds + XL_OFF);
    F.tid = threadIdx.x; F.lane = F.tid & 63; F.wave = __builtin_amdgcn_readfirstlane(F.tid >> 6);
    F.G = gridDim.x; { const int bx = blockIdx.x; F.vcu = (F.G % 8 == 0) ? (bx % 8) * (F.G / 8) + bx / 8 : bx; }
    F.ws = args.ws;
    unsigned char* ws = args.ws;
    for (int u = F.tid; u < (LDS_BYTES - LDSCTL_OFF) / 4; u += NWAVES * 64) ((LAS unsigned*)(F.lds + LDSCTL_OFF))[u] = 0u;
    __syncthreads();
    XcdBarrier bar; bar.bar = (unsigned*)(ws + WS_CTL) + CW_BAR; bar.x = 0; bar.st = nullptr; bar.wave = F.wave;
    if (N_LAUNCHES == 1) bar = xcd_barrier_post((unsigned*)(ws + WS_CTL) + CW_BAR, (volatile LAS unsigned*)(F.lds + MISC_OFF) + 8, F.wave);
#define GRID_BAR() do { if (N_LAUNCHES == 1) xcd_barrier(bar); } while (0)
    const int lo = args.ph_lo, hi = args.ph_hi;
#ifndef PH_MASK
#define PH_MASK 0x3ff
#endif
#define IN(k) (((PH_MASK >> (k)) & 1) && lo <= (k) && (k) < hi)
#define BOTH(k) (IN(k) && IN((k) + 1))
    float* MOD = (float*)(ws + WS_MOD);
    bf16_t* XN = (bf16_t*)(ws + WS_XN);

#define REFRESH_TID() do { int t_ = tid_from_wave(F.wave); asm volatile("" : "+v"(t_)); t_ &= 511; F.tid = t_; F.lane = t_ & 63; } while (0)
    if (IN(0)) { REFRESH_TID(); p0_mod(F, args); p0_prologue(F, args); mod_wait(F); gemv16<false>(F, ARGF(6), 1952, (const float*)(F.ws + WS_MOD), NMOD, (float*)(F.ws + WS_BIAS), 2048, 256); norm_rows<false, true>(F, ARGF(0), ARGF(5), 0, DM, XN); if (BOTH(1)) GRID_BAR(); }
    if (IN(2)) {
        pg8::Gemm g{XN, (const bf16_t*)(ws + WS_WIN), MTOK, 2048, 512  , nullptr, 1 << 30}; pg8::StaticOrder S; S.init(MTOK, 2048, F.G, (int)blockIdx.x);
        { const int t_ = tid_from_wave(F.wave); LAS float* cst = F.xl + XL_CONST;
          if (t_ < 256) cst[t_] = ARGF(7)[t_]; else if (t_ < 384) cst[t_] = ARGF(8)[t_ - 256]; else if (t_ < 448) cst[t_] = ARGF(13)[t_ - 384]; else cst[t_] = ARGF(14)[t_ - 448]; }
        EpiIn E{ws};
        pg8::gemm_phase(F.lds, F.xl, g, S, E, F.wave);
        if (BOTH(2)) GRID_BAR();
    }
    if (IN(3)) {
        pg8::Gemm g{(const bf16_t*)(ws + WS_QLN), (const bf16_t*)(ws + WS_WQUP), MTOK, 2048, 256, (const bf16_t*)(ws + WS_KVLN), 4}; pg8::StaticOrder S; S.init(MTOK, 2048, F.G, (int)blockIdx.x);
        EpiQKV E{EpiQ{ws, ARGF(11)}, EpiKV{ws, ARGF(12)}};
        pg8::gemm_phase(F.lds, F.xl, g, S, E, F.wave);
        if (BOTH(3)) GRID_BAR();
    }
    if (IN(4)) {
        unsigned char* OM = ws + WS_OM; float* REF = (float*)(ws + WS_REF); const float* PARTV = (const float*)(ws + WS_PARTV); unsigned* refcnt = (unsigned*)(ws + WS_CTL) + CW_REFCNT;
        int atid = tid_from_wave(F.wave); asm volatile("" : "+v"(atid)); atid &= 511;
        float S0_mla, S0_ca;
        { const int ln = atid & 63; float a = 0.f, c = 0.f, d = 0.f, e = 0.f;
          for (int i = ln; i < 96; i += 64) { a = fmaxf(a, fabsf(ARGF(11)[i])); c = fmaxf(c, fabsf(ARGF(12)[i])); }
          if (ln < 64) { d = fabsf(ARGF(13)[ln]); e = fabsf(ARGF(14)[ln]); }
          S0_mla = att::wave_max(a) * att::wave_max(c) * 9.797958971132712f * LOG2E * 1.13f; S0_ca = att::wave_max(d) * att::wave_max(e) * 8.0f * LOG2E * 1.13f; }
        if (F.G == 256) {
            const int bh = F.vcu >> 1, par = F.vcu & 1;
            const unsigned ul_mla = (unsigned)(2 * par) | ((unsigned)(7 - 2 * par) << 8) | ((unsigned)(2 * par + 1) << 16) | ((unsigned)(6 - 2 * par) << 24);
            const unsigned ul_ca = (unsigned)par | ((unsigned)(2 + par) << 8) | ((unsigned)(4 + par) << 16) | ((unsigned)(6 + par) << 24);
            att::attn_run<96, false>(atid, bh >> 3, bh & 7, ul_mla, 4, (const unsigned char*)(ws + WS_QM), (const unsigned char*)(ws + WS_KM), (const unsigned char*)(ws + WS_VM), OM, REF, refcnt, PARTV, nullptr, S0_mla, F.lds);
            att::attn_run<64, true>(atid, bh >> 3, bh & 7, ul_ca, 4, (const unsigned char*)(ws + WS_CQ), (const unsigned char*)(ws + WS_CK), (const unsigned char*)(ws + WS_CV), OM, REF, refcnt, PARTV, ARGF(15), S0_ca, F.lds);
            if (par == 0) { REFRESH_TID(); p4_bias(F, args, bh); }
        } else {
            for (int j = F.vcu; j < 2048; j += F.G) { const int kind = j >> 10, bh = (j & 1023) >> 3; const unsigned qb = (unsigned)(j & 7);
                if (kind == 0) att::attn_run<96, false>(atid, bh >> 3, bh & 7, qb, 1, (const unsigned char*)(ws + WS_QM), (const unsigned char*)(ws + WS_KM), (const unsigned char*)(ws + WS_VM), OM, REF, refcnt, PARTV, nullptr, S0_mla, F.lds);
                else att::attn_run<64, true>(atid, bh >> 3, bh & 7, qb, 1, (const unsigned char*)(ws + WS_CQ), (const unsigned char*)(ws + WS_CK), (const unsigned char*)(ws + WS_CV), OM, REF, refcnt, PARTV, ARGF(15), S0_ca, F.lds); }
        }
        if (BOTH(4)) GRID_BAR();
    }
    if (IN(5)) {
        pg8::Gemm g{(const bf16_t*)(ws + WS_OM), (const bf16_t*)(ws + WS_WOUT), MTOK, 1024, 512  , nullptr, 1 << 30}; pg8::StaticOrder S; S.init(MTOK, 1024, F.G, (int)blockIdx.x);
        if (F.G != 256) { REFRESH_TID(); p5_bias(F, args); }
        if (F.G == 256) { EpiResNorm E{ARGF(0), ws, MOD + 2 * DM, ARGF(17)}; pg8::gemm_phase(F.lds, F.xl, g, S, E, F.wave); }
        else { EpiRes<false, true, true> E{ARGF(0), (void*)(ws + WS_X1), MOD + 2 * DM, (const float*)(ws + WS_BIAS2)}; pg8::gemm_phase(F.lds, F.xl, g, S, E, F.wave); }
        if (BOTH(5)) GRID_BAR();
    }
    if (IN(6)) { if (F.G != 256) { REFRESH_TID(); norm_rows<true>(F, (const float*)(ws + WS_X1), ARGF(17), 3 * DM, 4 * DM, (bf16_t*)(ws + WS_H2)); if (BOTH(6)) GRID_BAR(); } }
    if (IN(7)) {
        pg8::Gemm g{(const bf16_t*)(ws + WS_H2), (const bf16_t*)(ws + WS_WUP), MTOK, DFF2, 1024, nullptr, 1 << 30}; pg8::StaticOrder S; S.init(MTOK, DFF2, F.G, (int)blockIdx.x);
        EpiUp E{ws, ARGF(19), ARGF(20)};
        pg8::gemm_phase(F.lds, F.xl, g, S, E, F.wave);
        if (BOTH(7)) GRID_BAR();
    }
    if (IN(8)) { REFRESH_TID(); conv_fixup(F, args); if (BOTH(8)) GRID_BAR(); }
    if (IN(9)) {
        pg8::Gemm g{(const bf16_t*)(ws + WS_ACT), (const bf16_t*)(ws + WS_WDOWN), MTOK, 1024, DFF, nullptr, 1 << 30}; pg8::StaticOrder S; S.init(MTOK, 1024, F.G, (int)blockIdx.x);
        if (STAG9 && (F.vcu & 1)) stagger_delay(STAG9);
        EpiRes<true, false> E{(const void*)(ws + WS_X1), (void*)args.out, MOD + 5 * DM};
        pg8::gemm_phase(F.lds, F.xl, g, S, E, F.wave);
    }
#undef IN
#undef BOTH
}

extern "C" void kernel_launch(void* const* d_in, const int* in_sizes, int n_in, void* d_out, int out_size, void* d_ws, size_t ws_size, hipStream_t stream) {
    static int grid = 0;
    if (grid == 0) {
        if (n_in != 22 || in_sizes[0] != MTOK * DM || out_size != MTOK * DM || ws_size < WS_END) {
            fprintf(stderr, "kernel_launch: unexpected shapes (n_in %d, in0 %d, out %d, ws %zu); nothing launched\n", n_in, n_in > 0 ? in_sizes[0] : -1, out_size, ws_size); grid = -1; return; }
        int dev = 0, cus = 0, per_cu = 0;
        if (hipGetDevice(&dev) != hipSuccess || hipDeviceGetAttribute(&cus, hipDeviceAttributeMultiprocessorCount, dev) != hipSuccess) { grid = -1; return; }
        if (hipFuncSetAttribute((const void*)fwd_kernel, hipFuncAttributeMaxDynamicSharedMemorySize, LDS_BYTES) != hipSuccess) { fprintf(stderr, "kernel_launch: hipFuncSetAttribute failed\n"); grid = -1; return; }
        if (hipOccupancyMaxActiveBlocksPerMultiprocessor(&per_cu, (const void*)fwd_kernel, NWAVES * 64, LDS_BYTES) != hipSuccess || per_cu < 1)
            fprintf(stderr, "kernel_launch: note: occupancy query reports %d workgroups per CU\n", per_cu);
        (void)hipGetLastError();
        grid = cus;
    }
    if (grid < 0) return;
    Args a{};
    for (int i = 0; i < 22; ++i) a.in[i] = d_in[i];
    a.out = (float*)d_out; a.ws = (unsigned char*)d_ws;
#ifndef PROBE_DUP
#define PROBE_DUP -1
#endif
    const int nl = (PROBE_DUP >= 0) ? 2 : N_LAUNCHES;
    for (int li = 0; li < nl; ++li) {
        if (hipMemsetAsync((char*)d_ws + WS_CTL, 0, CTL_ZERO_BYTES, stream) != hipSuccess) { fprintf(stderr, "kernel_launch: memset failed\n"); return; }
        a.ph_lo = (N_LAUNCHES == 1) ? 0 : li; a.ph_hi = (N_LAUNCHES == 1) ? NPHASE : li + 1; a.li = li;
        if (PROBE_DUP >= 0) { a.ph_lo = li == 0 ? 0 : PROBE_DUP; a.ph_hi = li == 0 ? PROBE_DUP + 1 : NPHASE; }
        hipLaunchKernelGGL(fwd_kernel, dim3(grid), dim3(NWAVES * 64), LDS_BYTES, stream, a);
        const hipError_t le = hipPeekAtLastError();
        if (le != hipSuccess) { fprintf(stderr, "kernel_launch: launch %d failed: %s\n", li, hipGetErrorName(le)); break; }
    }
}
```

```cpp
#include <hip/hip_runtime.h>
#include <cstdio>
#include <cstdint>

#define LAS __attribute__((address_space(3)))
#define GAS __attribute__((address_space(1)))
typedef unsigned short bf16_t;
typedef short bf16x8 __attribute__((ext_vector_type(8)));
typedef short s16x4 __attribute__((ext_vector_type(4)));
typedef short s16x2 __attribute__((ext_vector_type(2)));
typedef float f32x2 __attribute__((ext_vector_type(2)));
typedef float f32x4 __attribute__((ext_vector_type(4)));
typedef float f32x16 __attribute__((ext_vector_type(16)));
typedef unsigned u32x2 __attribute__((ext_vector_type(2)));
typedef unsigned u32x4 __attribute__((ext_vector_type(4)));
typedef int i32x2 __attribute__((ext_vector_type(2)));
typedef int i32x4 __attribute__((ext_vector_type(4)));
typedef int i32x8 __attribute__((ext_vector_type(8)));
typedef __bf16 bf16x2_t __attribute__((ext_vector_type(2)));

#ifndef MK_N_LAUNCHES
#define MK_N_LAUNCHES 1
#endif

constexpr int BATCH = 16, SEQ = 2048, DM = 1024, MTOK = BATCH * SEQ;
constexpr int NMOD = 6 * DM;
constexpr int DFF = 2816, DFF2 = 5632;
constexpr float EPS = 1e-6f;
constexpr float LOG2E = 1.4426950408889634f;
constexpr float C2_MLA = 0.10206207261596577f * LOG2E;
constexpr float C2_CA = 0.125f * LOG2E;

__device__ __forceinline__ unsigned cvtpk(float lo, float hi) { f32x2 v = {lo, hi}; bf16x2_t b = __builtin_convertvector(v, bf16x2_t); return __builtin_bit_cast(unsigned, b); }
__device__ __forceinline__ u32x4 pack8(f32x4 a, f32x4 b) { u32x4 w; w.x = cvtpk(a[0], a[1]); w.y = cvtpk(a[2], a[3]); w.z = cvtpk(b[0], b[1]); w.w = cvtpk(b[2], b[3]); return w; }
__device__ __forceinline__ u32x2 pack4(f32x4 a) { u32x2 w; w.x = cvtpk(a[0], a[1]); w.y = cvtpk(a[2], a[3]); return w; }
__device__ __forceinline__ float xsum16(float v) { auto r = __builtin_amdgcn_permlane16_swap(__float_as_uint(v), __float_as_uint(v), false, false); return __uint_as_float(r[0]) + __uint_as_float(r[1]); }
__device__ __forceinline__ float xsum32(float v) { auto r = __builtin_amdgcn_permlane32_swap(__float_as_uint(v), __float_as_uint(v), false, false); return __uint_as_float(r[0]) + __uint_as_float(r[1]); }
__device__ __forceinline__ float row16_sum(float v) {
    v += __builtin_bit_cast(float, __builtin_amdgcn_update_dpp(0, __builtin_bit_cast(int, v), 0xB1, 0xF, 0xF, true));
    v += __builtin_bit_cast(float, __builtin_amdgcn_update_dpp(0, __builtin_bit_cast(int, v), 0x4E, 0xF, 0xF, true));
    v += __builtin_bit_cast(float, __builtin_amdgcn_update_dpp(0, __builtin_bit_cast(int, v), 0x141, 0xF, 0xF, true));
    v += __builtin_bit_cast(float, __builtin_amdgcn_update_dpp(0, __builtin_bit_cast(int, v), 0x140, 0xF, 0xF, true));
    return v; }
__device__ __forceinline__ void colsum8(const f32x4 (&acc)[2][2][4][2], int bj, int fr, float* dst) {
    f32x4 s0 = acc[0][bj][0][0] + acc[1][bj][0][0], s1 = acc[0][bj][0][1] + acc[1][bj][0][1];
#pragma unroll
    for (int m = 1; m < 4; ++m) { s0 += acc[0][bj][m][0] + acc[1][bj][m][0]; s1 += acc[0][bj][m][1] + acc[1][bj][m][1]; }
#pragma unroll
    for (int e = 0; e < 4; ++e) { s0[e] = row16_sum(s0[e]); s1[e] = row16_sum(s1[e]); }
    if (fr == 0) { *(f32x4*)dst = s0; *(f32x4*)(dst + 4) = s1; }
}
__device__ __forceinline__ float dot4(f32x4 a) { return (a[0] * a[0] + a[1] * a[1]) + (a[2] * a[2] + a[3] * a[3]); }
__device__ __forceinline__ int undef_i32() { int w; asm volatile("" : "=v"(w)); return w; }
__device__ __forceinline__ unsigned pk_fp8x4(float a, float b, float c, float d) { int w = undef_i32();
    w = __builtin_amdgcn_cvt_pk_fp8_f32(__builtin_amdgcn_fmed3f(a, -448.f, 448.f), __builtin_amdgcn_fmed3f(b, -448.f, 448.f), w, false);
    w = __builtin_amdgcn_cvt_pk_fp8_f32(__builtin_amdgcn_fmed3f(c, -448.f, 448.f), __builtin_amdgcn_fmed3f(d, -448.f, 448.f), w, true); return (unsigned)w; }
__device__ __forceinline__ u32x2 f8x8(f32x4 a, f32x4 b) { return (u32x2){pk_fp8x4(a[0], a[1], a[2], a[3]), pk_fp8x4(b[0], b[1], b[2], b[3])}; }
__device__ __forceinline__ unsigned pk_fp8x4u(float a, float b, float c, float d) { int w = undef_i32(); w = __builtin_amdgcn_cvt_pk_fp8_f32(a, b, w, false); w = __builtin_amdgcn_cvt_pk_fp8_f32(c, d, w, true); return (unsigned)w; }
__device__ __forceinline__ u32x2 f8x8u(f32x4 a, f32x4 b) { return (u32x2){pk_fp8x4u(a[0], a[1], a[2], a[3]), pk_fp8x4u(b[0], b[1], b[2], b[3])}; }
__device__ __forceinline__ void st8pair(unsigned char* pa, unsigned char* pb, u32x2 a, u32x2 b, int fq) {
    auto r0 = __builtin_amdgcn_permlane16_swap(a.x, b.x, false, false); auto r1 = __builtin_amdgcn_permlane16_swap(a.y, b.y, false, false);
    *(u32x4*)((fq & 1) ? pb - 8 : pa) = (u32x4){r0[0], r1[0], r0[1], r1[1]}; }
__device__ __forceinline__ void glds16_(const void* gsrc, unsigned lds_dst) { unsigned keep;
    asm volatile("s_mov_b32 %0, m0\n\ts_mov_b32 m0, %2\n\ts_nop 0\n\tglobal_load_lds_dwordx4 %1, off\n\ts_mov_b32 m0, %0" : "=&s"(keep) : "v"(gsrc), "s"(lds_dst) : "memory"); }
#ifndef WT_STORES
#define WT_STORES 0
#endif
__device__ __forceinline__ void st16(void* p, u32x4 v) {
#if WT_STORES
    asm volatile("global_store_dwordx4 %0, %1, off sc1\n\ts_nop 1" :: "v"(p), "v"(v) : "memory");
#else
    *(u32x4*)p = v;
#endif
}
__device__ __forceinline__ void st16o(const void* sbase, unsigned voff, u32x4 v) {
#if WT_STORES
    asm volatile("global_store_dwordx4 %0, %1, %2 sc1\n\ts_nop 1" :: "v"(voff), "v"(v), "s"(sbase) : "memory");
#else
    *(u32x4*)((unsigned char*)sbase + voff) = v;
#endif
}
__device__ __forceinline__ int tid_from_wave(int wave) { int ln; asm volatile("v_mbcnt_lo_u32_b32 %0, -1, 0\n\tv_mbcnt_hi_u32_b32 %0, -1, %0" : "=v"(ln));
    return wave * 64 + ln; }
#define LDS_BARRIER() do { asm volatile("s_waitcnt lgkmcnt(0)" ::: "memory"); __builtin_amdgcn_s_barrier(); asm volatile("" ::: "memory"); } while (0)

#ifndef PG8_ASMDMA
#define PG8_ASMDMA 1
#endif
namespace pg8 {
constexpr int BM = 256, BK = 64, HALF = 128, HTB = HALF * BK * 2, STAGE_BYTES = 8 * HTB, NXCD = 8, WGM = 8;
__host__ __device__ __forceinline__ int lds_byte(int r, int c) { const int st = (r >> 4) * 2 + (c >> 5), rr = r & 15, cc = c & 31, ob = rr * 64 + cc * 2; return st * 1024 + (ob ^ (((ob >> 9) & 1) << 5)); }
__host__ __device__ __forceinline__ void stage_rc(int b, int& R, int& C) { const int st = b / 1024, sb = b % 1024, swz = sb ^ (((sb >> 9) & 1) << 5); R = (st >> 1) * 16 + swz / 64; C = (st & 1) * 32 + (swz % 64) / 2; }
__host__ __device__ __forceinline__ int perm32(int rho) { const int n = rho >> 4, i = rho & 15; return 8 * (i >> 2) + 4 * n + (i & 3); }

struct Unit { int pm, pn; };
struct Gemm { const bf16_t* A; const bf16_t* Bt; int M, N, K; const bf16_t* A2; int nsplit; };

struct StaticOrder {
    int nM, nN, nwg, G, c;
    __host__ __device__ void init(int M, int N, int G_, int c_) { nM = M / BM; nN = N / BM; nwg = nM * nN; G = G_; c = c_; }
    __host__ __device__ bool next(int i, Unit& u) const {
        const long L = (long)i * G + c; if (L >= nwg) return false;
        int wgid = (int)L; { const int q = nwg / NXCD, r = nwg % NXCD, xcd = wgid % NXCD, off = wgid / NXCD; wgid = (xcd < r ? xcd * (q + 1) : r * (q + 1) + (xcd - r) * q) + off; }
        const int nig = WGM * nN, gid = wgid / nig, fm = gid * WGM, gsz = (nM - fm) < WGM ? (nM - fm) : WGM;
        u.pm = fm + ((wgid % nig) % gsz); u.pn = (wgid % nig) / gsz; return true;
    }
};

template <class Epi, class Sched>
__device__ __forceinline__ void gemm_phase(LAS unsigned char* lds, LAS float* xl, const Gemm g, const Sched& S, const Epi& E, int wave_id) {
    int tid = tid_from_wave(wave_id); asm volatile("" : "+v"(tid)); tid &= 511;
    const int wid = __builtin_amdgcn_readfirstlane(tid >> 6), lane = tid & 63, wr = wid >> 2, wc = wid & 3, fr = lane & 15, fq = lane >> 4;
    const int K = g.K, nt = K / BK;
    unsigned voffA[2], voffB[2];
#pragma unroll
    for (int i = 0; i < 2; ++i) { int R, C; stage_rc(tid * 16 + i * 8192, R, C); const int Rb = (R & ~31) + perm32(R & 31);
        const int Ra = Epi::APERM ? ((R & 64) | ((R & 15) << 2) | ((R >> 4) & 3)) : R;
        voffA[i] = (unsigned)(Ra * K + C) * 2u; voffB[i] = (unsigned)(Rb * K + C) * 2u; }
    const size_t kstep = (size_t)(BK * 2);
    const size_t hstep = (size_t)HALF * K * 2;
    const size_t tstep = 2 * hstep;
    const unsigned ldsw = (unsigned)wid * 1024u; const unsigned ldsb = (unsigned)__builtin_amdgcn_readfirstlane((int)((unsigned)(uintptr_t)lds + ldsw));
    const int aoff = lds_byte(wr * 64 + fr, fq * 8), boff = lds_byte(wc * 32 + fr, fq * 8);
#define PG8_SA(b, h) (((b) * 2 + (h)) * HTB)
#define PG8_SB(b, h) ((4 + (b) * 2 + (h)) * HTB)
#if PG8_ASMDMA
#define PG8_STAGE(bufoff, gbase, voff) do { _Pragma("unroll") for (int _i = 0; _i < 2; ++_i) \
        asm volatile("s_mov_b32 m0, %2\n\ts_nop 0\n\tglobal_load_lds_dwordx4 %0, %1" :: "v"((voff)[_i]), "s"((const void*)(gbase)), "s"(ldsb + (unsigned)((bufoff) + _i * 8192)) : "memory", "m0"); } while (0)
#else
#define PG8_STAGE(bufoff, gbase, voff) do { _Pragma("unroll") for (int _i = 0; _i < 2; ++_i) \
        __builtin_amdgcn_global_load_lds((const unsigned*)((const char*)(gbase) + (voff)[_i]), (LAS unsigned*)(lds + (bufoff) + ldsw + _i * 8192), 16, 0, 0); } while (0)
#endif
#define PG8_LDA(dst, b, h) do { if constexpr (Epi::FP8) { _Pragma("unroll") for (int m = 0; m < 4; ++m) { const i32x4 lo_ = *(const LAS i32x4*)(lds + PG8_SA(b, h) + aoff + m * 2048), hi_ = *(const LAS i32x4*)(lds + PG8_SA(b, h) + aoff + m * 2048 + 1024); dst##8[m] = __builtin_shufflevector(lo_, hi_, 0, 1, 2, 3, 4, 5, 6, 7); } } \
        else { _Pragma("unroll") for (int m = 0; m < 4; ++m) _Pragma("unroll") for (int k = 0; k < 2; ++k) dst[m][k] = *(const LAS bf16x8*)(lds + PG8_SA(b, h) + aoff + m * 2048 + k * 1024); } } while (0)
#define PG8_LDB(dst, b, h) do { if constexpr (Epi::FP8) { _Pragma("unroll") for (int n = 0; n < 2; ++n) { const i32x4 lo_ = *(const LAS i32x4*)(lds + PG8_SB(b, h) + boff + n * 2048), hi_ = *(const LAS i32x4*)(lds + PG8_SB(b, h) + boff + n * 2048 + 1024); dst##8[n] = __builtin_shufflevector(lo_, hi_, 0, 1, 2, 3, 4, 5, 6, 7); } } \
        else { _Pragma("unroll") for (int n = 0; n < 2; ++n) _Pragma("unroll") for (int k = 0; k < 2; ++k) dst[n][k] = *(const LAS bf16x8*)(lds + PG8_SB(b, h) + boff + n * 2048 + k * 1024); } } while (0)
#define PG8_MMA(ai, bj, At, Bt) do { __builtin_amdgcn_s_setprio(1); if constexpr (Epi::FP8) { _Pragma("unroll") for (int m = 0; m < 4; ++m) _Pragma("unroll") for (int n = 0; n < 2; ++n) \
            acc[ai][bj][m][n] = __builtin_amdgcn_mfma_scale_f32_16x16x128_f8f6f4(Bt##8[n], At##8[m], acc[ai][bj][m][n], 0, 0, 0, 0, 0, 0); } \
        else { _Pragma("unroll") for (int m = 0; m < 4; ++m) _Pragma("unroll") for (int n = 0; n < 2; ++n) _Pragma("unroll") for (int k = 0; k < 2; ++k) \
            acc[ai][bj][m][n] = __builtin_amdgcn_mfma_f32_16x16x32_bf16(Bt[n][k], At[m][k], acc[ai][bj][m][n], 0, 0, 0); } __builtin_amdgcn_s_setprio(0); } while (0)
#define PG8_WAIT_V(n) asm volatile("s_waitcnt vmcnt(" #n ")" ::: "memory")
#define PG8_WAIT_L(n) asm volatile("s_waitcnt lgkmcnt(" #n ")" ::: "memory")
#define PG8_BAR __builtin_amdgcn_s_barrier()
#define PG8_SCHED __builtin_amdgcn_sched_barrier(0)
    Unit cur, nxt; int ui = 0;
    if (!S.next(0, cur)) return;
    f32x4 acc[2][2][4][2];
    { float z0; asm volatile("v_mov_b32 %0, 0" : "=v"(z0));
#pragma unroll
    for (int a = 0; a < 2; ++a)
#pragma unroll
        for (int b = 0; b < 2; ++b)
#pragma unroll
            for (int m = 0; m < 4; ++m)
#pragma unroll
                for (int n = 0; n < 2; ++n) acc[a][b][m][n] = (f32x4){z0, z0, z0, z0}; }
    bf16x8 At[4][2], B0[2][2], B1[2][2]; i32x8 At8[4], B08[2], B18[2];
    const char* cA = (const char*)(cur.pn < g.nsplit ? g.A : g.A2) + (size_t)cur.pm * tstep; const char* cB = (const char*)g.Bt + (size_t)cur.pn * tstep;
    if constexpr (Epi::PREFETCH) E.prefetch(cur, xl, 0, wid, lane);
    PG8_STAGE(PG8_SB(0, 0), cB, voffB); PG8_STAGE(PG8_SB(0, 1), cB + hstep, voffB); PG8_STAGE(PG8_SA(0, 0), cA, voffA); PG8_STAGE(PG8_SA(0, 1), cA + hstep, voffA);
    if (wr == 1) PG8_BAR;
    PG8_WAIT_V(2); PG8_BAR;
    PG8_STAGE(PG8_SB(1, 0), cB + kstep, voffB); PG8_STAGE(PG8_SA(1, 0), cA + kstep, voffA); PG8_STAGE(PG8_SB(1, 1), cB + hstep + kstep, voffB);
    PG8_WAIT_V(6); PG8_BAR;
    for (;;) {
        const bool has_next = S.next(ui + 1, nxt);
        const char* nA = has_next ? (const char*)(nxt.pn < g.nsplit ? g.A : g.A2) + (size_t)nxt.pm * tstep : cA; const char* nB = has_next ? (const char*)g.Bt + (size_t)nxt.pn * tstep : cB;
#pragma nounroll
        for (int t = 0; t < nt; t += 2) {
            const bool last = (t == nt - 2);
            const char* a1 = cA + (size_t)(t + 1) * kstep;
            const char* a2 = last ? nA : cA + (size_t)(t + 2) * kstep; const char* b2 = last ? nB : cB + (size_t)(t + 2) * kstep;
            const char* a3 = a2 + kstep; const char* b3 = b2 + kstep;
            PG8_LDB(B0, 0, 0); PG8_LDB(B1, 0, 1); PG8_SCHED; PG8_LDA(At, 0, 0); PG8_STAGE(PG8_SA(1, 1), a1 + hstep, voffA);
            PG8_WAIT_V(8); PG8_WAIT_L(0); PG8_BAR; PG8_MMA(0, 0, At, B0); PG8_MMA(0, 1, At, B1); PG8_BAR; PG8_SCHED;
            PG8_LDA(At, 0, 1); PG8_STAGE(PG8_SB(0, 0), b2, voffB); PG8_STAGE(PG8_SB(0, 1), b2 + hstep, voffB); PG8_STAGE(PG8_SA(0, 0), a2, voffA);
            PG8_WAIT_V(8); PG8_WAIT_L(0); PG8_BAR; PG8_MMA(1, 0, At, B0); PG8_MMA(1, 1, At, B1); PG8_BAR; PG8_SCHED;
            PG8_LDB(B0, 1, 0); PG8_LDB(B1, 1, 1); PG8_SCHED; PG8_LDA(At, 1, 0); PG8_STAGE(PG8_SA(0, 1), a2 + hstep, voffA);
            PG8_WAIT_V(8); PG8_WAIT_L(0); PG8_BAR; PG8_MMA(0, 0, At, B0); PG8_MMA(0, 1, At, B1); PG8_BAR; PG8_SCHED;
            PG8_LDA(At, 1, 1); PG8_STAGE(PG8_SB(1, 0), b3, voffB); PG8_STAGE(PG8_SB(1, 1), b3 + hstep, voffB); PG8_STAGE(PG8_SA(1, 0), a3, voffA);
            PG8_WAIT_V(8); PG8_WAIT_L(0); PG8_BAR; PG8_MMA(1, 0, At, B0); PG8_MMA(1, 1, At, B1); PG8_BAR; PG8_SCHED;
        }
        if (wr == 0) PG8_BAR;
        { const int le_ = tid_from_wave(0), fre = le_ & 15, fqe = le_ >> 4;
        if constexpr (Epi::FP8) { if constexpr (Epi::PREFETCH) E.pre(acc, cur, wc, fqe, xl, ui & 1); else E.pre(acc, cur, wc, fqe); }
        if constexpr (Epi::PREFETCH) { E(acc, cur, wr, wc, fre, fqe, xl, ui & 1); if (has_next) E.prefetch(nxt, xl, (ui + 1) & 1, wid, le_); }
        else E(acc, cur, wr, wc, fre, fqe, xl); }
        if (!has_next) break;
        { float z0; asm volatile("v_mov_b32 %0, 0" : "=v"(z0));
#pragma unroll
        for (int a = 0; a < 2; ++a)
#pragma unroll
            for (int b = 0; b < 2; ++b)
#pragma unroll
                for (int m = 0; m < 4; ++m)
#pragma unroll
                    for (int n = 0; n < 2; ++n) acc[a][b][m][n] = (f32x4){z0, z0, z0, z0}; }
        cur = nxt; cA = nA; cB = nB; ++ui;
        if (wr == 1) PG8_BAR;
    }
    PG8_WAIT_V(0);
    PG8_BAR;
#undef PG8_SA
#undef PG8_SB
#undef PG8_STAGE
#undef PG8_LDA
#undef PG8_LDB
#undef PG8_MMA
#undef PG8_WAIT_V
#undef PG8_WAIT_L
#undef PG8_BAR
#undef PG8_SCHED
}
}
using pg8::Unit;

constexpr size_t MiB = 1u << 20;
constexpr size_t WS_CTL = 0, CTL_ZERO_BYTES = 64 * 1024;
constexpr size_t WS_PART = 35 * (1u << 20), PART_BYTES = (size_t)32768 * 4 * 8;
constexpr size_t WS_MOD = 1 * MiB;
constexpr size_t WS_BIAS2 = 1 * MiB + 640 * 1024;
constexpr size_t WS_PARTV = 13 * MiB;
constexpr size_t WS_REF = 1 * MiB + 768 * 1024;
constexpr size_t WS_BIAS = 1 * MiB + 512 * 1024;
constexpr size_t WS_COS = 2 * MiB, WS_SIN = 4 * MiB;
constexpr size_t WS_KR = 6 * MiB;
constexpr size_t WS_SSR = 10 * MiB;
constexpr size_t WS_WIN = 11 * MiB;
constexpr size_t WS_WQUP = 15 * MiB;
constexpr size_t WS_WKVUP = WS_WQUP + 512 * 1024;
constexpr size_t WS_WOUT = 16 * MiB;
constexpr size_t WS_WUP = 18 * MiB;
constexpr size_t WS_WDOWN = 29 * MiB;
constexpr size_t WS_XN = 36 * MiB;
constexpr size_t WS_QLN = 100 * MiB, WS_KVLN = 116 * MiB;
constexpr size_t WS_CQ = 132 * MiB, WS_CK = 164 * MiB, WS_CV = 196 * MiB;
constexpr size_t WS_QM = 228 * MiB, WS_KM = 276 * MiB;
constexpr size_t WS_VM = 324 * MiB;
constexpr size_t WS_OM = WS_XN;
constexpr size_t WS_ACT = 100 * MiB;
constexpr size_t WS_X1 = 276 * MiB;
constexpr size_t WS_RAW4 = 404 * MiB;
constexpr size_t WS_H2 = 448 * MiB;
constexpr size_t WS_END = 512 * MiB;
static_assert(WS_ACT + (size_t)MTOK * DFF * 2 <= WS_X1 && WS_X1 + (size_t)MTOK * DM * 4 <= WS_RAW4 && WS_RAW4 + (size_t)512 * 4 * DFF2 * 4 <= WS_END, "overlay map");
constexpr int CW_BAR = 1024;


constexpr float F8_QS = 32.0f, F8_KS = 0.125f;
constexpr float F8_O_SCALE = 64.0f, F8_WOUT_SCALE = 1024.0f;
constexpr float F8_ACT_SCALE = 8.0f, F8_WIN_SCALE = 1024.0f;
constexpr int XL_CONST = 2048;
__device__ __forceinline__ void f8_pre_lds(f32x4 (&acc)[2][2][4][2], const LAS float* side, float descale, int wc, int fq) {
    asm volatile("" : "+v"(fq), "+s"(wc));
    const LAS float* sp = side + wc * 32 + 8 * fq;
    f32x4 bv[2][2];
#pragma unroll
    for (int bj = 0; bj < 2; ++bj)
#pragma unroll
        for (int n = 0; n < 2; ++n) bv[bj][n] = *(const LAS f32x4*)(sp + 128 * bj + 4 * n);
#pragma unroll
    for (int a = 0; a < 2; ++a)
#pragma unroll
        for (int bj = 0; bj < 2; ++bj)
#pragma unroll
            for (int m = 0; m < 4; ++m)
#pragma unroll
                for (int n = 0; n < 2; ++n) acc[a][bj][m][n] = acc[a][bj][m][n] * descale + bv[bj][n];
}
struct EpiIn {
    static constexpr bool APERM = false, PREFETCH = true, FP8 = true; static constexpr float DESCALE = 1.0f / (F8_ACT_SCALE * F8_WIN_SCALE);
    unsigned char* ws;
    __device__ __forceinline__ void prefetch(const Unit& u, LAS float* xl, int par, int wid, int lane) const {
        asm volatile("" : "+v"(lane));
        if (wid == 0) glds16_((const float*)(ws + WS_BIAS) + (size_t)(u.pm >> 3) * 2048 + u.pn * 256 + 4 * lane, (unsigned)__builtin_amdgcn_readfirstlane((unsigned)(uintptr_t)(xl + XL_CONST + 512 + par * 256)));
    }
    __device__ __forceinline__ void pre(f32x4 (&acc)[2][2][4][2], const Unit& u, int wc, int fq, LAS float* xl, int par) const { f8_pre_lds(acc, xl + XL_CONST + 512 + par * 256, DESCALE, wc, fq); }
    __device__ __forceinline__ void operator()(const f32x4 (&acc)[2][2][4][2], const Unit& u, int wr, int wc, int fr, int fq, LAS float* red, int  ) const {
        asm volatile("" : "+v"(fr), "+v"(fq), "+s"(wr), "+s"(wc));
        const int rl0 = wr * 64 + fr; const size_t row0 = (size_t)u.pm * 256 + rl0; const int pn = u.pn;
        bf16_t* const QLN = (bf16_t*)(ws + WS_QLN); bf16_t* const KVLN = (bf16_t*)(ws + WS_KVLN); bf16_t* const CQ = (bf16_t*)(ws + WS_CQ); bf16_t* const CK = (bf16_t*)(ws + WS_CK); bf16_t* const CV = (bf16_t*)(ws + WS_CV);
        float* const KR = (float*)(ws + WS_KR); float* const SSR = (float*)(ws + WS_SSR);
        if (pn >= 6) {
            { float* pv = (float*)(ws + WS_PARTV) + ((size_t)u.pm * 2 + wr) * 1024 + 512 + (pn - 6) * 256 + wc * 32 + 8 * fq;
              colsum8(acc, 0, fr, pv); colsum8(acc, 1, fr, pv + 128); }
            unsigned char* base = (unsigned char*)CV + (pn - 6) * 256 + wc * 32 + 8 * fq;
#pragma unroll
            for (int ai = 0; ai < 2; ++ai)
#pragma unroll
                for (int mp = 0; mp < 2; ++mp) { unsigned char* ra = base + (row0 + ai * 128 + (2 * mp) * 16) * 512; unsigned char* rb = ra + 16 * 512;
#pragma unroll
                    for (int bj = 0; bj < 2; ++bj) st8pair(ra + bj * 128, rb + bj * 128, f8x8(acc[ai][bj][2 * mp][0], acc[ai][bj][2 * mp][1]), f8x8(acc[ai][bj][2 * mp + 1][0], acc[ai][bj][2 * mp + 1][1]), fq); }
        } else if (pn >= 2) {
            const bool isq = pn < 4; const int head = 4 * ((pn - 2) & 1) + wc; const LAS float* g = red + XL_CONST + (isq ? 384 : 448); const float sc = isq ? C2_CA * F8_QS : F8_KS;
            f32x4 gv[2][2];
#pragma unroll
            for (int bj = 0; bj < 2; ++bj)
#pragma unroll
                for (int n = 0; n < 2; ++n) gv[bj][n] = *(const LAS f32x4*)(g + 32 * bj + 8 * fq + 4 * n) * sc;
            unsigned char* base = (unsigned char*)(isq ? CQ : CK) + head * 64 + 8 * fq;
#pragma unroll
            for (int ai = 0; ai < 2; ++ai)
#pragma unroll
                for (int mp = 0; mp < 2; ++mp) { float rr[2];
#pragma unroll
                    for (int mm = 0; mm < 2; ++mm) { const int m = 2 * mp + mm;
                        float ss = (dot4(acc[ai][0][m][0]) + dot4(acc[ai][0][m][1])) + (dot4(acc[ai][1][m][0]) + dot4(acc[ai][1][m][1]));
                        ss = xsum32(xsum16(ss));
                        rr[mm] = __builtin_amdgcn_rsqf(ss * (1.0f / 64.0f) + EPS); }
                    unsigned char* ra = base + (row0 + ai * 128 + (2 * mp) * 16) * 512; unsigned char* rb = ra + 16 * 512;
#pragma unroll
                    for (int bj = 0; bj < 2; ++bj) st8pair(ra + bj * 32, rb + bj * 32, f8x8u(acc[ai][bj][2 * mp][0] * rr[0] * gv[bj][0], acc[ai][bj][2 * mp][1] * rr[0] * gv[bj][1]),
                                                           f8x8u(acc[ai][bj][2 * mp + 1][0] * rr[1] * gv[bj][0], acc[ai][bj][2 * mp + 1][1] * rr[1] * gv[bj][1]), fq);
                }
        } else if (pn == 0) {
#pragma unroll
            for (int ai = 0; ai < 2; ++ai)
#pragma unroll
                for (int m = 0; m < 4; ++m) {
                    float ss = (dot4(acc[ai][0][m][0]) + dot4(acc[ai][0][m][1])) + (dot4(acc[ai][1][m][0]) + dot4(acc[ai][1][m][1]));
                    ss = xsum32(xsum16(ss));
                    if (fq == 0) red[(ai * 128 + m * 16 + rl0) * 8 + wc] = ss;
                }
            LDS_BARRIER();
            f32x4 gv[2][2];
#pragma unroll
            for (int bj = 0; bj < 2; ++bj)
#pragma unroll
                for (int n = 0; n < 2; ++n) gv[bj][n] = *(const LAS f32x4*)(red + XL_CONST + 128 * bj + 32 * wc + 8 * fq + 4 * n);
            bf16_t* base = QLN + wc * 32 + 8 * fq;
#pragma unroll
            for (int ai = 0; ai < 2; ++ai)
#pragma unroll
                for (int m = 0; m < 4; ++m) {
                    const f32x4 t = *(const LAS f32x4*)(red + (ai * 128 + m * 16 + rl0) * 8);
                    const float r = __builtin_amdgcn_rsqf(((t[0] + t[1]) + (t[2] + t[3])) * (1.0f / 256.0f) + EPS);
                    bf16_t* rp = base + (row0 + ai * 128 + m * 16) * 256;
#pragma unroll
                    for (int bj = 0; bj < 2; ++bj) st16(rp + bj * 128, pack8(acc[ai][bj][m][0] * r * gv[bj][0], acc[ai][bj][m][1] * r * gv[bj][1]));
                }
        } else {
#pragma unroll
            for (int ai = 0; ai < 2; ++ai)
#pragma unroll
                for (int m = 0; m < 4; ++m) {
                    float ss = dot4(acc[ai][0][m][0]) + dot4(acc[ai][0][m][1]);
                    ss = xsum32(xsum16(ss));
                    if (fq == 0) red[(ai * 128 + m * 16 + rl0) * 8 + wc] = ss;
                }
            LDS_BARRIER();
            f32x4 gv[2];
#pragma unroll
            for (int n = 0; n < 2; ++n) gv[n] = *(const LAS f32x4*)(red + XL_CONST + 256 + 32 * wc + 8 * fq + 4 * n);
            bf16_t* base = KVLN + wc * 32 + 8 * fq;
#pragma unroll
            for (int ai = 0; ai < 2; ++ai)
#pragma unroll
                for (int m = 0; m < 4; ++m) {
                    const f32x4 t = *(const LAS f32x4*)(red + (ai * 128 + m * 16 + rl0) * 8);
                    const float r = __builtin_amdgcn_rsqf(((t[0] + t[1]) + (t[2] + t[3])) * (1.0f / 128.0f) + EPS);
                    const size_t row = row0 + ai * 128 + m * 16;
                    bf16_t* rp = base + row * 256;
                    st16(rp, pack8(acc[ai][0][m][0] * r * gv[0], acc[ai][0][m][1] * r * gv[1]));
                    { unsigned z0; asm volatile("v_mov_b32 %0, 0" : "=v"(z0)); st16(rp + 128, (u32x4){z0, z0, z0, z0}); }
                    if (wc == 0) {
                        *(f32x4*)(KR + row * 32 + 8 * fq) = acc[ai][1][m][0]; *(f32x4*)(KR + row * 32 + 8 * fq + 4) = acc[ai][1][m][1];
                        float sr = dot4(acc[ai][1][m][0]) + dot4(acc[ai][1][m][1]);
                        sr = xsum32(xsum16(sr));
                        if (fq == 0) SSR[row] = sr;
                    }
                }
        }
    }
};

struct EpiQ {
    static constexpr bool APERM = false, PREFETCH = false, FP8 = false;
    unsigned char* ws; const float* g;
    __device__ __forceinline__ void operator()(const f32x4 (&acc)[2][2][4][2], const Unit& u, int wr, int wc, int fr, int fq, LAS float* red) const {
        asm volatile("" : "+v"(fr), "+v"(fq), "+s"(wr), "+s"(wc));
        const int rl0 = wr * 64 + fr; const size_t row0 = (size_t)u.pm * 256 + rl0;
        bf16_t* const QM = (bf16_t*)(ws + WS_QM); const float* const cosT = (const float*)(ws + WS_COS); const float* const sinT = (const float*)(ws + WS_SIN);
#pragma unroll
        for (int ai = 0; ai < 2; ++ai)
#pragma unroll
            for (int m = 0; m < 4; ++m)
#pragma unroll
                for (int bj = 0; bj < 2; ++bj) {
                    float ss = dot4(acc[ai][bj][m][0]) + dot4(acc[ai][bj][m][1]);
                    ss = xsum32(xsum16(ss));
                    if (fq == 0) red[(ai * 128 + m * 16 + rl0) * 8 + bj * 4 + wc] = ss;
                }
        LDS_BARRIER();
        if (wc < 2) {
            const f32x4 g0 = *(const f32x4*)(g + 32 * wc + 8 * fq) * (C2_MLA * F8_QS), g1 = *(const f32x4*)(g + 32 * wc + 8 * fq + 4) * (C2_MLA * F8_QS);
#pragma unroll
            for (int ai = 0; ai < 2; ++ai)
#pragma unroll
                for (int mp = 0; mp < 2; ++mp) {
                    const size_t row = row0 + ai * 128 + (2 * mp) * 16;
#pragma unroll
                    for (int bj = 0; bj < 2; ++bj) { u32x2 d[2];
#pragma unroll
                        for (int mm = 0; mm < 2; ++mm) { const int m = 2 * mp + mm;
                            const f32x4 t = *(const LAS f32x4*)(red + (ai * 128 + m * 16 + rl0) * 8 + bj * 4);
                            const float r = __builtin_amdgcn_rsqf(((t[0] + t[1]) + (t[2] + t[3])) * (1.0f / 96.0f) + EPS);
                            d[mm] = f8x8u(acc[ai][bj][m][0] * r * g0, acc[ai][bj][m][1] * r * g1); }
                        unsigned char* pa = (unsigned char*)QM + ((unsigned)row * 768u + (2 * u.pn + bj) * 96u + 32u * wc + 8u * fq);
                        st8pair(pa, pa + 16 * 768, d[0], d[1], fq);
                    }
                }
        } else if (wc == 2) {
            const f32x4 g0 = *(const f32x4*)(g + 64 + 4 * fq) * (C2_MLA * F8_QS), g1 = *(const f32x4*)(g + 80 + 4 * fq) * (C2_MLA * F8_QS);
            f32x4 csv[2][4], snv[2][4];
#pragma unroll
            for (int ai = 0; ai < 2; ++ai)
#pragma unroll
                for (int m = 0; m < 4; ++m) { const unsigned ro = ((unsigned)row0 + ai * 128 + m * 16) * 64u + 16u * fq; csv[ai][m] = *(const f32x4*)((const unsigned char*)cosT + ro); snv[ai][m] = *(const f32x4*)((const unsigned char*)sinT + ro); }
#pragma unroll
            for (int ai = 0; ai < 2; ++ai) {
#pragma unroll
                for (int m = 0; m < 4; ++m) {
                    const unsigned rowu = (unsigned)row0 + ai * 128 + m * 16;
#pragma unroll
                    for (int bj = 0; bj < 2; ++bj) {
                        const f32x4 t = *(const LAS f32x4*)(red + (ai * 128 + m * 16 + rl0) * 8 + bj * 4);
                        const float r = __builtin_amdgcn_rsqf(((t[0] + t[1]) + (t[2] + t[3])) * (1.0f / 96.0f) + EPS);
                        unsigned char* hp = (unsigned char*)QM + (rowu * 768u + (2 * u.pn + bj) * 96u);
                        const f32x4 x1 = acc[ai][bj][m][0] * r * g0, x2 = acc[ai][bj][m][1] * r * g1;
                        { const f32x4 ya = x1 * csv[ai][m] - x2 * snv[ai][m], yb = x2 * csv[ai][m] + x1 * snv[ai][m]; *(unsigned*)(hp + 64 + 4 * fq) = pk_fp8x4u(ya[0], ya[1], ya[2], ya[3]); *(unsigned*)(hp + 80 + 4 * fq) = pk_fp8x4u(yb[0], yb[1], yb[2], yb[3]); }
                    }
                }
                asm volatile("" ::: "memory");
            }
        }
    }
};

struct EpiKV {
    static constexpr bool APERM = false, PREFETCH = false, FP8 = false;
    unsigned char* ws; const float* g;
    __device__ __forceinline__ void operator()(const f32x4 (&acc)[2][2][4][2], const Unit& u, int wr, int wc, int fr, int fq, LAS float* red) const {
        asm volatile("" : "+v"(fr), "+v"(fq), "+s"(wr), "+s"(wc));
        const int rl0 = wr * 64 + fr; const size_t row0 = (size_t)u.pm * 256 + rl0;
        bf16_t* const KM = (bf16_t*)(ws + WS_KM); bf16_t* const VM = (bf16_t*)(ws + WS_VM); const float* const cosT = (const float*)(ws + WS_COS); const float* const sinT = (const float*)(ws + WS_SIN);
        const float* const KR = (const float*)(ws + WS_KR); const float* const SSR = (const float*)(ws + WS_SSR);
        if (wc < 2) {
#pragma unroll
            for (int ai = 0; ai < 2; ++ai)
#pragma unroll
                for (int m = 0; m < 4; ++m)
#pragma unroll
                    for (int bj = 0; bj < 2; ++bj) {
                        float ss = dot4(acc[ai][bj][m][0]) + dot4(acc[ai][bj][m][1]);
                        ss = xsum32(xsum16(ss));
                        if (fq == 0) red[(ai * 128 + m * 16 + rl0) * 8 + bj * 2 + wc] = ss;
                    }
        }
        LDS_BARRIER();
        if (wc < 2) {
            const f32x4 g0 = *(const f32x4*)(g + 32 * wc + 8 * fq) * F8_KS, g1 = *(const f32x4*)(g + 32 * wc + 8 * fq + 4) * F8_KS;
            float ssrv[2][4];
#pragma unroll
            for (int ai = 0; ai < 2; ++ai)
#pragma unroll
                for (int m = 0; m < 4; ++m) ssrv[ai][m] = SSR[row0 + ai * 128 + m * 16];
#pragma unroll
            for (int ai = 0; ai < 2; ++ai)
#pragma unroll
                for (int mp = 0; mp < 2; ++mp) {
                    const size_t row = row0 + ai * 128 + (2 * mp) * 16;
                    const f32x4 t0 = *(const LAS f32x4*)(red + (ai * 128 + (2 * mp) * 16 + rl0) * 8), t1 = *(const LAS f32x4*)(red + (ai * 128 + (2 * mp + 1) * 16 + rl0) * 8);
#pragma unroll
                    for (int bj = 0; bj < 2; ++bj) {
                        const float rk0 = __builtin_amdgcn_rsqf((t0[2 * bj] + t0[2 * bj + 1] + ssrv[ai][2 * mp]) * (1.0f / 96.0f) + EPS), rk1 = __builtin_amdgcn_rsqf((t1[2 * bj] + t1[2 * bj + 1] + ssrv[ai][2 * mp + 1]) * (1.0f / 96.0f) + EPS);
                        unsigned char* pa = (unsigned char*)KM + ((unsigned)row * 768u + (2 * u.pn + bj) * 96u + 32u * wc + 8u * fq);
                        st8pair(pa, pa + 16 * 768, f8x8u(acc[ai][bj][2 * mp][0] * rk0 * g0, acc[ai][bj][2 * mp][1] * rk0 * g1), f8x8u(acc[ai][bj][2 * mp + 1][0] * rk1 * g0, acc[ai][bj][2 * mp + 1][1] * rk1 * g1), fq);
                    }
                    asm volatile("" ::: "memory");
                }
        } else {
            const int bj0 = wc - 2, h0 = 2 * u.pn + bj0;
            { float* pv = (float*)(ws + WS_PARTV) + ((size_t)u.pm * 2 + wr) * 1024 + (2 * u.pn) * 64 + 32 * (wc - 2) + 8 * fq;
              colsum8(acc, 0, fr, pv); colsum8(acc, 1, fr, pv + 64); }
            const f32x4 g0 = *(const f32x4*)(g + 64 + 4 * fq) * F8_KS, g1 = *(const f32x4*)(g + 80 + 4 * fq) * F8_KS;
#pragma unroll
            for (int ai = 0; ai < 2; ++ai)
#pragma unroll
              for (int mp = 0; mp < 2; ++mp) { const unsigned rowa = (unsigned)row0 + ai * 128 + (2 * mp) * 16;
#pragma unroll
                  for (int bj = 0; bj < 2; ++bj) { unsigned char* pa = (unsigned char*)VM + (rowa * 512u + (2 * u.pn + bj) * 64u + 32u * (wc - 2) + 8u * fq);
                      st8pair(pa, pa + 16 * 512, f8x8(acc[ai][bj][2 * mp][0], acc[ai][bj][2 * mp][1]), f8x8(acc[ai][bj][2 * mp + 1][0], acc[ai][bj][2 * mp + 1][1]), fq); } }
            asm volatile("" ::: "memory");
#pragma unroll
            for (int ai = 0; ai < 2; ++ai) {
                f32x4 csv[4], snv[4], k1v[4], k2v[4]; float ssrv[4];
#pragma unroll
                for (int m = 0; m < 4; ++m) { const unsigned rowu = (unsigned)row0 + ai * 128 + m * 16; csv[m] = *(const f32x4*)((const unsigned char*)cosT + rowu * 64u + 16u * fq); snv[m] = *(const f32x4*)((const unsigned char*)sinT + rowu * 64u + 16u * fq);
                    k1v[m] = *(const f32x4*)((const unsigned char*)KR + rowu * 128u + 16u * fq); k2v[m] = *(const f32x4*)((const unsigned char*)KR + rowu * 128u + 64u + 16u * fq); ssrv[m] = *(const float*)((const unsigned char*)SSR + rowu * 4u); }
#pragma unroll
                for (int m = 0; m < 4; ++m) {
                    const unsigned rowu = (unsigned)row0 + ai * 128 + m * 16;
                    const f32x2 t = *(const LAS f32x2*)(red + (ai * 128 + m * 16 + rl0) * 8 + 2 * bj0);
                    const float rk = __builtin_amdgcn_rsqf((t[0] + t[1] + ssrv[m]) * (1.0f / 96.0f) + EPS);
                    const f32x4 x1 = k1v[m] * rk * g0, x2 = k2v[m] * rk * g1;
                    unsigned char* hp = (unsigned char*)KM + (rowu * 768u + h0 * 96u);
                    { const f32x4 ya = x1 * csv[m] - x2 * snv[m], yb = x2 * csv[m] + x1 * snv[m]; *(unsigned*)(hp + 64 + 4 * fq) = pk_fp8x4u(ya[0], ya[1], ya[2], ya[3]); *(unsigned*)(hp + 80 + 4 * fq) = pk_fp8x4u(yb[0], yb[1], yb[2], yb[3]); }
                }
                asm volatile("" ::: "memory");
            }
        }
    }
};

struct EpiQKV {
    static constexpr bool APERM = false, PREFETCH = false, FP8 = false;
    EpiQ q; EpiKV kv;
    __device__ __forceinline__ void operator()(const f32x4 (&acc)[2][2][4][2], const Unit& u, int wr, int wc, int fr, int fq, LAS float* red) const {
        if (u.pn < 4) q(acc, u, wr, wc, fr, fq, red);
        else { Unit v; v.pm = u.pm; v.pn = u.pn - 4; kv(acc, v, wr, wc, fr, fq, red); }
    }
};

__device__ __forceinline__ void f8_pre(f32x4 (&acc)[2][2][4][2], const float* side, int ld, float descale, const Unit& u, int wc, int fq) {
    asm volatile("" : "+v"(fq), "+s"(wc));
    const char* sb = (const char*)(side + (size_t)(u.pm >> 3) * ld + u.pn * 256 + wc * 32); const unsigned vo = (unsigned)fq * 32u;
    f32x4 bv[2][2];
#pragma unroll
    for (int bj = 0; bj < 2; ++bj)
#pragma unroll
        for (int n = 0; n < 2; ++n) bv[bj][n] = *(const f32x4*)(sb + vo + (128 * bj + 4 * n) * 4);
#pragma unroll
    for (int a = 0; a < 2; ++a)
#pragma unroll
        for (int bj = 0; bj < 2; ++bj)
#pragma unroll
            for (int m = 0; m < 4; ++m)
#pragma unroll
                for (int n = 0; n < 2; ++n) acc[a][bj][m][n] = acc[a][bj][m][n] * descale + bv[bj][n];
}
template <bool RES_BF16, bool OUT_BF16, bool F8 = false> struct EpiRes {
    static constexpr bool APERM = false, PREFETCH = false, FP8 = F8;
    __device__ __forceinline__ void pre(f32x4 (&acc)[2][2][4][2], const Unit& u, int wc, int fq) const { f8_pre(acc, side, 1024, 1.0f / (F8_O_SCALE * F8_WOUT_SCALE), u, wc, fq); }
    const void* base; void* out; const float* gate; const float* side = nullptr;
    __device__ __forceinline__ void operator()(const f32x4 (&acc)[2][2][4][2], const Unit& u, int wr, int wc, int fr, int fq, LAS float* red) const {
        asm volatile("" : "+v"(fr), "+v"(fq), "+s"(wr), "+s"(wc));
        const int b = u.pm >> 3; const int col0 = u.pn * 256 + wc * 32 + 8 * fq;
        f32x4 gv[2][2];
#pragma unroll
        for (int bj = 0; bj < 2; ++bj)
#pragma unroll
            for (int n = 0; n < 2; ++n) gv[bj][n] = *(const f32x4*)(gate + (size_t)b * NMOD + col0 + 128 * bj + 4 * n);
        if (RES_BF16) {
            u32x4 raw[2][4][2];
#pragma unroll
            for (int ai = 0; ai < 2; ++ai)
#pragma unroll
                for (int m = 0; m < 4; ++m)
#pragma unroll
                    for (int bj = 0; bj < 2; ++bj) raw[ai][m][bj] = *(const u32x4*)((const bf16_t*)base + ((size_t)u.pm * 256 + ai * 128 + wr * 64 + fr) * DM + col0 + (size_t)m * 16 * DM + 128 * bj);
#pragma unroll
            for (int ai = 0; ai < 2; ++ai) {
                const size_t off0 = ((size_t)u.pm * 256 + ai * 128 + wr * 64 + fr) * DM + col0;
#pragma unroll
                for (int m = 0; m < 4; ++m)
#pragma unroll
                    for (int bj = 0; bj < 2; ++bj) { const u32x4 w = raw[ai][m][bj];
                        const f32x4 x0 = (f32x4){__uint_as_float(w.x << 16), __uint_as_float(w.x & 0xffff0000u), __uint_as_float(w.y << 16), __uint_as_float(w.y & 0xffff0000u)};
                        const f32x4 x1 = (f32x4){__uint_as_float(w.z << 16), __uint_as_float(w.z & 0xffff0000u), __uint_as_float(w.w << 16), __uint_as_float(w.w & 0xffff0000u)};
                        const f32x4 v0 = x0 + gv[bj][0] * acc[ai][bj][m][0], v1 = x1 + gv[bj][1] * acc[ai][bj][m][1];
                        if (OUT_BF16) st16((bf16_t*)out + off0 + (size_t)m * 16 * DM + 128 * bj, pack8(v0, v1));
                        else { *(f32x4*)((float*)out + off0 + (size_t)m * 16 * DM + 128 * bj) = v0; *(f32x4*)((float*)out + off0 + (size_t)m * 16 * DM + 128 * bj + 4) = v1; } }
                asm volatile("" ::: "memory");
            }
        } else {
#pragma unroll
        for (int ai = 0; ai < 2; ++ai) {
            const size_t off0 = ((size_t)u.pm * 256 + ai * 128 + wr * 64 + fr) * DM + col0;
            f32x4 xs[4][2][2];
#pragma unroll
            for (int m = 0; m < 4; ++m)
#pragma unroll
                for (int bj = 0; bj < 2; ++bj)
#pragma unroll
                    for (int n = 0; n < 2; ++n) xs[m][bj][n] = *(const f32x4*)((const float*)base + off0 + (size_t)m * 16 * DM + 128 * bj + 4 * n);
#pragma unroll
            for (int m = 0; m < 4; ++m)
#pragma unroll
                for (int bj = 0; bj < 2; ++bj) {
                    const f32x4 v0 = xs[m][bj][0] + gv[bj][0] * acc[ai][bj][m][0], v1 = xs[m][bj][1] + gv[bj][1] * acc[ai][bj][m][1];
                    if (OUT_BF16) st16((bf16_t*)out + off0 + (size_t)m * 16 * DM + 128 * bj, pack8(v0, v1));
                    else { *(f32x4*)((float*)out + off0 + (size_t)m * 16 * DM + 128 * bj) = v0; *(f32x4*)((float*)out + off0 + (size_t)m * 16 * DM + 128 * bj + 4) = v1; }
                }
            asm volatile("" ::: "memory");
        }
        }
    }
};

struct EpiResNorm {
    static constexpr bool APERM = false, PREFETCH = true, FP8 = true;
    __device__ __forceinline__ void prefetch(const Unit& u, LAS float* xl, int par, int wid, int lane) const {
        asm volatile("" : "+v"(lane));
        if (wid < 5) { const int b = u.pm >> 3; const float* MODb = (const float*)(ws + WS_MOD) + (size_t)b * NMOD;
            const float* src = wid == 0 ? (const float*)(ws + WS_BIAS2) + (size_t)b * 1024 : wid == 1 ? gate + (size_t)b * NMOD : wid == 2 ? gn : wid == 3 ? MODb + 4 * DM : MODb + 3 * DM;
            glds16_(src + u.pn * 256 + 4 * lane, (unsigned)__builtin_amdgcn_readfirstlane((unsigned)(uintptr_t)(xl + XL_CONST + par * 1280 + wid * 256))); }
    }
    __device__ __forceinline__ void pre(f32x4 (&acc)[2][2][4][2], const Unit& u, int wc, int fq, LAS float* xl, int par) const { f8_pre_lds(acc, xl + XL_CONST + par * 1280, 1.0f / (F8_O_SCALE * F8_WOUT_SCALE), wc, fq); }
    const float* base; unsigned char* ws; const float* gate; const float* gn;
    __device__ __forceinline__ void operator()(f32x4 (&acc)[2][2][4][2], const Unit& u, int wr, int wc, int fr, int fq, LAS float* red, int par) const {
        asm volatile("" : "+v"(fr), "+v"(fq), "+s"(wr), "+s"(wc));
        const int b = u.pm >> 3; const int col0 = u.pn * 256 + wc * 32 + 8 * fq; const int rl0 = wr * 64 + fr;
        const LAS float* cst = red + XL_CONST + par * 1280 + wc * 32 + 8 * fq;
        bf16_t* const X1 = (bf16_t*)(ws + WS_X1); bf16_t* const H2 = (bf16_t*)(ws + WS_H2); const float* const MOD = (const float*)(ws + WS_MOD);
        {
            f32x4 gv[2][2];
#pragma unroll
            for (int bj = 0; bj < 2; ++bj)
#pragma unroll
                for (int n = 0; n < 2; ++n) gv[bj][n] = *(const LAS f32x4*)(cst + 256 + 128 * bj + 4 * n);
#pragma unroll
            for (int ai = 0; ai < 2; ++ai) {
                const size_t off0 = ((size_t)u.pm * 256 + ai * 128 + rl0) * DM + col0;
                f32x4 xs[4][2][2];
#pragma unroll
                for (int m = 0; m < 4; ++m)
#pragma unroll
                    for (int bj = 0; bj < 2; ++bj)
#pragma unroll
                        for (int n = 0; n < 2; ++n) xs[m][bj][n] = *(const f32x4*)(base + off0 + (size_t)m * 16 * DM + 128 * bj + 4 * n);
#pragma unroll
                for (int m = 0; m < 4; ++m) { float ss = 0.f;
#pragma unroll
                    for (int bj = 0; bj < 2; ++bj) {
#pragma unroll
                        for (int n = 0; n < 2; ++n) { const f32x4 v = xs[m][bj][n] + gv[bj][n] * acc[ai][bj][m][n]; acc[ai][bj][m][n] = v; ss += dot4(v); }
                        st16(X1 + off0 + (size_t)m * 16 * DM + 128 * bj, pack8(acc[ai][bj][m][0], acc[ai][bj][m][1])); }
                    ss = xsum32(xsum16(ss));
                    if (fq == 0) red[(ai * 128 + m * 16 + rl0) * 8 + wc] = ss;
                }
                asm volatile("" ::: "memory");
            }
        }
        LDS_BARRIER();
        const int tid = tid_from_wave(wr * 4 + wc);
        if (tid < 256) {
            const f32x4 t = *(const LAS f32x4*)(red + tid * 8);
            const float mine = (t[0] + t[1]) + (t[2] + t[3]);
            unsigned long long* slot = (unsigned long long*)(ws + WS_PART) + ((size_t)u.pm * 256 + tid) * 4;
            { unsigned tg; asm volatile("v_mov_b32 %0, 1" : "=v"(tg));
              __hip_atomic_store(slot + u.pn, ((unsigned long long)tg << 32) | (unsigned long long)__float_as_uint(mine), __ATOMIC_RELAXED, __HIP_MEMORY_SCOPE_AGENT); }
            float tot = mine;
#pragma unroll
            for (int k = 1; k < 4; ++k) { const int pk = (u.pn + k) & 3; unsigned long long w; unsigned sp = 0;
                for (;;) { w = __hip_atomic_load(slot + pk, __ATOMIC_RELAXED, __HIP_MEMORY_SCOPE_AGENT); if ((unsigned)(w >> 32) == 1u || ++sp > (1u << 22)) break; __builtin_amdgcn_s_sleep(1); }
                tot += __uint_as_float((unsigned)w); }
            red[tid * 8 + 4] = __builtin_amdgcn_rsqf(tot * (1.0f / DM) + EPS);
        }
        LDS_BARRIER();
        {
            f32x4 Gv[2][2], Sv[2][2];
#pragma unroll
            for (int bj = 0; bj < 2; ++bj)
#pragma unroll
                for (int n = 0; n < 2; ++n) { const int c = col0 + 128 * bj + 4 * n;
                    Gv[bj][n] = *(const LAS f32x4*)(cst + 512 + 128 * bj + 4 * n) * (*(const LAS f32x4*)(cst + 768 + 128 * bj + 4 * n) + 1.0f); Sv[bj][n] = *(const LAS f32x4*)(cst + 1024 + 128 * bj + 4 * n); (void)c; }
#pragma unroll
            for (int ai = 0; ai < 2; ++ai)
#pragma unroll
                for (int m = 0; m < 4; ++m) {
                    const float r = red[(ai * 128 + m * 16 + rl0) * 8 + 4];
                    bf16_t* rp = H2 + ((size_t)u.pm * 256 + ai * 128 + m * 16 + rl0) * DM + col0;
#pragma unroll
                    for (int bj = 0; bj < 2; ++bj) st16(rp + 128 * bj, pack8(acc[ai][bj][m][0] * r * Gv[bj][0] + Sv[bj][0], acc[ai][bj][m][1] * r * Gv[bj][1] + Sv[bj][1]));
                }
        }
    }
};

__device__ __forceinline__ float dpp_shr1(float v) { return __builtin_bit_cast(float, __builtin_amdgcn_update_dpp(0, __builtin_bit_cast(int, v), 0x111, 0xF, 0xF, true)); }
__device__ __forceinline__ f32x4 dpp_shr1(f32x4 v) { f32x4 r; r[0] = dpp_shr1(v[0]); r[1] = dpp_shr1(v[1]); r[2] = dpp_shr1(v[2]); r[3] = dpp_shr1(v[3]); return r; }
struct EpiUp {
    static constexpr bool APERM = true, PREFETCH = true, FP8 = false;
    unsigned char* ws; const float *cw, *cb;
    __device__ __forceinline__ void prefetch(const Unit& u, LAS float* xl, int par, int wid, int lane) const {
        asm volatile("" : "+v"(lane));
        if (wid < 4) { const float* src = (wid < 3 ? cw + (size_t)wid * DFF2 : cb) + (lane < 32 ? 128 * u.pn + 4 * lane : DFF + 128 * u.pn + 4 * (lane - 32));
            glds16_(src, (unsigned)__builtin_amdgcn_readfirstlane((unsigned)(uintptr_t)(xl + par * 1024 + wid * 256))); }
    }
    __device__ __forceinline__ void operator()(const f32x4 (&acc)[2][2][4][2], const Unit& u, int wr, int wc, int fr, int fq, LAS float* xl, int par) const {
        asm volatile("" : "+v"(fr), "+v"(fq), "+s"(wr), "+s"(wc));
        const int j = u.pn; const int cc0 = 32 * wc + 8 * fq;
        bf16_t* const ACT = (bf16_t*)(ws + WS_ACT); bf16_t* const RAW4 = (bf16_t*)(ws + WS_RAW4);
        const LAS float* W = xl + par * 1024 + cc0;
#pragma unroll
        for (int ai = 0; ai < 2; ++ai) {
            const size_t blk = (size_t)u.pm * 4 + 2 * ai + wr;
            u32x2 pend[4];
#pragma unroll
            for (int n = 0; n < 2; ++n) {
                const f32x4 wg0 = *(const LAS f32x4*)(W + 4 * n), wg1 = *(const LAS f32x4*)(W + 256 + 4 * n), wg2 = *(const LAS f32x4*)(W + 512 + 4 * n), bg = *(const LAS f32x4*)(W + 768 + 4 * n);
                const f32x4 wv0 = *(const LAS f32x4*)(W + 128 + 4 * n), wv1 = *(const LAS f32x4*)(W + 384 + 4 * n), wv2 = *(const LAS f32x4*)(W + 640 + 4 * n), bv = *(const LAS f32x4*)(W + 896 + 4 * n);
                const f32x4 g2s = dpp_shr1(acc[ai][0][2][n]), g3s = dpp_shr1(acc[ai][0][3][n]), v2s = dpp_shr1(acc[ai][1][2][n]), v3s = dpp_shr1(acc[ai][1][3][n]);
#pragma unroll
                for (int m = 0; m < 4; ++m) {
                    const f32x4 gr = acc[ai][0][m][n], vr = acc[ai][1][m][n];
                    const f32x4 gp1 = m == 0 ? g3s : acc[ai][0][m - 1 < 0 ? 0 : m - 1][n], gp2 = m == 0 ? g2s : (m == 1 ? g3s : acc[ai][0][m - 2 < 0 ? 0 : m - 2][n]);
                    const f32x4 vp1 = m == 0 ? v3s : acc[ai][1][m - 1 < 0 ? 0 : m - 1][n], vp2 = m == 0 ? v2s : (m == 1 ? v3s : acc[ai][1][m - 2 < 0 ? 0 : m - 2][n]);
                    const f32x4 G = wg2 * gr + (wg1 * gp1 + (wg0 * gp2 + bg)), V = wv2 * vr + (wv1 * vp1 + (wv0 * vp2 + bv));
                    f32x4 a;
#pragma unroll
                    for (int e = 0; e < 4; ++e) a[e] = G[e] * __builtin_amdgcn_rcpf(1.0f + __builtin_amdgcn_exp2f(-LOG2E * G[e])) * V[e];
                    if (n == 0) pend[m] = pack4(a);
                    else if (m >= 2 || fr > 0) { const u32x2 hi2 = pack4(a); const unsigned boff = (((unsigned)blk * 64u + 4u * fr + m) * DFF + 128u * j + cc0) * 2u;
                        st16o(ACT, boff, (u32x4){pend[m].x, pend[m].y, hi2.x, hi2.y}); }
                    if ((m < 2 && fr == 0) || (m >= 2 && fr == 15)) { const unsigned roff = (((unsigned)blk * 4u + m) * DFF2 + 256u * j + cc0 + 4u * n) * 2u; *(u32x2*)((unsigned char*)RAW4 + roff) = pack4(gr); *(u32x2*)((unsigned char*)RAW4 + roff + 256u) = pack4(vr); }
                }
            }
            asm volatile("" ::: "memory");
        }
    }
};

namespace att {
__device__ __forceinline__ int crow(int r, int hi) { return (r & 3) + 8 * (r >> 2) + 4 * hi; }
__device__ __forceinline__ void glds16(const void* gsrc, unsigned lds_dst) { unsigned keep;
    asm volatile("s_mov_b32 %0, m0\n\ts_mov_b32 m0, %2\n\ts_nop 0\n\tglobal_load_lds_dwordx4 %1, off\n\ts_mov_b32 m0, %0" : "=&s"(keep) : "v"(gsrc), "s"(lds_dst) : "memory"); }
__device__ __forceinline__ void glds16s(const void* sbase, unsigned voff, unsigned lds_dst) { unsigned keep;
    asm volatile("s_mov_b32 %0, m0\n\ts_mov_b32 m0, %3\n\ts_nop 0\n\tglobal_load_lds_dwordx4 %1, %2\n\ts_mov_b32 m0, %0" : "=&s"(keep) : "v"(voff), "s"(sbase), "s"(lds_dst) : "memory"); }
__device__ __forceinline__ float max3f(float a, float b, float c) { float r; asm("v_max3_f32 %0, %1, %2, %3" : "=v"(r) : "v"(a), "v"(b), "v"(c)); return r; }
__device__ __forceinline__ float rowmax(const f32x16& p0, const f32x16& p1) {
    float a = max3f(p0[0], p0[1], p1[0]), b = max3f(p0[2], p0[3], p1[1]); a = max3f(a, p1[2], p1[3]);
#pragma unroll
    for (int r = 4; r < 16; r += 4) { a = max3f(a, p0[r], p0[r + 1]); b = max3f(b, p0[r + 2], p0[r + 3]); a = max3f(a, p1[r], p1[r + 1]); b = max3f(b, p1[r + 2], p1[r + 3]); }
    const float m = fmaxf(a, b);
    auto rr = __builtin_amdgcn_permlane32_swap(__float_as_uint(m), __float_as_uint(m), false, false);
    return fmaxf(__uint_as_float(rr[0]), __uint_as_float(rr[1]));
}
typedef short v4i16_t __attribute__((ext_vector_type(4)));
__device__ __forceinline__ s16x4 vtr(const LAS unsigned char* p) { return __builtin_bit_cast(s16x4, __builtin_amdgcn_ds_read_tr16_b64_v4i16((LAS v4i16_t*)p)); }
__device__ __forceinline__ void pv(f32x16* o, const LAS unsigned char* vp, bf16x8 pa0, bf16x8 pa1, bf16x8 pa2, bf16x8 pa3) {
#pragma unroll
    for (int d0 = 0; d0 < 2; ++d0) { s16x4 lo[4], hi[4];
        __builtin_amdgcn_sched_barrier(0);
#pragma unroll
        for (int ks = 0; ks < 4; ++ks) { lo[ks] = vtr(vp + d0 * 4096 + ks * 1024); hi[ks] = vtr(vp + d0 * 4096 + ks * 1024 + 512); }
#define PK(k) (bf16x8){lo[k][0], lo[k][1], lo[k][2], lo[k][3], hi[k][0], hi[k][1], hi[k][2], hi[k][3]}
        o[d0] = __builtin_amdgcn_mfma_f32_32x32x16_bf16(pa0, PK(0), o[d0], 0, 0, 0);
        o[d0] = __builtin_amdgcn_mfma_f32_32x32x16_bf16(pa1, PK(1), o[d0], 0, 0, 0);
        o[d0] = __builtin_amdgcn_mfma_f32_32x32x16_bf16(pa2, PK(2), o[d0], 0, 0, 0);
        o[d0] = __builtin_amdgcn_mfma_f32_32x32x16_bf16(pa3, PK(3), o[d0], 0, 0, 0);
#undef PK
    }
}
constexpr int NSLOT = 4;
constexpr int ATT_LDS_BYTES = 3 * 6144 + 3 * 4096 + 8 * 256 + 2048 + 3 * 16384 + 8 * 2048 + 4096;

__device__ __forceinline__ float wave_max(float v) {
#pragma unroll
    for (int o = 1; o < 64; o <<= 1) v = fmaxf(v, __shfl_xor(v, o));
    return v;
}
template <int DQK, bool CA>
__device__ __forceinline__ void attn_run(int tid, int b, int h, unsigned ulist, int nu, const unsigned char* Q, const unsigned char* K, const unsigned char* V, unsigned char* O, float* REF, unsigned* refcnt, const float* PARTV, const float* relb, float S0, LAS unsigned char* shm) {
    constexpr int NQ = (DQK + 63) / 64, NGQ = 2 * NQ, NQL = 2 * NQ, NCH = DQK / 16, KSLOT = NCH * 1024, VSLOT = 4096, NS = 3;
    constexpr int LDS_K = 0, LDS_V = NS * KSLOT, LDS_WS = LDS_V + NS * VSLOT, LDS_TAB = LDS_WS + 8 * 256, LDS_IMG = LDS_TAB + 2048, LDS_OST = LDS_IMG + (CA ? 3 * 16384 : 0), LDS_VB = LDS_OST + 8 * 2048;
    constexpr int LDQ = CA ? 512 : 768, LDV = 512, LDO = 1024, OCOL = CA ? 512 : 0;
    const int lane = tid & 63, r32 = lane & 31, hi = lane >> 5; const int wid = __builtin_amdgcn_readfirstlane(tid >> 6);
    const long rowbase = (long)b * SEQ; const int tidl = wid * 64 + lane;
    const unsigned lds0 = (unsigned)(uintptr_t)shm;
    LAS float* tab = (LAS float*)(shm + LDS_TAB);
    const unsigned char* Kb = K + rowbase * LDQ + h * DQK; const unsigned char* Vb = V + rowbase * LDV + h * 64;
    const bool kw = wid < NCH, vw = wid >= 4;
    const unsigned kvoff = (unsigned)(lane * LDQ + (wid < NCH ? wid : 0) * 16);
    const unsigned vvoff = (unsigned)((16 * (wid & 3) + (lane >> 2)) * LDV + (lane & 3) * 16);
#define SBAR() __builtin_amdgcn_sched_barrier(0)
#define PIN(x) asm volatile("" : "+v"(x))
#define DMA_K(t, sl) do { if (kw) glds16s(Kb + (long)(t) * 64 * LDQ, kvoff, (unsigned)__builtin_amdgcn_readfirstlane(lds0 + LDS_K + (sl) * KSLOT + wid * 1024)); } while (0)
#define DMA_V(t, sl) do { if (vw) glds16s(Vb + (long)(t) * 64 * LDV, vvoff, (unsigned)__builtin_amdgcn_readfirstlane(lds0 + LDS_V + (sl) * VSLOT + (wid & 3) * 1024)); } while (0)
#define WAIT_BAR(N) asm volatile("s_waitcnt vmcnt(%0) lgkmcnt(0)\n\ts_barrier" :: "n"(N) : "memory")
#define WAIT_KV(nK, nV, X) do { if (kw && vw) WAIT_BAR((nK) + (nV) + (X)); else if (kw) WAIT_BAR((nK) + (X)); else if (vw) WAIT_BAR((nV) + (X)); else WAIT_BAR(X); } while (0)
#define TVALID(tau) (CA ? ((tau) + t0 <= cw && (tau) + t0 >= cw - 8) : ((tau) + t0 <= cw))
#define TABS(x) ((x) < NT ? t0 + (x) : t0n + (x) - NT)
#define T0OF(u_) (CA ? (4 * (u_) - 8 > 0 ? 4 * (u_) - 8 : 0) : 0)
#define QLOAD(u_) do { const unsigned char* Qw_ = Q + (rowbase + (u_) * 256 + wid * 32) * LDQ + h * DQK; const int lq_ = tid_from_wave(0); const unsigned qo_ = (unsigned)((lq_ & 31) * LDQ); \
        _Pragma("unroll") for (int p = 0; p < NQ; ++p) { const unsigned po_ = qo_ + ((p == 1 && DQK == 96) ? 64u : (unsigned)(p * 64 + (lq_ >> 5) * 32)); \
            const i32x4 lo_ = *(const i32x4*)(Qw_ + po_), hi_ = *(const i32x4*)(Qw_ + po_ + 16); qr[p] = __builtin_shufflevector(lo_, hi_, 0, 1, 2, 3, 4, 5, 6, 7); } } while (0)
#define QREADY() do { _Pragma("unroll") for (int p = 0; p < NQ; ++p) asm volatile("" :: "v"(qr[p])); \
        if (DQK == 96) { _Pragma("unroll") for (int e = 0; e < 8; ++e) qr[NQ - 1][e] = hi ? (e == 0 ? 0x38 : 0) : qr[NQ - 1][e]; } } while (0)
#ifndef SH_EXTRA
#define SH_EXTRA 0
#endif
    float SHI = fmaxf(ceilf(S0 - 15.5f), 0.0f) + SH_EXTRA; float pcadd = 4.0f * (15.0f - SHI);
    const int cbyte = __builtin_amdgcn_cvt_pk_fp8_f32(pcadd, 0.0f, 0, false) & 0xff;
    float tabc = 0.f;
    const LAS unsigned char* vp0 = shm + LDS_V + (4 * hi + (((lane & 15) >> 1) & 3) + 8 * ((lane & 15) >> 3)) * 64 + ((lane >> 4) & 1) * 16 + (lane & 1) * 8;
    const LAS unsigned char* kp0 = shm + LDS_K + hi * 2048 + r32 * 16;
    const LAS unsigned char* kp1 = shm + LDS_K + 4096 + r32 * 16;
    const LAS unsigned char* imgp = shm + LDS_IMG + (wid & 1) * 8192 + lane * 16;
    i32x8 qr[NQ]; i32x8 kf[NGQ]  ; i32x8 vb[2]; i32x8 pw; f32x16 pA0, pA1, pB0, pB1;
    i32x8 ones8;
#pragma unroll
    for (int e = 0; e < 8; ++e) ones8[e] = 0x38383838;
    PIN(ones8);
    int sl_prev = 0, sl_cur = 0, sl_next = 1;
#define ROT() do { sl_prev = sl_cur; sl_cur = sl_next; sl_next = (sl_next == NS - 1) ? 0 : sl_next + 1; } while (0)
#define KFL(g, ks_) do { const LAS unsigned char* a_ = (((g) >> 1) ? kp1 : kp0) + (ks_) + ((g) & 1) * 512; const i32x4 lo_ = *(const LAS i32x4*)(a_), hi_ = *(const LAS i32x4*)(a_ + 1024); kf[g] = __builtin_shufflevector(lo_, hi_, 0, 1, 2, 3, 4, 5, 6, 7); \
        if (DQK == 96 && ((g) >> 1)) kf[g][0] = hi ? cbyte : kf[g][0]; } while (0)
#define QKM(kfr, qfr, C) __builtin_amdgcn_mfma_scale_f32_32x32x64_f8f6f4(kfr, qfr, C, 0, 0, 0, 0, 0, 0)
#define VRD(i, vp_) do { const i32x2 t_ = __builtin_amdgcn_ds_read_tr8_b64_v2i32((LAS i32x2*)((vp_) + ((i) & 3) * 1024 + ((i) >> 2) * 32)); vb[(i) >> 2][2 * ((i) & 3)] = t_[0]; vb[(i) >> 2][2 * ((i) & 3) + 1] = t_[1]; } while (0)
#define PEL(P0, P1, e) ((e) < 16 ? P0[(e) & 15] : P1[(e) & 15])
#define PWSET(w, P0, P1) do { unsigned x_ = (unsigned)undef_i32(); x_ = __builtin_amdgcn_cvt_pk_u8_f32(PEL(P0, P1, 4 * (w)), 0, x_); x_ = __builtin_amdgcn_cvt_pk_u8_f32(PEL(P0, P1, 4 * (w) + 1), 1, x_); \
        x_ = __builtin_amdgcn_cvt_pk_u8_f32(PEL(P0, P1, 4 * (w) + 2), 2, x_); x_ = __builtin_amdgcn_cvt_pk_u8_f32(PEL(P0, P1, 4 * (w) + 3), 3, x_); pw[w] = (int)x_; } while (0)
#define PVM(d0) o[d0] = __builtin_amdgcn_mfma_scale_f32_32x32x64_f8f6f4(pw, vb[d0], o[d0], 1, 0, 0, 0, 0, 0)
#define PVL() lacc = __builtin_amdgcn_mfma_scale_f32_32x32x64_f8f6f4(pw, ones8, lacc, 1, 0, 0, 0, 0, 0)
#define QK_FIRST(C0, C1, A0, A1, tau) do { const int dist_ = cw - ((tau) + t0); \
        if (CA && TVALID(tau) && dist_ < 3) { const LAS unsigned char* ip_ = imgp + dist_ * 16384; \
            _Pragma("unroll") for (int g = 0; g < 4; ++g) { const f32x4 x_ = *(const LAS f32x4*)(ip_ + g * 1024); C0[4 * g] = x_[0]; C0[4 * g + 1] = x_[1]; C0[4 * g + 2] = x_[2]; C0[4 * g + 3] = x_[3]; } \
            C0 = QKM(A0, qr[0], C0); \
            _Pragma("unroll") for (int g = 0; g < 4; ++g) { const f32x4 y_ = *(const LAS f32x4*)(ip_ + (g + 4) * 1024); C1[4 * g] = y_[0]; C1[4 * g + 1] = y_[1]; C1[4 * g + 2] = y_[2]; C1[4 * g + 3] = y_[3]; } \
            C1 = QKM(A1, qr[0], C1); } \
        else if (TVALID(tau)) { const f32x16 cz_ = f32x16{}; C0 = QKM(A0, qr[0], cz_); C1 = QKM(A1, qr[0], cz_); }        \
        else { f32x16 cz_; _Pragma("unroll") for (int r = 0; r < 16; ++r) cz_[r] = -INFINITY; C0 = QKM(A0, qr[0], cz_); C1 = QKM(A1, qr[0], cz_); } } while (0)
#define FILLA(i0, i1) do { _Pragma("unroll") for (int w = (8 * (i0)) / NGQ; w < (8 * (i1)) / NGQ; ++w) PWSET(w, P0_, P1_); \
        PIN(pw); } while (0)
#define PHASE_A(C0, C1, P0, P1, tau, vsl, GK, GV, kdst, vdst) do { const LAS unsigned char* vp_ = vp0 + (vsl) * VSLOT; f32x16& P0_ = P0; f32x16& P1_ = P1; \
        VRD(0, vp_); VRD(1, vp_); SBAR(); \
        QK_FIRST(C0, C1, kf[0], kf[1], tau); \
        FILLA(0, 2); SBAR(); \
        _Pragma("unroll") for (int i = 2; i < NGQ; ++i) { \
            VRD(2 * i - 2, vp_); VRD(2 * i - 1, vp_); SBAR(); \
            if ((i & 1) == 0) C0 = QKM(kf[i], qr[i >> 1], C0); else C1 = QKM(kf[i], qr[i >> 1], C1); \
            FILLA(i, i + 1); \
            if (i == NGQ - 2 && (GK)) DMA_K(TABS((tau) + 3), kdst); if (i == NGQ - 1 && (GV)) DMA_V(TABS((tau) + 1), vdst);     \
            SBAR(); } \
        if (NGQ == 2) { VRD(2, vp_); VRD(3, vp_); VRD(4, vp_); VRD(5, vp_); if (GK) DMA_K(TABS((tau) + 3), kdst); if (GV) DMA_V(TABS((tau) + 1), vdst); SBAR(); } \
        } while (0)
#define PHASE_B(C0, C1, GL, ksl, vsl, tau) do { const int kso_ = (ksl) * KSLOT; const LAS unsigned char* vq_ = vp0 + (vsl) * VSLOT; \
        const float cadd_ = (CA && TVALID(tau) && cw - ((tau) + t0) < 3) ? 0.0f : pcadd; (void)cadd_; \
        _Pragma("unroll") for (int j = 0; j < 3; ++j) { \
            if (GL) { _Pragma("unroll") for (int g = (NGQ * j + 2) / 3; g < (NGQ * (j + 1) + 2) / 3; ++g) KFL(g, kso_); SBAR(); } \
            if (j == 0) { PVM(0); VRD(6, vq_); VRD(7, vq_); }       \
            else if (j == 1) PVM(1); else PVL(); \
            if (CA) { _Pragma("unroll") for (int e = (32 * j) / 3; e < (32 * (j + 1)) / 3; ++e) { if (e < 16) C0[e & 15] += cadd_; else C1[e & 15] += cadd_; } }        \
            PIN(C0); PIN(C1); SBAR(); } } while (0)
#define STEP(C0, C1, P0, P1, tau, GK, GV, GL) do { SBAR(); \
        PHASE_A(C0, C1, P0, P1, tau, sl_prev, GK, GV, sl_cur, sl_next); SBAR(); \
        PHASE_B(C0, C1, GL, sl_next, sl_prev, tau); } while (0)
#define ENDW(tau) do { if (has_next || (tau) + 3 < NT) { WAIT_KV(1, 1, 0); } else if ((tau) + 2 < NT) { WAIT_KV(0, 1, 0); } else { WAIT_BAR(0); } } while (0)
    for (int ui = 0; ui < nu; ++ui) {
        const int u = (int)((ulist >> (8 * ui)) & 255u); const bool has_next = ui + 1 < nu; const int un = has_next ? (int)((ulist >> (8 * (ui + 1))) & 255u) : 0;
        const int t0 = T0OF(u), t1 = 4 * u + 3, cw = 4 * u + (wid >> 1), NT = t1 - t0 + 1, t0n = T0OF(un);
        f32x16 o[2], lacc; o[0] = f32x16{}; o[1] = f32x16{}; lacc = f32x16{};
        int s0, s1, s2;
        if (ui == 0) {
            s0 = 0; s1 = 1; s2 = 2;
            DMA_K(t0 + 0, 0); DMA_V(t0 + 0, 0); DMA_K(t0 + 1, 1); DMA_K(t0 + 2, 2);
            QLOAD(u);
            if (CA) { for (int i = tidl; i < 320; i += 512) tab[i] = relb[h * 257 + (i < 256 ? i : 256)] * LOG2E; }
            if (wid == 0) { const int t2 = tid_from_wave(0); const float* pv = PARTV + (size_t)b * 16 * 1024 + OCOL + h * 64 + t2; float sm = 0.f;
#pragma unroll
                for (int j = 0; j < 16; ++j) sm += pv[j * 1024];
                sm *= (1.0f / SEQ); ((LAS float*)(shm + LDS_VB))[512 + t2] = sm; REF[(size_t)b * 1024 + OCOL + h * 64 + t2] = sm;
                asm volatile("s_waitcnt vmcnt(0)" ::: "memory"); __builtin_amdgcn_fence(__ATOMIC_RELEASE, "agent");
                if (t2 == 0) __hip_atomic_fetch_add(refcnt, 1u, __ATOMIC_RELAXED, __HIP_MEMORY_SCOPE_AGENT); }
            QREADY();
            if (CA) {
                asm volatile("s_waitcnt lgkmcnt(0)\n\ts_barrier" ::: "memory");
                float bm = 0.f; for (int i = lane; i < 257; i += 64) bm = fmaxf(bm, fabsf(tab[i]));
                S0 += 2.0f * wave_max(bm); SHI = fmaxf(ceilf(S0 - 15.5f), 0.0f) + SH_EXTRA; pcadd = 4.0f * (15.0f - SHI); tabc = tab[256];
                LAS float* img = (LAS float*)(shm + LDS_IMG);
                for (int i = tidl; i < 3 * 2 * 8 * 256; i += 512) { const int e = i & 3, ln = (i >> 2) & 63, g = (i >> 8) & 7, hf = (i >> 11) & 1, ds = i >> 12;
                    img[i] = 4.0f * (tab[64 * ds + 32 * hf + (ln & 31) + 128 - 4 * (ln >> 5) - (e + 8 * (g & 3)) - 32 * (g >> 2)] - tabc) + pcadd; }
            }
            WAIT_KV(2, 1, 0);
        } else {
            s0 = sl_cur; s1 = sl_next; s2 = (s1 == NS - 1) ? 0 : s1 + 1;
            QREADY();
        }
        { const int ks0_ = s0 * KSLOT;
#pragma unroll
          for (int g = 0; g < NGQ; ++g) KFL(g, ks0_);
          QK_FIRST(pA0, pA1, kf[0], kf[1], 0);
#pragma unroll
          for (int g = 2; g < NGQ; ++g) { if ((g & 1) == 0) pA0 = QKM(kf[g], qr[g >> 1], pA0); else pA1 = QKM(kf[g], qr[g >> 1], pA1); } }
        if (CA) { const float c0_ = (TVALID(0) && cw - t0 < 3) ? 0.0f : pcadd;
#pragma unroll
            for (int r = 0; r < 16; ++r) { pA0[r] += c0_; pA1[r] += c0_; } }
        WAIT_BAR(0);
        DMA_K(TABS(3), s0); DMA_V(TABS(1), s1);
        { const int ks1_ = s1 * KSLOT;
#pragma unroll
          for (int g = 0; g < NGQ; ++g) KFL(g, ks1_); }
        WAIT_KV(1, 1, 0);
        sl_prev = s0; sl_cur = s1; sl_next = s2;
        int tau = 1;
        for (; tau + 5 < NT; tau += 2) {
            STEP(pB0, pB1, pA0, pA1, tau, true, true, true);     WAIT_KV(1, 1, 0); ROT();
            STEP(pA0, pA1, pB0, pB1, tau + 1, true, true, true); WAIT_KV(1, 1, 0); ROT();
        }
        for (; tau + 1 < NT; tau += 2) {
            STEP(pB0, pB1, pA0, pA1, tau, (has_next || tau + 3 < NT), (has_next || tau + 1 < NT), (tau + 1 < NT));     ENDW(tau);     ROT();
            STEP(pA0, pA1, pB0, pB1, tau + 1, (has_next || tau + 4 < NT), (has_next || tau + 2 < NT), (tau + 2 < NT)); ENDW(tau + 1); ROT();
        }
        STEP(pB0, pB1, pA0, pA1, NT - 1, has_next, has_next, false);
        int vdr = sl_cur;
        if (has_next) { QLOAD(un);
            WAIT_KV(1, 1, NQL); ROT(); vdr = sl_prev; }
        { { const LAS unsigned char* vd_ = vp0 + vdr * VSLOT;
#pragma unroll
            for (int i = 0; i < 8; ++i) VRD(i, vd_);
#pragma unroll
            for (int w = 0; w < 8; ++w) PWSET(w, pB0, pB1);
            PVM(0); PVM(1); PVL(); } }
        { const int le = tid_from_wave(0), r32e = le & 31, hie = le >> 5;
          float rli[16];
#pragma unroll
          for (int r = 0; r < 16; ++r) rli[r] = __builtin_amdgcn_rcpf(lacc[r]);
          unsigned char* Ow = O + (rowbase + u * 256 + wid * 32) * LDO + OCOL + h * 64;
          LAS unsigned char* stg = shm + LDS_OST + wid * 2048;
          const LAS float* vbm = (const LAS float*)(shm + LDS_VB) + 512; const float vb0 = vbm[r32e], vb1 = vbm[32 + r32e];
#pragma unroll
          for (int r = 0; r < 16; ++r) { const int orow = crow(r, hie);
              const float y0 = (o[0][r] * rli[r] - vb0) * F8_O_SCALE, y1 = (o[1][r] * rli[r] - vb1) * F8_O_SCALE;
              const unsigned w = (unsigned)__builtin_amdgcn_cvt_pk_fp8_f32(__builtin_amdgcn_fmed3f(y0, -448.f, 448.f), __builtin_amdgcn_fmed3f(y1, -448.f, 448.f), undef_i32(), false);
              stg[orow * 64 + r32e] = (unsigned char)(w & 255u); stg[orow * 64 + 32 + r32e] = (unsigned char)((w >> 8) & 255u); }
#pragma unroll
          for (int i = 0; i < 2; ++i) { const int row = i * 16 + (le >> 2), ch = le & 3; const u32x4 v = *(const LAS u32x4*)(stg + row * 64 + ch * 16); st16((char*)Ow + (unsigned)(row * LDO + ch * 16), v); } }
    }
    asm volatile("s_waitcnt lgkmcnt(0)\n\ts_barrier" ::: "memory");
#undef SBAR
#undef PIN
#undef DMA_K
#undef WAIT_KV
#undef QREADY
#undef KFL
#undef QKM
#undef FILLA
#undef DMA_V
#undef WAIT_BAR
#undef TVALID
#undef TABS
#undef T0OF
#undef QLOAD
#undef VRD
#undef PVM
#undef PVL
#undef PEL
#undef PWSET
#undef QK_FIRST
#undef PHASE_A
#undef PHASE_B
#undef ROT
#undef STEP
#undef ENDW
}
}

constexpr int NWAVES = 8;
constexpr int NPHASE = 10;
constexpr int N_LAUNCHES = MK_N_LAUNCHES;
static_assert(N_LAUNCHES == 1 || N_LAUNCHES == NPHASE, "MK_N_LAUNCHES is 1 or 10");

constexpr int RING_BYTES = 131072, XL_OFF = RING_BYTES, LDS_BYTES = 155648, LDSCTL_OFF = LDS_BYTES - 1024, MISC_OFF = LDSCTL_OFF + 320;
static_assert(XL_OFF + 8192 + 12288 <= LDSCTL_OFF && att::ATT_LDS_BYTES <= LDSCTL_OFF, "LDS map");

typedef GAS unsigned gu32;
#define RLX_AGENT __ATOMIC_RELAXED, __HIP_MEMORY_SCOPE_AGENT

#define XB_TMO      128
#define XB_XCNT(j)  (256  + 64 * (j))
#define XB_XSUB(j)  (1280 + 64 * (j))
#define XB_XGEN(j)  (2304 + 64 * (j))
#define XB_TOP      3328
#define XB_TOPGEN   3392
#define XCD_BAR_WORDS 3456
#define XB_SPIN_CAP (1u << 18)
__device__ __forceinline__ unsigned xb_ld(unsigned* p)              { return __hip_atomic_load(p, __ATOMIC_RELAXED, __HIP_MEMORY_SCOPE_AGENT); }
__device__ __forceinline__ unsigned xb_add(unsigned* p, unsigned v) { return __hip_atomic_fetch_add(p, v, __ATOMIC_RELAXED, __HIP_MEMORY_SCOPE_AGENT); }
__device__ __forceinline__ unsigned xb_xcc_id() { return (unsigned)__builtin_amdgcn_s_getreg((3 << 11) | 20) & 0xFu; }
#define XB_SPIN(cond, bar) do { unsigned _sp = 0; while (cond) { __builtin_amdgcn_s_sleep(1); \
    if ((++_sp & 255u) == 0u) { if (xb_ld(&(bar)[XB_TMO])) break; if (_sp > XB_SPIN_CAP) { atomicAdd(&(bar)[XB_TMO], 1u); break; } } } } while (0)
struct XcdBarrier { unsigned* bar; unsigned x; volatile LAS unsigned* st; int wave; };
__device__ __forceinline__ XcdBarrier xcd_barrier_post(unsigned* bar, volatile LAS unsigned* st, int wave) {
    XcdBarrier b; b.bar = bar; b.x = xb_xcc_id(); b.st = st; b.wave = wave;
    if (tid_from_wave(wave) == 0) (void)xb_add(&bar[XB_XCNT(b.x)], 1u);
    return b;
}
__device__ __forceinline__ void xcd_barrier_complete(unsigned* bar, unsigned x, unsigned& nloc, unsigned& nx) {
    const unsigned G = gridDim.x * gridDim.y * gridDim.z;
    unsigned sum, cnt, mine, sp = 0u;
    for (;;) {
        sum = 0u; cnt = 0u; mine = 0u;
#pragma unroll
        for (unsigned j = 0; j < 16; ++j) { const unsigned c = xb_ld(&bar[XB_XCNT(j)]); sum += c; cnt += (c > 0u) ? 1u : 0u; mine = (j == x) ? c : mine; }
        if (sum == G) break;
        __builtin_amdgcn_s_sleep(1);
        if ((++sp & 255u) == 0u) { if (xb_ld(&bar[XB_TMO])) break; if (sp > XB_SPIN_CAP) { atomicAdd(&bar[XB_TMO], 1u); break; } }
    }
    nloc = mine > 0u ? mine : 1u; nx = cnt > 0u ? cnt : 1u;
}
__device__ __forceinline__ void xcd_barrier(const XcdBarrier& b) {
    asm volatile("s_waitcnt vmcnt(0)" ::: "memory");
    __syncthreads();
    if (tid_from_wave(b.wave) == 0) {
        unsigned* bar = b.bar;
        __builtin_amdgcn_s_waitcnt(0);
        unsigned nloc = b.st[0], nx = b.st[1];
        if (nloc == 0u) { xcd_barrier_complete(bar, b.x, nloc, nx); b.st[0] = nloc; b.st[1] = nx; }
        const unsigned old = xb_add(&bar[XB_XSUB(b.x)], 1u);
        const unsigned gen = old / nloc;
        if (old + 1u == (gen + 1u) * nloc) {
            __builtin_amdgcn_fence(__ATOMIC_RELEASE, "agent");
            asm volatile("s_waitcnt vmcnt(0)" ::: "memory");
            const unsigned og = xb_add(&bar[XB_TOP], 1u);
            const unsigned tg = og / nx;
            if (og + 1u == (tg + 1u) * nx) xb_add(&bar[XB_TOPGEN], 1u);
            else XB_SPIN(xb_ld(&bar[XB_TOPGEN]) == tg, bar);
            __builtin_amdgcn_fence(__ATOMIC_ACQUIRE, "agent");
            xb_add(&bar[XB_XGEN(b.x)], 1u);
            asm volatile("s_waitcnt vmcnt(0)" ::: "memory");
        } else {
            XB_SPIN(xb_ld(&bar[XB_XGEN(b.x)]) == gen, bar);
            __builtin_amdgcn_fence(__ATOMIC_ACQUIRE, "agent");
            asm volatile("s_waitcnt vmcnt(0)" ::: "memory");
        }
    }
    __syncthreads();
}

struct Args { const void* in[22]; float* out; unsigned char* ws; int ph_lo, ph_hi, li, pad; };
#define ARGF(k) ((const float*)args.in[k])
struct Frame {
    LAS unsigned char* lds; LAS float* xl;
    int tid, lane, wave, vcu, G;
    unsigned char* ws;
};

template <int WHICH> __device__ __forceinline__ int wmap(int n) {
    if (WHICH == 0) {
        if (n < 256) return n;
        if (n < 512) { const int c = n - 256; return c < 160 ? 256 + c : -1; }
        if (n < 1536) { const int t4 = (n - 512) >> 8, which = t4 >> 1, jj = t4 & 1, c = (n - 512) & 255, bj = c >> 7, wc = (c >> 5) & 3, i = c & 31; return 416 + which * 512 + (4 * jj + wc) * 64 + 32 * bj + i; }
        return 416 + 1024 + (n - 1536);
    } else if (WHICH == 1) {
        const int pn = n >> 8, c = n & 255, bj = c >> 7, wc = (c >> 5) & 3, i = c & 31, head = 2 * pn + bj;
        if (wc < 2) return head * 96 + 32 * wc + i;
        if (wc == 2) { const int fq = i >> 3, nn = (i >> 2) & 1, e = i & 3; return head * 96 + 64 + 4 * fq + e + 16 * nn; }
        return -1;
    } else if (WHICH == 2) {
        const int pn = n >> 8, c = n & 255, bj = c >> 7, wc = (c >> 5) & 3, i = c & 31, head = 2 * pn + bj;
        return wc < 2 ? head * 128 + 32 * wc + i : head * 128 + 64 + 32 * (wc - 2) + i;
    } else if (WHICH == 4) {
        const int j = n >> 8, c = n & 255; return c < 128 ? 128 * j + c : DFF + 128 * j + (c - 128);
    }
    return n;
}
template <int WHICH, bool F8 = false> __device__ __forceinline__ void cvt_item(const float* W, int K, int N, bf16_t* WT, int KP, int NP, LAS float* scr, int item, int lane, float f8s = 1.0f) {
    const int nblk = NP / 32, kb = item / nblk, nb = item % nblk, k0 = 64 * kb, n0 = 32 * nb;
    const int src = wmap<WHICH>(n0 + (lane & 31)); const bool live = (src >= 0) && (k0 < K);
    float wv[32];
#pragma unroll
    for (int i = 0; i < 32; ++i) { const int kk = 2 * i + (lane >> 5); wv[i] = live ? __builtin_nontemporal_load(W + (size_t)(k0 + kk) * N + src) : 0.f; }
#pragma unroll
    for (int i = 0; i < 32; ++i) { const int kk = 2 * i + (lane >> 5); scr[kk * 33 + (lane & 31)] = wv[i]; }
    asm volatile("s_waitcnt lgkmcnt(0)" ::: "memory");
    const int c = lane & 7;
#pragma unroll
    for (int j = 0; j < 4; ++j) { const int n = (lane >> 3) + 8 * j; const LAS float* s = scr + (8 * c) * 33 + n;
        if (F8) { u32x2 o; o.x = pk_fp8x4(s[0 * 33] * f8s, s[1 * 33] * f8s, s[2 * 33] * f8s, s[3 * 33] * f8s); o.y = pk_fp8x4(s[4 * 33] * f8s, s[5 * 33] * f8s, s[6 * 33] * f8s, s[7 * 33] * f8s);
            *(u32x2*)((unsigned char*)WT + (size_t)(n0 + n) * KP + k0 + 8 * c) = o; }
        else { u32x4 o; o.x = cvtpk(s[0 * 33], s[1 * 33]); o.y = cvtpk(s[2 * 33], s[3 * 33]); o.z = cvtpk(s[4 * 33], s[5 * 33]); o.w = cvtpk(s[6 * 33], s[7 * 33]);
            *(u32x4*)(WT + (size_t)(n0 + n) * KP + k0 + 8 * c) = o; } }
    asm volatile("s_waitcnt lgkmcnt(0)" ::: "memory");
}
__device__ __forceinline__ void p0_prologue(Frame& F, const Args& args) {
    LAS float* scr = (LAS float*)(F.lds) + F.wave * 4096;
    const int gw = F.vcu * NWAVES + F.wave, NGW = F.G * NWAVES;
    constexpr int I0 = 16 * 64, I1 = 4 * 32, I2 = 4 * 32, I3 = 16 * 32, I4 = 16 * 176, I5 = 44 * 32;
    constexpr int NITEMS = I0 + I1 + I2 + I3 + I4 + I5;
    for (int it = gw; it < NITEMS; it += NGW) {
        int r = it;
        if (r < I0) { cvt_item<0, true>(ARGF(6), 1024, 1952, (bf16_t*)(F.ws + WS_WIN), 1024, 2048, scr, r, F.lane, F8_WIN_SCALE); continue; } r -= I0;
        if (r < I1) { cvt_item<1>(ARGF(9), 256, 768, (bf16_t*)(F.ws + WS_WQUP), 256, 1024, scr, r, F.lane); continue; } r -= I1;
        if (r < I2) { cvt_item<2>(ARGF(10), 128, 1024, (bf16_t*)(F.ws + WS_WKVUP), 256, 1024, scr, r, F.lane); continue; } r -= I2;
        if (r < I3) { cvt_item<3, true>(ARGF(16), 1024, 1024, (bf16_t*)(F.ws + WS_WOUT), 1024, 1024, scr, r, F.lane, F8_WOUT_SCALE); continue; } r -= I3;
        if (r < I4) { cvt_item<4>(ARGF(18), 1024, DFF2, (bf16_t*)(F.ws + WS_WUP), 1024, DFF2, scr, r, F.lane); continue; } r -= I4;
        cvt_item<5>(ARGF(21), DFF, 1024, (bf16_t*)(F.ws + WS_WDOWN), DFF, 1024, scr, r, F.lane);
    }
    { u32x4* P = (u32x4*)(F.ws + WS_PART); const int NT = F.G * NWAVES * 64;
      for (int i = F.vcu * (NWAVES * 64) + F.tid; i < (int)(PART_BYTES / 16); i += NT) P[i] = (u32x4){0u, 0u, 0u, 0u}; }
    {
        float* cosT = (float*)(F.ws + WS_COS); float* sinT = (float*)(F.ws + WS_SIN);
        const int gt = F.vcu * (NWAVES * 64) + F.tid, NT = F.G * NWAVES * 64;
        for (int idx0 = gt; idx0 < MTOK * 16; idx0 += 4 * NT) {
            int pos[4];
#pragma unroll
            for (int j = 0; j < 4; ++j) { const int idx = idx0 + j * NT; pos[j] = idx < MTOK * 16 ? ((const int*)args.in[2])[idx >> 4] : 0; }
#pragma unroll
            for (int j = 0; j < 4; ++j) { const int idx = idx0 + j * NT; if (idx < MTOK * 16) { const int i = idx & 15;
                const float inv = __builtin_amdgcn_exp2f(-(float)i * (13.287712379549449f / 16.0f));
                const float ang = (float)pos[j] * inv;
                const float n = rintf(ang * 0.15915494309189535f);
                float r = fmaf(-n, 6.2831854820251465f, ang); r = fmaf(-n, -1.7484555e-7f, r);
                cosT[idx] = __cosf(r); sinT[idx] = __sinf(r); } }
        }
    }
}
constexpr int CW_MODCNT = 64, MOD_ITEMS = 192;
__device__ __forceinline__ void p0_mod(Frame& F, const Args& args) {
    LAS float* scr = (LAS float*)(F.lds) + F.wave * 4096;
    for (int item = F.vcu; item < MOD_ITEMS; item += F.G) {
        int kbase = F.wave * 128; asm volatile("" : "+s"(kbase));
        const int n0 = item * 32, col = F.lane & 31, kh = F.lane >> 5;
        { float tv[32];
          unsigned l4 = (unsigned)F.lane * 4u; asm volatile("" : "+v"(l4));
#pragma unroll
          for (int i = 0; i < 32; ++i) tv[i] = *(const float*)((const char*)(ARGF(1) + (i >> 1) * 1024 + kbase + 64 * (i & 1)) + l4);
#pragma unroll
          for (int i = 0; i < 32; ++i) { const int idx = F.lane + 64 * i, b = idx >> 7, k = idx & 127; const float xv = tv[i]; scr[k * 16 + b] = xv / (1.0f + __expf(-xv)); } }
        asm volatile("s_waitcnt lgkmcnt(0)" ::: "memory");
        f32x4 a0 = {0.f, 0.f, 0.f, 0.f}, a1 = a0, a2 = a0, a3 = a0;
        const unsigned wvo = (unsigned)(kh * NMOD + col) * 4u;
#pragma unroll
        for (int i0 = 0; i0 < 64; i0 += 32) { float wv[32];
#pragma unroll
            for (int i = 0; i < 32; ++i) wv[i] = *(const float*)((const char*)(ARGF(3) + (size_t)(kbase + 2 * (i0 + i)) * NMOD + n0) + wvo);
#pragma unroll
            for (int i = 0; i < 32; ++i) { const int k = 2 * (i0 + i) + kh; const float w = wv[i];
                const LAS f32x4* sp = (const LAS f32x4*)(scr + k * 16);
                a0 += sp[0] * w; a1 += sp[1] * w; a2 += sp[2] * w; a3 += sp[3] * w; } }
#pragma unroll
        for (int e = 0; e < 4; ++e) { a0[e] += __shfl_xor(a0[e], 32); a1[e] += __shfl_xor(a1[e], 32); a2[e] += __shfl_xor(a2[e], 32); a3[e] += __shfl_xor(a3[e], 32); }
        if (kh == 0) {
#pragma unroll
            for (int e = 0; e < 4; ++e) { scr[2048 + (0 + e) * 32 + col] = a0[e]; scr[2048 + (4 + e) * 32 + col] = a1[e]; scr[2048 + (8 + e) * 32 + col] = a2[e]; scr[2048 + (12 + e) * 32 + col] = a3[e]; } }
        __syncthreads();
        float* MOD = (float*)(F.ws + WS_MOD);
        { const int b = 2 * F.wave + kh; float s = ARGF(4)[n0 + col];
#pragma unroll
            for (int w2 = 0; w2 < 8; ++w2) s += ((LAS float*)F.lds)[w2 * 4096 + 2048 + b * 32 + col];
            MOD[(size_t)b * NMOD + n0 + col] = s; }
        asm volatile("s_waitcnt vmcnt(0)" ::: "memory");
        __syncthreads();
        if (F.tid == 0) { __builtin_amdgcn_fence(__ATOMIC_RELEASE, "agent"); asm volatile("s_waitcnt vmcnt(0)" ::: "memory");
            __hip_atomic_fetch_add((unsigned*)(F.ws + WS_CTL) + CW_MODCNT, 1u, __ATOMIC_RELAXED, __HIP_MEMORY_SCOPE_AGENT); }
    }
}
__device__ __forceinline__ void mod_wait(Frame& F) {
    if (F.tid == 0) { unsigned sp = 0;
        while (__hip_atomic_load((unsigned*)(F.ws + WS_CTL) + CW_MODCNT, __ATOMIC_RELAXED, __HIP_MEMORY_SCOPE_AGENT) < (unsigned)MOD_ITEMS && ++sp < (1u << 22)) __builtin_amdgcn_s_sleep(2);
        __builtin_amdgcn_fence(__ATOMIC_ACQUIRE, "agent"); asm volatile("s_waitcnt vmcnt(0)" ::: "memory"); }
    __syncthreads();
}
template <bool IDMAP> __device__ __forceinline__ void gemv16_item(Frame& F, const float* W, int ldw, const float* IN, int ldin, float* OUT, int ldout, int item) {
    LAS float* scr = (LAS float*)(F.lds) + F.wave * 4096;
    {
        int kbase = F.wave * 128; asm volatile("" : "+s"(kbase));
        const int col = F.lane & 7, kh = F.lane >> 3; const int src = IDMAP ? item * 8 + col : wmap<0>(item * 8 + col);
        { float tv[32];
          unsigned l4 = (unsigned)F.lane * 4u; asm volatile("" : "+v"(l4));
#pragma unroll
          for (int i = 0; i < 32; ++i) tv[i] = *(const float*)((const char*)(IN + (size_t)(i >> 1) * ldin + kbase + 64 * (i & 1)) + l4);
#pragma unroll
          for (int i = 0; i < 32; ++i) { const int idx = F.lane + 64 * i, b = idx >> 7, k = idx & 127; scr[k * 16 + b] = tv[i]; } }
        asm volatile("s_waitcnt lgkmcnt(0)" ::: "memory");
        f32x4 a0 = {0.f, 0.f, 0.f, 0.f}, a1 = a0, a2 = a0, a3 = a0;
        float wv[16]; const unsigned wvo = (unsigned)(kh * ldw + (src >= 0 ? src : 0)) * 4u; const float msk = src >= 0 ? 1.0f : 0.0f;
#pragma unroll
        for (int i = 0; i < 16; ++i) wv[i] = *(const float*)((const char*)(W + (size_t)(kbase + 8 * i) * ldw) + wvo);
#pragma unroll
        for (int i = 0; i < 16; ++i) { const int k = 8 * i + kh; const float w = wv[i] * msk;
            if ((i & 3) == 0) __builtin_amdgcn_sched_barrier(0);
            const LAS f32x4* sp = (const LAS f32x4*)(scr + k * 16);
            a0 += sp[0] * w; a1 += sp[1] * w; a2 += sp[2] * w; a3 += sp[3] * w;
        }
#pragma unroll
        for (int o = 8; o < 64; o <<= 1)
#pragma unroll
            for (int e = 0; e < 4; ++e) { a0[e] += __shfl_xor(a0[e], o); a1[e] += __shfl_xor(a1[e], o); a2[e] += __shfl_xor(a2[e], o); a3[e] += __shfl_xor(a3[e], o); }
        if (kh == 0) {
#pragma unroll
            for (int e = 0; e < 4; ++e) { scr[2048 + (0 + e) * 8 + col] = a0[e]; scr[2048 + (4 + e) * 8 + col] = a1[e]; scr[2048 + (8 + e) * 8 + col] = a2[e]; scr[2048 + (12 + e) * 8 + col] = a3[e]; } }
        __syncthreads();
        if (F.tid < 128) { float sm = 0.f;
#pragma unroll
            for (int w2 = 0; w2 < 8; ++w2) sm += ((LAS float*)F.lds)[w2 * 4096 + 2048 + F.tid];
            OUT[(size_t)(F.tid >> 3) * ldout + item * 8 + (F.tid & 7)] = sm; }
        __syncthreads();
    }
}
template <bool IDMAP> __device__ __forceinline__ void gemv16(Frame& F, const float* W, int ldw, const float* IN, int ldin, float* OUT, int ldout, int nitems) {
    for (int item = F.vcu; item < nitems; item += F.G) gemv16_item<IDMAP>(F, W, ldw, IN, ldin, OUT, ldout, item);
}
constexpr int CW_B2CNT = 96, CW_REFCNT = 112;
__device__ __forceinline__ void p4_bias(Frame& F, const Args& args, int item) {
    if (F.tid == 0) { unsigned sp = 0; unsigned* cnt = (unsigned*)(F.ws + WS_CTL) + CW_REFCNT;
        while (__hip_atomic_load(cnt, __ATOMIC_RELAXED, __HIP_MEMORY_SCOPE_AGENT) < 2u * (unsigned)F.G && ++sp < (1u << 22)) __builtin_amdgcn_s_sleep(2);
        __builtin_amdgcn_fence(__ATOMIC_ACQUIRE, "agent"); asm volatile("s_waitcnt vmcnt(0)" ::: "memory"); }
    __syncthreads();
    gemv16_item<true>(F, ARGF(16), 1024, (const float*)(F.ws + WS_REF), 1024, (float*)(F.ws + WS_BIAS2), 1024, item);
}
__device__ __forceinline__ void p5_bias(Frame& F, const Args& args) {
    gemv16<true>(F, ARGF(16), 1024, (const float*)(F.ws + WS_REF), 1024, (float*)(F.ws + WS_BIAS2), 1024, 128);
    unsigned* cnt = (unsigned*)(F.ws + WS_CTL) + CW_B2CNT;
    int mine = 0; for (int item = F.vcu; item < 128; item += F.G) ++mine;
    asm volatile("s_waitcnt vmcnt(0)" ::: "memory");
    __syncthreads();
    if (F.tid == 0) {
        if (mine) { __builtin_amdgcn_fence(__ATOMIC_RELEASE, "agent"); asm volatile("s_waitcnt vmcnt(0)" ::: "memory"); __hip_atomic_fetch_add(cnt, (unsigned)mine, __ATOMIC_RELAXED, __HIP_MEMORY_SCOPE_AGENT); }
        unsigned sp = 0;
        while (__hip_atomic_load(cnt, __ATOMIC_RELAXED, __HIP_MEMORY_SCOPE_AGENT) < 128u && ++sp < (1u << 22)) __builtin_amdgcn_s_sleep(2);
        __builtin_amdgcn_fence(__ATOMIC_ACQUIRE, "agent"); asm volatile("s_waitcnt vmcnt(0)" ::: "memory"); }
    __syncthreads();
}
__device__ __forceinline__ float wave_sum(float v) {
#pragma unroll
    for (int o = 1; o < 64; o <<= 1) v += __shfl_xor(v, o);
    return v;
}
template <bool XBF16 = false, bool OUTF8 = false> __device__ __forceinline__ void norm_rows(Frame& F, const float* X, const float* g, int shift_off, int scale_off, bf16_t* out) {
    const float* MOD = (const float*)(F.ws + WS_MOD);
    const int gw = F.vcu * NWAVES + F.wave, NGW = F.G * NWAVES;
    for (int base = gw * 16; base < MTOK; base += NGW * 16) {
        const int b = base >> 11;
        f32x4 gm[4], sh[4];
        { const f32x4* gp = (const f32x4*)g + 4 * F.lane; const f32x4* shp = (const f32x4*)(MOD + (size_t)b * NMOD + shift_off) + 4 * F.lane; const f32x4* scp = (const f32x4*)(MOD + (size_t)b * NMOD + scale_off) + 4 * F.lane;
#pragma unroll
          for (int j = 0; j < 4; ++j) { gm[j] = gp[j] * (scp[j] + 1.0f) * (OUTF8 ? F8_ACT_SCALE : 1.0f); if (!OUTF8) sh[j] = shp[j]; } }
        for (int i0 = 0; i0 < 16; i0 += 4) {
            f32x4 v[4][4]; float sq[4];
#pragma unroll
            for (int rr = 0; rr < 4; ++rr) { const size_t m = (size_t)(base + i0 + rr);
                if (XBF16) { const u32x2* xr = (const u32x2*)((const bf16_t*)X + m * DM) + 4 * F.lane;
#pragma unroll
                    for (int j = 0; j < 4; ++j) { const u32x2 w = xr[j]; v[rr][j] = (f32x4){__uint_as_float(w.x << 16), __uint_as_float(w.x & 0xffff0000u), __uint_as_float(w.y << 16), __uint_as_float(w.y & 0xffff0000u)}; } }
                else { const f32x4* xr = (const f32x4*)(X + m * DM) + 4 * F.lane;
#pragma unroll
                    for (int j = 0; j < 4; ++j) v[rr][j] = xr[j]; } }
#pragma unroll
            for (int rr = 0; rr < 4; ++rr) { float s = 0.f;
#pragma unroll
                for (int j = 0; j < 4; ++j) s += dot4(v[rr][j]);
                sq[rr] = s; }
#pragma unroll
            for (int o = 1; o < 64; o <<= 1)
#pragma unroll
                for (int rr = 0; rr < 4; ++rr) sq[rr] += __shfl_xor(sq[rr], o);
#pragma unroll
            for (int rr = 0; rr < 4; ++rr) { const size_t m = (size_t)(base + i0 + rr);
                const float r = __builtin_amdgcn_rsqf(sq[rr] * (1.0f / DM) + EPS);
                if (OUTF8) { u32x4 w;
#pragma unroll
                    for (int j = 0; j < 4; ++j) { const f32x4 y = v[rr][j] * r * gm[j]; w[j] = pk_fp8x4(y[0], y[1], y[2], y[3]); }
                    *((u32x4*)((unsigned char*)out + m * DM) + F.lane) = w; }
                else { u32x2* o8 = (u32x2*)(out + m * DM) + 4 * F.lane;
#pragma unroll
                    for (int j = 0; j < 4; ++j) { const f32x4 y = v[rr][j] * r * gm[j] + sh[j]; o8[j] = pack4(y); } } }
        }
    }
}
__device__ __forceinline__ void conv_fixup(Frame& F, const Args& args) {
    const unsigned char* RAW4 = F.ws + WS_RAW4; bf16_t* ACT = (bf16_t*)(F.ws + WS_ACT);
    constexpr int NCP = DFF / 2;
    const int gt = F.vcu * (NWAVES * 64) + F.tid, NT = F.G * NWAVES * 64, NGRP = NT / NCP;
    const int grp = gt / NCP, cp = gt - grp * NCP, c = 2 * cp, j = c >> 7, cc = c & 127;
    if (grp >= NGRP) return;
    f32x2 w0[2], w1[2], w2[2], bb[2];
#pragma unroll
    for (int half = 0; half < 2; ++half) { const int ocol = half * DFF + c;
        w0[half] = *(const f32x2*)(ARGF(19) + ocol); w1[half] = *(const f32x2*)(ARGF(19) + DFF2 + ocol); w2[half] = *(const f32x2*)(ARGF(19) + 2 * DFF2 + ocol); bb[half] = *(const f32x2*)(ARGF(20) + ocol); }
#define RAW2(row, tcol) (*(const unsigned*)(RAW4 + ((size_t)(row) * DFF2 + (tcol)) * 2))
#define LO(w) __uint_as_float((w) << 16)
#define HI(w) __uint_as_float((w) & 0xffff0000u)
#pragma unroll 3
    for (int blk = grp; blk < 512; blk += NGRP) {
        const bool first = (blk & 31) == 0;
        f32x2 o[2][2];
#pragma unroll
        for (int half = 0; half < 2; ++half) {
            const int tcol = 256 * j + 128 * half + cc;
            const unsigned q2 = first ? 0u : RAW2((blk - 1) * 4 + 2, tcol), q1 = first ? 0u : RAW2((blk - 1) * 4 + 3, tcol), r0 = RAW2(blk * 4 + 0, tcol), r1 = RAW2(blk * 4 + 1, tcol);
            const f32x2 pm2 = {LO(q2), HI(q2)}, pm1 = {LO(q1), HI(q1)}, x0 = {LO(r0), HI(r0)}, x1 = {LO(r1), HI(r1)};
            o[half][0] = w2[half] * x0 + (w1[half] * pm1 + (w0[half] * pm2 + bb[half])); o[half][1] = w2[half] * x1 + (w1[half] * x0 + (w0[half] * pm1 + bb[half]));
        }
#pragma unroll
        for (int rr = 0; rr < 2; ++rr) { const f32x2 G = o[0][rr]; f32x2 a;
#pragma unroll
            for (int e = 0; e < 2; ++e) a[e] = G[e] / (1.0f + __expf(-G[e])) * o[1][rr][e];
            *(unsigned*)(ACT + ((size_t)blk * 64 + rr) * DFF + c) = cvtpk(a[0], a[1]); }
    }
#undef RAW2
#undef LO
#undef HI
}

__device__ __forceinline__ void stagger_delay(unsigned us10) { const unsigned long long t0 = __builtin_amdgcn_s_memrealtime(); while (__builtin_amdgcn_s_memrealtime() - t0 < (unsigned long long)us10 * 10ull) __builtin_amdgcn_s_sleep(8); }
#ifndef STAG5
#define STAG5 0
#endif
#ifndef STAG9
#define STAG9 0
#endif
__global__ void __launch_bounds__(NWAVES * 64, 2) fwd_kernel(Args args) {
    extern __shared__ __attribute__((aligned(16))) unsigned char lds_raw[];
    Frame F;
    F.lds = (LAS unsigned char*)lds_raw; F.xl = (LAS float*)(F.lds + XL_OFF);
    F.tid = threadIdx.x; F.lane = F.tid & 63; F.wave = __builtin_amdgcn_readfirstlane(F.tid >> 6);
    F.G = gridDim.x; { const int bx = blockIdx.x; F.vcu = (F.G % 8 == 0) ? (bx % 8) * (F.G / 8) + bx / 8 : bx; }
    F.ws = args.ws;
    unsigned char* ws = args.ws;
    for (int u = F.tid; u < (LDS_BYTES - LDSCTL_OFF) / 4; u += NWAVES * 64) ((LAS unsigned*)(F.lds + LDSCTL_OFF))[u] = 0u;
    __syncthreads();
    XcdBarrier bar; bar.bar = (unsigned*)(ws + WS_CTL) + CW_BAR; bar.x = 0; bar.st = nullptr; bar.wave = F.wave;
    if (N_LAUNCHES == 1) bar = xcd_barrier_post((unsigned*)(ws + WS_CTL) + CW_BAR, (volatile LAS unsigned*)(F.lds + MISC_OFF) + 8, F.wave);
#define GRID_BAR() do { if (N_LAUNCHES == 1) xcd_barrier(bar); } while (0)
    const int lo = args.ph_lo, hi = args.ph_hi;
#ifndef PH_MASK
#define PH_MASK 0x3ff
#endif
#define IN(k) (((PH_MASK >> (k)) & 1) && lo <= (k) && (k) < hi)
#define BOTH(k) (IN(k) && IN((k) + 1))
    float* MOD = (float*)(ws + WS_MOD);
    bf16_t* XN = (bf16_t*)(ws + WS_XN);

#define REFRESH_TID() do { int t_ = tid_from_wave(F.wave); asm volatile("" : "+v"(t_)); t_ &= 511; F.tid = t_; F.lane = t_ & 63; } while (0)
    if (IN(0)) { REFRESH_TID(); p0_mod(F, args); p0_prologue(F, args); mod_wait(F); gemv16<false>(F, ARGF(6), 1952, (const float*)(F.ws + WS_MOD), NMOD, (float*)(F.ws + WS_BIAS), 2048, 256); norm_rows<false, true>(F, ARGF(0), ARGF(5), 0, DM, XN); if (BOTH(1)) GRID_BAR(); }
    if (IN(2)) {
        pg8::Gemm g{XN, (const bf16_t*)(ws + WS_WIN), MTOK, 2048, 512  , nullptr, 1 << 30}; pg8::StaticOrder S; S.init(MTOK, 2048, F.G, (int)blockIdx.x);
        { const int t_ = tid_from_wave(F.wave); LAS float* cst = F.xl + XL_CONST;
          if (t_ < 256) cst[t_] = ARGF(7)[t_]; else if (t_ < 384) cst[t_] = ARGF(8)[t_ - 256]; else if (t_ < 448) cst[t_] = ARGF(13)[t_ - 384]; else cst[t_] = ARGF(14)[t_ - 448]; }
        EpiIn E{ws};
        pg8::gemm_phase(F.lds, F.xl, g, S, E, F.wave);
        if (BOTH(2)) GRID_BAR();
    }
    if (IN(3)) {
        pg8::Gemm g{(const bf16_t*)(ws + WS_QLN), (const bf16_t*)(ws + WS_WQUP), MTOK, 2048, 256, (const bf16_t*)(ws + WS_KVLN), 4}; pg8::StaticOrder S; S.init(MTOK, 2048, F.G, (int)blockIdx.x);
        EpiQKV E{EpiQ{ws, ARGF(11)}, EpiKV{ws, ARGF(12)}};
        pg8::gemm_phase(F.lds, F.xl, g, S, E, F.wave);
        if (BOTH(3)) GRID_BAR();
    }
    if (IN(4)) {
        unsigned char* OM = ws + WS_OM; float* REF = (float*)(ws + WS_REF); const float* PARTV = (const float*)(ws + WS_PARTV); unsigned* refcnt = (unsigned*)(ws + WS_CTL) + CW_REFCNT;
        int atid = tid_from_wave(F.wave); asm volatile("" : "+v"(atid)); atid &= 511;
        float S0_mla, S0_ca;
        { const int ln = atid & 63; float a = 0.f, c = 0.f, d = 0.f, e = 0.f;
          for (int i = ln; i < 96; i += 64) { a = fmaxf(a, fabsf(ARGF(11)[i])); c = fmaxf(c, fabsf(ARGF(12)[i])); }
          if (ln < 64) { d = fabsf(ARGF(13)[ln]); e = fabsf(ARGF(14)[ln]); }
          S0_mla = att::wave_max(a) * att::wave_max(c) * 9.797958971132712f * LOG2E * 1.13f; S0_ca = att::wave_max(d) * att::wave_max(e) * 8.0f * LOG2E * 1.13f; }
        if (F.G == 256) {
            const int bh = F.vcu >> 1, par = F.vcu & 1;
            const unsigned ul_mla = (unsigned)(2 * par) | ((unsigned)(7 - 2 * par) << 8) | ((unsigned)(2 * par + 1) << 16) | ((unsigned)(6 - 2 * par) << 24);
            const unsigned ul_ca = (unsigned)par | ((unsigned)(2 + par) << 8) | ((unsigned)(4 + par) << 16) | ((unsigned)(6 + par) << 24);
            att::attn_run<96, false>(atid, bh >> 3, bh & 7, ul_mla, 4, (const unsigned char*)(ws + WS_QM), (const unsigned char*)(ws + WS_KM), (const unsigned char*)(ws + WS_VM), OM, REF, refcnt, PARTV, nullptr, S0_mla, F.lds);
            att::attn_run<64, true>(atid, bh >> 3, bh & 7, ul_ca, 4, (const unsigned char*)(ws + WS_CQ), (const unsigned char*)(ws + WS_CK), (const unsigned char*)(ws + WS_CV), OM, REF, refcnt, PARTV, ARGF(15), S0_ca, F.lds);
            if (par == 0) { REFRESH_TID(); p4_bias(F, args, bh); }
        } else {
            for (int j = F.vcu; j < 2048; j += F.G) { const int kind = j >> 10, bh = (j & 1023) >> 3; const unsigned qb = (unsigned)(j & 7);
                if (kind == 0) att::attn_run<96, false>(atid, bh >> 3, bh & 7, qb, 1, (const unsigned char*)(ws + WS_QM), (const unsigned char*)(ws + WS_KM), (const unsigned char*)(ws + WS_VM), OM, REF, refcnt, PARTV, nullptr, S0_mla, F.lds);
                else att::attn_run<64, true>(atid, bh >> 3, bh & 7, qb, 1, (const unsigned char*)(ws + WS_CQ), (const unsigned char*)(ws + WS_CK), (const unsigned char*)(ws + WS_CV), OM, REF, refcnt, PARTV, ARGF(15), S0_ca, F.lds); }
        }
        if (BOTH(4)) GRID_BAR();
    }
    if (IN(5)) {
        pg8::Gemm g{(const bf16_t*)(ws + WS_OM), (const bf16_t*)(ws + WS_WOUT), MTOK, 1024, 512  , nullptr, 1 << 30}; pg8::StaticOrder S; S.init(MTOK, 1024, F.G, (int)blockIdx.x);
        if (F.G != 256) { REFRESH_TID(); p5_bias(F, args); }
        if (F.G == 256) { EpiResNorm E{ARGF(0), ws, MOD + 2 * DM, ARGF(17)}; pg8::gemm_phase(F.lds, F.xl, g, S, E, F.wave); }
        else { EpiRes<false, true, true> E{ARGF(0), (void*)(ws + WS_X1), MOD + 2 * DM, (const float*)(ws + WS_BIAS2)}; pg8::gemm_phase(F.lds, F.xl, g, S, E, F.wave); }
        if (BOTH(5)) GRID_BAR();
    }
    if (IN(6)) { if (F.G != 256) { REFRESH_TID(); norm_rows<true>(F, (const float*)(ws + WS_X1), ARGF(17), 3 * DM, 4 * DM, (bf16_t*)(ws + WS_H2)); if (BOTH(6)) GRID_BAR(); } }
    if (IN(7)) {
        pg8::Gemm g{(const bf16_t*)(ws + WS_H2), (const bf16_t*)(ws + WS_WUP), MTOK, DFF2, 1024, nullptr, 1 << 30}; pg8::StaticOrder S; S.init(MTOK, DFF2, F.G, (int)blockIdx.x);
        EpiUp E{ws, ARGF(19), ARGF(20)};
        pg8::gemm_phase(F.lds, F.xl, g, S, E, F.wave);
        if (BOTH(7)) GRID_BAR();
    }
    if (IN(8)) { REFRESH_TID(); conv_fixup(F, args); if (BOTH(8)) GRID_BAR(); }
    if (IN(9)) {
        pg8::Gemm g{(const bf16_t*)(ws + WS_ACT), (const bf16_t*)(ws + WS_WDOWN), MTOK, 1024, DFF, nullptr, 1 << 30}; pg8::StaticOrder S; S.init(MTOK, 1024, F.G, (int)blockIdx.x);
        if (STAG9 && (F.vcu & 1)) stagger_delay(STAG9);
        EpiRes<true, false> E{(const void*)(ws + WS_X1), (void*)args.out, MOD + 5 * DM};
        pg8::gemm_phase(F.lds, F.xl, g, S, E, F.wave);
    }
#undef IN
#undef BOTH
}

extern "C" void kernel_launch(void* const* d_in, const int* in_sizes, int n_in, void* d_out, int out_size, void* d_ws, size_t ws_size, hipStream_t stream) {
    static int grid = 0;
    if (grid == 0) {
        if (n_in != 22 || in_sizes[0] != MTOK * DM || out_size != MTOK * DM || ws_size < WS_END) {
            fprintf(stderr, "kernel_launch: unexpected shapes (n_in %d, in0 %d, out %d, ws %zu); nothing launched\n", n_in, n_in > 0 ? in_sizes[0] : -1, out_size, ws_size); grid = -1; return; }
        int dev = 0, cus = 0, per_cu = 0;
        if (hipGetDevice(&dev) != hipSuccess || hipDeviceGetAttribute(&cus, hipDeviceAttributeMultiprocessorCount, dev) != hipSuccess) { grid = -1; return; }
        if (hipFuncSetAttribute((const void*)fwd_kernel, hipFuncAttributeMaxDynamicSharedMemorySize, LDS_BYTES) != hipSuccess) { fprintf(stderr, "kernel_launch: hipFuncSetAttribute failed\n"); grid = -1; return; }
        if (hipOccupancyMaxActiveBlocksPerMultiprocessor(&per_cu, (const void*)fwd_kernel, NWAVES * 64, LDS_BYTES) != hipSuccess || per_cu < 1)
            fprintf(stderr, "kernel_launch: note: occupancy query reports %d workgroups per CU\n", per_cu);
        (void)hipGetLastError();
        grid = cus;
    }
    if (grid < 0) return;
    Args a{};
    for (int i = 0; i < 22; ++i) a.in[i] = d_in[i];
    a.out = (float*)d_out; a.ws = (unsigned char*)d_ws;
#ifndef PROBE_DUP
#define PROBE_DUP -1
#endif
    const int nl = (PROBE_DUP >= 0) ? 2 : N_LAUNCHES;
    for (int li = 0; li < nl; ++li) {
        if (hipMemsetAsync((char*)d_ws + WS_CTL, 0, CTL_ZERO_BYTES, stream) != hipSuccess) { fprintf(stderr, "kernel_launch: memset failed\n"); return; }
        a.ph_lo = (N_LAUNCHES == 1) ? 0 : li; a.ph_hi = (N_LAUNCHES == 1) ? NPHASE : li + 1; a.li = li;
        if (PROBE_DUP >= 0) { a.ph_lo = li == 0 ? 0 : PROBE_DUP; a.ph_hi = li == 0 ? PROBE_DUP + 1 : NPHASE; }
        hipLaunchKernelGGL(fwd_kernel, dim3(grid), dim3(NWAVES * 64), LDS_BYTES, stream, a);
        const hipError_t le = hipPeekAtLastError();
        if (le != hipSuccess) { fprintf(stderr, "kernel_launch: launch %d failed: %s\n", li, hipGetErrorName(le)); break; }
    }
}
```

```cpp
#include <hip/hip_runtime.h>
#include <cstdio>
#include <cstdint>

#define LAS __attribute__((address_space(3)))
#define GAS __attribute__((address_space(1)))
typedef unsigned short bf16_t;
typedef short bf16x8 __attribute__((ext_vector_type(8)));
typedef short s16x4 __attribute__((ext_vector_type(4)));
typedef short s16x2 __attribute__((ext_vector_type(2)));
typedef float f32x2 __attribute__((ext_vector_type(2)));
typedef float f32x4 __attribute__((ext_vector_type(4)));
typedef float f32x16 __attribute__((ext_vector_type(16)));
typedef unsigned u32x2 __attribute__((ext_vector_type(2)));
typedef unsigned u32x4 __attribute__((ext_vector_type(4)));
typedef int i32x2 __attribute__((ext_vector_type(2)));
typedef int i32x4 __attribute__((ext_vector_type(4)));
typedef int i32x8 __attribute__((ext_vector_type(8)));
typedef __bf16 bf16x2_t __attribute__((ext_vector_type(2)));

#ifndef MK_N_LAUNCHES
#define MK_N_LAUNCHES 1
#endif

constexpr int BATCH = 16, SEQ = 2048, DM = 1024, MTOK = BATCH * SEQ;
constexpr int NMOD = 6 * DM;
constexpr int DFF = 2816, DFF2 = 5632;
constexpr float EPS = 1e-6f;
constexpr float LOG2E = 1.4426950408889634f;
constexpr float C2_MLA = 0.10206207261596577f * LOG2E;
constexpr float C2_CA = 0.125f * LOG2E;

__device__ __forceinline__ unsigned cvtpk(float lo, float hi) { f32x2 v = {lo, hi}; bf16x2_t b = __builtin_convertvector(v, bf16x2_t); return __builtin_bit_cast(unsigned, b); }
__device__ __forceinline__ u32x4 pack8(f32x4 a, f32x4 b) { u32x4 w; w.x = cvtpk(a[0], a[1]); w.y = cvtpk(a[2], a[3]); w.z = cvtpk(b[0], b[1]); w.w = cvtpk(b[2], b[3]); return w; }
__device__ __forceinline__ u32x2 pack4(f32x4 a) { u32x2 w; w.x = cvtpk(a[0], a[1]); w.y = cvtpk(a[2], a[3]); return w; }
__device__ __forceinline__ float xsum16(float v) { auto r = __builtin_amdgcn_permlane16_swap(__float_as_uint(v), __float_as_uint(v), false, false); return __uint_as_float(r[0]) + __uint_as_float(r[1]); }
__device__ __forceinline__ float xsum32(float v) { auto r = __builtin_amdgcn_permlane32_swap(__float_as_uint(v), __float_as_uint(v), false, false); return __uint_as_float(r[0]) + __uint_as_float(r[1]); }
__device__ __forceinline__ float row16_sum(float v) {
    v += __builtin_bit_cast(float, __builtin_amdgcn_update_dpp(0, __builtin_bit_cast(int, v), 0xB1, 0xF, 0xF, true));
    v += __builtin_bit_cast(float, __builtin_amdgcn_update_dpp(0, __builtin_bit_cast(int, v), 0x4E, 0xF, 0xF, true));
    v += __builtin_bit_cast(float, __builtin_amdgcn_update_dpp(0, __builtin_bit_cast(int, v), 0x141, 0xF, 0xF, true));
    v += __builtin_bit_cast(float, __builtin_amdgcn_update_dpp(0, __builtin_bit_cast(int, v), 0x140, 0xF, 0xF, true));
    return v; }
__device__ __forceinline__ void colsum8(const f32x4 (&acc)[2][2][4][2], int bj, int fr, float* dst) {
    f32x4 s0 = acc[0][bj][0][0] + acc[1][bj][0][0], s1 = acc[0][bj][0][1] + acc[1][bj][0][1];
#pragma unroll
    for (int m = 1; m < 4; ++m) { s0 += acc[0][bj][m][0] + acc[1][bj][m][0]; s1 += acc[0][bj][m][1] + acc[1][bj][m][1]; }
#pragma unroll
    for (int e = 0; e < 4; ++e) { s0[e] = row16_sum(s0[e]); s1[e] = row16_sum(s1[e]); }
    if (fr == 0) { *(f32x4*)dst = s0; *(f32x4*)(dst + 4) = s1; }
}
__device__ __forceinline__ float dot4(f32x4 a) { return (a[0] * a[0] + a[1] * a[1]) + (a[2] * a[2] + a[3] * a[3]); }
__device__ __forceinline__ int undef_i32() { int w; asm volatile("" : "=v"(w)); return w; }
__device__ __forceinline__ unsigned pk_fp8x4(float a, float b, float c, float d) { int w = undef_i32();
    w = __builtin_amdgcn_cvt_pk_fp8_f32(__builtin_amdgcn_fmed3f(a, -448.f, 448.f), __builtin_amdgcn_fmed3f(b, -448.f, 448.f), w, false);
    w = __builtin_amdgcn_cvt_pk_fp8_f32(__builtin_amdgcn_fmed3f(c, -448.f, 448.f), __builtin_amdgcn_fmed3f(d, -448.f, 448.f), w, true); return (unsigned)w; }
__device__ __forceinline__ u32x2 f8x8(f32x4 a, f32x4 b) { return (u32x2){pk_fp8x4(a[0], a[1], a[2], a[3]), pk_fp8x4(b[0], b[1], b[2], b[3])}; }
__device__ __forceinline__ unsigned pk_fp8x4u(float a, float b, float c, float d) { int w = undef_i32(); w = __builtin_amdgcn_cvt_pk_fp8_f32(a, b, w, false); w = __builtin_amdgcn_cvt_pk_fp8_f32(c, d, w, true); return (unsigned)w; }
__device__ __forceinline__ u32x2 f8x8u(f32x4 a, f32x4 b) { return (u32x2){pk_fp8x4u(a[0], a[1], a[2], a[3]), pk_fp8x4u(b[0], b[1], b[2], b[3])}; }
__device__ __forceinline__ void st8pair(unsigned char* pa, unsigned char* pb, u32x2 a, u32x2 b, int fq) {
    auto r0 = __builtin_amdgcn_permlane16_swap(a.x, b.x, false, false); auto r1 = __builtin_amdgcn_permlane16_swap(a.y, b.y, false, false);
    *(u32x4*)((fq & 1) ? pb - 8 : pa) = (u32x4){r0[0], r1[0], r0[1], r1[1]}; }
__device__ __forceinline__ void glds16_(const void* gsrc, unsigned lds_dst) { unsigned keep;
    asm volatile("s_mov_b32 %0, m0\n\ts_mov_b32 m0, %2\n\ts_nop 0\n\tglobal_load_lds_dwordx4 %1, off\n\ts_mov_b32 m0, %0" : "=&s"(keep) : "v"(gsrc), "s"(lds_dst) : "memory"); }
#ifndef WT_STORES
#define WT_STORES 0
#endif
__device__ __forceinline__ void st16(void* p, u32x4 v) {
#if WT_STORES
    asm volatile("global_store_dwordx4 %0, %1, off sc1\n\ts_nop 1" :: "v"(p), "v"(v) : "memory");
#else
    *(u32x4*)p = v;
#endif
}
__device__ __forceinline__ void st16o(const void* sbase, unsigned voff, u32x4 v) {
#if WT_STORES
    asm volatile("global_store_dwordx4 %0, %1, %2 sc1\n\ts_nop 1" :: "v"(voff), "v"(v), "s"(sbase) : "memory");
#else
    *(u32x4*)((unsigned char*)sbase + voff) = v;
#endif
}
__device__ __forceinline__ int tid_from_wave(int wave) { int ln; asm volatile("v_mbcnt_lo_u32_b32 %0, -1, 0\n\tv_mbcnt_hi_u32_b32 %0, -1, %0" : "=v"(ln));
    return wave * 64 + ln; }
#define LDS_BARRIER() do { asm volatile("s_waitcnt lgkmcnt(0)" ::: "memory"); __builtin_amdgcn_s_barrier(); asm volatile("" ::: "memory"); } while (0)

#ifndef PG8_ASMDMA
#define PG8_ASMDMA 1
#endif
namespace pg8 {
constexpr int BM = 256, BK = 64, HALF = 128, HTB = HALF * BK * 2, STAGE_BYTES = 8 * HTB, NXCD = 8, WGM = 8;
__host__ __device__ __forceinline__ int lds_byte(int r, int c) { const int st = (r >> 4) * 2 + (c >> 5), rr = r & 15, cc = c & 31, ob = rr * 64 + cc * 2; return st * 1024 + (ob ^ (((ob >> 9) & 1) << 5)); }
__host__ __device__ __forceinline__ void stage_rc(int b, int& R, int& C) { const int st = b / 1024, sb = b % 1024, swz = sb ^ (((sb >> 9) & 1) << 5); R = (st >> 1) * 16 + swz / 64; C = (st & 1) * 32 + (swz % 64) / 2; }
__host__ __device__ __forceinline__ int perm32(int rho) { const int n = rho >> 4, i = rho & 15; return 8 * (i >> 2) + 4 * n + (i & 3); }

struct Unit { int pm, pn; };
struct Gemm { const bf16_t* A; const bf16_t* Bt; int M, N, K; const bf16_t* A2; int nsplit; };

struct StaticOrder {
    int nM, nN, nwg, G, c;
    __host__ __device__ void init(int M, int N, int G_, int c_) { nM = M / BM; nN = N / BM; nwg = nM * nN; G = G_; c = c_; }
    __host__ __device__ bool next(int i, Unit& u) const {
        const long L = (long)i * G + c; if (L >= nwg) return false;
        int wgid = (int)L; { const int q = nwg / NXCD, r = nwg % NXCD, xcd = wgid % NXCD, off = wgid / NXCD; wgid = (xcd < r ? xcd * (q + 1) : r * (q + 1) + (xcd - r) * q) + off; }
        const int nig = WGM * nN, gid = wgid / nig, fm = gid * WGM, gsz = (nM - fm) < WGM ? (nM - fm) : WGM;
        u.pm = fm + ((wgid % nig) % gsz); u.pn = (wgid % nig) / gsz; return true;
    }
};

template <class Epi, class Sched>
__device__ __forceinline__ void gemm_phase(LAS unsigned char* lds, LAS float* xl, const Gemm g, const Sched& S, const Epi& E, int wave_id) {
    int tid = tid_from_wave(wave_id); asm volatile("" : "+v"(tid)); tid &= 511;
    const int wid = __builtin_amdgcn_readfirstlane(tid >> 6), lane = tid & 63, wr = wid >> 2, wc = wid & 3, fr = lane & 15, fq = lane >> 4;
    const int K = g.K, nt = K / BK;
    unsigned voffA[2], voffB[2];
#pragma unroll
    for (int i = 0; i < 2; ++i) { int R, C; stage_rc(tid * 16 + i * 8192, R, C); const int Rb = (R & ~31) + perm32(R & 31);
        const int Ra = Epi::APERM ? ((R & 64) | ((R & 15) << 2) | ((R >> 4) & 3)) : R;
        voffA[i] = (unsigned)(Ra * K + C) * 2u; voffB[i] = (unsigned)(Rb * K + C) * 2u; }
    const size_t kstep = (size_t)(BK * 2);
    const size_t hstep = (size_t)HALF * K * 2;
    const size_t tstep = 2 * hstep;
    const unsigned ldsw = (unsigned)wid * 1024u; const unsigned ldsb = (unsigned)__builtin_amdgcn_readfirstlane((int)((unsigned)(uintptr_t)lds + ldsw));
    const int aoff = lds_byte(wr * 64 + fr, fq * 8), boff = lds_byte(wc * 32 + fr, fq * 8);
#define PG8_SA(b, h) (((b) * 2 + (h)) * HTB)
#define PG8_SB(b, h) ((4 + (b) * 2 + (h)) * HTB)
#if PG8_ASMDMA
#define PG8_STAGE(bufoff, gbase, voff) do { _Pragma("unroll") for (int _i = 0; _i < 2; ++_i) \
        asm volatile("s_mov_b32 m0, %2\n\ts_nop 0\n\tglobal_load_lds_dwordx4 %0, %1" :: "v"((voff)[_i]), "s"((const void*)(gbase)), "s"(ldsb + (unsigned)((bufoff) + _i * 8192)) : "memory", "m0"); } while (0)
#else
#define PG8_STAGE(bufoff, gbase, voff) do { _Pragma("unroll") for (int _i = 0; _i < 2; ++_i) \
        __builtin_amdgcn_global_load_lds((const unsigned*)((const char*)(gbase) + (voff)[_i]), (LAS unsigned*)(lds + (bufoff) + ldsw + _i * 8192), 16, 0, 0); } while (0)
#endif
#define PG8_LDA(dst, b, h) do { if constexpr (Epi::FP8) { _Pragma("unroll") for (int m = 0; m < 4; ++m) { const i32x4 lo_ = *(const LAS i32x4*)(lds + PG8_SA(b, h) + aoff + m * 2048), hi_ = *(const LAS i32x4*)(lds + PG8_SA(b, h) + aoff + m * 2048 + 1024); dst##8[m] = __builtin_shufflevector(lo_, hi_, 0, 1, 2, 3, 4, 5, 6, 7); } } \
        else { _Pragma("unroll") for (int m = 0; m < 4; ++m) _Pragma("unroll") for (int k = 0; k < 2; ++k) dst[m][k] = *(const LAS bf16x8*)(lds + PG8_SA(b, h) + aoff + m * 2048 + k * 1024); } } while (0)
#define PG8_LDB(dst, b, h) do { if constexpr (Epi::FP8) { _Pragma("unroll") for (int n = 0; n < 2; ++n) { const i32x4 lo_ = *(const LAS i32x4*)(lds + PG8_SB(b, h) + boff + n * 2048), hi_ = *(const LAS i32x4*)(lds + PG8_SB(b, h) + boff + n * 2048 + 1024); dst##8[n] = __builtin_shufflevector(lo_, hi_, 0, 1, 2, 3, 4, 5, 6, 7); } } \
        else { _Pragma("unroll") for (int n = 0; n < 2; ++n) _Pragma("unroll") for (int k = 0; k < 2; ++k) dst[n][k] = *(const LAS bf16x8*)(lds + PG8_SB(b, h) + boff + n * 2048 + k * 1024); } } while (0)
#define PG8_MMA(ai, bj, At, Bt) do { __builtin_amdgcn_s_setprio(1); if constexpr (Epi::FP8) { _Pragma("unroll") for (int m = 0; m < 4; ++m) _Pragma("unroll") for (int n = 0; n < 2; ++n) \
            acc[ai][bj][m][n] = __builtin_amdgcn_mfma_scale_f32_16x16x128_f8f6f4(Bt##8[n], At##8[m], acc[ai][bj][m][n], 0, 0, 0, 0, 0, 0); } \
        else { _Pragma("unroll") for (int m = 0; m < 4; ++m) _Pragma("unroll") for (int n = 0; n < 2; ++n) _Pragma("unroll") for (int k = 0; k < 2; ++k) \
            acc[ai][bj][m][n] = __builtin_amdgcn_mfma_f32_16x16x32_bf16(Bt[n][k], At[m][k], acc[ai][bj][m][n], 0, 0, 0); } __builtin_amdgcn_s_setprio(0); } while (0)
#define PG8_WAIT_V(n) asm volatile("s_waitcnt vmcnt(" #n ")" ::: "memory")
#define PG8_WAIT_L(n) asm volatile("s_waitcnt lgkmcnt(" #n ")" ::: "memory")
#define PG8_BAR __builtin_amdgcn_s_barrier()
#define PG8_SCHED __builtin_amdgcn_sched_barrier(0)
    Unit cur, nxt; int ui = 0;
    if (!S.next(0, cur)) return;
    f32x4 acc[2][2][4][2];
    { float z0; asm volatile("v_mov_b32 %0, 0" : "=v"(z0));
#pragma unroll
    for (int a = 0; a < 2; ++a)
#pragma unroll
        for (int b = 0; b < 2; ++b)
#pragma unroll
            for (int m = 0; m < 4; ++m)
#pragma unroll
                for (int n = 0; n < 2; ++n) acc[a][b][m][n] = (f32x4){z0, z0, z0, z0}; }
    bf16x8 At[4][2], B0[2][2], B1[2][2]; i32x8 At8[4], B08[2], B18[2];
    const char* cA = (const char*)(cur.pn < g.nsplit ? g.A : g.A2) + (size_t)cur.pm * tstep; const char* cB = (const char*)g.Bt + (size_t)cur.pn * tstep;
    if constexpr (Epi::PREFETCH) E.prefetch(cur, xl, 0, wid, lane);
    PG8_STAGE(PG8_SB(0, 0), cB, voffB); PG8_STAGE(PG8_SB(0, 1), cB + hstep, voffB); PG8_STAGE(PG8_SA(0, 0), cA, voffA); PG8_STAGE(PG8_SA(0, 1), cA + hstep, voffA);
    if (wr == 1) PG8_BAR;
    PG8_WAIT_V(2); PG8_BAR;
    PG8_STAGE(PG8_SB(1, 0), cB + kstep, voffB); PG8_STAGE(PG8_SA(1, 0), cA + kstep, voffA); PG8_STAGE(PG8_SB(1, 1), cB + hstep + kstep, voffB);
    PG8_WAIT_V(6); PG8_BAR;
    for (;;) {
        const bool has_next = S.next(ui + 1, nxt);
        const char* nA = has_next ? (const char*)(nxt.pn < g.nsplit ? g.A : g.A2) + (size_t)nxt.pm * tstep : cA; const char* nB = has_next ? (const char*)g.Bt + (size_t)nxt.pn * tstep : cB;
#pragma nounroll
        for (int t = 0; t < nt; t += 2) {
            const bool last = (t == nt - 2);
            const char* a1 = cA + (size_t)(t + 1) * kstep;
            const char* a2 = last ? nA : cA + (size_t)(t + 2) * kstep; const char* b2 = last ? nB : cB + (size_t)(t + 2) * kstep;
            const char* a3 = a2 + kstep; const char* b3 = b2 + kstep;
            PG8_LDB(B0, 0, 0); PG8_LDB(B1, 0, 1); PG8_SCHED; PG8_LDA(At, 0, 0); PG8_STAGE(PG8_SA(1, 1), a1 + hstep, voffA);
            PG8_WAIT_V(8); PG8_WAIT_L(0); PG8_BAR; PG8_MMA(0, 0, At, B0); PG8_MMA(0, 1, At, B1); PG8_BAR; PG8_SCHED;
            PG8_LDA(At, 0, 1); PG8_STAGE(PG8_SB(0, 0), b2, voffB); PG8_STAGE(PG8_SB(0, 1), b2 + hstep, voffB); PG8_STAGE(PG8_SA(0, 0), a2, voffA);
            PG8_WAIT_V(8); PG8_WAIT_L(0); PG8_BAR; PG8_MMA(1, 0, At, B0); PG8_MMA(1, 1, At, B1); PG8_BAR; PG8_SCHED;
            PG8_LDB(B0, 1, 0); PG8_LDB(B1, 1, 1); PG8_SCHED; PG8_LDA(At, 1, 0); PG8_STAGE(PG8_SA(0, 1), a2 + hstep, voffA);
            PG8_WAIT_V(8); PG8_WAIT_L(0); PG8_BAR; PG8_MMA(0, 0, At, B0); PG8_MMA(0, 1, At, B1); PG8_BAR; PG8_SCHED;
            PG8_LDA(At, 1, 1); PG8_STAGE(PG8_SB(1, 0), b3, voffB); PG8_STAGE(PG8_SB(1, 1), b3 + hstep, voffB); PG8_STAGE(PG8_SA(1, 0), a3, voffA);
            PG8_WAIT_V(8); PG8_WAIT_L(0); PG8_BAR; PG8_MMA(1, 0, At, B0); PG8_MMA(1, 1, At, B1); PG8_BAR; PG8_SCHED;
        }
        if (wr == 0) PG8_BAR;
        { const int le_ = tid_from_wave(0), fre = le_ & 15, fqe = le_ >> 4;
        if constexpr (Epi::FP8) { if constexpr (Epi::PREFETCH) E.pre(acc, cur, wc, fqe, xl, ui & 1); else E.pre(acc, cur, wc, fqe); }
        if constexpr (Epi::PREFETCH) { E(acc, cur, wr, wc, fre, fqe, xl, ui & 1); if (has_next) E.prefetch(nxt, xl, (ui + 1) & 1, wid, le_); }
        else E(acc, cur, wr, wc, fre, fqe, xl); }
        if (!has_next) break;
        { float z0; asm volatile("v_mov_b32 %0, 0" : "=v"(z0));
#pragma unroll
        for (int a = 0; a < 2; ++a)
#pragma unroll
            for (int b = 0; b < 2; ++b)
#pragma unroll
                for (int m = 0; m < 4; ++m)
#pragma unroll
                    for (int n = 0; n < 2; ++n) acc[a][b][m][n] = (f32x4){z0, z0, z0, z0}; }
        cur = nxt; cA = nA; cB = nB; ++ui;
        if (wr == 1) PG8_BAR;
    }
    PG8_WAIT_V(0);
    PG8_BAR;
#undef PG8_SA
#undef PG8_SB
#undef PG8_STAGE
#undef PG8_LDA
#undef PG8_LDB
#undef PG8_MMA
#undef PG8_WAIT_V
#undef PG8_WAIT_L
#undef PG8_BAR
#undef PG8_SCHED
}
}
using pg8::Unit;

constexpr size_t MiB = 1u << 20;
constexpr size_t WS_CTL = 0, CTL_ZERO_BYTES = 64 * 1024;
constexpr size_t WS_PART = 35 * (1u << 20), PART_BYTES = (size_t)32768 * 4 * 8;
constexpr size_t WS_MOD = 1 * MiB;
constexpr size_t WS_BIAS2 = 1 * MiB + 640 * 1024;
constexpr size_t WS_PARTV = 13 * MiB;
constexpr size_t WS_REF = 1 * MiB + 768 * 1024;
constexpr size_t WS_BIAS = 1 * MiB + 512 * 1024;
constexpr size_t WS_COS = 2 * MiB, WS_SIN = 4 * MiB;
constexpr size_t WS_KR = 6 * MiB;
constexpr size_t WS_SSR = 10 * MiB;
constexpr size_t WS_WIN = 11 * MiB;
constexpr size_t WS_WQUP = 15 * MiB;
constexpr size_t WS_WKVUP = WS_WQUP + 512 * 1024;
constexpr size_t WS_WOUT = 16 * MiB;
constexpr size_t WS_WUP = 18 * MiB;
constexpr size_t WS_WDOWN = 29 * MiB;
constexpr size_t WS_XN = 36 * MiB;
constexpr size_t WS_QLN = 100 * MiB, WS_KVLN = 116 * MiB;
constexpr size_t WS_CQ = 132 * MiB, WS_CK = 164 * MiB, WS_CV = 196 * MiB;
constexpr size_t WS_QM = 228 * MiB, WS_KM = 276 * MiB;
constexpr size_t WS_VM = 324 * MiB;
constexpr size_t WS_OM = WS_XN;
constexpr size_t WS_ACT = 100 * MiB;
constexpr size_t WS_X1 = 276 * MiB;
constexpr size_t WS_RAW4 = 404 * MiB;
constexpr size_t WS_H2 = 448 * MiB;
constexpr size_t WS_END = 512 * MiB;
static_assert(WS_ACT + (size_t)MTOK * DFF * 2 <= WS_X1 && WS_X1 + (size_t)MTOK * DM * 4 <= WS_RAW4 && WS_RAW4 + (size_t)512 * 4 * DFF2 * 4 <= WS_END, "overlay map");
constexpr int CW_BAR = 1024;


constexpr float F8_QS = 32.0f, F8_KS = 0.125f;
constexpr float F8_O_SCALE = 64.0f, F8_WOUT_SCALE = 1024.0f;
constexpr float F8_ACT_SCALE = 8.0f, F8_WIN_SCALE = 1024.0f;
constexpr int XL_CONST = 2048;
__device__ __forceinline__ void f8_pre_lds(f32x4 (&acc)[2][2][4][2], const LAS float* side, float descale, int wc, int fq) {
    asm volatile("" : "+v"(fq), "+s"(wc));
    const LAS float* sp = side + wc * 32 + 8 * fq;
    f32x4 bv[2][2];
#pragma unroll
    for (int bj = 0; bj < 2; ++bj)
#pragma unroll
        for (int n = 0; n < 2; ++n) bv[bj][n] = *(const LAS f32x4*)(sp + 128 * bj + 4 * n);
#pragma unroll
    for (int a = 0; a < 2; ++a)
#pragma unroll
        for (int bj = 0; bj < 2; ++bj)
#pragma unroll
            for (int m = 0; m < 4; ++m)
#pragma unroll
                for (int n = 0; n < 2; ++n) acc[a][bj][m][n] = acc[a][bj][m][n] * descale + bv[bj][n];
}
struct EpiIn {
    static constexpr bool APERM = false, PREFETCH = true, FP8 = true; static constexpr float DESCALE = 1.0f / (F8_ACT_SCALE * F8_WIN_SCALE);
    unsigned char* ws;
    __device__ __forceinline__ void prefetch(const Unit& u, LAS float* xl, int par, int wid, int lane) const {
        asm volatile("" : "+v"(lane));
        if (wid == 0) glds16_((const float*)(ws + WS_BIAS) + (size_t)(u.pm >> 3) * 2048 + u.pn * 256 + 4 * lane, (unsigned)__builtin_amdgcn_readfirstlane((unsigned)(uintptr_t)(xl + XL_CONST + 512 + par * 256)));
    }
    __device__ __forceinline__ void pre(f32x4 (&acc)[2][2][4][2], const Unit& u, int wc, int fq, LAS float* xl, int par) const { f8_pre_lds(acc, xl + XL_CONST + 512 + par * 256, DESCALE, wc, fq); }
    __device__ __forceinline__ void operator()(const f32x4 (&acc)[2][2][4][2], const Unit& u, int wr, int wc, int fr, int fq, LAS float* red, int  ) const {
        asm volatile("" : "+v"(fr), "+v"(fq), "+s"(wr), "+s"(wc));
        const int rl0 = wr * 64 + fr; const size_t row0 = (size_t)u.pm * 256 + rl0; const int pn = u.pn;
        bf16_t* const QLN = (bf16_t*)(ws + WS_QLN); bf16_t* const KVLN = (bf16_t*)(ws + WS_KVLN); bf16_t* const CQ = (bf16_t*)(ws + WS_CQ); bf16_t* const CK = (bf16_t*)(ws + WS_CK); bf16_t* const CV = (bf16_t*)(ws + WS_CV);
        float* const KR = (float*)(ws + WS_KR); float* const SSR = (float*)(ws + WS_SSR);
        if (pn >= 6) {
            { float* pv = (float*)(ws + WS_PARTV) + ((size_t)u.pm * 2 + wr) * 1024 + 512 + (pn - 6) * 256 + wc * 32 + 8 * fq;
              colsum8(acc, 0, fr, pv); colsum8(acc, 1, fr, pv + 128); }
            unsigned char* base = (unsigned char*)CV + (pn - 6) * 256 + wc * 32 + 8 * fq;
#pragma unroll
            for (int ai = 0; ai < 2; ++ai)
#pragma unroll
                for (int mp = 0; mp < 2; ++mp) { unsigned char* ra = base + (row0 + ai * 128 + (2 * mp) * 16) * 512; unsigned char* rb = ra + 16 * 512;
#pragma unroll
                    for (int bj = 0; bj < 2; ++bj) st8pair(ra + bj * 128, rb + bj * 128, f8x8(acc[ai][bj][2 * mp][0], acc[ai][bj][2 * mp][1]), f8x8(acc[ai][bj][2 * mp + 1][0], acc[ai][bj][2 * mp + 1][1]), fq); }
        } else if (pn >= 2) {
            const bool isq = pn < 4; const int head = 4 * ((pn - 2) & 1) + wc; const LAS float* g = red + XL_CONST + (isq ? 384 : 448); const float sc = isq ? C2_CA * F8_QS : F8_KS;
            f32x4 gv[2][2];
#pragma unroll
            for (int bj = 0; bj < 2; ++bj)
#pragma unroll
                for (int n = 0; n < 2; ++n) gv[bj][n] = *(const LAS f32x4*)(g + 32 * bj + 8 * fq + 4 * n) * sc;
            unsigned char* base = (unsigned char*)(isq ? CQ : CK) + head * 64 + 8 * fq;
#pragma unroll
            for (int ai = 0; ai < 2; ++ai)
#pragma unroll
                for (int mp = 0; mp < 2; ++mp) { float rr[2];
#pragma unroll
                    for (int mm = 0; mm < 2; ++mm) { const int m = 2 * mp + mm;
                        float ss = (dot4(acc[ai][0][m][0]) + dot4(acc[ai][0][m][1])) + (dot4(acc[ai][1][m][0]) + dot4(acc[ai][1][m][1]));
                        ss = xsum32(xsum16(ss));
                        rr[mm] = __builtin_amdgcn_rsqf(ss * (1.0f / 64.0f) + EPS); }
                    unsigned char* ra = base + (row0 + ai * 128 + (2 * mp) * 16) * 512; unsigned char* rb = ra + 16 * 512;
#pragma unroll
                    for (int bj = 0; bj < 2; ++bj) st8pair(ra + bj * 32, rb + bj * 32, f8x8u(acc[ai][bj][2 * mp][0] * rr[0] * gv[bj][0], acc[ai][bj][2 * mp][1] * rr[0] * gv[bj][1]),
                                                           f8x8u(acc[ai][bj][2 * mp + 1][0] * rr[1] * gv[bj][0], acc[ai][bj][2 * mp + 1][1] * rr[1] * gv[bj][1]), fq);
                }
        } else if (pn == 0) {
#pragma unroll
            for (int ai = 0; ai < 2; ++ai)
#pragma unroll
                for (int m = 0; m < 4; ++m) {
                    float ss = (dot4(acc[ai][0][m][0]) + dot4(acc[ai][0][m][1])) + (dot4(acc[ai][1][m][0]) + dot4(acc[ai][1][m][1]));
                    ss = xsum32(xsum16(ss));
                    if (fq == 0) red[(ai * 128 + m * 16 + rl0) * 8 + wc] = ss;
                }
            LDS_BARRIER();
            f32x4 gv[2][2];
#pragma unroll
            for (int bj = 0; bj < 2; ++bj)
#pragma unroll
                for (int n = 0; n < 2; ++n) gv[bj][n] = *(const LAS f32x4*)(red + XL_CONST + 128 * bj + 32 * wc + 8 * fq + 4 * n);
            bf16_t* base = QLN + wc * 32 + 8 * fq;
#pragma unroll
            for (int ai = 0; ai < 2; ++ai)
#pragma unroll
                for (int m = 0; m < 4; ++m) {
                    const f32x4 t = *(const LAS f32x4*)(red + (ai * 128 + m * 16 + rl0) * 8);
                    const float r = __builtin_amdgcn_rsqf(((t[0] + t[1]) + (t[2] + t[3])) * (1.0f / 256.0f) + EPS);
                    bf16_t* rp = base + (row0 + ai * 128 + m * 16) * 256;
#pragma unroll
                    for (int bj = 0; bj < 2; ++bj) st16(rp + bj * 128, pack8(acc[ai][bj][m][0] * r * gv[bj][0], acc[ai][bj][m][1] * r * gv[bj][1]));
                }
        } else {
#pragma unroll
            for (int ai = 0; ai < 2; ++ai)
#pragma unroll
                for (int m = 0; m < 4; ++m) {
                    float ss = dot4(acc[ai][0][m][0]) + dot4(acc[ai][0][m][1]);
                    ss = xsum32(xsum16(ss));
                    if (fq == 0) red[(ai * 128 + m * 16 + rl0) * 8 + wc] = ss;
                }
            LDS_BARRIER();
            f32x4 gv[2];
#pragma unroll
            for (int n = 0; n < 2; ++n) gv[n] = *(const LAS f32x4*)(red + XL_CONST + 256 + 32 * wc + 8 * fq + 4 * n);
            bf16_t* base = KVLN + wc * 32 + 8 * fq;
#pragma unroll
            for (int ai = 0; ai < 2; ++ai)
#pragma unroll
                for (int m = 0; m < 4; ++m) {
                    const f32x4 t = *(const LAS f32x4*)(red + (ai * 128 + m * 16 + rl0) * 8);
                    const float r = __builtin_amdgcn_rsqf(((t[0] + t[1]) + (t[2] + t[3])) * (1.0f / 128.0f) + EPS);
                    const size_t row = row0 + ai * 128 + m * 16;
                    bf16_t* rp = base + row * 256;
                    st16(rp, pack8(acc[ai][0][m][0] * r * gv[0], acc[ai][0][m][1] * r * gv[1]));
                    { unsigned z0; asm volatile("v_mov_b32 %0, 0" : "=v"(z0)); st16(rp + 128, (u32x4){z0, z0, z0, z0}); }
                    if (wc == 0) {
                        *(f32x4*)(KR + row * 32 + 8 * fq) = acc[ai][1][m][0]; *(f32x4*)(KR + row * 32 + 8 * fq + 4) = acc[ai][1][m][1];
                        float sr = dot4(acc[ai][1][m][0]) + dot4(acc[ai][1][m][1]);
                        sr = xsum32(xsum16(sr));
                        if (fq == 0) SSR[row] = sr;
                    }
                }
        }
    }
};

struct EpiQ {
    static constexpr bool APERM = false, PREFETCH = false, FP8 = false;
    unsigned char* ws; const float* g;
    __device__ __forceinline__ void operator()(const f32x4 (&acc)[2][2][4][2], const Unit& u, int wr, int wc, int fr, int fq, LAS float* red) const {
        asm volatile("" : "+v"(fr), "+v"(fq), "+s"(wr), "+s"(wc));
        const int rl0 = wr * 64 + fr; const size_t row0 = (size_t)u.pm * 256 + rl0;
        bf16_t* const QM = (bf16_t*)(ws + WS_QM); const float* const cosT = (const float*)(ws + WS_COS); const float* const sinT = (const float*)(ws + WS_SIN);
#pragma unroll
        for (int ai = 0; ai < 2; ++ai)
#pragma unroll
            for (int m = 0; m < 4; ++m)
#pragma unroll
                for (int bj = 0; bj < 2; ++bj) {
                    float ss = dot4(acc[ai][bj][m][0]) + dot4(acc[ai][bj][m][1]);
                    ss = xsum32(xsum16(ss));
                    if (fq == 0) red[(ai * 128 + m * 16 + rl0) * 8 + bj * 4 + wc] = ss;
                }
        LDS_BARRIER();
        if (wc < 2) {
            const f32x4 g0 = *(const f32x4*)(g + 32 * wc + 8 * fq) * (C2_MLA * F8_QS), g1 = *(const f32x4*)(g + 32 * wc + 8 * fq + 4) * (C2_MLA * F8_QS);
#pragma unroll
            for (int ai = 0; ai < 2; ++ai)
#pragma unroll
                for (int mp = 0; mp < 2; ++mp) {
                    const size_t row = row0 + ai * 128 + (2 * mp) * 16;
#pragma unroll
                    for (int bj = 0; bj < 2; ++bj) { u32x2 d[2];
#pragma unroll
                        for (int mm = 0; mm < 2; ++mm) { const int m = 2 * mp + mm;
                            const f32x4 t = *(const LAS f32x4*)(red + (ai * 128 + m * 16 + rl0) * 8 + bj * 4);
                            const float r = __builtin_amdgcn_rsqf(((t[0] + t[1]) + (t[2] + t[3])) * (1.0f / 96.0f) + EPS);
                            d[mm] = f8x8u(acc[ai][bj][m][0] * r * g0, acc[ai][bj][m][1] * r * g1); }
                        unsigned char* pa = (unsigned char*)QM + ((unsigned)row * 768u + (2 * u.pn + bj) * 96u + 32u * wc + 8u * fq);
                        st8pair(pa, pa + 16 * 768, d[0], d[1], fq);
                    }
                }
        } else if (wc == 2) {
            const f32x4 g0 = *(const f32x4*)(g + 64 + 4 * fq) * (C2_MLA * F8_QS), g1 = *(const f32x4*)(g + 80 + 4 * fq) * (C2_MLA * F8_QS);
            f32x4 csv[2][4], snv[2][4];
#pragma unroll
            for (int ai = 0; ai < 2; ++ai)
#pragma unroll
                for (int m = 0; m < 4; ++m) { const unsigned ro = ((unsigned)row0 + ai * 128 + m * 16) * 64u + 16u * fq; csv[ai][m] = *(const f32x4*)((const unsigned char*)cosT + ro); snv[ai][m] = *(const f32x4*)((const unsigned char*)sinT + ro); }
#pragma unroll
            for (int ai = 0; ai < 2; ++ai) {
#pragma unroll
                for (int m = 0; m < 4; ++m) {
                    const unsigned rowu = (unsigned)row0 + ai * 128 + m * 16;
#pragma unroll
                    for (int bj = 0; bj < 2; ++bj) {
                        const f32x4 t = *(const LAS f32x4*)(red + (ai * 128 + m * 16 + rl0) * 8 + bj * 4);
                        const float r = __builtin_amdgcn_rsqf(((t[0] + t[1]) + (t[2] + t[3])) * (1.0f / 96.0f) + EPS);
                        unsigned char* hp = (unsigned char*)QM + (rowu * 768u + (2 * u.pn + bj) * 96u);
                        const f32x4 x1 = acc[ai][bj][m][0] * r * g0, x2 = acc[ai][bj][m][1] * r * g1;
                        { const f32x4 ya = x1 * csv[ai][m] - x2 * snv[ai][m], yb = x2 * csv[ai][m] + x1 * snv[ai][m]; *(unsigned*)(hp + 64 + 4 * fq) = pk_fp8x4u(ya[0], ya[1], ya[2], ya[3]); *(unsigned*)(hp + 80 + 4 * fq) = pk_fp8x4u(yb[0], yb[1], yb[2], yb[3]); }
                    }
                }
                asm volatile("" ::: "memory");
            }
        }
    }
};

struct EpiKV {
    static constexpr bool APERM = false, PREFETCH = false, FP8 = false;
    unsigned char* ws; const float* g;
    __device__ __forceinline__ void operator()(const f32x4 (&acc)[2][2][4][2], const Unit& u, int wr, int wc, int fr, int fq, LAS float* red) const {
        asm volatile("" : "+v"(fr), "+v"(fq), "+s"(wr), "+s"(wc));
        const int rl0 = wr * 64 + fr; const size_t row0 = (size_t)u.pm * 256 + rl0;
        bf16_t* const KM = (bf16_t*)(ws + WS_KM); bf16_t* const VM = (bf16_t*)(ws + WS_VM); const float* const cosT = (const float*)(ws + WS_COS); const float* const sinT = (const float*)(ws + WS_SIN);
        const float* const KR = (const float*)(ws + WS_KR); const float* const SSR = (const float*)(ws + WS_SSR);
        if (wc < 2) {
#pragma unroll
            for (int ai = 0; ai < 2; ++ai)
#pragma unroll
                for (int m = 0; m < 4; ++m)
#pragma unroll
                    for (int bj = 0; bj < 2; ++bj) {
                        float ss = dot4(acc[ai][bj][m][0]) + dot4(acc[ai][bj][m][1]);
                        ss = xsum32(xsum16(ss));
                        if (fq == 0) red[(ai * 128 + m * 16 + rl0) * 8 + bj * 2 + wc] = ss;
                    }
        }
        LDS_BARRIER();
        if (wc < 2) {
            const f32x4 g0 = *(const f32x4*)(g + 32 * wc + 8 * fq) * F8_KS, g1 = *(const f32x4*)(g + 32 * wc + 8 * fq + 4) * F8_KS;
            float ssrv[2][4];
#pragma unroll
            for (int ai = 0; ai < 2; ++ai)
#pragma unroll
                for (int m = 0; m < 4; ++m) ssrv[ai][m] = SSR[row0 + ai * 128 + m * 16];
#pragma unroll
            for (int ai = 0; ai < 2; ++ai)
#pragma unroll
                for (int mp = 0; mp < 2; ++mp) {
                    const size_t row = row0 + ai * 128 + (2 * mp) * 16;
                    const f32x4 t0 = *(const LAS f32x4*)(red + (ai * 128 + (2 * mp) * 16 + rl0) * 8), t1 = *(const LAS f32x4*)(red + (ai * 128 + (2 * mp + 1) * 16 + rl0) * 8);
#pragma unroll
                    for (int bj = 0; bj < 2; ++bj) {
                        const float rk0 = __builtin_amdgcn_rsqf((t0[2 * bj] + t0[2 * bj + 1] + ssrv[ai][2 * mp]) * (1.0f / 96.0f) + EPS), rk1 = __builtin_amdgcn_rsqf((t1[2 * bj] + t1[2 * bj + 1] + ssrv[ai][2 * mp + 1]) * (1.0f / 96.0f) + EPS);
                        unsigned char* pa = (unsigned char*)KM + ((unsigned)row * 768u + (2 * u.pn + bj) * 96u + 32u * wc + 8u * fq);
                        st8pair(pa, pa + 16 * 768, f8x8u(acc[ai][bj][2 * mp][0] * rk0 * g0, acc[ai][bj][2 * mp][1] * rk0 * g1), f8x8u(acc[ai][bj][2 * mp + 1][0] * rk1 * g0, acc[ai][bj][2 * mp + 1][1] * rk1 * g1), fq);
                    }
                    asm volatile("" ::: "memory");
                }
        } else {
            const int bj0 = wc - 2, h0 = 2 * u.pn + bj0;
            { float* pv = (float*)(ws + WS_PARTV) + ((size_t)u.pm * 2 + wr) * 1024 + (2 * u.pn) * 64 + 32 * (wc - 2) + 8 * fq;
              colsum8(acc, 0, fr, pv); colsum8(acc, 1, fr, pv + 64); }
            const f32x4 g0 = *(const f32x4*)(g + 64 + 4 * fq) * F8_KS, g1 = *(const f32x4*)(g + 80 + 4 * fq) * F8_KS;
#pragma unroll
            for (int ai = 0; ai < 2; ++ai)
#pragma unroll
              for (int mp = 0; mp < 2; ++mp) { const unsigned rowa = (unsigned)row0 + ai * 128 + (2 * mp) * 16;
#pragma unroll
                  for (int bj = 0; bj < 2; ++bj) { unsigned char* pa = (unsigned char*)VM + (rowa * 512u + (2 * u.pn + bj) * 64u + 32u * (wc - 2) + 8u * fq);
                      st8pair(pa, pa + 16 * 512, f8x8(acc[ai][bj][2 * mp][0], acc[ai][bj][2 * mp][1]), f8x8(acc[ai][bj][2 * mp + 1][0], acc[ai][bj][2 * mp + 1][1]), fq); } }
            asm volatile("" ::: "memory");
#pragma unroll
            for (int ai = 0; ai < 2; ++ai) {
                f32x4 csv[4], snv[4], k1v[4], k2v[4]; float ssrv[4];
#pragma unroll
                for (int m = 0; m < 4; ++m) { const unsigned rowu = (unsigned)row0 + ai * 128 + m * 16; csv[m] = *(const f32x4*)((const unsigned char*)cosT + rowu * 64u + 16u * fq); snv[m] = *(const f32x4*)((const unsigned char*)sinT + rowu * 64u + 16u * fq);
                    k1v[m] = *(const f32x4*)((const unsigned char*)KR + rowu * 128u + 16u * fq); k2v[m] = *(const f32x4*)((const unsigned char*)KR + rowu * 128u + 64u + 16u * fq); ssrv[m] = *(const float*)((const unsigned char*)SSR + rowu * 4u); }
#pragma unroll
                for (int m = 0; m < 4; ++m) {
                    const unsigned rowu = (unsigned)row0 + ai * 128 + m * 16;
                    const f32x2 t = *(const LAS f32x2*)(red + (ai * 128 + m * 16 + rl0) * 8 + 2 * bj0);
                    const float rk = __builtin_amdgcn_rsqf((t[0] + t[1] + ssrv[m]) * (1.0f / 96.0f) + EPS);
                    const f32x4 x1 = k1v[m] * rk * g0, x2 = k2v[m] * rk * g1;
                    unsigned char* hp = (unsigned char*)KM + (rowu * 768u + h0 * 96u);
                    { const f32x4 ya = x1 * csv[m] - x2 * snv[m], yb = x2 * csv[m] + x1 * snv[m]; *(unsigned*)(hp + 64 + 4 * fq) = pk_fp8x4u(ya[0], ya[1], ya[2], ya[3]); *(unsigned*)(hp + 80 + 4 * fq) = pk_fp8x4u(yb[0], yb[1], yb[2], yb[3]); }
                }
                asm volatile("" ::: "memory");
            }
        }
    }
};

struct EpiQKV {
    static constexpr bool APERM = false, PREFETCH = false, FP8 = false;
    EpiQ q; EpiKV kv;
    __device__ __forceinline__ void operator()(const f32x4 (&acc)[2][2][4][2], const Unit& u, int wr, int wc, int fr, int fq, LAS float* red) const {
        if (u.pn < 4) q(acc, u, wr, wc, fr, fq, red);
        else { Unit v; v.pm = u.pm; v.pn = u.pn - 4; kv(acc, v, wr, wc, fr, fq, red); }
    }
};

__device__ __forceinline__ void f8_pre(f32x4 (&acc)[2][2][4][2], const float* side, int ld, float descale, const Unit& u, int wc, int fq) {
    asm volatile("" : "+v"(fq), "+s"(wc));
    const char* sb = (const char*)(side + (size_t)(u.pm >> 3) * ld + u.pn * 256 + wc * 32); const unsigned vo = (unsigned)fq * 32u;
    f32x4 bv[2][2];
#pragma unroll
    for (int bj = 0; bj < 2; ++bj)
#pragma unroll
        for (int n = 0; n < 2; ++n) bv[bj][n] = *(const f32x4*)(sb + vo + (128 * bj + 4 * n) * 4);
#pragma unroll
    for (int a = 0; a < 2; ++a)
#pragma unroll
        for (int bj = 0; bj < 2; ++bj)
#pragma unroll
            for (int m = 0; m < 4; ++m)
#pragma unroll
                for (int n = 0; n < 2; ++n) acc[a][bj][m][n] = acc[a][bj][m][n] * descale + bv[bj][n];
}
template <bool RES_BF16, bool OUT_BF16, bool F8 = false> struct EpiRes {
    static constexpr bool APERM = false, PREFETCH = false, FP8 = F8;
    __device__ __forceinline__ void pre(f32x4 (&acc)[2][2][4][2], const Unit& u, int wc, int fq) const { f8_pre(acc, side, 1024, 1.0f / (F8_O_SCALE * F8_WOUT_SCALE), u, wc, fq); }
    const void* base; void* out; const float* gate; const float* side = nullptr;
    __device__ __forceinline__ void operator()(const f32x4 (&acc)[2][2][4][2], const Unit& u, int wr, int wc, int fr, int fq, LAS float* red) const {
        asm volatile("" : "+v"(fr), "+v"(fq), "+s"(wr), "+s"(wc));
        const int b = u.pm >> 3; const int col0 = u.pn * 256 + wc * 32 + 8 * fq;
        f32x4 gv[2][2];
#pragma unroll
        for (int bj = 0; bj < 2; ++bj)
#pragma unroll
            for (int n = 0; n < 2; ++n) gv[bj][n] = *(const f32x4*)(gate + (size_t)b * NMOD + col0 + 128 * bj + 4 * n);
        if (RES_BF16) {
            u32x4 raw[2][4][2];
#pragma unroll
            for (int ai = 0; ai < 2; ++ai)
#pragma unroll
                for (int m = 0; m < 4; ++m)
#pragma unroll
                    for (int bj = 0; bj < 2; ++bj) raw[ai][m][bj] = *(const u32x4*)((const bf16_t*)base + ((size_t)u.pm * 256 + ai * 128 + wr * 64 + fr) * DM + col0 + (size_t)m * 16 * DM + 128 * bj);
#pragma unroll
            for (int ai = 0; ai < 2; ++ai) {
                const size_t off0 = ((size_t)u.pm * 256 + ai * 128 + wr * 64 + fr) * DM + col0;
#pragma unroll
                for (int m = 0; m < 4; ++m)
#pragma unroll
                    for (int bj = 0; bj < 2; ++bj) { const u32x4 w = raw[ai][m][bj];
                        const f32x4 x0 = (f32x4){__uint_as_float(w.x << 16), __uint_as_float(w.x & 0xffff0000u), __uint_as_float(w.y << 16), __uint_as_float(w.y & 0xffff0000u)};
                        const f32x4 x1 = (f32x4){__uint_as_float(w.z << 16), __uint_as_float(w.z & 0xffff0000u), __uint_as_float(w.w << 16), __uint_as_float(w.w & 0xffff0000u)};
                        const f32x4 v0 = x0 + gv[bj][0] * acc[ai][bj][m][0], v1 = x1 + gv[bj][1] * acc[ai][bj][m][1];
                        if (OUT_BF16) st16((bf16_t*)out + off0 + (size_t)m * 16 * DM + 128 * bj, pack8(v0, v1));
                        else { *(f32x4*)((float*)out + off0 + (size_t)m * 16 * DM + 128 * bj) = v0; *(f32x4*)((float*)out + off0 + (size_t)m * 16 * DM + 128 * bj + 4) = v1; } }
                asm volatile("" ::: "memory");
            }
        } else {
#pragma unroll
        for (int ai = 0; ai < 2; ++ai) {
            const size_t off0 = ((size_t)u.pm * 256 + ai * 128 + wr * 64 + fr) * DM + col0;
            f32x4 xs[4][2][2];
#pragma unroll
            for (int m = 0; m < 4; ++m)
#pragma unroll
                for (int bj = 0; bj < 2; ++bj)
#pragma unroll
                    for (int n = 0; n < 2; ++n) xs[m][bj][n] = *(const f32x4*)((const float*)base + off0 + (size_t)m * 16 * DM + 128 * bj + 4 * n);
#pragma unroll
            for (int m = 0; m < 4; ++m)
#pragma unroll
                for (int bj = 0; bj < 2; ++bj) {
                    const f32x4 v0 = xs[m][bj][0] + gv[bj][0] * acc[ai][bj][m][0], v1 = xs[m][bj][1] + gv[bj][1] * acc[ai][bj][m][1];
                    if (OUT_BF16) st16((bf16_t*)out + off0 + (size_t)m * 16 * DM + 128 * bj, pack8(v0, v1));
                    else { *(f32x4*)((float*)out + off0 + (size_t)m * 16 * DM + 128 * bj) = v0; *(f32x4*)((float*)out + off0 + (size_t)m * 16 * DM + 128 * bj + 4) = v1; }
                }
            asm volatile("" ::: "memory");
        }
        }
    }
};

struct EpiResNorm {
    static constexpr bool APERM = false, PREFETCH = true, FP8 = true;
    __device__ __forceinline__ void prefetch(const Unit& u, LAS float* xl, int par, int wid, int lane) const {
        asm volatile("" : "+v"(lane));
        if (wid < 5) { const int b = u.pm >> 3; const float* MODb = (const float*)(ws + WS_MOD) + (size_t)b * NMOD;
            const float* src = wid == 0 ? (const float*)(ws + WS_BIAS2) + (size_t)b * 1024 : wid == 1 ? gate + (size_t)b * NMOD : wid == 2 ? gn : wid == 3 ? MODb + 4 * DM : MODb + 3 * DM;
            glds16_(src + u.pn * 256 + 4 * lane, (unsigned)__builtin_amdgcn_readfirstlane((unsigned)(uintptr_t)(xl + XL_CONST + par * 1280 + wid * 256))); }
    }
    __device__ __forceinline__ void pre(f32x4 (&acc)[2][2][4][2], const Unit& u, int wc, int fq, LAS float* xl, int par) const { f8_pre_lds(acc, xl + XL_CONST + par * 1280, 1.0f / (F8_O_SCALE * F8_WOUT_SCALE), wc, fq); }
    const float* base; unsigned char* ws; const float* gate; const float* gn;
    __device__ __forceinline__ void operator()(f32x4 (&acc)[2][2][4][2], const Unit& u, int wr, int wc, int fr, int fq, LAS float* red, int par) const {
        asm volatile("" : "+v"(fr), "+v"(fq), "+s"(wr), "+s"(wc));
        const int b = u.pm >> 3; const int col0 = u.pn * 256 + wc * 32 + 8 * fq; const int rl0 = wr * 64 + fr;
        const LAS float* cst = red + XL_CONST + par * 1280 + wc * 32 + 8 * fq;
        bf16_t* const X1 = (bf16_t*)(ws + WS_X1); bf16_t* const H2 = (bf16_t*)(ws + WS_H2); const float* const MOD = (const float*)(ws + WS_MOD);
        {
            f32x4 gv[2][2];
#pragma unroll
            for (int bj = 0; bj < 2; ++bj)
#pragma unroll
                for (int n = 0; n < 2; ++n) gv[bj][n] = *(const LAS f32x4*)(cst + 256 + 128 * bj + 4 * n);
#pragma unroll
            for (int ai = 0; ai < 2; ++ai) {
                const size_t off0 = ((size_t)u.pm * 256 + ai * 128 + rl0) * DM + col0;
                f32x4 xs[4][2][2];
#pragma unroll
                for (int m = 0; m < 4; ++m)
#pragma unroll
                    for (int bj = 0; bj < 2; ++bj)
#pragma unroll
                        for (int n = 0; n < 2; ++n) xs[m][bj][n] = *(const f32x4*)(base + off0 + (size_t)m * 16 * DM + 128 * bj + 4 * n);
#pragma unroll
                for (int m = 0; m < 4; ++m) { float ss = 0.f;
#pragma unroll
                    for (int bj = 0; bj < 2; ++bj) {
#pragma unroll
                        for (int n = 0; n < 2; ++n) { const f32x4 v = xs[m][bj][n] + gv[bj][n] * acc[ai][bj][m][n]; acc[ai][bj][m][n] = v; ss += dot4(v); }
                        st16(X1 + off0 + (size_t)m * 16 * DM + 128 * bj, pack8(acc[ai][bj][m][0], acc[ai][bj][m][1])); }
                    ss = xsum32(xsum16(ss));
                    if (fq == 0) red[(ai * 128 + m * 16 + rl0) * 8 + wc] = ss;
                }
                asm volatile("" ::: "memory");
            }
        }
        LDS_BARRIER();
        const int tid = tid_from_wave(wr * 4 + wc);
        if (tid < 256) {
            const f32x4 t = *(const LAS f32x4*)(red + tid * 8);
            const float mine = (t[0] + t[1]) + (t[2] + t[3]);
            unsigned long long* slot = (unsigned long long*)(ws + WS_PART) + ((size_t)u.pm * 256 + tid) * 4;
            { unsigned tg; asm volatile("v_mov_b32 %0, 1" : "=v"(tg));
              __hip_atomic_store(slot + u.pn, ((unsigned long long)tg << 32) | (unsigned long long)__float_as_uint(mine), __ATOMIC_RELAXED, __HIP_MEMORY_SCOPE_AGENT); }
            float tot = mine;
#pragma unroll
            for (int k = 1; k < 4; ++k) { const int pk = (u.pn + k) & 3; unsigned long long w; unsigned sp = 0;
                for (;;) { w = __hip_atomic_load(slot + pk, __ATOMIC_RELAXED, __HIP_MEMORY_SCOPE_AGENT); if ((unsigned)(w >> 32) == 1u || ++sp > (1u << 22)) break; __builtin_amdgcn_s_sleep(1); }
                tot += __uint_as_float((unsigned)w); }
            red[tid * 8 + 4] = __builtin_amdgcn_rsqf(tot * (1.0f / DM) + EPS);
        }
        LDS_BARRIER();
        {
            f32x4 Gv[2][2], Sv[2][2];
#pragma unroll
            for (int bj = 0; bj < 2; ++bj)
#pragma unroll
                for (int n = 0; n < 2; ++n) { const int c = col0 + 128 * bj + 4 * n;
                    Gv[bj][n] = *(const LAS f32x4*)(cst + 512 + 128 * bj + 4 * n) * (*(const LAS f32x4*)(cst + 768 + 128 * bj + 4 * n) + 1.0f); Sv[bj][n] = *(const LAS f32x4*)(cst + 1024 + 128 * bj + 4 * n); (void)c; }
#pragma unroll
            for (int ai = 0; ai < 2; ++ai)
#pragma unroll
                for (int m = 0; m < 4; ++m) {
                    const float r = red[(ai * 128 + m * 16 + rl0) * 8 + 4];
                    bf16_t* rp = H2 + ((size_t)u.pm * 256 + ai * 128 + m * 16 + rl0) * DM + col0;
#pragma unroll
                    for (int bj = 0; bj < 2; ++bj) st16(rp + 128 * bj, pack8(acc[ai][bj][m][0] * r * Gv[bj][0] + Sv[bj][0], acc[ai][bj][m][1] * r * Gv[bj][1] + Sv[bj][1]));
                }
        }
    }
};

__device__ __forceinline__ float dpp_shr1(float v) { return __builtin_bit_cast(float, __builtin_amdgcn_update_dpp(0, __builtin_bit_cast(int, v), 0x111, 0xF, 0xF, true)); }
__device__ __forceinline__ f32x4 dpp_shr1(f32x4 v) { f32x4 r; r[0] = dpp_shr1(v[0]); r[1] = dpp_shr1(v[1]); r[2] = dpp_shr1(v[2]); r[3] = dpp_shr1(v[3]); return r; }
struct EpiUp {
    static constexpr bool APERM = true, PREFETCH = true, FP8 = false;
    unsigned char* ws; const float *cw, *cb;
    __device__ __forceinline__ void prefetch(const Unit& u, LAS float* xl, int par, int wid, int lane) const {
        asm volatile("" : "+v"(lane));
        if (wid < 4) { const float* src = (wid < 3 ? cw + (size_t)wid * DFF2 : cb) + (lane < 32 ? 128 * u.pn + 4 * lane : DFF + 128 * u.pn + 4 * (lane - 32));
            glds16_(src, (unsigned)__builtin_amdgcn_readfirstlane((unsigned)(uintptr_t)(xl + par * 1024 + wid * 256))); }
    }
    __device__ __forceinline__ void operator()(const f32x4 (&acc)[2][2][4][2], const Unit& u, int wr, int wc, int fr, int fq, LAS float* xl, int par) const {
        asm volatile("" : "+v"(fr), "+v"(fq), "+s"(wr), "+s"(wc));
        const int j = u.pn; const int cc0 = 32 * wc + 8 * fq;
        bf16_t* const ACT = (bf16_t*)(ws + WS_ACT); bf16_t* const RAW4 = (bf16_t*)(ws + WS_RAW4);
        const LAS float* W = xl + par * 1024 + cc0;
#pragma unroll
        for (int ai = 0; ai < 2; ++ai) {
            const size_t blk = (size_t)u.pm * 4 + 2 * ai + wr;
            u32x2 pend[4];
#pragma unroll
            for (int n = 0; n < 2; ++n) {
                const f32x4 wg0 = *(const LAS f32x4*)(W + 4 * n), wg1 = *(const LAS f32x4*)(W + 256 + 4 * n), wg2 = *(const LAS f32x4*)(W + 512 + 4 * n), bg = *(const LAS f32x4*)(W + 768 + 4 * n);
                const f32x4 wv0 = *(const LAS f32x4*)(W + 128 + 4 * n), wv1 = *(const LAS f32x4*)(W + 384 + 4 * n), wv2 = *(const LAS f32x4*)(W + 640 + 4 * n), bv = *(const LAS f32x4*)(W + 896 + 4 * n);
                const f32x4 g2s = dpp_shr1(acc[ai][0][2][n]), g3s = dpp_shr1(acc[ai][0][3][n]), v2s = dpp_shr1(acc[ai][1][2][n]), v3s = dpp_shr1(acc[ai][1][3][n]);
#pragma unroll
                for (int m = 0; m < 4; ++m) {
                    const f32x4 gr = acc[ai][0][m][n], vr = acc[ai][1][m][n];
                    const f32x4 gp1 = m == 0 ? g3s : acc[ai][0][m - 1 < 0 ? 0 : m - 1][n], gp2 = m == 0 ? g2s : (m == 1 ? g3s : acc[ai][0][m - 2 < 0 ? 0 : m - 2][n]);
                    const f32x4 vp1 = m == 0 ? v3s : acc[ai][1][m - 1 < 0 ? 0 : m - 1][n], vp2 = m == 0 ? v2s : (m == 1 ? v3s : acc[ai][1][m - 2 < 0 ? 0 : m - 2][n]);
                    const f32x4 G = wg2 * gr + (wg1 * gp1 + (wg0 * gp2 + bg)), V = wv2 * vr + (wv1 * vp1 + (wv0 * vp2 + bv));
                    f32x4 a;
#pragma unroll
                    for (int e = 0; e < 4; ++e) a[e] = G[e] * __builtin_amdgcn_rcpf(1.0f + __builtin_amdgcn_exp2f(-LOG2E * G[e])) * V[e];
                    if (n == 0) pend[m] = pack4(a);
                    else if (m >= 2 || fr > 0) { const u32x2 hi2 = pack4(a); const unsigned boff = (((unsigned)blk * 64u + 4u * fr + m) * DFF + 128u * j + cc0) * 2u;
                        st16o(ACT, boff, (u32x4){pend[m].x, pend[m].y, hi2.x, hi2.y}); }
                    if ((m < 2 && fr == 0) || (m >= 2 && fr == 15)) { const unsigned roff = (((unsigned)blk * 4u + m) * DFF2 + 256u * j + cc0 + 4u * n) * 2u; *(u32x2*)((unsigned char*)RAW4 + roff) = pack4(gr); *(u32x2*)((unsigned char*)RAW4 + roff + 256u) = pack4(vr); }
                }
            }
            asm volatile("" ::: "memory");
        }
    }
};

namespace att {
__device__ __forceinline__ int crow(int r, int hi) { return (r & 3) + 8 * (r >> 2) + 4 * hi; }
__device__ __forceinline__ void glds16(const void* gsrc, unsigned lds_dst) { unsigned keep;
    asm volatile("s_mov_b32 %0, m0\n\ts_mov_b32 m0, %2\n\ts_nop 0\n\tglobal_load_lds_dwordx4 %1, off\n\ts_mov_b32 m0, %0" : "=&s"(keep) : "v"(gsrc), "s"(lds_dst) : "memory"); }
__device__ __forceinline__ void glds16s(const void* sbase, unsigned voff, unsigned lds_dst) { unsigned keep;
    asm volatile("s_mov_b32 %0, m0\n\ts_mov_b32 m0, %3\n\ts_nop 0\n\tglobal_load_lds_dwordx4 %1, %2\n\ts_mov_b32 m0, %0" : "=&s"(keep) : "v"(voff), "s"(sbase), "s"(lds_dst) : "memory"); }
__device__ __forceinline__ float max3f(float a, float b, float c) { float r; asm("v_max3_f32 %0, %1, %2, %3" : "=v"(r) : "v"(a), "v"(b), "v"(c)); return r; }
__device__ __forceinline__ float rowmax(const f32x16& p0, const f32x16& p1) {
    float a = max3f(p0[0], p0[1], p1[0]), b = max3f(p0[2], p0[3], p1[1]); a = max3f(a, p1[2], p1[3]);
#pragma unroll
    for (int r = 4; r < 16; r += 4) { a = max3f(a, p0[r], p0[r + 1]); b = max3f(b, p0[r + 2], p0[r + 3]); a = max3f(a, p1[r], p1[r + 1]); b = max3f(b, p1[r + 2], p1[r + 3]); }
    const float m = fmaxf(a, b);
    auto rr = __builtin_amdgcn_permlane32_swap(__float_as_uint(m), __float_as_uint(m), false, false);
    return fmaxf(__uint_as_float(rr[0]), __uint_as_float(rr[1]));
}
typedef short v4i16_t __attribute__((ext_vector_type(4)));
__device__ __forceinline__ s16x4 vtr(const LAS unsigned char* p) { return __builtin_bit_cast(s16x4, __builtin_amdgcn_ds_read_tr16_b64_v4i16((LAS v4i16_t*)p)); }
__device__ __forceinline__ void pv(f32x16* o, const LAS unsigned char* vp, bf16x8 pa0, bf16x8 pa1, bf16x8 pa2, bf16x8 pa3) {
#pragma unroll
    for (int d0 = 0; d0 < 2; ++d0) { s16x4 lo[4], hi[4];
        __builtin_amdgcn_sched_barrier(0);
#pragma unroll
        for (int ks = 0; ks < 4; ++ks) { lo[ks] = vtr(vp + d0 * 4096 + ks * 1024); hi[ks] = vtr(vp + d0 * 4096 + ks * 1024 + 512); }
#define PK(k) (bf16x8){lo[k][0], lo[k][1], lo[k][2], lo[k][3], hi[k][0], hi[k][1], hi[k][2], hi[k][3]}
        o[d0] = __builtin_amdgcn_mfma_f32_32x32x16_bf16(pa0, PK(0), o[d0], 0, 0, 0);
        o[d0] = __builtin_amdgcn_mfma_f32_32x32x16_bf16(pa1, PK(1), o[d0], 0, 0, 0);
        o[d0] = __builtin_amdgcn_mfma_f32_32x32x16_bf16(pa2, PK(2), o[d0], 0, 0, 0);
        o[d0] = __builtin_amdgcn_mfma_f32_32x32x16_bf16(pa3, PK(3), o[d0], 0, 0, 0);
#undef PK
    }
}
constexpr int NSLOT = 4;
constexpr int ATT_LDS_BYTES = 3 * 6144 + 3 * 4096 + 8 * 256 + 2048 + 3 * 16384 + 8 * 2048 + 4096;

__device__ __forceinline__ float wave_max(float v) {
#pragma unroll
    for (int o = 1; o < 64; o <<= 1) v = fmaxf(v, __shfl_xor(v, o));
    return v;
}
template <int DQK, bool CA>
__device__ __forceinline__ void attn_run(int tid, int b, int h, unsigned ulist, int nu, const unsigned char* Q, const unsigned char* K, const unsigned char* V, unsigned char* O, float* REF, unsigned* refcnt, const float* PARTV, const float* relb, float S0, LAS unsigned char* shm) {
    constexpr int NQ = (DQK + 63) / 64, NGQ = 2 * NQ, NQL = 2 * NQ, NCH = DQK / 16, KSLOT = NCH * 1024, VSLOT = 4096, NS = 3;
    constexpr int LDS_K = 0, LDS_V = NS * KSLOT, LDS_WS = LDS_V + NS * VSLOT, LDS_TAB = LDS_WS + 8 * 256, LDS_IMG = LDS_TAB + 2048, LDS_OST = LDS_IMG + (CA ? 3 * 16384 : 0), LDS_VB = LDS_OST + 8 * 2048;
    constexpr int LDQ = CA ? 512 : 768, LDV = 512, LDO = 1024, OCOL = CA ? 512 : 0;
    const int lane = tid & 63, r32 = lane & 31, hi = lane >> 5; const int wid = __builtin_amdgcn_readfirstlane(tid >> 6);
    const long rowbase = (long)b * SEQ; const int tidl = wid * 64 + lane;
    const unsigned lds0 = (unsigned)(uintptr_t)shm;
    LAS float* tab = (LAS float*)(shm + LDS_TAB);
    const unsigned char* Kb = K + rowbase * LDQ + h * DQK; const unsigned char* Vb = V + rowbase * LDV + h * 64;
    const bool kw = wid < NCH, vw = wid >= 4;
    const unsigned kvoff = (unsigned)(lane * LDQ + (wid < NCH ? wid : 0) * 16);
    const unsigned vvoff = (unsigned)((16 * (wid & 3) + (lane >> 2)) * LDV + (lane & 3) * 16);
#define SBAR() __builtin_amdgcn_sched_barrier(0)
#define PIN(x) asm volatile("" : "+v"(x))
#define DMA_K(t, sl) do { if (kw) glds16s(Kb + (long)(t) * 64 * LDQ, kvoff, (unsigned)__builtin_amdgcn_readfirstlane(lds0 + LDS_K + (sl) * KSLOT + wid * 1024)); } while (0)
#define DMA_V(t, sl) do { if (vw) glds16s(Vb + (long)(t) * 64 * LDV, vvoff, (unsigned)__builtin_amdgcn_readfirstlane(lds0 + LDS_V + (sl) * VSLOT + (wid & 3) * 1024)); } while (0)
#define WAIT_BAR(N) asm volatile("s_waitcnt vmcnt(%0) lgkmcnt(0)\n\ts_barrier" :: "n"(N) : "memory")
#define WAIT_KV(nK, nV, X) do { if (kw && vw) WAIT_BAR((nK) + (nV) + (X)); else if (kw) WAIT_BAR((nK) + (X)); else if (vw) WAIT_BAR((nV) + (X)); else WAIT_BAR(X); } while (0)
#define TVALID(tau) (CA ? ((tau) + t0 <= cw && (tau) + t0 >= cw - 8) : ((tau) + t0 <= cw))
#define TABS(x) ((x) < NT ? t0 + (x) : t0n + (x) - NT)
#define T0OF(u_) (CA ? (4 * (u_) - 8 > 0 ? 4 * (u_) - 8 : 0) : 0)
#define QLOAD(u_) do { const unsigned char* Qw_ = Q + (rowbase + (u_) * 256 + wid * 32) * LDQ + h * DQK; const int lq_ = tid_from_wave(0); const unsigned qo_ = (unsigned)((lq_ & 31) * LDQ); \
        _Pragma("unroll") for (int p = 0; p < NQ; ++p) { const unsigned po_ = qo_ + ((p == 1 && DQK == 96) ? 64u : (unsigned)(p * 64 + (lq_ >> 5) * 32)); \
            const i32x4 lo_ = *(const i32x4*)(Qw_ + po_), hi_ = *(const i32x4*)(Qw_ + po_ + 16); qr[p] = __builtin_shufflevector(lo_, hi_, 0, 1, 2, 3, 4, 5, 6, 7); } } while (0)
#define QREADY() do { _Pragma("unroll") for (int p = 0; p < NQ; ++p) asm volatile("" :: "v"(qr[p])); \
        if (DQK == 96) { _Pragma("unroll") for (int e = 0; e < 8; ++e) qr[NQ - 1][e] = hi ? (e == 0 ? 0x38 : 0) : qr[NQ - 1][e]; } } while (0)
#ifndef SH_EXTRA
#define SH_EXTRA 0
#endif
    float SHI = fmaxf(ceilf(S0 - 15.5f), 0.0f) + SH_EXTRA; float pcadd = 4.0f * (15.0f - SHI);
    const int cbyte = __builtin_amdgcn_cvt_pk_fp8_f32(pcadd, 0.0f, 0, false) & 0xff;
    float tabc = 0.f;
    const LAS unsigned char* vp0 = shm + LDS_V + (4 * hi + (((lane & 15) >> 1) & 3) + 8 * ((lane & 15) >> 3)) * 64 + ((lane >> 4) & 1) * 16 + (lane & 1) * 8;
    const LAS unsigned char* kp0 = shm + LDS_K + hi * 2048 + r32 * 16;
    const LAS unsigned char* kp1 = shm + LDS_K + 4096 + r32 * 16;
    const LAS unsigned char* imgp = shm + LDS_IMG + (wid & 1) * 8192 + lane * 16;
    i32x8 qr[NQ]; i32x8 kf[NGQ]  ; i32x8 vb[2]; i32x8 pw; f32x16 pA0, pA1, pB0, pB1;
    i32x8 ones8;
#pragma unroll
    for (int e = 0; e < 8; ++e) ones8[e] = 0x38383838;
    PIN(ones8);
    int sl_prev = 0, sl_cur = 0, sl_next = 1;
#define ROT() do { sl_prev = sl_cur; sl_cur = sl_next; sl_next = (sl_next == NS - 1) ? 0 : sl_next + 1; } while (0)
#define KFL(g, ks_) do { const LAS unsigned char* a_ = (((g) >> 1) ? kp1 : kp0) + (ks_) + ((g) & 1) * 512; const i32x4 lo_ = *(const LAS i32x4*)(a_), hi_ = *(const LAS i32x4*)(a_ + 1024); kf[g] = __builtin_shufflevector(lo_, hi_, 0, 1, 2, 3, 4, 5, 6, 7); \
        if (DQK == 96 && ((g) >> 1)) kf[g][0] = hi ? cbyte : kf[g][0]; } while (0)
#define QKM(kfr, qfr, C) __builtin_amdgcn_mfma_scale_f32_32x32x64_f8f6f4(kfr, qfr, C, 0, 0, 0, 0, 0, 0)
#define VRD(i, vp_) do { const i32x2 t_ = __builtin_amdgcn_ds_read_tr8_b64_v2i32((LAS i32x2*)((vp_) + ((i) & 3) * 1024 + ((i) >> 2) * 32)); vb[(i) >> 2][2 * ((i) & 3)] = t_[0]; vb[(i) >> 2][2 * ((i) & 3) + 1] = t_[1]; } while (0)
#define PEL(P0, P1, e) ((e) < 16 ? P0[(e) & 15] : P1[(e) & 15])
#define PWSET(w, P0, P1) do { unsigned x_ = (unsigned)undef_i32(); x_ = __builtin_amdgcn_cvt_pk_u8_f32(PEL(P0, P1, 4 * (w)), 0, x_); x_ = __builtin_amdgcn_cvt_pk_u8_f32(PEL(P0, P1, 4 * (w) + 1), 1, x_); \
        x_ = __builtin_amdgcn_cvt_pk_u8_f32(PEL(P0, P1, 4 * (w) + 2), 2, x_); x_ = __builtin_amdgcn_cvt_pk_u8_f32(PEL(P0, P1, 4 * (w) + 3), 3, x_); pw[w] = (int)x_; } while (0)
#define PVM(d0) o[d0] = __builtin_amdgcn_mfma_scale_f32_32x32x64_f8f6f4(pw, vb[d0], o[d0], 1, 0, 0, 0, 0, 0)
#define PVL() lacc = __builtin_amdgcn_mfma_scale_f32_32x32x64_f8f6f4(pw, ones8, lacc, 1, 0, 0, 0, 0, 0)
#define QK_FIRST(C0, C1, A0, A1, tau) do { const int dist_ = cw - ((tau) + t0); \
        if (CA && TVALID(tau) && dist_ < 3) { const LAS unsigned char* ip_ = imgp + dist_ * 16384; \
            _Pragma("unroll") for (int g = 0; g < 4; ++g) { const f32x4 x_ = *(const LAS f32x4*)(ip_ + g * 1024); C0[4 * g] = x_[0]; C0[4 * g + 1] = x_[1]; C0[4 * g + 2] = x_[2]; C0[4 * g + 3] = x_[3]; } \
            C0 = QKM(A0, qr[0], C0); \
            _Pragma("unroll") for (int g = 0; g < 4; ++g) { const f32x4 y_ = *(const LAS f32x4*)(ip_ + (g + 4) * 1024); C1[4 * g] = y_[0]; C1[4 * g + 1] = y_[1]; C1[4 * g + 2] = y_[2]; C1[4 * g + 3] = y_[3]; } \
            C1 = QKM(A1, qr[0], C1); } \
        else if (TVALID(tau)) { if (CA) { C0 = QKM(A0, qr[0], czc); C1 = QKM(A1, qr[0], czc); } else { const f32x16 cz_ = f32x16{}; C0 = QKM(A0, qr[0], cz_); C1 = QKM(A1, qr[0], cz_); } }        \
        else { f32x16 cz_; _Pragma("unroll") for (int r = 0; r < 16; ++r) cz_[r] = -INFINITY; C0 = QKM(A0, qr[0], cz_); C1 = QKM(A1, qr[0], cz_); } } while (0)
#define FILLA(i0, i1) do { _Pragma("unroll") for (int w = (8 * (i0)) / NGQ; w < (8 * (i1)) / NGQ; ++w) PWSET(w, P0_, P1_); \
        PIN(pw); } while (0)
#define PHASE_A(C0, C1, P0, P1, tau, vsl, GK, GV, kdst, vdst) do { const LAS unsigned char* vp_ = vp0 + (vsl) * VSLOT; f32x16& P0_ = P0; f32x16& P1_ = P1; \
        VRD(0, vp_); VRD(1, vp_); SBAR(); \
        QK_FIRST(C0, C1, kf[0], kf[1], tau); \
        FILLA(0, 2); SBAR(); \
        _Pragma("unroll") for (int i = 2; i < NGQ; ++i) { \
            VRD(2 * i - 2, vp_); VRD(2 * i - 1, vp_); SBAR(); \
            if ((i & 1) == 0) C0 = QKM(kf[i], qr[i >> 1], C0); else C1 = QKM(kf[i], qr[i >> 1], C1); \
            FILLA(i, i + 1); \
            if (i == NGQ - 2 && (GK)) DMA_K(TABS((tau) + 3), kdst); if (i == NGQ - 1 && (GV)) DMA_V(TABS((tau) + 1), vdst);     \
            SBAR(); } \
        if (NGQ == 2) { VRD(2, vp_); VRD(3, vp_); VRD(4, vp_); VRD(5, vp_); if (GK) DMA_K(TABS((tau) + 3), kdst); if (GV) DMA_V(TABS((tau) + 1), vdst); SBAR(); } \
        } while (0)
#define PHASE_B(C0, C1, GL, ksl, vsl, tau) do { const int kso_ = (ksl) * KSLOT; const LAS unsigned char* vq_ = vp0 + (vsl) * VSLOT; \
        _Pragma("unroll") for (int j = 0; j < 3; ++j) { \
            if (GL) { _Pragma("unroll") for (int g = (NGQ * j + 2) / 3; g < (NGQ * (j + 1) + 2) / 3; ++g) KFL(g, kso_); SBAR(); } \
            if (j == 0) { PVM(0); VRD(6, vq_); VRD(7, vq_); }       \
            else if (j == 1) PVM(1); else PVL(); \
            PIN(C0); PIN(C1); SBAR(); } } while (0)
#define STEP(C0, C1, P0, P1, tau, GK, GV, GL) do { SBAR(); \
        PHASE_A(C0, C1, P0, P1, tau, sl_prev, GK, GV, sl_cur, sl_next); SBAR(); \
        PHASE_B(C0, C1, GL, sl_next, sl_prev, tau); } while (0)
#define ENDW(tau) do { if (has_next || (tau) + 3 < NT) { WAIT_KV(1, 1, 0); } else if ((tau) + 2 < NT) { WAIT_KV(0, 1, 0); } else { WAIT_BAR(0); } } while (0)
    f32x16 czc;
#pragma unroll
    for (int r = 0; r < 16; ++r) czc[r] = pcadd;
    if (CA) PIN(czc);
    for (int ui = 0; ui < nu; ++ui) {
        const int u = (int)((ulist >> (8 * ui)) & 255u); const bool has_next = ui + 1 < nu; const int un = has_next ? (int)((ulist >> (8 * (ui + 1))) & 255u) : 0;
        const int t0 = T0OF(u), t1 = 4 * u + 3, cw = 4 * u + (wid >> 1), NT = t1 - t0 + 1, t0n = T0OF(un);
        f32x16 o[2], lacc; o[0] = f32x16{}; o[1] = f32x16{}; lacc = f32x16{};
        int s0, s1, s2;
        if (ui == 0) {
            s0 = 0; s1 = 1; s2 = 2;
            DMA_K(t0 + 0, 0); DMA_V(t0 + 0, 0); DMA_K(t0 + 1, 1); DMA_K(t0 + 2, 2);
            QLOAD(u);
            if (CA) { for (int i = tidl; i < 320; i += 512) tab[i] = relb[h * 257 + (i < 256 ? i : 256)] * LOG2E; }
            if (wid == 0) { const int t2 = tid_from_wave(0); const float* pv = PARTV + (size_t)b * 16 * 1024 + OCOL + h * 64 + t2; float sm = 0.f;
#pragma unroll
                for (int j = 0; j < 16; ++j) sm += pv[j * 1024];
                sm *= (1.0f / SEQ); ((LAS float*)(shm + LDS_VB))[512 + t2] = sm; REF[(size_t)b * 1024 + OCOL + h * 64 + t2] = sm;
                asm volatile("s_waitcnt vmcnt(0)" ::: "memory"); __builtin_amdgcn_fence(__ATOMIC_RELEASE, "agent");
                if (t2 == 0) __hip_atomic_fetch_add(refcnt, 1u, __ATOMIC_RELAXED, __HIP_MEMORY_SCOPE_AGENT); }
            QREADY();
            if (CA) {
                asm volatile("s_waitcnt lgkmcnt(0)\n\ts_barrier" ::: "memory");
                float bm = 0.f; for (int i = lane; i < 257; i += 64) bm = fmaxf(bm, fabsf(tab[i]));
                S0 += 2.0f * wave_max(bm); SHI = fmaxf(ceilf(S0 - 15.5f), 0.0f) + SH_EXTRA; pcadd = 4.0f * (15.0f - SHI); tabc = tab[256];
#pragma unroll
                for (int r = 0; r < 16; ++r) czc[r] = pcadd;
                PIN(czc);
                LAS float* img = (LAS float*)(shm + LDS_IMG);
                for (int i = tidl; i < 3 * 2 * 8 * 256; i += 512) { const int e = i & 3, ln = (i >> 2) & 63, g = (i >> 8) & 7, hf = (i >> 11) & 1, ds = i >> 12;
                    img[i] = 4.0f * (tab[64 * ds + 32 * hf + (ln & 31) + 128 - 4 * (ln >> 5) - (e + 8 * (g & 3)) - 32 * (g >> 2)] - tabc) + pcadd; }
            }
            WAIT_KV(2, 1, 0);
        } else {
            s0 = sl_cur; s1 = sl_next; s2 = (s1 == NS - 1) ? 0 : s1 + 1;
            QREADY();
        }
        { const int ks0_ = s0 * KSLOT;
#pragma unroll
          for (int g = 0; g < NGQ; ++g) KFL(g, ks0_);
          QK_FIRST(pA0, pA1, kf[0], kf[1], 0);
#pragma unroll
          for (int g = 2; g < NGQ; ++g) { if ((g & 1) == 0) pA0 = QKM(kf[g], qr[g >> 1], pA0); else pA1 = QKM(kf[g], qr[g >> 1], pA1); } }
        WAIT_BAR(0);
        DMA_K(TABS(3), s0); DMA_V(TABS(1), s1);
        { const int ks1_ = s1 * KSLOT;
#pragma unroll
          for (int g = 0; g < NGQ; ++g) KFL(g, ks1_); }
        WAIT_KV(1, 1, 0);
        sl_prev = s0; sl_cur = s1; sl_next = s2;
        int tau = 1;
        for (; tau + 5 < NT; tau += 2) {
            STEP(pB0, pB1, pA0, pA1, tau, true, true, true);     WAIT_KV(1, 1, 0); ROT();
            STEP(pA0, pA1, pB0, pB1, tau + 1, true, true, true); WAIT_KV(1, 1, 0); ROT();
        }
        for (; tau + 1 < NT; tau += 2) {
            STEP(pB0, pB1, pA0, pA1, tau, (has_next || tau + 3 < NT), (has_next || tau + 1 < NT), (tau + 1 < NT));     ENDW(tau);     ROT();
            STEP(pA0, pA1, pB0, pB1, tau + 1, (has_next || tau + 4 < NT), (has_next || tau + 2 < NT), (tau + 2 < NT)); ENDW(tau + 1); ROT();
        }
        STEP(pB0, pB1, pA0, pA1, NT - 1, has_next, has_next, false);
        int vdr = sl_cur;
        if (has_next) { QLOAD(un);
            WAIT_KV(1, 1, NQL); ROT(); vdr = sl_prev; }
        { { const LAS unsigned char* vd_ = vp0 + vdr * VSLOT;
#pragma unroll
            for (int i = 0; i < 8; ++i) VRD(i, vd_);
#pragma unroll
            for (int w = 0; w < 8; ++w) PWSET(w, pB0, pB1);
            PVM(0); PVM(1); PVL(); } }
        { const int le = tid_from_wave(0), r32e = le & 31, hie = le >> 5;
          float rli[16];
#pragma unroll
          for (int r = 0; r < 16; ++r) rli[r] = __builtin_amdgcn_rcpf(lacc[r]);
          unsigned char* Ow = O + (rowbase + u * 256 + wid * 32) * LDO + OCOL + h * 64;
          LAS unsigned char* stg = shm + LDS_OST + wid * 2048;
          const LAS float* vbm = (const LAS float*)(shm + LDS_VB) + 512; const float vb0 = vbm[r32e], vb1 = vbm[32 + r32e];
#pragma unroll
          for (int r = 0; r < 16; ++r) { const int orow = crow(r, hie);
              const float y0 = (o[0][r] * rli[r] - vb0) * F8_O_SCALE, y1 = (o[1][r] * rli[r] - vb1) * F8_O_SCALE;
              const unsigned w = (unsigned)__builtin_amdgcn_cvt_pk_fp8_f32(__builtin_amdgcn_fmed3f(y0, -448.f, 448.f), __builtin_amdgcn_fmed3f(y1, -448.f, 448.f), undef_i32(), false);
              stg[orow * 64 + r32e] = (unsigned char)(w & 255u); stg[orow * 64 + 32 + r32e] = (unsigned char)((w >> 8) & 255u); }
#pragma unroll
          for (int i = 0; i < 2; ++i) { const int row = i * 16 + (le >> 2), ch = le & 3; const u32x4 v = *(const LAS u32x4*)(stg + row * 64 + ch * 16); st16((char*)Ow + (unsigned)(row * LDO + ch * 16), v); } }
    }
    asm volatile("s_waitcnt lgkmcnt(0)\n\ts_barrier" ::: "memory");
#undef SBAR
#undef PIN
#undef DMA_K
#undef WAIT_KV
#undef QREADY
#undef KFL
#undef QKM
#undef FILLA
#undef DMA_V
#undef WAIT_BAR
#undef TVALID
#undef TABS
#undef T0OF
#undef QLOAD
#undef VRD
#undef PVM
#undef PVL
#undef PEL
#undef PWSET
#undef QK_FIRST
#undef PHASE_A
#undef PHASE_B
#undef ROT
#undef STEP
#undef ENDW
}
}

constexpr int NWAVES = 8;
constexpr int NPHASE = 10;
constexpr int N_LAUNCHES = MK_N_LAUNCHES;
static_assert(N_LAUNCHES == 1 || N_LAUNCHES == NPHASE, "MK_N_LAUNCHES is 1 or 10");

constexpr int RING_BYTES = 131072, XL_OFF = RING_BYTES, LDS_BYTES = 155648, LDSCTL_OFF = LDS_BYTES - 1024, MISC_OFF = LDSCTL_OFF + 320;
static_assert(XL_OFF + 8192 + 12288 <= LDSCTL_OFF && att::ATT_LDS_BYTES <= LDSCTL_OFF, "LDS map");

typedef GAS unsigned gu32;
#define RLX_AGENT __ATOMIC_RELAXED, __HIP_MEMORY_SCOPE_AGENT

#define XB_TMO      128
#define XB_XCNT(j)  (256  + 64 * (j))
#define XB_XSUB(j)  (1280 + 64 * (j))
#define XB_XGEN(j)  (2304 + 64 * (j))
#define XB_TOP      3328
#define XB_TOPGEN   3392
#define XCD_BAR_WORDS 3456
#define XB_SPIN_CAP (1u << 18)
__device__ __forceinline__ unsigned xb_ld(unsigned* p)              { return __hip_atomic_load(p, __ATOMIC_RELAXED, __HIP_MEMORY_SCOPE_AGENT); }
__device__ __forceinline__ unsigned xb_add(unsigned* p, unsigned v) { return __hip_atomic_fetch_add(p, v, __ATOMIC_RELAXED, __HIP_MEMORY_SCOPE_AGENT); }
__device__ __forceinline__ unsigned xb_xcc_id() { return (unsigned)__builtin_amdgcn_s_getreg((3 << 11) | 20) & 0xFu; }
#define XB_SPIN(cond, bar) do { unsigned _sp = 0; while (cond) { __builtin_amdgcn_s_sleep(1); \
    if ((++_sp & 255u) == 0u) { if (xb_ld(&(bar)[XB_TMO])) break; if (_sp > XB_SPIN_CAP) { atomicAdd(&(bar)[XB_TMO], 1u); break; } } } } while (0)
struct XcdBarrier { unsigned* bar; unsigned x; volatile LAS unsigned* st; int wave; };
__device__ __forceinline__ XcdBarrier xcd_barrier_post(unsigned* bar, volatile LAS unsigned* st, int wave) {
    XcdBarrier b; b.bar = bar; b.x = xb_xcc_id(); b.st = st; b.wave = wave;
    if (tid_from_wave(wave) == 0) (void)xb_add(&bar[XB_XCNT(b.x)], 1u);
    return b;
}
__device__ __forceinline__ void xcd_barrier_complete(unsigned* bar, unsigned x, unsigned& nloc, unsigned& nx) {
    const unsigned G = gridDim.x * gridDim.y * gridDim.z;
    unsigned sum, cnt, mine, sp = 0u;
    for (;;) {
        sum = 0u; cnt = 0u; mine = 0u;
#pragma unroll
        for (unsigned j = 0; j < 16; ++j) { const unsigned c = xb_ld(&bar[XB_XCNT(j)]); sum += c; cnt += (c > 0u) ? 1u : 0u; mine = (j == x) ? c : mine; }
        if (sum == G) break;
        __builtin_amdgcn_s_sleep(1);
        if ((++sp & 255u) == 0u) { if (xb_ld(&bar[XB_TMO])) break; if (sp > XB_SPIN_CAP) { atomicAdd(&bar[XB_TMO], 1u); break; } }
    }
    nloc = mine > 0u ? mine : 1u; nx = cnt > 0u ? cnt : 1u;
}
__device__ __forceinline__ void xcd_barrier(const XcdBarrier& b) {
    asm volatile("s_waitcnt vmcnt(0)" ::: "memory");
    __syncthreads();
    if (tid_from_wave(b.wave) == 0) {
        unsigned* bar = b.bar;
        __builtin_amdgcn_s_waitcnt(0);
        unsigned nloc = b.st[0], nx = b.st[1];
        if (nloc == 0u) { xcd_barrier_complete(bar, b.x, nloc, nx); b.st[0] = nloc; b.st[1] = nx; }
        const unsigned old = xb_add(&bar[XB_XSUB(b.x)], 1u);
        const unsigned gen = old / nloc;
        if (old + 1u == (gen + 1u) * nloc) {
            __builtin_amdgcn_fence(__ATOMIC_RELEASE, "agent");
            asm volatile("s_waitcnt vmcnt(0)" ::: "memory");
            const unsigned og = xb_add(&bar[XB_TOP], 1u);
            const unsigned tg = og / nx;
            if (og + 1u == (tg + 1u) * nx) xb_add(&bar[XB_TOPGEN], 1u);
            else XB_SPIN(xb_ld(&bar[XB_TOPGEN]) == tg, bar);
            __builtin_amdgcn_fence(__ATOMIC_ACQUIRE, "agent");
            xb_add(&bar[XB_XGEN(b.x)], 1u);
            asm volatile("s_waitcnt vmcnt(0)" ::: "memory");
        } else {
            XB_SPIN(xb_ld(&bar[XB_XGEN(b.x)]) == gen, bar);
            __builtin_amdgcn_fence(__ATOMIC_ACQUIRE, "agent");
            asm volatile("s_waitcnt vmcnt(0)" ::: "memory");
        }
    }
    __syncthreads();
}

struct Args { const void* in[22]; float* out; unsigned char* ws; int ph_lo, ph_hi, li, pad; };
#define ARGF(k) ((const float*)args.in[k])
struct Frame {
    LAS unsigned char* lds; LAS float* xl;
    int tid, lane, wave, vcu, G;
    unsigned char* ws;
};

template <int WHICH> __device__ __forceinline__ int wmap(int n) {
    if (WHICH == 0) {
        if (n < 256) return n;
        if (n < 512) { const int c = n - 256; return c < 160 ? 256 + c : -1; }
        if (n < 1536) { const int t4 = (n - 512) >> 8, which = t4 >> 1, jj = t4 & 1, c = (n - 512) & 255, bj = c >> 7, wc = (c >> 5) & 3, i = c & 31; return 416 + which * 512 + (4 * jj + wc) * 64 + 32 * bj + i; }
        return 416 + 1024 + (n - 1536);
    } else if (WHICH == 1) {
        const int pn = n >> 8, c = n & 255, bj = c >> 7, wc = (c >> 5) & 3, i = c & 31, head = 2 * pn + bj;
        if (wc < 2) return head * 96 + 32 * wc + i;
        if (wc == 2) { const int fq = i >> 3, nn = (i >> 2) & 1, e = i & 3; return head * 96 + 64 + 4 * fq + e + 16 * nn; }
        return -1;
    } else if (WHICH == 2) {
        const int pn = n >> 8, c = n & 255, bj = c >> 7, wc = (c >> 5) & 3, i = c & 31, head = 2 * pn + bj;
        return wc < 2 ? head * 128 + 32 * wc + i : head * 128 + 64 + 32 * (wc - 2) + i;
    } else if (WHICH == 4) {
        const int j = n >> 8, c = n & 255; return c < 128 ? 128 * j + c : DFF + 128 * j + (c - 128);
    }
    return n;
}
template <int WHICH, bool F8 = false> __device__ __forceinline__ void cvt_item(const float* W, int K, int N, bf16_t* WT, int KP, int NP, LAS float* scr, int item, int lane, float f8s = 1.0f) {
    const int nblk = NP / 32, kb = item / nblk, nb = item % nblk, k0 = 64 * kb, n0 = 32 * nb;
    const int src = wmap<WHICH>(n0 + (lane & 31)); const bool live = (src >= 0) && (k0 < K);
    float wv[32];
#pragma unroll
    for (int i = 0; i < 32; ++i) { const int kk = 2 * i + (lane >> 5); wv[i] = live ? __builtin_nontemporal_load(W + (size_t)(k0 + kk) * N + src) : 0.f; }
#pragma unroll
    for (int i = 0; i < 32; ++i) { const int kk = 2 * i + (lane >> 5); scr[kk * 33 + (lane & 31)] = wv[i]; }
    asm volatile("s_waitcnt lgkmcnt(0)" ::: "memory");
    const int c = lane & 7;
#pragma unroll
    for (int j = 0; j < 4; ++j) { const int n = (lane >> 3) + 8 * j; const LAS float* s = scr + (8 * c) * 33 + n;
        if (F8) { u32x2 o; o.x = pk_fp8x4(s[0 * 33] * f8s, s[1 * 33] * f8s, s[2 * 33] * f8s, s[3 * 33] * f8s); o.y = pk_fp8x4(s[4 * 33] * f8s, s[5 * 33] * f8s, s[6 * 33] * f8s, s[7 * 33] * f8s);
            *(u32x2*)((unsigned char*)WT + (size_t)(n0 + n) * KP + k0 + 8 * c) = o; }
        else { u32x4 o; o.x = cvtpk(s[0 * 33], s[1 * 33]); o.y = cvtpk(s[2 * 33], s[3 * 33]); o.z = cvtpk(s[4 * 33], s[5 * 33]); o.w = cvtpk(s[6 * 33], s[7 * 33]);
            *(u32x4*)(WT + (size_t)(n0 + n) * KP + k0 + 8 * c) = o; } }
    asm volatile("s_waitcnt lgkmcnt(0)" ::: "memory");
}
__device__ __forceinline__ void p0_prologue(Frame& F, const Args& args) {
    LAS float* scr = (LAS float*)(F.lds) + F.wave * 4096;
    const int gw = F.vcu * NWAVES + F.wave, NGW = F.G * NWAVES;
    constexpr int I0 = 16 * 64, I1 = 4 * 32, I2 = 4 * 32, I3 = 16 * 32, I4 = 16 * 176, I5 = 44 * 32;
    constexpr int NITEMS = I0 + I1 + I2 + I3 + I4 + I5;
    for (int it = gw; it < NITEMS; it += NGW) {
        int r = it;
        if (r < I0) { cvt_item<0, true>(ARGF(6), 1024, 1952, (bf16_t*)(F.ws + WS_WIN), 1024, 2048, scr, r, F.lane, F8_WIN_SCALE); continue; } r -= I0;
        if (r < I1) { cvt_item<1>(ARGF(9), 256, 768, (bf16_t*)(F.ws + WS_WQUP), 256, 1024, scr, r, F.lane); continue; } r -= I1;
        if (r < I2) { cvt_item<2>(ARGF(10), 128, 1024, (bf16_t*)(F.ws + WS_WKVUP), 256, 1024, scr, r, F.lane); continue; } r -= I2;
        if (r < I3) { cvt_item<3, true>(ARGF(16), 1024, 1024, (bf16_t*)(F.ws + WS_WOUT), 1024, 1024, scr, r, F.lane, F8_WOUT_SCALE); continue; } r -= I3;
        if (r < I4) { cvt_item<4>(ARGF(18), 1024, DFF2, (bf16_t*)(F.ws + WS_WUP), 1024, DFF2, scr, r, F.lane); continue; } r -= I4;
        cvt_item<5>(ARGF(21), DFF, 1024, (bf16_t*)(F.ws + WS_WDOWN), DFF, 1024, scr, r, F.lane);
    }
    { u32x4* P = (u32x4*)(F.ws + WS_PART); const int NT = F.G * NWAVES * 64;
      for (int i = F.vcu * (NWAVES * 64) + F.tid; i < (int)(PART_BYTES / 16); i += NT) P[i] = (u32x4){0u, 0u, 0u, 0u}; }
    {
        float* cosT = (float*)(F.ws + WS_COS); float* sinT = (float*)(F.ws + WS_SIN);
        const int gt = F.vcu * (NWAVES * 64) + F.tid, NT = F.G * NWAVES * 64;
        for (int idx0 = gt; idx0 < MTOK * 16; idx0 += 4 * NT) {
            int pos[4];
#pragma unroll
            for (int j = 0; j < 4; ++j) { const int idx = idx0 + j * NT; pos[j] = idx < MTOK * 16 ? ((const int*)args.in[2])[idx >> 4] : 0; }
#pragma unroll
            for (int j = 0; j < 4; ++j) { const int idx = idx0 + j * NT; if (idx < MTOK * 16) { const int i = idx & 15;
                const float inv = __builtin_amdgcn_exp2f(-(float)i * (13.287712379549449f / 16.0f));
                const float ang = (float)pos[j] * inv;
                const float n = rintf(ang * 0.15915494309189535f);
                float r = fmaf(-n, 6.2831854820251465f, ang); r = fmaf(-n, -1.7484555e-7f, r);
                cosT[idx] = __cosf(r); sinT[idx] = __sinf(r); } }
        }
    }
}
constexpr int CW_MODCNT = 64, MOD_ITEMS = 192;
__device__ __forceinline__ void p0_mod(Frame& F, const Args& args) {
    LAS float* scr = (LAS float*)(F.lds) + F.wave * 4096;
    for (int item = F.vcu; item < MOD_ITEMS; item += F.G) {
        int kbase = F.wave * 128; asm volatile("" : "+s"(kbase));
        const int n0 = item * 32, col = F.lane & 31, kh = F.lane >> 5;
        { float tv[32];
          unsigned l4 = (unsigned)F.lane * 4u; asm volatile("" : "+v"(l4));
#pragma unroll
          for (int i = 0; i < 32; ++i) tv[i] = *(const float*)((const char*)(ARGF(1) + (i >> 1) * 1024 + kbase + 64 * (i & 1)) + l4);
#pragma unroll
          for (int i = 0; i < 32; ++i) { const int idx = F.lane + 64 * i, b = idx >> 7, k = idx & 127; const float xv = tv[i]; scr[k * 16 + b] = xv / (1.0f + __expf(-xv)); } }
        asm volatile("s_waitcnt lgkmcnt(0)" ::: "memory");
        f32x4 a0 = {0.f, 0.f, 0.f, 0.f}, a1 = a0, a2 = a0, a3 = a0;
        const unsigned wvo = (unsigned)(kh * NMOD + col) * 4u;
#pragma unroll
        for (int i0 = 0; i0 < 64; i0 += 32) { float wv[32];
#pragma unroll
            for (int i = 0; i < 32; ++i) wv[i] = *(const float*)((const char*)(ARGF(3) + (size_t)(kbase + 2 * (i0 + i)) * NMOD + n0) + wvo);
#pragma unroll
            for (int i = 0; i < 32; ++i) { const int k = 2 * (i0 + i) + kh; const float w = wv[i];
                const LAS f32x4* sp = (const LAS f32x4*)(scr + k * 16);
                a0 += sp[0] * w; a1 += sp[1] * w; a2 += sp[2] * w; a3 += sp[3] * w; } }
#pragma unroll
        for (int e = 0; e < 4; ++e) { a0[e] += __shfl_xor(a0[e], 32); a1[e] += __shfl_xor(a1[e], 32); a2[e] += __shfl_xor(a2[e], 32); a3[e] += __shfl_xor(a3[e], 32); }
        if (kh == 0) {
#pragma unroll
            for (int e = 0; e < 4; ++e) { scr[2048 + (0 + e) * 32 + col] = a0[e]; scr[2048 + (4 + e) * 32 + col] = a1[e]; scr[2048 + (8 + e) * 32 + col] = a2[e]; scr[2048 + (12 + e) * 32 + col] = a3[e]; } }
        __syncthreads();
        float* MOD = (float*)(F.ws + WS_MOD);
        { const int b = 2 * F.wave + kh; float s = ARGF(4)[n0 + col];
#pragma unroll
            for (int w2 = 0; w2 < 8; ++w2) s += ((LAS float*)F.lds)[w2 * 4096 + 2048 + b * 32 + col];
            MOD[(size_t)b * NMOD + n0 + col] = s; }
        asm volatile("s_waitcnt vmcnt(0)" ::: "memory");
        __syncthreads();
        if (F.tid == 0) { __builtin_amdgcn_fence(__ATOMIC_RELEASE, "agent"); asm volatile("s_waitcnt vmcnt(0)" ::: "memory");
            __hip_atomic_fetch_add((unsigned*)(F.ws + WS_CTL) + CW_MODCNT, 1u, __ATOMIC_RELAXED, __HIP_MEMORY_SCOPE_AGENT); }
    }
}
__device__ __forceinline__ void mod_wait(Frame& F) {
    if (F.tid == 0) { unsigned sp = 0;
        while (__hip_atomic_load((unsigned*)(F.ws + WS_CTL) + CW_MODCNT, __ATOMIC_RELAXED, __HIP_MEMORY_SCOPE_AGENT) < (unsigned)MOD_ITEMS && ++sp < (1u << 22)) __builtin_amdgcn_s_sleep(2);
        __builtin_amdgcn_fence(__ATOMIC_ACQUIRE, "agent"); asm volatile("s_waitcnt vmcnt(0)" ::: "memory"); }
    __syncthreads();
}
template <bool IDMAP> __device__ __forceinline__ void gemv16_item(Frame& F, const float* W, int ldw, const float* IN, int ldin, float* OUT, int ldout, int item) {
    LAS float* scr = (LAS float*)(F.lds) + F.wave * 4096;
    {
        int kbase = F.wave * 128; asm volatile("" : "+s"(kbase));
        const int col = F.lane & 7, kh = F.lane >> 3; const int src = IDMAP ? item * 8 + col : wmap<0>(item * 8 + col);
        { float tv[32];
          unsigned l4 = (unsigned)F.lane * 4u; asm volatile("" : "+v"(l4));
#pragma unroll
          for (int i = 0; i < 32; ++i) tv[i] = *(const float*)((const char*)(IN + (size_t)(i >> 1) * ldin + kbase + 64 * (i & 1)) + l4);
#pragma unroll
          for (int i = 0; i < 32; ++i) { const int idx = F.lane + 64 * i, b = idx >> 7, k = idx & 127; scr[k * 16 + b] = tv[i]; } }
        asm volatile("s_waitcnt lgkmcnt(0)" ::: "memory");
        f32x4 a0 = {0.f, 0.f, 0.f, 0.f}, a1 = a0, a2 = a0, a3 = a0;
        float wv[16]; const unsigned wvo = (unsigned)(kh * ldw + (src >= 0 ? src : 0)) * 4u; const float msk = src >= 0 ? 1.0f : 0.0f;
#pragma unroll
        for (int i = 0; i < 16; ++i) wv[i] = *(const float*)((const char*)(W + (size_t)(kbase + 8 * i) * ldw) + wvo);
#pragma unroll
        for (int i = 0; i < 16; ++i) { const int k = 8 * i + kh; const float w = wv[i] * msk;
            if ((i & 3) == 0) __builtin_amdgcn_sched_barrier(0);
            const LAS f32x4* sp = (const LAS f32x4*)(scr + k * 16);
            a0 += sp[0] * w; a1 += sp[1] * w; a2 += sp[2] * w; a3 += sp[3] * w;
        }
#pragma unroll
        for (int o = 8; o < 64; o <<= 1)
#pragma unroll
            for (int e = 0; e < 4; ++e) { a0[e] += __shfl_xor(a0[e], o); a1[e] += __shfl_xor(a1[e], o); a2[e] += __shfl_xor(a2[e], o); a3[e] += __shfl_xor(a3[e], o); }
        if (kh == 0) {
#pragma unroll
            for (int e = 0; e < 4; ++e) { scr[2048 + (0 + e) * 8 + col] = a0[e]; scr[2048 + (4 + e) * 8 + col] = a1[e]; scr[2048 + (8 + e) * 8 + col] = a2[e]; scr[2048 + (12 + e) * 8 + col] = a3[e]; } }
        __syncthreads();
        if (F.tid < 128) { float sm = 0.f;
#pragma unroll
            for (int w2 = 0; w2 < 8; ++w2) sm += ((LAS float*)F.lds)[w2 * 4096 + 2048 + F.tid];
            OUT[(size_t)(F.tid >> 3) * ldout + item * 8 + (F.tid & 7)] = sm; }
        __syncthreads();
    }
}
template <bool IDMAP> __device__ __forceinline__ void gemv16(Frame& F, const float* W, int ldw, const float* IN, int ldin, float* OUT, int ldout, int nitems) {
    for (int item = F.vcu; item < nitems; item += F.G) gemv16_item<IDMAP>(F, W, ldw, IN, ldin, OUT, ldout, item);
}
constexpr int CW_B2CNT = 96, CW_REFCNT = 112;
__device__ __forceinline__ void p4_bias(Frame& F, const Args& args, int item) {
    if (F.tid == 0) { unsigned sp = 0; unsigned* cnt = (unsigned*)(F.ws + WS_CTL) + CW_REFCNT;
        while (__hip_atomic_load(cnt, __ATOMIC_RELAXED, __HIP_MEMORY_SCOPE_AGENT) < 2u * (unsigned)F.G && ++sp < (1u << 22)) __builtin_amdgcn_s_sleep(2);
        __builtin_amdgcn_fence(__ATOMIC_ACQUIRE, "agent"); asm volatile("s_waitcnt vmcnt(0)" ::: "memory"); }
    __syncthreads();
    gemv16_item<true>(F, ARGF(16), 1024, (const float*)(F.ws + WS_REF), 1024, (float*)(F.ws + WS_BIAS2), 1024, item);
}
__device__ __forceinline__ void p5_bias(Frame& F, const Args& args) {
    gemv16<true>(F, ARGF(16), 1024, (const float*)(F.ws + WS_REF), 1024, (float*)(F.ws + WS_BIAS2), 1024, 128);
    unsigned* cnt = (unsigned*)(F.ws + WS_CTL) + CW_B2CNT;
    int mine = 0; for (int item = F.vcu; item < 128; item += F.G) ++mine;
    asm volatile("s_waitcnt vmcnt(0)" ::: "memory");
    __syncthreads();
    if (F.tid == 0) {
        if (mine) { __builtin_amdgcn_fence(__ATOMIC_RELEASE, "agent"); asm volatile("s_waitcnt vmcnt(0)" ::: "memory"); __hip_atomic_fetch_add(cnt, (unsigned)mine, __ATOMIC_RELAXED, __HIP_MEMORY_SCOPE_AGENT); }
        unsigned sp = 0;
        while (__hip_atomic_load(cnt, __ATOMIC_RELAXED, __HIP_MEMORY_SCOPE_AGENT) < 128u && ++sp < (1u << 22)) __builtin_amdgcn_s_sleep(2);
        __builtin_amdgcn_fence(__ATOMIC_ACQUIRE, "agent"); asm volatile("s_waitcnt vmcnt(0)" ::: "memory"); }
    __syncthreads();
}
__device__ __forceinline__ float wave_sum(float v) {
#pragma unroll
    for (int o = 1; o < 64; o <<= 1) v += __shfl_xor(v, o);
    return v;
}
template <bool XBF16 = false, bool OUTF8 = false> __device__ __forceinline__ void norm_rows(Frame& F, const float* X, const float* g, int shift_off, int scale_off, bf16_t* out) {
    const float* MOD = (const float*)(F.ws + WS_MOD);
    const int gw = F.vcu * NWAVES + F.wave, NGW = F.G * NWAVES;
    for (int base = gw * 16; base < MTOK; base += NGW * 16) {
        const int b = base >> 11;
        f32x4 gm[4], sh[4];
        { const f32x4* gp = (const f32x4*)g + 4 * F.lane; const f32x4* shp = (const f32x4*)(MOD + (size_t)b * NMOD + shift_off) + 4 * F.lane; const f32x4* scp = (const f32x4*)(MOD + (size_t)b * NMOD + scale_off) + 4 * F.lane;
#pragma unroll
          for (int j = 0; j < 4; ++j) { gm[j] = gp[j] * (scp[j] + 1.0f) * (OUTF8 ? F8_ACT_SCALE : 1.0f); if (!OUTF8) sh[j] = shp[j]; } }
        for (int i0 = 0; i0 < 16; i0 += 4) {
            f32x4 v[4][4]; float sq[4];
#pragma unroll
            for (int rr = 0; rr < 4; ++rr) { const size_t m = (size_t)(base + i0 + rr);
                if (XBF16) { const u32x2* xr = (const u32x2*)((const bf16_t*)X + m * DM) + 4 * F.lane;
#pragma unroll
                    for (int j = 0; j < 4; ++j) { const u32x2 w = xr[j]; v[rr][j] = (f32x4){__uint_as_float(w.x << 16), __uint_as_float(w.x & 0xffff0000u), __uint_as_float(w.y << 16), __uint_as_float(w.y & 0xffff0000u)}; } }
                else { const f32x4* xr = (const f32x4*)(X + m * DM) + 4 * F.lane;
#pragma unroll
                    for (int j = 0; j < 4; ++j) v[rr][j] = xr[j]; } }
#pragma unroll
            for (int rr = 0; rr < 4; ++rr) { float s = 0.f;
#pragma unroll
                for (int j = 0; j < 4; ++j) s += dot4(v[rr][j]);
                sq[rr] = s; }
#pragma unroll
            for (int o = 1; o < 64; o <<= 1)
#pragma unroll
                for (int rr = 0; rr < 4; ++rr) sq[rr] += __shfl_xor(sq[rr], o);
#pragma unroll
            for (int rr = 0; rr < 4; ++rr) { const size_t m = (size_t)(base + i0 + rr);
                const float r = __builtin_amdgcn_rsqf(sq[rr] * (1.0f / DM) + EPS);
                if (OUTF8) { u32x4 w;
#pragma unroll
                    for (int j = 0; j < 4; ++j) { const f32x4 y = v[rr][j] * r * gm[j]; w[j] = pk_fp8x4(y[0], y[1], y[2], y[3]); }
                    *((u32x4*)((unsigned char*)out + m * DM) + F.lane) = w; }
                else { u32x2* o8 = (u32x2*)(out + m * DM) + 4 * F.lane;
#pragma unroll
                    for (int j = 0; j < 4; ++j) { const f32x4 y = v[rr][j] * r * gm[j] + sh[j]; o8[j] = pack4(y); } } }
        }
    }
}
__device__ __forceinline__ void conv_fixup(Frame& F, const Args& args) {
    const unsigned char* RAW4 = F.ws + WS_RAW4; bf16_t* ACT = (bf16_t*)(F.ws + WS_ACT);
    constexpr int NCP = DFF / 2;
    const int gt = F.vcu * (NWAVES * 64) + F.tid, NT = F.G * NWAVES * 64, NGRP = NT / NCP;
    const int grp = gt / NCP, cp = gt - grp * NCP, c = 2 * cp, j = c >> 7, cc = c & 127;
    if (grp >= NGRP) return;
    f32x2 w0[2], w1[2], w2[2], bb[2];
#pragma unroll
    for (int half = 0; half < 2; ++half) { const int ocol = half * DFF + c;
        w0[half] = *(const f32x2*)(ARGF(19) + ocol); w1[half] = *(const f32x2*)(ARGF(19) + DFF2 + ocol); w2[half] = *(const f32x2*)(ARGF(19) + 2 * DFF2 + ocol); bb[half] = *(const f32x2*)(ARGF(20) + ocol); }
#define RAW2(row, tcol) (*(const unsigned*)(RAW4 + ((size_t)(row) * DFF2 + (tcol)) * 2))
#define LO(w) __uint_as_float((w) << 16)
#define HI(w) __uint_as_float((w) & 0xffff0000u)
#pragma unroll 3
    for (int blk = grp; blk < 512; blk += NGRP) {
        const bool first = (blk & 31) == 0;
        f32x2 o[2][2];
#pragma unroll
        for (int half = 0; half < 2; ++half) {
            const int tcol = 256 * j + 128 * half + cc;
            const unsigned q2 = first ? 0u : RAW2((blk - 1) * 4 + 2, tcol), q1 = first ? 0u : RAW2((blk - 1) * 4 + 3, tcol), r0 = RAW2(blk * 4 + 0, tcol), r1 = RAW2(blk * 4 + 1, tcol);
            const f32x2 pm2 = {LO(q2), HI(q2)}, pm1 = {LO(q1), HI(q1)}, x0 = {LO(r0), HI(r0)}, x1 = {LO(r1), HI(r1)};
            o[half][0] = w2[half] * x0 + (w1[half] * pm1 + (w0[half] * pm2 + bb[half])); o[half][1] = w2[half] * x1 + (w1[half] * x0 + (w0[half] * pm1 + bb[half]));
        }
#pragma unroll
        for (int rr = 0; rr < 2; ++rr) { const f32x2 G = o[0][rr]; f32x2 a;
#pragma unroll
            for (int e = 0; e < 2; ++e) a[e] = G[e] / (1.0f + __expf(-G[e])) * o[1][rr][e];
            *(unsigned*)(ACT + ((size_t)blk * 64 + rr) * DFF + c) = cvtpk(a[0], a[1]); }
    }
#undef RAW2
#undef LO
#undef HI
}

__device__ __forceinline__ void stagger_delay(unsigned us10) { const unsigned long long t0 = __builtin_amdgcn_s_memrealtime(); while (__builtin_amdgcn_s_memrealtime() - t0 < (unsigned long long)us10 * 10ull) __builtin_amdgcn_s_sleep(8); }
#ifndef STAG5
#define STAG5 0
#endif
#ifndef STAG9
#define STAG9 0
#endif
__global__ void __launch_bounds__(NWAVES * 64, 2) fwd_kernel(Args args) {
    extern __shared__ __attribute__((aligned(16))) unsigned char lds_raw[];
    Frame F;
    F.lds = (LAS unsigned char*)lds_raw; F.xl = (LAS float*)(F.lds + XL_OFF);
    F.tid = threadIdx.x; F.lane = F.tid & 63; F.wave = __builtin_amdgcn_readfirstlane(F.tid >> 6);
    F.G = gridDim.x; { const int bx = blockIdx.x; F.vcu = (F.G % 8 == 0) ? (bx % 8) * (F.G / 8) + bx / 8 : bx; }
    F.ws = args.ws;
    unsigned char* ws = args.ws;
    for (int u = F.tid; u < (LDS_BYTES - LDSCTL_OFF) / 4; u += NWAVES * 64) ((LAS unsigned*)(F.lds + LDSCTL_OFF))[u] = 0u;
    __syncthreads();
    XcdBarrier bar; bar.bar = (unsigned*)(ws + WS_CTL) + CW_BAR; bar.x = 0; bar.st = nullptr; bar.wave = F.wave;
    if (N_LAUNCHES == 1) bar = xcd_barrier_post((unsigned*)(ws + WS_CTL) + CW_BAR, (volatile LAS unsigned*)(F.lds + MISC_OFF) + 8, F.wave);
#define GRID_BAR() do { if (N_LAUNCHES == 1) xcd_barrier(bar); } while (0)
    const int lo = args.ph_lo, hi = args.ph_hi;
#ifndef PH_MASK
#define PH_MASK 0x3ff
#endif
#define IN(k) (((PH_MASK >> (k)) & 1) && lo <= (k) && (k) < hi)
#define BOTH(k) (IN(k) && IN((k) + 1))
    float* MOD = (float*)(ws + WS_MOD);
    bf16_t* XN = (bf16_t*)(ws + WS_XN);

#define REFRESH_TID() do { int t_ = tid_from_wave(F.wave); asm volatile("" : "+v"(t_)); t_ &= 511; F.tid = t_; F.lane = t_ & 63; } while (0)
    if (IN(0)) { REFRESH_TID(); p0_mod(F, args); p0_prologue(F, args); mod_wait(F); gemv16<false>(F, ARGF(6), 1952, (const float*)(F.ws + WS_MOD), NMOD, (float*)(F.ws + WS_BIAS), 2048, 256); norm_rows<false, true>(F, ARGF(0), ARGF(5), 0, DM, XN); if (BOTH(1)) GRID_BAR(); }
    if (IN(2)) {
        pg8::Gemm g{XN, (const bf16_t*)(ws + WS_WIN), MTOK, 2048, 512  , nullptr, 1 << 30}; pg8::StaticOrder S; S.init(MTOK, 2048, F.G, (int)blockIdx.x);
        { const int t_ = tid_from_wave(F.wave); LAS float* cst = F.xl + XL_CONST;
          if (t_ < 256) cst[t_] = ARGF(7)[t_]; else if (t_ < 384) cst[t_] = ARGF(8)[t_ - 256]; else if (t_ < 448) cst[t_] = ARGF(13)[t_ - 384]; else cst[t_] = ARGF(14)[t_ - 448]; }
        EpiIn E{ws};
        pg8::gemm_phase(F.lds, F.xl, g, S, E, F.wave);
        if (BOTH(2)) GRID_BAR();
    }
    if (IN(3)) {
        pg8::Gemm g{(const bf16_t*)(ws + WS_QLN), (const bf16_t*)(ws + WS_WQUP), MTOK, 2048, 256, (const bf16_t*)(ws + WS_KVLN), 4}; pg8::StaticOrder S; S.init(MTOK, 2048, F.G, (int)blockIdx.x);
        EpiQKV E{EpiQ{ws, ARGF(11)}, EpiKV{ws, ARGF(12)}};
        pg8::gemm_phase(F.lds, F.xl, g, S, E, F.wave);
        if (BOTH(3)) GRID_BAR();
    }
    if (IN(4)) {
        unsigned char* OM = ws + WS_OM; float* REF = (float*)(ws + WS_REF); const float* PARTV = (const float*)(ws + WS_PARTV); unsigned* refcnt = (unsigned*)(ws + WS_CTL) + CW_REFCNT;
        int atid = tid_from_wave(F.wave); asm volatile("" : "+v"(atid)); atid &= 511;
        float S0_mla, S0_ca;
        { const int ln = atid & 63; float a = 0.f, c = 0.f, d = 0.f, e = 0.f;
          for (int i = ln; i < 96; i += 64) { a = fmaxf(a, fabsf(ARGF(11)[i])); c = fmaxf(c, fabsf(ARGF(12)[i])); }
          if (ln < 64) { d = fabsf(ARGF(13)[ln]); e = fabsf(ARGF(14)[ln]); }
          S0_mla = att::wave_max(a) * att::wave_max(c) * 9.797958971132712f * LOG2E * 1.13f; S0_ca = att::wave_max(d) * att::wave_max(e) * 8.0f * LOG2E * 1.13f; }
        if (F.G == 256) {
            const int bh = F.vcu >> 1, par = F.vcu & 1;
            const unsigned ul_mla = (unsigned)(2 * par) | ((unsigned)(7 - 2 * par) << 8) | ((unsigned)(2 * par + 1) << 16) | ((unsigned)(6 - 2 * par) << 24);
            const unsigned ul_ca = (unsigned)par | ((unsigned)(2 + par) << 8) | ((unsigned)(4 + par) << 16) | ((unsigned)(6 + par) << 24);
            att::attn_run<96, false>(atid, bh >> 3, bh & 7, ul_mla, 4, (const unsigned char*)(ws + WS_QM), (const unsigned char*)(ws + WS_KM), (const unsigned char*)(ws + WS_VM), OM, REF, refcnt, PARTV, nullptr, S0_mla, F.lds);
            att::attn_run<64, true>(atid, bh >> 3, bh & 7, ul_ca, 4, (const unsigned char*)(ws + WS_CQ), (const unsigned char*)(ws + WS_CK), (const unsigned char*)(ws + WS_CV), OM, REF, refcnt, PARTV, ARGF(15), S0_ca, F.lds);
            if (par == 0) { REFRESH_TID(); p4_bias(F, args, bh); }
        } else {
            for (int j = F.vcu; j < 2048; j += F.G) { const int kind = j >> 10, bh = (j & 1023) >> 3; const unsigned qb = (unsigned)(j & 7);
                if (kind == 0) att::attn_run<96, false>(atid, bh >> 3, bh & 7, qb, 1, (const unsigned char*)(ws + WS_QM), (const unsigned char*)(ws + WS_KM), (const unsigned char*)(ws + WS_VM), OM, REF, refcnt, PARTV, nullptr, S0_mla, F.lds);
                else att::attn_run<64, true>(atid, bh >> 3, bh & 7, qb, 1, (const unsigned char*)(ws + WS_CQ), (const unsigned char*)(ws + WS_CK), (const unsigned char*)(ws + WS_CV), OM, REF, refcnt, PARTV, ARGF(15), S0_ca, F.lds); }
        }
        if (BOTH(4)) GRID_BAR();
    }
    if (IN(5)) {
        pg8::Gemm g{(const bf16_t*)(ws + WS_OM), (const bf16_t*)(ws + WS_WOUT), MTOK, 1024, 512  , nullptr, 1 << 30}; pg8::StaticOrder S; S.init(MTOK, 1024, F.G, (int)blockIdx.x);
        if (F.G != 256) { REFRESH_TID(); p5_bias(F, args); }
        if (F.G == 256) { EpiResNorm E{ARGF(0), ws, MOD + 2 * DM, ARGF(17)}; pg8::gemm_phase(F.lds, F.xl, g, S, E, F.wave); }
        else { EpiRes<false, true, true> E{ARGF(0), (void*)(ws + WS_X1), MOD + 2 * DM, (const float*)(ws + WS_BIAS2)}; pg8::gemm_phase(F.lds, F.xl, g, S, E, F.wave); }
        if (BOTH(5)) GRID_BAR();
    }
    if (IN(6)) { if (F.G != 256) { REFRESH_TID(); norm_rows<true>(F, (const float*)(ws + WS_X1), ARGF(17), 3 * DM, 4 * DM, (bf16_t*)(ws + WS_H2)); if (BOTH(6)) GRID_BAR(); } }
    if (IN(7)) {
        pg8::Gemm g{(const bf16_t*)(ws + WS_H2), (const bf16_t*)(ws + WS_WUP), MTOK, DFF2, 1024, nullptr, 1 << 30}; pg8::StaticOrder S; S.init(MTOK, DFF2, F.G, (int)blockIdx.x);
        EpiUp E{ws, ARGF(19), ARGF(20)};
        pg8::gemm_phase(F.lds, F.xl, g, S, E, F.wave);
        if (BOTH(7)) GRID_BAR();
    }
    if (IN(8)) { REFRESH_TID(); conv_fixup(F, args); if (BOTH(8)) GRID_BAR(); }
    if (IN(9)) {
        pg8::Gemm g{(const bf16_t*)(ws + WS_ACT), (const bf16_t*)(ws + WS_WDOWN), MTOK, 1024, DFF, nullptr, 1 << 30}; pg8::StaticOrder S; S.init(MTOK, 1024, F.G, (int)blockIdx.x);
        if (STAG9 && (F.vcu & 1)) stagger_delay(STAG9);
        EpiRes<true, false> E{(const void*)(ws + WS_X1), (void*)args.out, MOD + 5 * DM};
        pg8::gemm_phase(F.lds, F.xl, g, S, E, F.wave);
    }
#undef IN
#undef BOTH
}

extern "C" void kernel_launch(void* const* d_in, const int* in_sizes, int n_in, void* d_out, int out_size, void* d_ws, size_t ws_size, hipStream_t stream) {
    static int grid = 0;
    if (grid == 0) {
        if (n_in != 22 || in_sizes[0] != MTOK * DM || out_size != MTOK * DM || ws_size < WS_END) {
            fprintf(stderr, "kernel_launch: unexpected shapes (n_in %d, in0 %d, out %d, ws %zu); nothing launched\n", n_in, n_in > 0 ? in_sizes[0] : -1, out_size, ws_size); grid = -1; return; }
        int dev = 0, cus = 0, per_cu = 0;
        if (hipGetDevice(&dev) != hipSuccess || hipDeviceGetAttribute(&cus, hipDeviceAttributeMultiprocessorCount, dev) != hipSuccess) { grid = -1; return; }
        if (hipFuncSetAttribute((const void*)fwd_kernel, hipFuncAttributeMaxDynamicSharedMemorySize, LDS_BYTES) != hipSuccess) { fprintf(stderr, "kernel_launch: hipFuncSetAttribute failed\n"); grid = -1; return; }
        if (hipOccupancyMaxActiveBlocksPerMultiprocessor(&per_cu, (const void*)fwd_kernel, NWAVES * 64, LDS_BYTES) != hipSuccess || per_cu < 1)
            fprintf(stderr, "kernel_launch: note: occupancy query reports %d workgroups per CU\n", per_cu);
        (void)hipGetLastError();
        grid = cus;
    }
    if (grid < 0) return;
    Args a{};
    for (int i = 0; i < 22; ++i) a.in[i] = d_in[i];
    a.out = (float*)d_out; a.ws = (unsigned char*)d_ws;
#ifndef PROBE_DUP
#define PROBE_DUP -1
#endif
    const int nl = (PROBE_DUP >= 0) ? 2 : N_LAUNCHES;
    for (int li = 0; li < nl; ++li) {
        if (hipMemsetAsync((char*)d_ws + WS_CTL, 0, CTL_ZERO_BYTES, stream) != hipSuccess) { fprintf(stderr, "kernel_launch: memset failed\n"); return; }
        a.ph_lo = (N_LAUNCHES == 1) ? 0 : li; a.ph_hi = (N_LAUNCHES == 1) ? NPHASE : li + 1; a.li = li;
        if (PROBE_DUP >= 0) { a.ph_lo = li == 0 ? 0 : PROBE_DUP; a.ph_hi = li == 0 ? PROBE_DUP + 1 : NPHASE; }
        hipLaunchKernelGGL(fwd_kernel, dim3(grid), dim3(NWAVES * 64), LDS_BYTES, stream, a);
        const hipError_t le = hipPeekAtLastError();
        if (le != hipSuccess) { fprintf(stderr, "kernel_launch: launch %d failed: %s\n", li, hipGetErrorName(le)); break; }
    }
}
```
